# Optimizing an MI355X kernel written in HIP

```python
import math
import jax, jax.numpy as jnp
from jax import lax
import numpy as np

D_MODEL = 1024
BATCH = 8
SEQ = 4096
DEPTH = 4

N_MIXERS = 2
N_HEADS = 8
QK_HEAD_DIM = 128
V_HEAD_DIM = 128
KV_RANK = 256
IDX_HEADS = 8
IDX_HEAD_DIM = 64
TOPK_MAX = 256
Q_BLOCK = 128
A_IN = N_HEADS * QK_HEAD_DIM + KV_RANK + IDX_HEADS * IDX_HEAD_DIM + IDX_HEAD_DIM + IDX_HEADS
GMLP_HALF = 2 * D_MODEL
GMLP_GROUPS = 8
GMLP_GROUP_DIM = GMLP_HALF // GMLP_GROUPS
CHUNK = 128
D_FF = -(-8 * D_MODEL // (3 * 256)) * 256
N_MOD = 6
EPS = 1e-6
N_A = (DEPTH + 1) // 2
N_B = DEPTH // 2

kernel_name = 'hybrid_dsa_gmlp_swiglu_adaln'


def rmsnorm(x, g):
    xf = x.astype(jnp.float32)
    y = xf * lax.rsqrt(jnp.mean(xf * xf, axis=-1, keepdims=True) + EPS)
    return (y * g.astype(jnp.float32)).astype(x.dtype)


def layernorm(x, g, b):
    xf = x.astype(jnp.float32)
    mu = jnp.mean(xf, axis=-1, keepdims=True)
    xc = xf - mu
    var = jnp.mean(xc * xc, axis=-1, keepdims=True)
    return (xc * lax.rsqrt(var + EPS) * g.astype(jnp.float32) + b.astype(jnp.float32)).astype(x.dtype)


def modulate(h, shift, scale):
    return h * (1 + scale[:, None, :]) + shift[:, None, :]


def dsa_mixer(h, w_in, g_kv, g_kidx, b_kidx, w_uk, w_uv, w_o):
    B, T, _ = h.shape
    proj = h @ w_in
    o1 = N_HEADS * QK_HEAD_DIM
    o2 = o1 + KV_RANK
    o3 = o2 + IDX_HEADS * IDX_HEAD_DIM
    o4 = o3 + IDX_HEAD_DIM
    q = proj[..., :o1].reshape(B, T, N_HEADS, QK_HEAD_DIM)
    c_kv = rmsnorm(proj[..., o1:o2], g_kv)
    q_idx = proj[..., o2:o3].reshape(B, T, IDX_HEADS, IDX_HEAD_DIM)
    k_idx = layernorm(proj[..., o3:o4], g_kidx, b_kidx)
    w_idx = proj[..., o4:] * (IDX_HEADS ** -0.5 * IDX_HEAD_DIM ** -0.5)
    q_lat = jnp.einsum('bthd,hdr->bthr', q, w_uk) * (QK_HEAD_DIM ** -0.5)
    top_k = min(TOPK_MAX, T // 4)
    nb = T // Q_BLOCK
    key_pos = jnp.arange(T)

    def to_blocks(a):
        return a.reshape(B, nb, Q_BLOCK, *a.shape[2:]).swapaxes(0, 1)

    def block(args):
        qi_b, wi_b, ql_b, start = args
        q_pos = start + jnp.arange(Q_BLOCK)
        causal = key_pos[None, :] <= q_pos[:, None]
        logits = jnp.einsum('bqhd,bsd->bqhs', qi_b, k_idx).astype(jnp.float32)
        score = jnp.einsum('bqhs,bqh->bqs', jax.nn.relu(logits), wi_b.astype(jnp.float32))
        score = jnp.where(causal[None], score, -jnp.inf)
        _, idx = lax.top_k(score, top_k)
        valid = idx <= q_pos[None, :, None]
        c_sel = jax.vmap(lambda cb, ib: cb[ib])(c_kv, idx)
        att = jnp.einsum('bqhr,bqkr->bqhk', ql_b, c_sel).astype(jnp.float32)
        att = jnp.where(valid[:, :, None, :], att, -jnp.inf)
        p = jax.nn.softmax(att, axis=-1).astype(c_sel.dtype)
        return jnp.einsum('bqhk,bqkr->bqhr', p, c_sel)

    starts = jnp.arange(nb, dtype=jnp.int32) * Q_BLOCK
    o_lat = lax.map(block, (to_blocks(q_idx), to_blocks(w_idx), to_blocks(q_lat), starts))
    o_lat = o_lat.swapaxes(0, 1).reshape(B, T, N_HEADS, KV_RANK)
    o = jnp.einsum('bthr,hrd->bthd', o_lat, w_uv).reshape(B, T, N_HEADS * V_HEAD_DIM)
    return o @ w_o


def gmlp_mixer(h, w_in, ln_g, ln_b, w_s, b_s, w_out):
    B, T, _ = h.shape
    z = jax.nn.gelu(h @ w_in, approximate=False)
    u = z[..., :GMLP_HALF]
    v = layernorm(z[..., GMLP_HALF:], ln_g, ln_b)
    nc = T // CHUNK
    v = v.reshape(B, nc, CHUNK, GMLP_GROUPS, GMLP_GROUP_DIM)
    w_causal = w_s * jnp.tril(jnp.ones((CHUNK, CHUNK), dtype=w_s.dtype))
    mixed = jnp.einsum('gts,bcsge->bctge', w_causal, v) + b_s.T[:, :, None]
    y = u * mixed.reshape(B, T, GMLP_HALF)
    return y @ w_out


def swiglu(h, w_gate, w_up, w_down):
    return (jax.nn.silu(h @ w_gate) * (h @ w_up)) @ w_down


def setup_inputs(seed: int = 0) -> dict:
    key = jax.random.key(seed)
    ks = jax.random.split(key, 24)
    f32 = jnp.float32
    nrm = lambda k, shape, s: jax.random.normal(k, shape, f32) * s
    D = D_MODEL
    return {
        'x': nrm(ks[0], (BATCH, SEQ, D), 1.0),
        'c': nrm(ks[1], (BATCH, D), 1.0),
        'mod_w': nrm(ks[2], (DEPTH, D, N_MOD * D), 0.5 * D ** -0.5),
        'mod_b': nrm(ks[3], (DEPTH, N_MOD * D), 0.02),
        'norm_mix_g': 1.0 + nrm(ks[4], (DEPTH, D), 0.02),
        'norm_ffn_g': 1.0 + nrm(ks[5], (DEPTH, D), 0.02),
        'a_w_in': nrm(ks[6], (N_A, D, A_IN), D ** -0.5),
        'a_g_kv': 1.0 + nrm(ks[7], (N_A, KV_RANK), 0.02),
        'a_g_kidx': 1.0 + nrm(ks[8], (N_A, IDX_HEAD_DIM), 0.02),
        'a_b_kidx': nrm(ks[9], (N_A, IDX_HEAD_DIM), 0.02),
        'a_w_uk': nrm(ks[10], (N_A, N_HEADS, QK_HEAD_DIM, KV_RANK), QK_HEAD_DIM ** -0.5),
        'a_w_uv': nrm(ks[11], (N_A, N_HEADS, KV_RANK, V_HEAD_DIM), KV_RANK ** -0.5),
        'a_w_o': nrm(ks[12], (N_A, N_HEADS * V_HEAD_DIM, D), (N_HEADS * V_HEAD_DIM) ** -0.5),
        'b_w_in': nrm(ks[13], (N_B, D, 2 * GMLP_HALF), D ** -0.5),
        'b_ln_g': 1.0 + nrm(ks[14], (N_B, GMLP_HALF), 0.02),
        'b_ln_b': nrm(ks[15], (N_B, GMLP_HALF), 0.02),
        'b_w_s': nrm(ks[16], (N_B, GMLP_GROUPS, CHUNK, CHUNK), 0.5 * CHUNK ** -0.5),
        'b_b_s': 1.0 + nrm(ks[17], (N_B, GMLP_GROUPS, CHUNK), 0.1),
        'b_w_out': nrm(ks[18], (N_B, GMLP_HALF, D), GMLP_HALF ** -0.5),
        'ffn_w_gate': nrm(ks[19], (DEPTH, D, D_FF), D ** -0.5),
        'ffn_w_up': nrm(ks[20], (DEPTH, D, D_FF), D ** -0.5),
        'ffn_w_down': nrm(ks[21], (DEPTH, D_FF, D), D_FF ** -0.5),
        'final_g': 1.0 + nrm(ks[22], (D,), 0.02),
    }


def reference(x, c, mod_w, mod_b, norm_mix_g, norm_ffn_g, a_w_in, a_g_kv, a_g_kidx, a_b_kidx,
              a_w_uk, a_w_uv, a_w_o, b_w_in, b_ln_g, b_ln_b, b_w_s, b_b_s, b_w_out,
              ffn_w_gate, ffn_w_up, ffn_w_down, final_g):
    c_act = jax.nn.silu(c)
    for layer in range(DEPTH):
        mod = c_act @ mod_w[layer] + mod_b[layer]
        sh1, sc1, g1, sh2, sc2, g2 = jnp.split(mod, N_MOD, axis=-1)
        h = modulate(rmsnorm(x, norm_mix_g[layer]), sh1, sc1)
        j = layer // N_MIXERS
        if layer % N_MIXERS == 0:
            y = dsa_mixer(h, a_w_in[j], a_g_kv[j], a_g_kidx[j], a_b_kidx[j],
                          a_w_uk[j], a_w_uv[j], a_w_o[j])
        else:
            y = gmlp_mixer(h, b_w_in[j], b_ln_g[j], b_ln_b[j], b_w_s[j], b_b_s[j], b_w_out[j])
        x = x + g1[:, None, :] * y
        h = modulate(rmsnorm(x, norm_ffn_g[layer]), sh2, sc2)
        x = x + g2[:, None, :] * swiglu(h, ffn_w_gate[layer], ffn_w_up[layer], ffn_w_down[layer])
    return rmsnorm(x, final_g)
```

```cpp
#include <hip/hip_runtime.h>
#include <hip/hip_cooperative_groups.h>
#include <cstdio>
#include <cstdint>
namespace cg = cooperative_groups;

#define LAS __attribute__((address_space(3)))
typedef unsigned short bf16_t;
typedef short bf16x8 __attribute__((ext_vector_type(8)));
typedef short s16x4 __attribute__((ext_vector_type(4)));
typedef float f32x4 __attribute__((ext_vector_type(4)));
typedef float f32x16 __attribute__((ext_vector_type(16)));
typedef float f32x2 __attribute__((ext_vector_type(2)));
typedef unsigned u32x4 __attribute__((ext_vector_type(4)));
typedef unsigned u32x2 __attribute__((ext_vector_type(2)));

constexpr int D = 1024, NB = 8, T = 4096, M = NB * T, DFF = 2816, NMOD = 6 * D;
constexpr float EPS = 1e-6f;
constexpr int AIN = 1864;
constexpr size_t MiB = 1u << 20;
constexpr size_t WS_MOD = 0;
constexpr size_t WS_MODP = 1 * MiB;
constexpr size_t WS_W = 13 * MiB;
constexpr size_t W_AIN = WS_W;
constexpr size_t W_UK = W_AIN + 8 * MiB;
constexpr size_t W_UV = W_UK + 2 * MiB;
constexpr size_t W_O = W_UV + 2 * MiB;
constexpr size_t W_BIN = W_O + 4 * MiB;
constexpr size_t W_BOUT = W_BIN + 16 * MiB;
constexpr size_t W_GU = W_BOUT + 8 * MiB;
constexpr size_t W_DN = W_GU + 44 * MiB;
constexpr size_t WS_R1 = W_DN + 22 * MiB;
constexpr size_t WS_H = WS_R1;
constexpr size_t WS_Q = WS_R1 + 64 * MiB;
constexpr size_t WS_OLAT = WS_R1;
constexpr size_t WS_R2 = WS_R1 + 128 * MiB;
constexpr size_t WS_QLAT = WS_R2;
constexpr size_t WS_O = WS_R2;
constexpr size_t WS_R3 = WS_R2 + 128 * MiB;
constexpr size_t WS_CKVR = WS_R3;
constexpr size_t WS_CKV = WS_CKVR + 32 * MiB;
constexpr size_t WS_QIDX = WS_CKV + 16 * MiB;
constexpr size_t WS_KRAW = WS_QIDX + 32 * MiB;
constexpr size_t WS_KIDX = WS_KRAW + 16 * MiB;
constexpr size_t WS_WIDX = WS_KIDX + 4 * MiB;
constexpr size_t WS_IDX = WS_WIDX + 1 * MiB;
constexpr size_t WS_END = WS_IDX + 16 * MiB;
constexpr size_t WS_HID = WS_R1 + 64 * MiB;
constexpr size_t WS_U = WS_R1 + 64 * MiB;
constexpr size_t WS_V = WS_U + 128 * MiB;
constexpr size_t WS_STATS = WS_V + 128 * MiB;
static_assert(WS_STATS + 8 * MiB <= WS_END && WS_HID + 176 * MiB <= WS_R3, "ws map");
constexpr int LDS_BYTES = 147456;

__device__ __forceinline__ unsigned cvt_pk_bf16(float lo, float hi) { unsigned r; asm volatile("v_cvt_pk_bf16_f32 %0, %1, %2" : "=v"(r) : "v"(lo), "v"(hi)); return r; }
__device__ __forceinline__ float bf2f(unsigned b) { return __uint_as_float(b << 16); }
__device__ __forceinline__ float bf_round(float f) { unsigned u = __float_as_uint(f); u = (u + 0x7fffu + ((u >> 16) & 1u)) & 0xffff0000u; return __uint_as_float(u); }
__device__ __forceinline__ float wave_sum(float v) {
#pragma unroll
    for (int o = 1; o < 64; o <<= 1) v += __shfl_xor(v, o);
    return v;
}
#define LDS_WAIT() asm volatile("s_waitcnt lgkmcnt(0)" ::: "memory")

namespace pg8 {
constexpr int BM = 256, BK = 64, HALF = 128, HTB = HALF * BK * 2, STAGE_BYTES = 8 * HTB, NXCD = 8, WGM = 8;
__host__ __device__ __forceinline__ int lds_byte(int r, int c) { const int st = (r >> 4) * 2 + (c >> 5), rr = r & 15, cc = c & 31, ob = rr * 64 + cc * 2; return st * 1024 + (ob ^ (((ob >> 9) & 1) << 5)); }
__host__ __device__ __forceinline__ void stage_rc(int b, int& R, int& C) { const int st = b / 1024, sb = b % 1024, swz = sb ^ (((sb >> 9) & 1) << 5); R = (st >> 1) * 16 + swz / 64; C = (st & 1) * 32 + (swz % 64) / 2; }
__host__ __device__ __forceinline__ int perm32(int rho) { const int n = rho >> 4, i = rho & 15; return 8 * (i >> 2) + 4 * n + (i & 3); }

struct Unit { int pm, pn; };
struct Gemm { const bf16_t* A; const bf16_t* Bt; int M, N, K, lda, agrp_shift, agrp_stride; };

struct StaticOrder {
    int nM, nN, nwg, G, c;
    __device__ void init(int M_, int N_, int G_, int c_) { nM = M_ / BM; nN = N_ / BM; nwg = nM * nN; G = G_; c = c_; }
    __device__ bool next(int i, Unit& u) const {
        const long L = (long)i * G + c; if (L >= nwg) return false;
        int wgid = (int)L; { const int q = nwg / NXCD, r = nwg % NXCD, xcd = wgid % NXCD, off = wgid / NXCD; wgid = (xcd < r ? xcd * (q + 1) : r * (q + 1) + (xcd - r) * q) + off; }
        const int nig = WGM * nN, gid = wgid / nig, fm = gid * WGM, gsz = (nM - fm) < WGM ? (nM - fm) : WGM;
        u.pm = fm + ((wgid % nig) % gsz); u.pn = (wgid % nig) / gsz; return true;
    }
};

typedef f32x4 Acc[2][2][4][2];

__device__ __forceinline__ f32x2 gelu_pk(f32x2 v) {
    const f32x2 av = __builtin_elementwise_abs(v), d = av * 0.2316418882f + 1.0f;
    f32x2 t; t.x = __builtin_amdgcn_rcpf(d.x); t.y = __builtin_amdgcn_rcpf(d.y);
    f32x2 q = t * 0.5307027145f + (-0.7265760135f); q = q * t + 0.7107068705f; q = q * t + (-0.142248368f); q = q * t + 0.127414796f; q = q * t;
    const f32x2 s = (v * v) * (-0.72134752044f);
    f32x2 e; e.x = __builtin_amdgcn_exp2f(s.x); e.y = __builtin_amdgcn_exp2f(s.y);
    const f32x2 m = v * (q * e), r = v - m;
    f32x2 o; o.x = v.x < 0.f ? m.x : r.x; o.y = v.y < 0.f ? m.y : r.y; return o;
}
__device__ __forceinline__ f32x4 gelu4(f32x4 v) { f32x2 a = gelu_pk((f32x2){v[0], v[1]}), b = gelu_pk((f32x2){v[2], v[3]}); return (f32x4){a.x, a.y, b.x, b.y}; }
__device__ __forceinline__ u32x4 pack8(f32x4 v0, f32x4 v1) { u32x4 w; w.x = cvt_pk_bf16(v0[0], v0[1]); w.y = cvt_pk_bf16(v0[2], v0[3]); w.z = cvt_pk_bf16(v1[0], v1[1]); w.w = cvt_pk_bf16(v1[2], v1[3]); return w; }

struct EpiInproj {
    bf16_t* Q; float* CKVR; bf16_t* QIDX; float* KRAW;
    __device__ __forceinline__ void operator()(const Acc& acc, const Unit& u, int wr, int wc, int fr, int fq) const {
        const int row0 = u.pm * BM + wr * 64 + fr, cl = wc * 32 + 8 * fq;
#pragma unroll
        for (int ai = 0; ai < 2; ++ai)
#pragma unroll
            for (int m = 0; m < 4; ++m) { const size_t row = (size_t)(row0 + ai * HALF + m * 16);
#pragma unroll
                for (int bj = 0; bj < 2; ++bj) { const f32x4 v0 = acc[ai][bj][m][0], v1 = acc[ai][bj][m][1]; const int c = bj * HALF + cl;
                    if (u.pn < 4) *(u32x4*)(Q + row * 1024 + u.pn * 256 + c) = pack8(v0, v1);
                    else if (u.pn == 4) { float* p = CKVR + row * 256 + c; *(f32x4*)p = v0; *(f32x4*)(p + 4) = v1; }
                    else if (u.pn < 7) *(u32x4*)(QIDX + row * 512 + (u.pn - 5) * 256 + c) = pack8(v0, v1);
                    else if (bj == 0) { float* p = KRAW + row * 128 + c; *(f32x4*)p = v0; *(f32x4*)(p + 4) = v1; } } }
    }
};
struct EpiBf16 {
    bf16_t* O; int ldc; float scale;
    __device__ __forceinline__ void operator()(const Acc& acc, const Unit& u, int wr, int wc, int fr, int fq) const {
        const int row0 = u.pm * BM + wr * 64 + fr, col0 = u.pn * BM + wc * 32 + 8 * fq;
#pragma unroll
        for (int ai = 0; ai < 2; ++ai)
#pragma unroll
            for (int m = 0; m < 4; ++m) { bf16_t* rowp = O + (size_t)(row0 + ai * HALF + m * 16) * ldc + col0;
#pragma unroll
                for (int bj = 0; bj < 2; ++bj) *(u32x4*)(rowp + bj * HALF) = pack8(acc[ai][bj][m][0] * scale, acc[ai][bj][m][1] * scale); }
    }
};
struct EpiResid {
    const float* xin; float* xout; const float* gate;
    __device__ __forceinline__ void operator()(const Acc& acc, const Unit& u, int wr, int wc, int fr, int fq) const {
        const int row0 = u.pm * BM + wr * 64 + fr, col0 = u.pn * BM + wc * 32 + 8 * fq;
        const float* gp = gate + (size_t)(u.pm >> 4) * NMOD + col0;
        f32x4 gv[2][2];
#pragma unroll
        for (int bj = 0; bj < 2; ++bj)
#pragma unroll
            for (int n = 0; n < 2; ++n) gv[bj][n] = *(const f32x4*)(gp + bj * HALF + 4 * n);
#pragma unroll
        for (int ai = 0; ai < 2; ++ai)
#pragma unroll
            for (int m = 0; m < 4; ++m) { const size_t off = (size_t)(row0 + ai * HALF + m * 16) * D + col0;
#pragma unroll
                for (int bj = 0; bj < 2; ++bj)
#pragma unroll
                    for (int n = 0; n < 2; ++n) { const f32x4 xo = *(const f32x4*)(xin + off + bj * HALF + 4 * n);
                        *(f32x4*)(xout + off + bj * HALF + 4 * n) = xo + gv[bj][n] * acc[ai][bj][m][n]; } }
    }
};
struct EpiGelu {
    bf16_t* U; bf16_t* V; f32x2* STATS;
    __device__ __forceinline__ void operator()(const Acc& acc, const Unit& u, int wr, int wc, int fr, int fq) const {
        const int row0 = u.pm * BM + wr * 64 + fr, cl = wc * 32 + 8 * fq;
        const bool isv = u.pn >= 8; bf16_t* base = isv ? V + (u.pn - 8) * 256 : U + u.pn * 256;
#pragma unroll
        for (int ai = 0; ai < 2; ++ai)
#pragma unroll
            for (int m = 0; m < 4; ++m) { const size_t row = (size_t)(row0 + ai * HALF + m * 16); float s = 0.f, ss = 0.f;
#pragma unroll
                for (int bj = 0; bj < 2; ++bj) { const f32x4 v0 = gelu4(acc[ai][bj][m][0]), v1 = gelu4(acc[ai][bj][m][1]);
                    *(u32x4*)(base + row * 2048 + bj * HALF + cl) = pack8(v0, v1);
                    s += (v0[0] + v0[1]) + (v0[2] + v0[3]) + (v1[0] + v1[1]) + (v1[2] + v1[3]);
                    ss += (v0[0] * v0[0] + v0[1] * v0[1]) + (v0[2] * v0[2] + v0[3] * v0[3]) + (v1[0] * v1[0] + v1[1] * v1[1]) + (v1[2] * v1[2] + v1[3] * v1[3]); }
                if (isv) { s += __shfl_xor(s, 16); ss += __shfl_xor(ss, 16); s += __shfl_xor(s, 32); ss += __shfl_xor(ss, 32);
                    if (fq == 0) STATS[row * 32 + (u.pn - 8) * 4 + wc] = (f32x2){s, ss}; } }
    }
};
struct EpiSwiglu {
    bf16_t* HID;
    __device__ __forceinline__ void operator()(const Acc& acc, const Unit& u, int wr, int wc, int fr, int fq) const {
        const int row0 = u.pm * BM + wr * 64 + fr, col0 = u.pn * 128 + wc * 32 + 8 * fq;
#pragma unroll
        for (int ai = 0; ai < 2; ++ai)
#pragma unroll
            for (int m = 0; m < 4; ++m) { f32x4 h[2];
#pragma unroll
                for (int n = 0; n < 2; ++n) { const f32x4 g = acc[ai][0][m][n], up = acc[ai][1][m][n];
#pragma unroll
                    for (int j = 0; j < 4; ++j) h[n][j] = g[j] * __builtin_amdgcn_rcpf(1.0f + __expf(-g[j])) * up[j]; }
                *(u32x4*)(HID + (size_t)(row0 + ai * HALF + m * 16) * DFF + col0) = pack8(h[0], h[1]); }
    }
};

template <class Epi>
__device__ __forceinline__ void gemm_phase(LAS unsigned char* lds, const Gemm g, const StaticOrder& S, const Epi& E) {
    int tid = threadIdx.x; asm volatile("" : "+v"(tid));
    const int wid = __builtin_amdgcn_readfirstlane(tid >> 6), lane = tid & 63, wr = wid >> 2, wc = wid & 3, fr = lane & 15, fq = lane >> 4;
    const int K = g.K, nt = K / BK, lda = g.lda;
    unsigned voffA[2], voffB[2];
#pragma unroll
    for (int i = 0; i < 2; ++i) { int R, C; stage_rc(tid * 16 + i * 8192, R, C); const int Rb = (R & ~31) + perm32(R & 31);
        voffA[i] = (unsigned)(R * lda + C) * 2u; voffB[i] = (unsigned)(Rb * K + C) * 2u; }
    const size_t kstep = (size_t)(BK * 2);
    const size_t hstepA = (size_t)HALF * lda * 2, hstepB = (size_t)HALF * K * 2;
    const unsigned ldsw = (unsigned)wid * 1024u;
    const int aoff = lds_byte(wr * 64 + fr, fq * 8), boff = lds_byte(wc * 32 + fr, fq * 8);
#define PG8_SA(b, h) (((b) * 2 + (h)) * HTB)
#define PG8_SB(b, h) ((4 + (b) * 2 + (h)) * HTB)
#define PG8_STAGE(bufoff, gbase, voff) do { _Pragma("unroll") for (int _i = 0; _i < 2; ++_i) \
        __builtin_amdgcn_global_load_lds((const unsigned*)((const char*)(gbase) + (voff)[_i]), (LAS unsigned*)(lds + (bufoff) + ldsw + _i * 8192), 16, 0, 0); } while (0)
#define PG8_LDA(dst, b, h) do { _Pragma("unroll") for (int m = 0; m < 4; ++m) _Pragma("unroll") for (int k = 0; k < 2; ++k) dst[m][k] = *(const LAS bf16x8*)(lds + PG8_SA(b, h) + aoff + m * 2048 + k * 1024); } while (0)
#define PG8_LDB(dst, b, h) do { _Pragma("unroll") for (int n = 0; n < 2; ++n) _Pragma("unroll") for (int k = 0; k < 2; ++k) dst[n][k] = *(const LAS bf16x8*)(lds + PG8_SB(b, h) + boff + n * 2048 + k * 1024); } while (0)
#define PG8_MMA(ai, bj, At, Bt) do { __builtin_amdgcn_s_setprio(1); _Pragma("unroll") for (int m = 0; m < 4; ++m) _Pragma("unroll") for (int n = 0; n < 2; ++n) _Pragma("unroll") for (int k = 0; k < 2; ++k) \
        acc[ai][bj][m][n] = __builtin_amdgcn_mfma_f32_16x16x32_bf16(Bt[n][k], At[m][k], acc[ai][bj][m][n], 0, 0, 0); __builtin_amdgcn_s_setprio(0); } while (0)
#define PG8_WAIT_V(n) asm volatile("s_waitcnt vmcnt(" #n ")" ::: "memory")
#define PG8_WAIT_L(n) asm volatile("s_waitcnt lgkmcnt(" #n ")" ::: "memory")
#define PG8_BAR __builtin_amdgcn_s_barrier()
#define PG8_SCHED __builtin_amdgcn_sched_barrier(0)
#define PG8_ABASE(u) ((const char*)g.A + ((size_t)(u).pm * BM * lda + (size_t)((u).pn >> g.agrp_shift) * g.agrp_stride) * 2)
#define PG8_BBASE(u) ((const char*)g.Bt + (size_t)(u).pn * 2 * hstepB)
    Unit cur, nxt; int ui = 0;
    if (!S.next(0, cur)) return;
    Acc acc;
#pragma unroll
    for (int a = 0; a < 2; ++a)
#pragma unroll
        for (int b = 0; b < 2; ++b)
#pragma unroll
            for (int m = 0; m < 4; ++m)
#pragma unroll
                for (int n = 0; n < 2; ++n) acc[a][b][m][n] = (f32x4){0.f, 0.f, 0.f, 0.f};
    bf16x8 At[4][2], B0[2][2], B1[2][2];
    const char* cA = PG8_ABASE(cur); const char* cB = PG8_BBASE(cur);
    PG8_STAGE(PG8_SB(0, 0), cB, voffB); PG8_STAGE(PG8_SB(0, 1), cB + hstepB, voffB); PG8_STAGE(PG8_SA(0, 0), cA, voffA); PG8_STAGE(PG8_SA(0, 1), cA + hstepA, voffA);
    if (wr == 1) PG8_BAR;
    PG8_WAIT_V(2); PG8_BAR;
    PG8_STAGE(PG8_SB(1, 0), cB + kstep, voffB); PG8_STAGE(PG8_SA(1, 0), cA + kstep, voffA); PG8_STAGE(PG8_SB(1, 1), cB + hstepB + kstep, voffB);
    PG8_WAIT_V(6); PG8_BAR;
    for (;;) {
        const bool has_next = S.next(ui + 1, nxt);
        const char* nA = has_next ? PG8_ABASE(nxt) : cA; const char* nB = has_next ? PG8_BBASE(nxt) : cB;
        for (int t = 0; t < nt; t += 2) {
            const bool last = (t == nt - 2);
            const char* a1 = cA + (size_t)(t + 1) * kstep;
            const char* a2 = last ? nA : cA + (size_t)(t + 2) * kstep; const char* b2 = last ? nB : cB + (size_t)(t + 2) * kstep;
            const char* a3 = a2 + kstep; const char* b3 = b2 + kstep;
            PG8_LDB(B0, 0, 0); PG8_LDB(B1, 0, 1); PG8_SCHED; PG8_LDA(At, 0, 0); PG8_STAGE(PG8_SA(1, 1), a1 + hstepA, voffA);
            PG8_WAIT_V(8); PG8_WAIT_L(0); PG8_BAR; PG8_MMA(0, 0, At, B0); PG8_MMA(0, 1, At, B1); PG8_BAR; PG8_SCHED;
            PG8_LDA(At, 0, 1); PG8_STAGE(PG8_SB(0, 0), b2, voffB); PG8_STAGE(PG8_SB(0, 1), b2 + hstepB, voffB); PG8_STAGE(PG8_SA(0, 0), a2, voffA);
            PG8_WAIT_V(8); PG8_WAIT_L(0); PG8_BAR; PG8_MMA(1, 0, At, B0); PG8_MMA(1, 1, At, B1); PG8_BAR; PG8_SCHED;
            PG8_LDB(B0, 1, 0); PG8_LDB(B1, 1, 1); PG8_SCHED; PG8_LDA(At, 1, 0); PG8_STAGE(PG8_SA(0, 1), a2 + hstepA, voffA);
            PG8_WAIT_V(8); PG8_WAIT_L(0); PG8_BAR; PG8_MMA(0, 0, At, B0); PG8_MMA(0, 1, At, B1); PG8_BAR; PG8_SCHED;
            PG8_LDA(At, 1, 1); PG8_STAGE(PG8_SB(1, 0), b3, voffB); PG8_STAGE(PG8_SB(1, 1), b3 + hstepB, voffB); PG8_STAGE(PG8_SA(1, 0), a3, voffA);
            PG8_WAIT_V(8); PG8_WAIT_L(0); PG8_BAR; PG8_MMA(1, 0, At, B0); PG8_MMA(1, 1, At, B1); PG8_BAR; PG8_SCHED;
        }
        if (wr == 0) PG8_BAR;
        E(acc, cur, wr, wc, fr, fq);
        if (!has_next) break;
#pragma unroll
        for (int a = 0; a < 2; ++a)
#pragma unroll
            for (int b = 0; b < 2; ++b)
#pragma unroll
                for (int m = 0; m < 4; ++m)
#pragma unroll
                    for (int n = 0; n < 2; ++n) acc[a][b][m][n] = (f32x4){0.f, 0.f, 0.f, 0.f};
        cur = nxt; cA = nA; cB = nB; ++ui;
        if (wr == 1) PG8_BAR;
    }
    PG8_WAIT_V(0);
    PG8_BAR;
#undef PG8_SA
#undef PG8_SB
#undef PG8_STAGE
#undef PG8_LDA
#undef PG8_LDB
#undef PG8_MMA
#undef PG8_WAIT_V
#undef PG8_WAIT_L
#undef PG8_BAR
#undef PG8_SCHED
#undef PG8_ABASE
#undef PG8_BBASE
}
}

struct Args { const float* in[23]; float* out; unsigned char* ws; int ph_lo, ph_hi; };

__device__ __forceinline__ void cvt_item(const float* src, int K, int N, bf16_t* dst, int ldd, int mode, int r0, int c0, LAS float* scr, int li, int lane) {
    const int nblk = (N + 31) >> 5, kb = li / nblk, nb = li % nblk, k0 = 64 * kb, n0 = 32 * nb;
    { const int n = n0 + (lane & 31);
#pragma unroll 8
      for (int i = 0; i < 32; ++i) { const int kk = 2 * i + (lane >> 5); scr[kk * 33 + (lane & 31)] = (n < N) ? src[(size_t)(k0 + kk) * N + n] : 0.f; } }
    LDS_WAIT();
    const int c = lane & 7;
#pragma unroll
    for (int j = 0; j < 4; ++j) { const int nl = (lane >> 3) + 8 * j, n = n0 + nl; const LAS float* s = scr + (8 * c) * 33 + nl;
        u32x4 o; o.x = cvt_pk_bf16(s[0 * 33], s[1 * 33]); o.y = cvt_pk_bf16(s[2 * 33], s[3 * 33]); o.z = cvt_pk_bf16(s[4 * 33], s[5 * 33]); o.w = cvt_pk_bf16(s[6 * 33], s[7 * 33]);
        if (n < N) { const int drow = mode ? ((n >> 7) * 256 + (n & 127) + r0) : (r0 + n); *(u32x4*)(dst + (size_t)drow * ldd + c0 + k0 + 8 * c) = o; } }
    LDS_WAIT();
}

__device__ __forceinline__ void p0_phase(const Args& a, LAS unsigned char* lds, int bid, int G) {
    int tid = threadIdx.x; asm volatile("" : "+v"(tid));
    const int lane = tid & 63, wave = __builtin_amdgcn_readfirstlane(tid >> 6);
    unsigned char* ws = a.ws;
    LAS float* scr = (LAS float*)(lds + wave * 8704);
    const int gw = bid * 8 + wave, NGW = G * 8;
    constexpr int NITEMS = 1888 + 256 + 256 + 1024 + 4096 + 2048 + 11264 + 5632;
    for (int it = gw; it < NITEMS; it += NGW) {
        int r = it;
        if (r < 1888) { const int j = r / 944; cvt_item(a.in[6] + (size_t)j * 1024 * AIN, 1024, AIN, (bf16_t*)(ws + W_AIN) + (size_t)j * 2048 * 1024, 1024, 0, 0, 0, scr, r % 944, lane); continue; } r -= 1888;
        if (r < 256) { const int jj = r >> 4, la = jj >> 3, h = jj & 7; cvt_item(a.in[10] + (size_t)(la * 8 + h) * 128 * 256, 128, 256, (bf16_t*)(ws + W_UK) + (size_t)la * 2048 * 256, 256, 0, h * 256, (h & 1) * 128, scr, r & 15, lane); continue; } r -= 256;
        if (r < 256) { const int jj = r >> 4, la = jj >> 3, h = jj & 7; cvt_item(a.in[11] + (size_t)(la * 8 + h) * 256 * 128, 256, 128, (bf16_t*)(ws + W_UV) + (size_t)la * 1024 * 512, 512, 0, (h >> 1) * 256 + (h & 1) * 128, (h & 1) * 256, scr, r & 15, lane); continue; } r -= 256;
        if (r < 1024) { const int la = r >> 9; cvt_item(a.in[12] + (size_t)la * 1024 * 1024, 1024, 1024, (bf16_t*)(ws + W_O) + (size_t)la * 1024 * 1024, 1024, 0, 0, 0, scr, r & 511, lane); continue; } r -= 1024;
        if (r < 4096) { const int la = r >> 11; cvt_item(a.in[13] + (size_t)la * 1024 * 4096, 1024, 4096, (bf16_t*)(ws + W_BIN) + (size_t)la * 4096 * 1024, 1024, 0, 0, 0, scr, r & 2047, lane); continue; } r -= 4096;
        if (r < 2048) { const int la = r >> 10; cvt_item(a.in[18] + (size_t)la * 2048 * 1024, 2048, 1024, (bf16_t*)(ws + W_BOUT) + (size_t)la * 1024 * 2048, 2048, 0, 0, 0, scr, r & 1023, lane); continue; } r -= 2048;
        if (r < 11264) { const int jj = r / 1408, l = jj & 3, isup = jj >> 2; cvt_item(a.in[isup ? 20 : 19] + (size_t)l * 1024 * DFF, 1024, DFF, (bf16_t*)(ws + W_GU) + (size_t)l * 5632 * 1024, 1024, 1, isup * 128, 0, scr, r % 1408, lane); continue; } r -= 11264;
        { const int l = r / 1408; cvt_item(a.in[21] + (size_t)l * DFF * 1024, DFF, 1024, (bf16_t*)(ws + W_DN) + (size_t)l * 1024 * DFF, DFF, 0, 0, 0, scr, r % 1408, lane); }
    }
    const size_t gt = (size_t)bid * 512 + tid, NT = (size_t)G * 512;
    const u32x4 z = (u32x4){0u, 0u, 0u, 0u};
    for (size_t i = gt; i < 2 * 184 * 128; i += NT) { const int j = (int)(i / (184 * 128)), rem = (int)(i % (184 * 128)), rr = AIN + rem / 128, ch = rem % 128;
        *(u32x4*)((bf16_t*)(ws + W_AIN) + ((size_t)j * 2048 + rr) * 1024 + ch * 8) = z; }
    for (size_t i = gt; i < 2 * 2048 * 16; i += NT) { const int j = (int)(i / (2048 * 16)), rem = (int)(i % (2048 * 16)), rr = rem >> 4, ch = rem & 15, h = rr >> 8;
        *(u32x4*)((bf16_t*)(ws + W_UK) + ((size_t)j * 2048 + rr) * 256 + (1 - (h & 1)) * 128 + ch * 8) = z; }
    for (size_t i = gt; i < 2 * 1024 * 32; i += NT) { const int j = (int)(i / (1024 * 32)), rem = (int)(i % (1024 * 32)), rr = rem >> 5, ch = rem & 31, hh = (rr >> 7) & 1;
        *(u32x4*)((bf16_t*)(ws + W_UV) + ((size_t)j * 1024 + rr) * 512 + (1 - hh) * 256 + ch * 8) = z; }
    __syncthreads();
    LAS float* ca = (LAS float*)lds;
    const float* cvec = a.in[1]; const float* modw = a.in[2]; float* MODP = (float*)(ws + WS_MODP);
    for (int it = bid; it < 768; it += G) {
        const int l = it / 192, rem = it % 192, ng = rem >> 4, kc = rem & 15;
        { const int b = tid >> 6, k = tid & 63; const float cv = cvec[b * 1024 + kc * 64 + k]; ca[b * 64 + k] = cv / (1.0f + __expf(-cv)); }
        __syncthreads();
        const int n = ng * 512 + tid; float acc[8];
#pragma unroll
        for (int b = 0; b < 8; ++b) acc[b] = 0.f;
        const float* wp = modw + ((size_t)l * 1024 + kc * 64) * NMOD + n;
#pragma unroll 8
        for (int k = 0; k < 64; ++k) { const float w = wp[(size_t)k * NMOD];
#pragma unroll
            for (int b = 0; b < 8; ++b) acc[b] += ca[b * 64 + k] * w; }
#pragma unroll
        for (int b = 0; b < 8; ++b) MODP[((size_t)(kc * 4 + l) * 8 + b) * NMOD + n] = acc[b];
        __syncthreads();
    }
}
__device__ __forceinline__ void p0c_phase(const Args& a, int bid, int G) {
    const float* MODP = (const float*)(a.ws + WS_MODP); float* MOD = (float*)(a.ws + WS_MOD); const float* modb = a.in[3];
    int tid0 = threadIdx.x; asm volatile("" : "+v"(tid0));
    for (int i = bid * 512 + tid0; i < 4 * 8 * NMOD; i += G * 512) { const int l = i / (8 * NMOD), n = i % NMOD; float s = modb[l * NMOD + n];
#pragma unroll
        for (int kc = 0; kc < 16; ++kc) s += MODP[(size_t)kc * (4 * 8 * NMOD) + i];
        MOD[i] = s; }
}

__device__ __forceinline__ void norm_mod_phase(const float* x, const float* gain, const float* sh, const float* sc, bf16_t* H, int bid, int G) {
    int tid = threadIdx.x; asm volatile("" : "+v"(tid));
    const int lane = tid & 63, wave = tid >> 6;
    for (int rb = (bid * 8 + wave) * 16; rb < M; rb += G * 8 * 16) {
        const int b = rb / T; f32x4 gs[4], sv[4];
#pragma unroll
        for (int j = 0; j < 4; ++j) { const int c = 4 * lane + 256 * j; const f32x4 g4 = *(const f32x4*)(gain + c), s4 = *(const f32x4*)(sc + (size_t)b * NMOD + c); gs[j] = g4 * (s4 + 1.0f); sv[j] = *(const f32x4*)(sh + (size_t)b * NMOD + c); }
        for (int r = rb; r < rb + 16; ++r) {
            const f32x4* xr = (const f32x4*)(x + (size_t)r * D) + lane; f32x4 v[4]; float ss = 0.f;
#pragma unroll
            for (int j = 0; j < 4; ++j) { v[j] = xr[64 * j]; ss += (v[j][0] * v[j][0] + v[j][1] * v[j][1]) + (v[j][2] * v[j][2] + v[j][3] * v[j][3]); }
            const float rstd = rsqrtf(wave_sum(ss) * (1.0f / D) + EPS);
            u32x2* o = (u32x2*)(H + (size_t)r * D) + lane;
#pragma unroll
            for (int j = 0; j < 4; ++j) { const f32x4 y = v[j] * rstd * gs[j] + sv[j]; u32x2 w; w.x = cvt_pk_bf16(y[0], y[1]); w.y = cvt_pk_bf16(y[2], y[3]); o[64 * j] = w; }
        }
    }
}
__device__ __forceinline__ void final_norm_phase(const float* x, const float* gain, float* out, int bid, int G) {
    int tid = threadIdx.x; asm volatile("" : "+v"(tid));
    const int lane = tid & 63, wave = tid >> 6;
    f32x4 gs[4];
#pragma unroll
    for (int j = 0; j < 4; ++j) gs[j] = *(const f32x4*)(gain + 4 * lane + 256 * j);
    for (int r = bid * 8 + wave; r < M; r += G * 8) {
        const f32x4* xr = (const f32x4*)(x + (size_t)r * D) + lane; f32x4 v[4]; float ss = 0.f;
#pragma unroll
        for (int j = 0; j < 4; ++j) { v[j] = xr[64 * j]; ss += (v[j][0] * v[j][0] + v[j][1] * v[j][1]) + (v[j][2] * v[j][2] + v[j][3] * v[j][3]); }
        const float rstd = rsqrtf(wave_sum(ss) * (1.0f / D) + EPS);
        f32x4* o = (f32x4*)(out + (size_t)r * D) + lane;
#pragma unroll
        for (int j = 0; j < 4; ++j) o[64 * j] = v[j] * rstd * gs[j];
    }
}
__device__ __forceinline__ void dsa_rows_phase(const float* CKVR, const float* KRAW, const float* gkv, const float* gk, const float* bk, bf16_t* CKV, bf16_t* KIDX, float* WIDX, int bid, int G) {
    int tid = threadIdx.x; asm volatile("" : "+v"(tid));
    const int lane = tid & 63, wave = tid >> 6;
    const f32x4 g4 = *(const f32x4*)(gkv + 4 * lane);
    f32x4 gk4 = (f32x4){0.f, 0.f, 0.f, 0.f}, bk4 = gk4;
    if (lane < 16) { gk4 = *(const f32x4*)(gk + 4 * lane); bk4 = *(const f32x4*)(bk + 4 * lane); }
    for (int r = bid * 8 + wave; r < M; r += G * 8) {
        const f32x4 v = *(const f32x4*)(CKVR + (size_t)r * 256 + 4 * lane);
        f32x4 kv = (f32x4){0.f, 0.f, 0.f, 0.f}; if (lane < 32) kv = *(const f32x4*)(KRAW + (size_t)r * 128 + 4 * lane);
        const float ss = wave_sum((v[0] * v[0] + v[1] * v[1]) + (v[2] * v[2] + v[3] * v[3]));
        const float rstd = rsqrtf(ss * (1.0f / 256.0f) + EPS);
        { const f32x4 y = v * rstd * g4; u32x2 w; w.x = cvt_pk_bf16(y[0], y[1]); w.y = cvt_pk_bf16(y[2], y[3]); *(u32x2*)(CKV + (size_t)r * 256 + 4 * lane) = w; }
        const float ks = (lane < 16) ? (kv[0] + kv[1]) + (kv[2] + kv[3]) : 0.f;
        const float mean = wave_sum(ks) * (1.0f / 64.0f);
        const f32x4 dv = kv - mean;
        const float kq = (lane < 16) ? (dv[0] * dv[0] + dv[1] * dv[1]) + (dv[2] * dv[2] + dv[3] * dv[3]) : 0.f;
        const float krstd = rsqrtf(wave_sum(kq) * (1.0f / 64.0f) + EPS);
        if (lane < 16) { const f32x4 y = dv * krstd * gk4 + bk4; u32x2 w; w.x = cvt_pk_bf16(y[0], y[1]); w.y = cvt_pk_bf16(y[2], y[3]); *(u32x2*)(KIDX + (size_t)r * 64 + 4 * lane) = w; }
        else if (lane < 18) { *(f32x4*)(WIDX + (size_t)r * 8 + 4 * (lane - 16)) = kv * 0.04419417382f; }
    }
}

__device__ __forceinline__ unsigned long long idx_comp(float v, float lo, float scale, int s) {
    const unsigned key = (unsigned)((v - lo) * scale);
    return ((unsigned long long)key << 12) | (unsigned)(4095 - s);
}
__device__ __forceinline__ void indexer_phase(LAS unsigned char* lds, const bf16_t* QIDX, const bf16_t* KIDX, const float* WIDX, unsigned short* IDX, int bid, int G) {
    int tid = threadIdx.x; asm volatile("" : "+v"(tid));
    const int lane = tid & 63, wave = __builtin_amdgcn_readfirstlane(tid >> 6);
    LAS float* SC = (LAS float*)lds;
    LAS unsigned* HIST = (LAS unsigned*)(lds + 131072) + wave * 256;
    const int hf = lane >> 5, col = lane & 31;
    for (int it = bid; it < 4096; it += G) {
        const int b = it & 7, qb = it >> 3, t0 = qb * 8; const size_t mb = (size_t)b * T;
        const int t = t0 + wave, N = t + 1;
        unsigned short* out = IDX + (mb + t) * 256;
        if (t0 + 8 <= 256) { for (int j = lane; j < N; j += 64) out[j] = (unsigned short)j; continue; }
        bf16x8 af[2][4]; float w[2][4][4];
#pragma unroll
        for (int rg = 0; rg < 2; ++rg) {
            const bf16_t* qp = QIDX + (mb + t0 + 4 * rg + (col >> 3)) * 512 + (col & 7) * 64 + 8 * hf;
#pragma unroll
            for (int ks = 0; ks < 4; ++ks) af[rg][ks] = *(const bf16x8*)(qp + 16 * ks);
#pragma unroll
            for (int qq = 0; qq < 4; ++qq) { const f32x4 wv = *(const f32x4*)(WIDX + (mb + t0 + 4 * rg + qq) * 8 + 4 * hf);
                w[rg][qq][0] = wv[0]; w[rg][qq][1] = wv[1]; w[rg][qq][2] = wv[2]; w[rg][qq][3] = wv[3]; }
        }
        const int ntile = (t0 + 8 + 31) >> 5;
        for (int kt = wave; kt < ntile; kt += 8) {
            const int s = 32 * kt + col; bf16x8 bfr[4];
            const bf16_t* kp = KIDX + (mb + s) * 64 + 8 * hf;
#pragma unroll
            for (int ks = 0; ks < 4; ++ks) bfr[ks] = *(const bf16x8*)(kp + 16 * ks);
#pragma unroll
            for (int rg = 0; rg < 2; ++rg) {
                f32x16 acc;
#pragma unroll
                for (int i = 0; i < 16; ++i) acc[i] = 0.f;
#pragma unroll
                for (int ks = 0; ks < 4; ++ks) acc = __builtin_amdgcn_mfma_f32_32x32x16_bf16(af[rg][ks], bfr[ks], acc, 0, 0, 0);
#pragma unroll
                for (int qq = 0; qq < 4; ++qq) {
                    float p = 0.f;
#pragma unroll
                    for (int ii = 0; ii < 4; ++ii) p += fmaxf(acc[4 * qq + ii], 0.f) * w[rg][qq][ii];
                    const float tot = p + __shfl_xor(p, 32);
                    if ((qq >> 1) == hf) SC[(4 * rg + qq) * 4096 + s] = tot;
                }
            }
        }
        __syncthreads();
        const LAS float* sc = SC + wave * 4096;
        float lo = 3.0e38f, hi = -3.0e38f;
        for (int s = lane; s < N; s += 64) { const float v = sc[s]; lo = fminf(lo, v); hi = fmaxf(hi, v); }
#pragma unroll
        for (int o = 1; o < 64; o <<= 1) { lo = fminf(lo, __shfl_xor(lo, o)); hi = fmaxf(hi, __shfl_xor(hi, o)); }
        const float scale = 4.0e9f / fmaxf(hi - lo, 1e-30f);
        unsigned long long prefix = 0ull; unsigned need = 256u;
#pragma unroll 1
        for (int p = 0; p < 6; ++p) {
            const int shift = (p == 5) ? 0 : 36 - 8 * p, width = (p == 5) ? 4 : 8; const unsigned dmask = (1u << width) - 1u;
            for (int i = lane; i < 256; i += 64) HIST[i] = 0u;
            __syncthreads();
            for (int s = lane; s < N; s += 64) { const unsigned long long c = idx_comp(sc[s], lo, scale, s);
                if ((c >> (shift + width)) == prefix) __hip_atomic_fetch_add(HIST + ((unsigned)(c >> shift) & dmask), 1u, __ATOMIC_RELAXED, __HIP_MEMORY_SCOPE_WORKGROUP); }
            __syncthreads();
            unsigned hb[4];
#pragma unroll
            for (int j = 0; j < 4; ++j) hb[j] = HIST[4 * lane + j];
            const unsigned ls = hb[0] + hb[1] + hb[2] + hb[3];
            unsigned incl = ls;
#pragma unroll
            for (int o = 1; o < 64; o <<= 1) { const unsigned v = __shfl_down(incl, o); if (lane + o < 64) incl += v; }
            unsigned cnt = incl - ls; bool found = false; unsigned dsel = 0u, nn = 0u;
#pragma unroll
            for (int j = 3; j >= 0; --j) { if (!found && cnt < need && need <= cnt + hb[j]) { found = true; dsel = 4u * lane + j; nn = need - cnt; } cnt += hb[j]; }
            const unsigned long long fm = __ballot(found);
            const int src = (fm != 0ull) ? (__ffsll((long long)fm) - 1) : 0;
            dsel = __shfl(dsel, src); need = __shfl(nn, src);
            prefix = (prefix << width) | dsel;
            __syncthreads();
        }
        int base = 0;
        for (int s0 = 0; s0 < N; s0 += 64) { const int s = s0 + lane; const bool sel = (s < N) && (idx_comp(sc[s < N ? s : 0], lo, scale, s) >= prefix);
            const unsigned long long mk = __ballot(sel); const int pos = base + __popcll(mk & ((1ull << lane) - 1ull));
            if (sel && pos < 256) out[pos] = (unsigned short)s; base += __popcll(mk); }
        __syncthreads();
    }
}

__device__ __forceinline__ void attn_phase(LAS unsigned char* lds, const bf16_t* QLAT, const bf16_t* CKV, const unsigned short* IDX, bf16_t* OLAT, int bid, int G) {
    int tid = threadIdx.x; asm volatile("" : "+v"(tid));
    const int lane = tid & 63, wave = __builtin_amdgcn_readfirstlane(tid >> 6);
    const int g = lane >> 4, c16 = lane & 15, hd = c16 & 7, q4 = c16 >> 2, p4 = c16 & 3;
    LAS unsigned char* tile = lds + wave * 16896;
    constexpr float L2E = 1.4426950408889634f;
    for (int it = bid; it < 4096; it += G) {
        const int b = it & 7, t = (it >> 3) * 8 + wave; const size_t m = (size_t)b * T + t; const int cnt = (t + 1 < 256) ? t + 1 : 256;
        bf16x8 qf[8];
        { const bf16_t* qp = QLAT + m * 2048 + hd * 256 + 8 * g;
#pragma unroll
          for (int ks = 0; ks < 8; ++ks) qf[ks] = *(const bf16x8*)(qp + 32 * ks); }
        f32x4 o[16];
#pragma unroll
        for (int nt = 0; nt < 16; ++nt) o[nt] = (f32x4){0.f, 0.f, 0.f, 0.f};
        float mrun = -INFINITY, lrun = 0.f;
        const unsigned short* ip = IDX + m * 256;
#pragma unroll 1
        for (int ch = 0; ch < 8; ++ch) {
            const int j0 = 32 * ch + c16, j1 = j0 + 16;
            const int k0 = (j0 < cnt) ? (int)ip[j0] : 0, k1 = (j1 < cnt) ? (int)ip[j1] : 0;
            const bf16_t* r0 = CKV + ((size_t)b * T + k0) * 256 + 8 * g; const bf16_t* r1 = CKV + ((size_t)b * T + k1) * 256 + 8 * g;
            bf16x8 a0[8], a1[8];
#pragma unroll
            for (int ks = 0; ks < 8; ++ks) { a0[ks] = *(const bf16x8*)(r0 + 32 * ks); a1[ks] = *(const bf16x8*)(r1 + 32 * ks); }
            f32x4 s0 = (f32x4){0.f, 0.f, 0.f, 0.f}, s1 = s0;
#pragma unroll
            for (int ks = 0; ks < 8; ++ks) { s0 = __builtin_amdgcn_mfma_f32_16x16x32_bf16(a0[ks], qf[ks], s0, 0, 0, 0); s1 = __builtin_amdgcn_mfma_f32_16x16x32_bf16(a1[ks], qf[ks], s1, 0, 0, 0); }
#pragma unroll
            for (int ks = 0; ks < 8; ++ks) { *(LAS bf16x8*)(tile + c16 * 528 + (32 * ks + 8 * g) * 2) = a0[ks]; *(LAS bf16x8*)(tile + (16 + c16) * 528 + (32 * ks + 8 * g) * 2) = a1[ks]; }
            float cm = -INFINITY;
#pragma unroll
            for (int i = 0; i < 4; ++i) { if (32 * ch + 4 * g + i >= cnt) s0[i] = -INFINITY; if (32 * ch + 16 + 4 * g + i >= cnt) s1[i] = -INFINITY; cm = fmaxf(cm, fmaxf(s0[i], s1[i])); }
            cm = fmaxf(cm, __shfl_xor(cm, 16)); cm = fmaxf(cm, __shfl_xor(cm, 32));
            const float mnew = fmaxf(mrun, cm), alpha = __builtin_amdgcn_exp2f((mrun - mnew) * L2E);
            float p0[4], p1[4], ps = 0.f;
#pragma unroll
            for (int i = 0; i < 4; ++i) { p0[i] = __builtin_amdgcn_exp2f((s0[i] - mnew) * L2E); p1[i] = __builtin_amdgcn_exp2f((s1[i] - mnew) * L2E); ps += p0[i] + p1[i]; }
            lrun = lrun * alpha + ps; mrun = mnew;
#pragma unroll
            for (int nt = 0; nt < 16; ++nt) o[nt] = o[nt] * alpha;
            u32x4 pw; pw.x = cvt_pk_bf16(p0[0], p0[1]); pw.y = cvt_pk_bf16(p0[2], p0[3]); pw.z = cvt_pk_bf16(p1[0], p1[1]); pw.w = cvt_pk_bf16(p1[2], p1[3]);
            const bf16x8 pb = __builtin_bit_cast(bf16x8, pw);
            LDS_WAIT();
#pragma unroll
            for (int nt = 0; nt < 16; ++nt) {
                const s16x4 t0v = __builtin_amdgcn_ds_read_tr16_b64_v4i16((LAS s16x4*)(tile + (4 * g + q4) * 528 + (16 * nt + 4 * p4) * 2));
                const s16x4 t1v = __builtin_amdgcn_ds_read_tr16_b64_v4i16((LAS s16x4*)(tile + (16 + 4 * g + q4) * 528 + (16 * nt + 4 * p4) * 2));
                const bf16x8 cf = __builtin_shufflevector(t0v, t1v, 0, 1, 2, 3, 4, 5, 6, 7);
                o[nt] = __builtin_amdgcn_mfma_f32_16x16x32_bf16(cf, pb, o[nt], 0, 0, 0);
            }
            LDS_WAIT();
        }
        float lt = lrun + __shfl_xor(lrun, 16); lt += __shfl_xor(lt, 32);
        const float inv = 1.0f / lt;
        if (c16 < 8) { bf16_t* op = OLAT + m * 2048 + c16 * 256 + 4 * g;
#pragma unroll
            for (int nt = 0; nt < 16; ++nt) { const f32x4 y = o[nt] * inv; u32x2 wv; wv.x = cvt_pk_bf16(y[0], y[1]); wv.y = cvt_pk_bf16(y[2], y[3]); *(u32x2*)(op + 16 * nt) = wv; } }
    }
}

__device__ __forceinline__ void smix_phase(LAS unsigned char* lds, bf16_t* UY, const bf16_t* V, const f32x2* STATS, const float* Wc, const float* bsp, const float* lng, const float* lnb, int bid, int G) {
    int tid = threadIdx.x; asm volatile("" : "+v"(tid));
    const int lane = tid & 63, wave = __builtin_amdgcn_readfirstlane(tid >> 6);
    const int gq = lane >> 4, c16 = lane & 15, q4 = c16 >> 2, p4 = c16 & 3;
    LAS unsigned char* VT = lds;
    LAS unsigned char* AP = lds + 67584;
    LAS float* MU = (LAS float*)(lds + 102400); LAS float* RSTD = MU + 128; LAS float* R1 = MU + 256; LAS float* R2 = MU + 384;
    for (int it = bid; it < 2048; it += G) {
        const int gi = it & 7, rem = it >> 3, b = rem >> 5, ck = rem & 31; const size_t m0 = (size_t)b * T + ck * 128;
        if (tid < 128) { const f32x2* sp = STATS + (m0 + tid) * 32; float s = 0.f, ss = 0.f;
#pragma unroll 8
            for (int p = 0; p < 32; ++p) { const f32x2 v = sp[p]; s += v.x; ss += v.y; }
            const float mu = s * (1.0f / 2048.0f), var = ss * (1.0f / 2048.0f) - mu * mu; MU[tid] = mu; RSTD[tid] = rsqrtf(fmaxf(var, 0.f) + EPS); }
#pragma unroll
        for (int i = 0; i < 8; ++i) { const int cidx = tid + 512 * i, s = cidx >> 5, ch = cidx & 31;
            *(LAS u32x4*)(VT + s * 528 + ch * 16) = *(const u32x4*)(V + (m0 + s) * 2048 + gi * 256 + ch * 8); }
        __syncthreads();
        { const int t = tid >> 2, qd = tid & 3; const float* wp = Wc + ((size_t)gi * 128 + t) * 128 + 32 * qd; float r1 = 0.f, r2 = 0.f;
#pragma unroll
          for (int s8 = 0; s8 < 4; ++s8) { const f32x4 wa = *(const f32x4*)(wp + 8 * s8), wb = *(const f32x4*)(wp + 8 * s8 + 4); float av[8];
#pragma unroll
              for (int e = 0; e < 8; ++e) { const int s = 32 * qd + 8 * s8 + e; const float wv = (s <= t) ? (e < 4 ? wa[e] : wb[e - 4]) : 0.f; const float ab = bf_round(wv * RSTD[s]); av[e] = ab; r1 += ab * MU[s]; r2 += wv; }
              u32x4 o; o.x = cvt_pk_bf16(av[0], av[1]); o.y = cvt_pk_bf16(av[2], av[3]); o.z = cvt_pk_bf16(av[4], av[5]); o.w = cvt_pk_bf16(av[6], av[7]);
              *(LAS u32x4*)(AP + t * 272 + (32 * qd + 8 * s8) * 2) = o; }
          r1 += __shfl_xor(r1, 1); r2 += __shfl_xor(r2, 1); r1 += __shfl_xor(r1, 2); r2 += __shfl_xor(r2, 2);
          if (qd == 0) { R1[t] = r1; R2[t] = r2; } }
        __syncthreads();
        f32x4 acc[8][2];
#pragma unroll
        for (int mt = 0; mt < 8; ++mt) { acc[mt][0] = (f32x4){0.f, 0.f, 0.f, 0.f}; acc[mt][1] = acc[mt][0]; }
#pragma unroll
        for (int ks = 0; ks < 4; ++ks) {
            bf16x8 vf[2];
#pragma unroll
            for (int n2 = 0; n2 < 2; ++n2) { const int nt = 2 * wave + n2;
                const s16x4 t0v = __builtin_amdgcn_ds_read_tr16_b64_v4i16((LAS s16x4*)(VT + (32 * ks + 8 * gq + q4) * 528 + (16 * nt + 4 * p4) * 2));
                const s16x4 t1v = __builtin_amdgcn_ds_read_tr16_b64_v4i16((LAS s16x4*)(VT + (32 * ks + 8 * gq + 4 + q4) * 528 + (16 * nt + 4 * p4) * 2));
                vf[n2] = __builtin_shufflevector(t0v, t1v, 0, 1, 2, 3, 4, 5, 6, 7); }
#pragma unroll
            for (int mt = 0; mt < 8; ++mt) if (mt >= 2 * ks) {
                const bf16x8 afr = *(const LAS bf16x8*)(AP + (16 * mt + c16) * 272 + (32 * ks + 8 * gq) * 2);
                acc[mt][0] = __builtin_amdgcn_mfma_f32_16x16x32_bf16(vf[0], afr, acc[mt][0], 0, 0, 0);
                acc[mt][1] = __builtin_amdgcn_mfma_f32_16x16x32_bf16(vf[1], afr, acc[mt][1], 0, 0, 0); }
        }
#pragma unroll
        for (int n2 = 0; n2 < 2; ++n2) { const int e0 = 16 * (2 * wave + n2) + 4 * gq; const f32x4 lg4 = *(const f32x4*)(lng + gi * 256 + e0), lb4 = *(const f32x4*)(lnb + gi * 256 + e0);
#pragma unroll
            for (int mt = 0; mt < 8; ++mt) { const int t = 16 * mt + c16; const float r1 = R1[t], r2 = R2[t], bsv = bsp[gi * 128 + t];
                bf16_t* up = UY + (m0 + t) * 2048 + gi * 256 + e0; const u32x2 uw = *(const u32x2*)up;
                const f32x4 mixed = lg4 * (acc[mt][n2] - r1) + lb4 * r2 + bsv;
                const float y0 = bf2f(uw.x & 0xffffu) * mixed[0], y1 = bf2f(uw.x >> 16) * mixed[1], y2 = bf2f(uw.y & 0xffffu) * mixed[2], y3 = bf2f(uw.y >> 16) * mixed[3];
                u32x2 yw; yw.x = cvt_pk_bf16(y0, y1); yw.y = cvt_pk_bf16(y2, y3); *(u32x2*)up = yw; } }
        __syncthreads();
    }
}

__global__ void __launch_bounds__(512, 2) mk_fwd(Args a) {
    extern __shared__ __attribute__((aligned(16))) unsigned char lds_raw[];
    LAS unsigned char* lds = (LAS unsigned char*)lds_raw;
    cg::grid_group grid = cg::this_grid();
    const int bid = blockIdx.x, G = gridDim.x;
    unsigned char* ws = a.ws;
    float* MOD = (float*)(ws + WS_MOD);
    bf16_t* H = (bf16_t*)(ws + WS_H);
    float* X = a.out;
    int ph = 0;
#define PHASE_BEGIN if (ph >= a.ph_lo && ph < a.ph_hi) {
#define PHASE_END(dosync) if ((dosync) && ph + 1 < a.ph_hi) grid.sync(); } ++ph;

    PHASE_BEGIN p0_phase(a, lds, bid, G); PHASE_END(true)
    PHASE_BEGIN p0c_phase(a, bid, G); PHASE_END(true)

#pragma unroll 1
    for (int layer = 0; layer < 4; ++layer) {
        const int j = layer >> 1; const float* xin = (layer == 0) ? a.in[0] : X;
        const float* modl = MOD + (size_t)layer * 8 * NMOD;
        PHASE_BEGIN norm_mod_phase(xin, a.in[4] + layer * D, modl + 0 * D, modl + 1 * D, H, bid, G); PHASE_END(true)
        if ((layer & 1) == 0) {
            bf16_t* Q = (bf16_t*)(ws + WS_Q); float* CKVR = (float*)(ws + WS_CKVR); bf16_t* QIDX = (bf16_t*)(ws + WS_QIDX); float* KRAW = (float*)(ws + WS_KRAW);
            bf16_t* CKV = (bf16_t*)(ws + WS_CKV); bf16_t* KIDX = (bf16_t*)(ws + WS_KIDX); float* WIDX = (float*)(ws + WS_WIDX); unsigned short* IDX = (unsigned short*)(ws + WS_IDX);
            bf16_t* QLAT = (bf16_t*)(ws + WS_QLAT); bf16_t* OLAT = (bf16_t*)(ws + WS_OLAT); bf16_t* O = (bf16_t*)(ws + WS_O);
            PHASE_BEGIN { pg8::Gemm g{H, (const bf16_t*)(ws + W_AIN) + (size_t)j * 2048 * 1024, M, 2048, 1024, 1024, 0, 0}; pg8::StaticOrder S; S.init(M, 2048, G, bid);
                pg8::EpiInproj E{Q, CKVR, QIDX, KRAW}; pg8::gemm_phase(lds, g, S, E); } PHASE_END(true)
            PHASE_BEGIN { dsa_rows_phase(CKVR, KRAW, a.in[7] + j * 256, a.in[8] + j * 64, a.in[9] + j * 64, CKV, KIDX, WIDX, bid, G);
                __syncthreads();
                pg8::Gemm g{Q, (const bf16_t*)(ws + W_UK) + (size_t)j * 2048 * 256, M, 2048, 256, 1024, 1, 256}; pg8::StaticOrder S; S.init(M, 2048, G, bid);
                pg8::EpiBf16 E{QLAT, 2048, 0.08838834764831845f}; pg8::gemm_phase(lds, g, S, E); } PHASE_END(true)
            PHASE_BEGIN indexer_phase(lds, QIDX, KIDX, WIDX, IDX, bid, G); PHASE_END(true)
            PHASE_BEGIN attn_phase(lds, QLAT, CKV, IDX, OLAT, bid, G); PHASE_END(true)
            PHASE_BEGIN { pg8::Gemm g{OLAT, (const bf16_t*)(ws + W_UV) + (size_t)j * 1024 * 512, M, 1024, 512, 2048, 0, 512}; pg8::StaticOrder S; S.init(M, 1024, G, bid);
                pg8::EpiBf16 E{O, 1024, 1.0f}; pg8::gemm_phase(lds, g, S, E); } PHASE_END(true)
            PHASE_BEGIN { pg8::Gemm g{O, (const bf16_t*)(ws + W_O) + (size_t)j * 1024 * 1024, M, 1024, 1024, 1024, 0, 0}; pg8::StaticOrder S; S.init(M, 1024, G, bid);
                pg8::EpiResid E{xin, X, modl + 2 * D}; pg8::gemm_phase(lds, g, S, E); } PHASE_END(true)
        } else {
            bf16_t* U = (bf16_t*)(ws + WS_U); bf16_t* V = (bf16_t*)(ws + WS_V); f32x2* STATS = (f32x2*)(ws + WS_STATS);
            PHASE_BEGIN { pg8::Gemm g{H, (const bf16_t*)(ws + W_BIN) + (size_t)j * 4096 * 1024, M, 4096, 1024, 1024, 0, 0}; pg8::StaticOrder S; S.init(M, 4096, G, bid);
                pg8::EpiGelu E{U, V, STATS}; pg8::gemm_phase(lds, g, S, E); } PHASE_END(true)
            PHASE_BEGIN smix_phase(lds, U, V, STATS, a.in[16] + (size_t)j * 8 * 128 * 128, a.in[17] + (size_t)j * 8 * 128, a.in[14] + (size_t)j * 2048, a.in[15] + (size_t)j * 2048, bid, G); PHASE_END(true)
            PHASE_BEGIN { pg8::Gemm g{U, (const bf16_t*)(ws + W_BOUT) + (size_t)j * 1024 * 2048, M, 1024, 2048, 2048, 0, 0}; pg8::StaticOrder S; S.init(M, 1024, G, bid);
                pg8::EpiResid E{xin, X, modl + 2 * D}; pg8::gemm_phase(lds, g, S, E); } PHASE_END(true)
        }
        PHASE_BEGIN norm_mod_phase(X, a.in[5] + layer * D, modl + 3 * D, modl + 4 * D, H, bid, G); PHASE_END(true)
        PHASE_BEGIN { pg8::Gemm g{H, (const bf16_t*)(ws + W_GU) + (size_t)layer * 5632 * 1024, M, 5632, 1024, 1024, 0, 0}; pg8::StaticOrder S; S.init(M, 5632, G, bid);
            pg8::EpiSwiglu E{(bf16_t*)(ws + WS_HID)}; pg8::gemm_phase(lds, g, S, E); } PHASE_END(true)
        PHASE_BEGIN { pg8::Gemm g{(const bf16_t*)(ws + WS_HID), (const bf16_t*)(ws + W_DN) + (size_t)layer * 1024 * DFF, M, 1024, DFF, DFF, 0, 0}; pg8::StaticOrder S; S.init(M, 1024, G, bid);
            pg8::EpiResid E{X, X, modl + 5 * D}; pg8::gemm_phase(lds, g, S, E); } PHASE_END(true)
    }
    PHASE_BEGIN final_norm_phase(X, a.in[22], a.out, bid, G); PHASE_END(false)
}

extern "C" void kernel_launch(void* const* d_in, const int* in_sizes, int n_in, void* d_out, int out_size, void* d_ws, size_t ws_size, hipStream_t stream) {
    static int grid_blocks = 0;
    if (grid_blocks == 0) {
        int dev = 0, cus = 0, per_cu = 0;
        if (n_in != 23 || out_size != M * D || ws_size < WS_END) { fprintf(stderr, "kernel_launch: unexpected problem (n_in %d out %d ws %zu, need ws >= %zu)\n", n_in, out_size, ws_size, (size_t)WS_END); grid_blocks = -1; return; }
        (void)hipGetDevice(&dev);
        (void)hipDeviceGetAttribute(&cus, hipDeviceAttributeMultiprocessorCount, dev);
        (void)hipFuncSetAttribute((const void*)mk_fwd, hipFuncAttributeMaxDynamicSharedMemorySize, LDS_BYTES);
        (void)hipOccupancyMaxActiveBlocksPerMultiprocessor(&per_cu, (const void*)mk_fwd, 512, LDS_BYTES);
        fprintf(stderr, "kernel_launch: cus %d per_cu %d ws %zu\n", cus, per_cu, ws_size);
        if (per_cu < 1) { fprintf(stderr, "kernel_launch: kernel does not fit a CU\n"); grid_blocks = -1; return; }
        grid_blocks = cus;
    }
    if (grid_blocks < 0) return;
    Args a{};
    for (int i = 0; i < 23; ++i) a.in[i] = (const float*)d_in[i];
    a.out = (float*)d_out; a.ws = (unsigned char*)d_ws; a.ph_lo = 0; a.ph_hi = 1000;
    void* args[] = {&a};
    hipError_t e = hipLaunchCooperativeKernel((const void*)mk_fwd, dim3(grid_blocks), dim3(512), args, LDS_BYTES, stream);
    if (e != hipSuccess) fprintf(stderr, "cooperative launch failed: %s (grid %d)\n", hipGetErrorString(e), grid_blocks);
}
```

```cpp
#include <hip/hip_runtime.h>
#include <hip/hip_cooperative_groups.h>
#include <cstdio>
#include <cstdint>
namespace cg = cooperative_groups;

#define LAS __attribute__((address_space(3)))
typedef unsigned short bf16_t;
typedef short bf16x8 __attribute__((ext_vector_type(8)));
typedef short s16x4 __attribute__((ext_vector_type(4)));
typedef float f32x4 __attribute__((ext_vector_type(4)));
typedef float f32x16 __attribute__((ext_vector_type(16)));
typedef float f32x2 __attribute__((ext_vector_type(2)));
typedef unsigned u32x4 __attribute__((ext_vector_type(4)));
typedef unsigned u32x2 __attribute__((ext_vector_type(2)));

constexpr int D = 1024, NB = 8, T = 4096, M = NB * T, DFF = 2816, NMOD = 6 * D;
constexpr float EPS = 1e-6f;
constexpr int AIN = 1864;
constexpr size_t MiB = 1u << 20;
constexpr size_t WS_MOD = 0;
constexpr size_t WS_MODP = 1 * MiB;
constexpr size_t WS_W = 13 * MiB;
constexpr size_t W_AIN = WS_W;
constexpr size_t W_UK = W_AIN + 8 * MiB;
constexpr size_t W_UV = W_UK + 2 * MiB;
constexpr size_t W_O = W_UV + 2 * MiB;
constexpr size_t W_BIN = W_O + 4 * MiB;
constexpr size_t W_BOUT = W_BIN + 16 * MiB;
constexpr size_t W_GU = W_BOUT + 8 * MiB;
constexpr size_t W_DN = W_GU + 44 * MiB;
constexpr size_t WS_R1 = W_DN + 22 * MiB;
constexpr size_t WS_H = WS_R1;
constexpr size_t WS_Q = WS_R1 + 64 * MiB;
constexpr size_t WS_OLAT = WS_R1;
constexpr size_t WS_R2 = WS_R1 + 128 * MiB;
constexpr size_t WS_QLAT = WS_R2;
constexpr size_t WS_O = WS_R2;
constexpr size_t WS_R3 = WS_R2 + 128 * MiB;
constexpr size_t WS_CKVR = WS_R3;
constexpr size_t WS_CKV = WS_CKVR + 32 * MiB;
constexpr size_t WS_QIDX = WS_CKV + 16 * MiB;
constexpr size_t WS_KRAW = WS_QIDX + 32 * MiB;
constexpr size_t WS_KIDX = WS_KRAW + 16 * MiB;
constexpr size_t WS_WIDX = WS_KIDX + 4 * MiB;
constexpr size_t WS_IDX = WS_WIDX + 1 * MiB;
constexpr size_t WS_END = WS_IDX + 16 * MiB;
constexpr size_t WS_HID = WS_R1 + 64 * MiB;
constexpr size_t WS_U = WS_R1 + 64 * MiB;
constexpr size_t WS_V = WS_U + 128 * MiB;
constexpr size_t WS_STATS = WS_V + 128 * MiB;
static_assert(WS_STATS + 8 * MiB <= WS_END && WS_HID + 176 * MiB <= WS_R3, "ws map");
constexpr int LDS_BYTES = 147456;
constexpr int LDS_MISC = LDS_BYTES - 256;
constexpr size_t WS_BAR = 1 * MiB - 16384;

__device__ __forceinline__ unsigned cvt_pk_bf16(float lo, float hi) { unsigned r; asm volatile("v_cvt_pk_bf16_f32 %0, %1, %2" : "=v"(r) : "v"(lo), "v"(hi)); return r; }
__device__ __forceinline__ float bf2f(unsigned b) { return __uint_as_float(b << 16); }
__device__ __forceinline__ float bf_round(float f) { unsigned u = __float_as_uint(f); u = (u + 0x7fffu + ((u >> 16) & 1u)) & 0xffff0000u; return __uint_as_float(u); }
__device__ __forceinline__ float wave_sum(float v) {
#pragma unroll
    for (int o = 1; o < 64; o <<= 1) v += __shfl_xor(v, o);
    return v;
}
#define LDS_WAIT() asm volatile("s_waitcnt lgkmcnt(0)" ::: "memory")


#define XB_TMO      128
#define XB_XCNT(j)  (256  + 64 * (j))
#define XB_XSUB(j)  (1280 + 64 * (j))
#define XB_XGEN(j)  (2304 + 64 * (j))
#define XB_TOP      3328
#define XB_TOPGEN   3392
#define XCD_BAR_WORDS 3456
#define XB_SPIN_CAP (1u << 22)
__device__ __forceinline__ unsigned xb_ld(unsigned* p)              { return __hip_atomic_load(p, __ATOMIC_RELAXED, __HIP_MEMORY_SCOPE_AGENT); }
__device__ __forceinline__ unsigned xb_add(unsigned* p, unsigned v) { return __hip_atomic_fetch_add(p, v, __ATOMIC_RELAXED, __HIP_MEMORY_SCOPE_AGENT); }
__device__ __forceinline__ unsigned xb_xcc_id() { return (unsigned)__builtin_amdgcn_s_getreg((3 << 11) | 20) & 0xFu; }
#define XB_SPIN(cond, bar) do { unsigned _sp = 0; while (cond) { __builtin_amdgcn_s_sleep(1); \
    if ((++_sp & 255u) == 0u) { if (xb_ld(&(bar)[XB_TMO])) break; if (_sp > XB_SPIN_CAP) { atomicAdd(&(bar)[XB_TMO], 1u); break; } } } } while (0)
struct XcdBarrier { unsigned* bar; unsigned x; volatile LAS unsigned* st; };
__device__ __forceinline__ XcdBarrier xcd_barrier_post(unsigned* bar, volatile LAS unsigned* st) {
    XcdBarrier b; b.bar = bar; b.x = xb_xcc_id(); b.st = st;
    if (threadIdx.x == 0) (void)xb_add(&bar[XB_XCNT(b.x)], 1u);
    return b;
}
__device__ __forceinline__ void xcd_barrier_complete(unsigned* bar, unsigned x, unsigned& nloc, unsigned& nx) {
    const unsigned G = gridDim.x * gridDim.y * gridDim.z;
    unsigned sum, cnt, mine, sp = 0u;
    for (;;) {
        sum = 0u; cnt = 0u; mine = 0u;
#pragma unroll
        for (unsigned j = 0; j < 16; ++j) { const unsigned c = xb_ld(&bar[XB_XCNT(j)]); sum += c; cnt += (c > 0u) ? 1u : 0u; mine = (j == x) ? c : mine; }
        if (sum == G) break;
        __builtin_amdgcn_s_sleep(1);
        if ((++sp & 255u) == 0u) { if (xb_ld(&bar[XB_TMO])) break; if (sp > XB_SPIN_CAP) { atomicAdd(&bar[XB_TMO], 1u); break; } }
    }
    nloc = mine > 0u ? mine : 1u; nx = cnt > 0u ? cnt : 1u;
}
__device__ __forceinline__ void xcd_barrier(const XcdBarrier& b) {
    asm volatile("s_waitcnt vmcnt(0)" ::: "memory");
    __syncthreads();
    if (threadIdx.x == 0) {
        unsigned* bar = b.bar;
        __builtin_amdgcn_s_waitcnt(0);
        unsigned nloc = b.st[0], nx = b.st[1];
        if (nloc == 0u) { xcd_barrier_complete(bar, b.x, nloc, nx); b.st[0] = nloc; b.st[1] = nx; }
        const unsigned old = xb_add(&bar[XB_XSUB(b.x)], 1u);
        const unsigned gen = old / nloc;
        if (old + 1u == (gen + 1u) * nloc) {
            __builtin_amdgcn_fence(__ATOMIC_RELEASE, "agent");
            asm volatile("s_waitcnt vmcnt(0)" ::: "memory");
            const unsigned og = xb_add(&bar[XB_TOP], 1u);
            const unsigned tg = og / nx;
            if (og + 1u == (tg + 1u) * nx) xb_add(&bar[XB_TOPGEN], 1u);
            else XB_SPIN(xb_ld(&bar[XB_TOPGEN]) == tg, bar);
            __builtin_amdgcn_fence(__ATOMIC_ACQUIRE, "agent");
            xb_add(&bar[XB_XGEN(b.x)], 1u);
            asm volatile("s_waitcnt vmcnt(0)" ::: "memory");
        } else {
            XB_SPIN(xb_ld(&bar[XB_XGEN(b.x)]) == gen, bar);
            __builtin_amdgcn_fence(__ATOMIC_ACQUIRE, "agent");
            asm volatile("s_waitcnt vmcnt(0)" ::: "memory");
        }
    }
    __syncthreads();
}

namespace pg8 {
constexpr int BM = 256, BK = 64, HALF = 128, HTB = HALF * BK * 2, STAGE_BYTES = 8 * HTB, NXCD = 8, WGM = 8;
__host__ __device__ __forceinline__ int lds_byte(int r, int c) { const int st = (r >> 4) * 2 + (c >> 5), rr = r & 15, cc = c & 31, ob = rr * 64 + cc * 2; return st * 1024 + (ob ^ (((ob >> 9) & 1) << 5)); }
__host__ __device__ __forceinline__ void stage_rc(int b, int& R, int& C) { const int st = b / 1024, sb = b % 1024, swz = sb ^ (((sb >> 9) & 1) << 5); R = (st >> 1) * 16 + swz / 64; C = (st & 1) * 32 + (swz % 64) / 2; }
__host__ __device__ __forceinline__ int perm32(int rho) { const int n = rho >> 4, i = rho & 15; return 8 * (i >> 2) + 4 * n + (i & 3); }

struct Unit { int pm, pn; };
struct Gemm { const bf16_t* A; const bf16_t* Bt; int M, N, K, lda, agrp_shift, agrp_stride; };

struct StaticOrder {
    int nM, nN, nwg, G, c;
    __device__ void init(int M_, int N_, int G_, int c_) { nM = M_ / BM; nN = N_ / BM; nwg = nM * nN; G = G_; c = c_; }
    __device__ bool next(int i, Unit& u) const {
        const long L = (long)i * G + c; if (L >= nwg) return false;
        int wgid = (int)L; { const int q = nwg / NXCD, r = nwg % NXCD, xcd = wgid % NXCD, off = wgid / NXCD; wgid = (xcd < r ? xcd * (q + 1) : r * (q + 1) + (xcd - r) * q) + off; }
        const int nig = WGM * nN, gid = wgid / nig, fm = gid * WGM, gsz = (nM - fm) < WGM ? (nM - fm) : WGM;
        u.pm = fm + ((wgid % nig) % gsz); u.pn = (wgid % nig) / gsz; return true;
    }
};

typedef f32x4 Acc[2][2][4][2];

__device__ __forceinline__ f32x2 gelu_pk(f32x2 v) {
    const f32x2 av = __builtin_elementwise_abs(v), d = av * 0.2316418882f + 1.0f;
    f32x2 t; t.x = __builtin_amdgcn_rcpf(d.x); t.y = __builtin_amdgcn_rcpf(d.y);
    f32x2 q = t * 0.5307027145f + (-0.7265760135f); q = q * t + 0.7107068705f; q = q * t + (-0.142248368f); q = q * t + 0.127414796f; q = q * t;
    const f32x2 s = (v * v) * (-0.72134752044f);
    f32x2 e; e.x = __builtin_amdgcn_exp2f(s.x); e.y = __builtin_amdgcn_exp2f(s.y);
    const f32x2 m = v * (q * e), r = v - m;
    f32x2 o; o.x = v.x < 0.f ? m.x : r.x; o.y = v.y < 0.f ? m.y : r.y; return o;
}
__device__ __forceinline__ f32x4 gelu4(f32x4 v) { f32x2 a = gelu_pk((f32x2){v[0], v[1]}), b = gelu_pk((f32x2){v[2], v[3]}); return (f32x4){a.x, a.y, b.x, b.y}; }
__device__ __forceinline__ u32x4 pack8(f32x4 v0, f32x4 v1) { u32x4 w; w.x = cvt_pk_bf16(v0[0], v0[1]); w.y = cvt_pk_bf16(v0[2], v0[3]); w.z = cvt_pk_bf16(v1[0], v1[1]); w.w = cvt_pk_bf16(v1[2], v1[3]); return w; }

struct EpiInproj {
    bf16_t* Q; float* CKVR; bf16_t* QIDX; float* KRAW;
    __device__ __forceinline__ void operator()(const Acc& acc, const Unit& u, int wr, int wc, int fr, int fq) const {
        const int row0 = u.pm * BM + wr * 64 + fr, cl = wc * 32 + 8 * fq;
#pragma unroll
        for (int ai = 0; ai < 2; ++ai)
#pragma unroll
            for (int m = 0; m < 4; ++m) { const size_t row = (size_t)(row0 + ai * HALF + m * 16);
#pragma unroll
                for (int bj = 0; bj < 2; ++bj) { const f32x4 v0 = acc[ai][bj][m][0], v1 = acc[ai][bj][m][1]; const int c = bj * HALF + cl;
                    if (u.pn < 4) *(u32x4*)(Q + row * 1024 + u.pn * 256 + c) = pack8(v0, v1);
                    else if (u.pn == 4) { float* p = CKVR + row * 256 + c; *(f32x4*)p = v0; *(f32x4*)(p + 4) = v1; }
                    else if (u.pn < 7) *(u32x4*)(QIDX + row * 512 + (u.pn - 5) * 256 + c) = pack8(v0, v1);
                    else if (bj == 0) { float* p = KRAW + row * 128 + c; *(f32x4*)p = v0; *(f32x4*)(p + 4) = v1; } } }
    }
};
struct EpiBf16 {
    bf16_t* O; int ldc; float scale;
    __device__ __forceinline__ void operator()(const Acc& acc, const Unit& u, int wr, int wc, int fr, int fq) const {
        const int row0 = u.pm * BM + wr * 64 + fr, col0 = u.pn * BM + wc * 32 + 8 * fq;
#pragma unroll
        for (int ai = 0; ai < 2; ++ai)
#pragma unroll
            for (int m = 0; m < 4; ++m) { bf16_t* rowp = O + (size_t)(row0 + ai * HALF + m * 16) * ldc + col0;
#pragma unroll
                for (int bj = 0; bj < 2; ++bj) *(u32x4*)(rowp + bj * HALF) = pack8(acc[ai][bj][m][0] * scale, acc[ai][bj][m][1] * scale); }
    }
};
struct EpiResid {
    const float* xin; float* xout; const float* gate;
    __device__ __forceinline__ void operator()(const Acc& acc, const Unit& u, int wr, int wc, int fr, int fq) const {
        const int row0 = u.pm * BM + wr * 64 + fr, col0 = u.pn * BM + wc * 32 + 8 * fq;
        const float* gp = gate + (size_t)(u.pm >> 4) * NMOD + col0;
        f32x4 gv[2][2];
#pragma unroll
        for (int bj = 0; bj < 2; ++bj)
#pragma unroll
            for (int n = 0; n < 2; ++n) gv[bj][n] = *(const f32x4*)(gp + bj * HALF + 4 * n);
#pragma unroll
        for (int ai = 0; ai < 2; ++ai)
#pragma unroll
            for (int m = 0; m < 4; ++m) { const size_t off = (size_t)(row0 + ai * HALF + m * 16) * D + col0;
#pragma unroll
                for (int bj = 0; bj < 2; ++bj)
#pragma unroll
                    for (int n = 0; n < 2; ++n) { const f32x4 xo = *(const f32x4*)(xin + off + bj * HALF + 4 * n);
                        *(f32x4*)(xout + off + bj * HALF + 4 * n) = xo + gv[bj][n] * acc[ai][bj][m][n]; } }
    }
};
struct EpiGelu {
    bf16_t* U; bf16_t* V; f32x2* STATS;
    __device__ __forceinline__ void operator()(const Acc& acc, const Unit& u, int wr, int wc, int fr, int fq) const {
        const int row0 = u.pm * BM + wr * 64 + fr, cl = wc * 32 + 8 * fq;
        const bool isv = u.pn >= 8; bf16_t* base = isv ? V + (u.pn - 8) * 256 : U + u.pn * 256;
#pragma unroll
        for (int ai = 0; ai < 2; ++ai)
#pragma unroll
            for (int m = 0; m < 4; ++m) { const size_t row = (size_t)(row0 + ai * HALF + m * 16); float s = 0.f, ss = 0.f;
#pragma unroll
                for (int bj = 0; bj < 2; ++bj) { const f32x4 v0 = gelu4(acc[ai][bj][m][0]), v1 = gelu4(acc[ai][bj][m][1]);
                    *(u32x4*)(base + row * 2048 + bj * HALF + cl) = pack8(v0, v1);
                    s += (v0[0] + v0[1]) + (v0[2] + v0[3]) + (v1[0] + v1[1]) + (v1[2] + v1[3]);
                    ss += (v0[0] * v0[0] + v0[1] * v0[1]) + (v0[2] * v0[2] + v0[3] * v0[3]) + (v1[0] * v1[0] + v1[1] * v1[1]) + (v1[2] * v1[2] + v1[3] * v1[3]); }
                if (isv) { s += __shfl_xor(s, 16); ss += __shfl_xor(ss, 16); s += __shfl_xor(s, 32); ss += __shfl_xor(ss, 32);
                    if (fq == 0) STATS[row * 32 + (u.pn - 8) * 4 + wc] = (f32x2){s, ss}; } }
    }
};
struct EpiSwiglu {
    bf16_t* HID;
    __device__ __forceinline__ void operator()(const Acc& acc, const Unit& u, int wr, int wc, int fr, int fq) const {
        const int row0 = u.pm * BM + wr * 64 + fr, col0 = u.pn * 128 + wc * 32 + 8 * fq;
#pragma unroll
        for (int ai = 0; ai < 2; ++ai)
#pragma unroll
            for (int m = 0; m < 4; ++m) { f32x4 h[2];
#pragma unroll
                for (int n = 0; n < 2; ++n) { const f32x4 g = acc[ai][0][m][n], up = acc[ai][1][m][n];
#pragma unroll
                    for (int j = 0; j < 4; ++j) h[n][j] = g[j] * __builtin_amdgcn_rcpf(1.0f + __expf(-g[j])) * up[j]; }
                *(u32x4*)(HID + (size_t)(row0 + ai * HALF + m * 16) * DFF + col0) = pack8(h[0], h[1]); }
    }
};

template <class Epi>
__device__ __forceinline__ void gemm_phase(LAS unsigned char* lds, const Gemm g, const StaticOrder& S, const Epi& E) {
    int tid = threadIdx.x; asm volatile("" : "+v"(tid));
    const int wid = __builtin_amdgcn_readfirstlane(tid >> 6), lane = tid & 63, wr = wid >> 2, wc = wid & 3, fr = lane & 15, fq = lane >> 4;
    const int K = g.K, nt = K / BK, lda = g.lda;
    unsigned voffA[2], voffB[2];
#pragma unroll
    for (int i = 0; i < 2; ++i) { int R, C; stage_rc(tid * 16 + i * 8192, R, C); const int Rb = (R & ~31) + perm32(R & 31);
        voffA[i] = (unsigned)(R * lda + C) * 2u; voffB[i] = (unsigned)(Rb * K + C) * 2u; }
    const size_t kstep = (size_t)(BK * 2);
    const size_t hstepA = (size_t)HALF * lda * 2, hstepB = (size_t)HALF * K * 2;
    const unsigned ldsw = (unsigned)wid * 1024u;
    const int aoff = lds_byte(wr * 64 + fr, fq * 8), boff = lds_byte(wc * 32 + fr, fq * 8);
#define PG8_SA(b, h) (((b) * 2 + (h)) * HTB)
#define PG8_SB(b, h) ((4 + (b) * 2 + (h)) * HTB)
#define PG8_STAGE(bufoff, gbase, voff) do { _Pragma("unroll") for (int _i = 0; _i < 2; ++_i) \
        __builtin_amdgcn_global_load_lds((const unsigned*)((const char*)(gbase) + (voff)[_i]), (LAS unsigned*)(lds + (bufoff) + ldsw + _i * 8192), 16, 0, 0); } while (0)
#define PG8_LDA(dst, b, h) do { _Pragma("unroll") for (int m = 0; m < 4; ++m) _Pragma("unroll") for (int k = 0; k < 2; ++k) dst[m][k] = *(const LAS bf16x8*)(lds + PG8_SA(b, h) + aoff + m * 2048 + k * 1024); } while (0)
#define PG8_LDB(dst, b, h) do { _Pragma("unroll") for (int n = 0; n < 2; ++n) _Pragma("unroll") for (int k = 0; k < 2; ++k) dst[n][k] = *(const LAS bf16x8*)(lds + PG8_SB(b, h) + boff + n * 2048 + k * 1024); } while (0)
#define PG8_MMA(ai, bj, At, Bt) do { __builtin_amdgcn_s_setprio(1); _Pragma("unroll") for (int m = 0; m < 4; ++m) _Pragma("unroll") for (int n = 0; n < 2; ++n) _Pragma("unroll") for (int k = 0; k < 2; ++k) \
        acc[ai][bj][m][n] = __builtin_amdgcn_mfma_f32_16x16x32_bf16(Bt[n][k], At[m][k], acc[ai][bj][m][n], 0, 0, 0); __builtin_amdgcn_s_setprio(0); } while (0)
#define PG8_WAIT_V(n) asm volatile("s_waitcnt vmcnt(" #n ")" ::: "memory")
#define PG8_WAIT_L(n) asm volatile("s_waitcnt lgkmcnt(" #n ")" ::: "memory")
#define PG8_BAR __builtin_amdgcn_s_barrier()
#define PG8_SCHED __builtin_amdgcn_sched_barrier(0)
#define PG8_ABASE(u) ((const char*)g.A + ((size_t)(u).pm * BM * lda + (size_t)((u).pn >> g.agrp_shift) * g.agrp_stride) * 2)
#define PG8_BBASE(u) ((const char*)g.Bt + (size_t)(u).pn * 2 * hstepB)
    Unit cur, nxt; int ui = 0;
    if (!S.next(0, cur)) return;
    Acc acc;
#pragma unroll
    for (int a = 0; a < 2; ++a)
#pragma unroll
        for (int b = 0; b < 2; ++b)
#pragma unroll
            for (int m = 0; m < 4; ++m)
#pragma unroll
                for (int n = 0; n < 2; ++n) acc[a][b][m][n] = (f32x4){0.f, 0.f, 0.f, 0.f};
    bf16x8 At[4][2], B0[2][2], B1[2][2];
    const char* cA = PG8_ABASE(cur); const char* cB = PG8_BBASE(cur);
    PG8_STAGE(PG8_SB(0, 0), cB, voffB); PG8_STAGE(PG8_SB(0, 1), cB + hstepB, voffB); PG8_STAGE(PG8_SA(0, 0), cA, voffA); PG8_STAGE(PG8_SA(0, 1), cA + hstepA, voffA);
    if (wr == 1) PG8_BAR;
    PG8_WAIT_V(2); PG8_BAR;
    PG8_STAGE(PG8_SB(1, 0), cB + kstep, voffB); PG8_STAGE(PG8_SA(1, 0), cA + kstep, voffA); PG8_STAGE(PG8_SB(1, 1), cB + hstepB + kstep, voffB);
    PG8_WAIT_V(6); PG8_BAR;
    for (;;) {
        const bool has_next = S.next(ui + 1, nxt);
        const char* nA = has_next ? PG8_ABASE(nxt) : cA; const char* nB = has_next ? PG8_BBASE(nxt) : cB;
        for (int t = 0; t < nt; t += 2) {
            const bool last = (t == nt - 2);
            const char* a1 = cA + (size_t)(t + 1) * kstep;
            const char* a2 = last ? nA : cA + (size_t)(t + 2) * kstep; const char* b2 = last ? nB : cB + (size_t)(t + 2) * kstep;
            const char* a3 = a2 + kstep; const char* b3 = b2 + kstep;
            PG8_LDB(B0, 0, 0); PG8_LDB(B1, 0, 1); PG8_SCHED; PG8_LDA(At, 0, 0); PG8_STAGE(PG8_SA(1, 1), a1 + hstepA, voffA);
            PG8_WAIT_V(8); PG8_WAIT_L(0); PG8_BAR; PG8_MMA(0, 0, At, B0); PG8_MMA(0, 1, At, B1); PG8_BAR; PG8_SCHED;
            PG8_LDA(At, 0, 1); PG8_STAGE(PG8_SB(0, 0), b2, voffB); PG8_STAGE(PG8_SB(0, 1), b2 + hstepB, voffB); PG8_STAGE(PG8_SA(0, 0), a2, voffA);
            PG8_WAIT_V(8); PG8_WAIT_L(0); PG8_BAR; PG8_MMA(1, 0, At, B0); PG8_MMA(1, 1, At, B1); PG8_BAR; PG8_SCHED;
            PG8_LDB(B0, 1, 0); PG8_LDB(B1, 1, 1); PG8_SCHED; PG8_LDA(At, 1, 0); PG8_STAGE(PG8_SA(0, 1), a2 + hstepA, voffA);
            PG8_WAIT_V(8); PG8_WAIT_L(0); PG8_BAR; PG8_MMA(0, 0, At, B0); PG8_MMA(0, 1, At, B1); PG8_BAR; PG8_SCHED;
            PG8_LDA(At, 1, 1); PG8_STAGE(PG8_SB(1, 0), b3, voffB); PG8_STAGE(PG8_SB(1, 1), b3 + hstepB, voffB); PG8_STAGE(PG8_SA(1, 0), a3, voffA);
            PG8_WAIT_V(8); PG8_WAIT_L(0); PG8_BAR; PG8_MMA(1, 0, At, B0); PG8_MMA(1, 1, At, B1); PG8_BAR; PG8_SCHED;
        }
        if (wr == 0) PG8_BAR;
        E(acc, cur, wr, wc, fr, fq);
        if (!has_next) break;
#pragma unroll
        for (int a = 0; a < 2; ++a)
#pragma unroll
            for (int b = 0; b < 2; ++b)
#pragma unroll
                for (int m = 0; m < 4; ++m)
#pragma unroll
                    for (int n = 0; n < 2; ++n) acc[a][b][m][n] = (f32x4){0.f, 0.f, 0.f, 0.f};
        cur = nxt; cA = nA; cB = nB; ++ui;
        if (wr == 1) PG8_BAR;
    }
    PG8_WAIT_V(0);
    PG8_BAR;
#undef PG8_SA
#undef PG8_SB
#undef PG8_STAGE
#undef PG8_LDA
#undef PG8_LDB
#undef PG8_MMA
#undef PG8_WAIT_V
#undef PG8_WAIT_L
#undef PG8_BAR
#undef PG8_SCHED
#undef PG8_ABASE
#undef PG8_BBASE
}
}

struct Args { const float* in[23]; float* out; unsigned char* ws; int ph_lo, ph_hi; };

__device__ __forceinline__ void cvt_item(const float* src, int K, int N, bf16_t* dst, int ldd, int mode, int r0, int c0, LAS float* scr, int li, int lane) {
    const int nblk = (N + 31) >> 5, kb = li / nblk, nb = li % nblk, k0 = 64 * kb, n0 = 32 * nb;
    { const int n = n0 + (lane & 31);
#pragma unroll 8
      for (int i = 0; i < 32; ++i) { const int kk = 2 * i + (lane >> 5); scr[kk * 33 + (lane & 31)] = (n < N) ? src[(size_t)(k0 + kk) * N + n] : 0.f; } }
    LDS_WAIT();
    const int c = lane & 7;
#pragma unroll
    for (int j = 0; j < 4; ++j) { const int nl = (lane >> 3) + 8 * j, n = n0 + nl; const LAS float* s = scr + (8 * c) * 33 + nl;
        u32x4 o; o.x = cvt_pk_bf16(s[0 * 33], s[1 * 33]); o.y = cvt_pk_bf16(s[2 * 33], s[3 * 33]); o.z = cvt_pk_bf16(s[4 * 33], s[5 * 33]); o.w = cvt_pk_bf16(s[6 * 33], s[7 * 33]);
        if (n < N) { const int drow = mode ? ((n >> 7) * 256 + (n & 127) + r0) : (r0 + n); *(u32x4*)(dst + (size_t)drow * ldd + c0 + k0 + 8 * c) = o; } }
    LDS_WAIT();
}

__device__ __forceinline__ void p0_phase(const Args& a, LAS unsigned char* lds, int bid, int G) {
    int tid = threadIdx.x; asm volatile("" : "+v"(tid));
    const int lane = tid & 63, wave = __builtin_amdgcn_readfirstlane(tid >> 6);
    unsigned char* ws = a.ws;
    LAS float* scr = (LAS float*)(lds + wave * 8704);
    const int gw = bid * 8 + wave, NGW = G * 8;
    constexpr int NITEMS = 1888 + 256 + 256 + 1024 + 4096 + 2048 + 11264 + 5632;
    for (int it = gw; it < NITEMS; it += NGW) {
        int r = it;
        if (r < 1888) { const int j = r / 944; cvt_item(a.in[6] + (size_t)j * 1024 * AIN, 1024, AIN, (bf16_t*)(ws + W_AIN) + (size_t)j * 2048 * 1024, 1024, 0, 0, 0, scr, r % 944, lane); continue; } r -= 1888;
        if (r < 256) { const int jj = r >> 4, la = jj >> 3, h = jj & 7; cvt_item(a.in[10] + (size_t)(la * 8 + h) * 128 * 256, 128, 256, (bf16_t*)(ws + W_UK) + (size_t)la * 2048 * 256, 256, 0, h * 256, (h & 1) * 128, scr, r & 15, lane); continue; } r -= 256;
        if (r < 256) { const int jj = r >> 4, la = jj >> 3, h = jj & 7; cvt_item(a.in[11] + (size_t)(la * 8 + h) * 256 * 128, 256, 128, (bf16_t*)(ws + W_UV) + (size_t)la * 1024 * 512, 512, 0, (h >> 1) * 256 + (h & 1) * 128, (h & 1) * 256, scr, r & 15, lane); continue; } r -= 256;
        if (r < 1024) { const int la = r >> 9; cvt_item(a.in[12] + (size_t)la * 1024 * 1024, 1024, 1024, (bf16_t*)(ws + W_O) + (size_t)la * 1024 * 1024, 1024, 0, 0, 0, scr, r & 511, lane); continue; } r -= 1024;
        if (r < 4096) { const int la = r >> 11; cvt_item(a.in[13] + (size_t)la * 1024 * 4096, 1024, 4096, (bf16_t*)(ws + W_BIN) + (size_t)la * 4096 * 1024, 1024, 0, 0, 0, scr, r & 2047, lane); continue; } r -= 4096;
        if (r < 2048) { const int la = r >> 10; cvt_item(a.in[18] + (size_t)la * 2048 * 1024, 2048, 1024, (bf16_t*)(ws + W_BOUT) + (size_t)la * 1024 * 2048, 2048, 0, 0, 0, scr, r & 1023, lane); continue; } r -= 2048;
        if (r < 11264) { const int jj = r / 1408, l = jj & 3, isup = jj >> 2; cvt_item(a.in[isup ? 20 : 19] + (size_t)l * 1024 * DFF, 1024, DFF, (bf16_t*)(ws + W_GU) + (size_t)l * 5632 * 1024, 1024, 1, isup * 128, 0, scr, r % 1408, lane); continue; } r -= 11264;
        { const int l = r / 1408; cvt_item(a.in[21] + (size_t)l * DFF * 1024, DFF, 1024, (bf16_t*)(ws + W_DN) + (size_t)l * 1024 * DFF, DFF, 0, 0, 0, scr, r % 1408, lane); }
    }
    const size_t gt = (size_t)bid * 512 + tid, NT = (size_t)G * 512;
    const u32x4 z = (u32x4){0u, 0u, 0u, 0u};
    for (size_t i = gt; i < 2 * 184 * 128; i += NT) { const int j = (int)(i / (184 * 128)), rem = (int)(i % (184 * 128)), rr = AIN + rem / 128, ch = rem % 128;
        *(u32x4*)((bf16_t*)(ws + W_AIN) + ((size_t)j * 2048 + rr) * 1024 + ch * 8) = z; }
    for (size_t i = gt; i < 2 * 2048 * 16; i += NT) { const int j = (int)(i / (2048 * 16)), rem = (int)(i % (2048 * 16)), rr = rem >> 4, ch = rem & 15, h = rr >> 8;
        *(u32x4*)((bf16_t*)(ws + W_UK) + ((size_t)j * 2048 + rr) * 256 + (1 - (h & 1)) * 128 + ch * 8) = z; }
    for (size_t i = gt; i < 2 * 1024 * 32; i += NT) { const int j = (int)(i / (1024 * 32)), rem = (int)(i % (1024 * 32)), rr = rem >> 5, ch = rem & 31, hh = (rr >> 7) & 1;
        *(u32x4*)((bf16_t*)(ws + W_UV) + ((size_t)j * 1024 + rr) * 512 + (1 - hh) * 256 + ch * 8) = z; }
    __syncthreads();
    LAS float* ca = (LAS float*)lds;
    const float* cvec = a.in[1]; const float* modw = a.in[2]; float* MODP = (float*)(ws + WS_MODP);
    for (int it = bid; it < 768; it += G) {
        const int l = it / 192, rem = it % 192, ng = rem >> 4, kc = rem & 15;
        { const int b = tid >> 6, k = tid & 63; const float cv = cvec[b * 1024 + kc * 64 + k]; ca[b * 64 + k] = cv / (1.0f + __expf(-cv)); }
        __syncthreads();
        const int n = ng * 512 + tid; float acc[8];
#pragma unroll
        for (int b = 0; b < 8; ++b) acc[b] = 0.f;
        const float* wp = modw + ((size_t)l * 1024 + kc * 64) * NMOD + n;
#pragma unroll 8
        for (int k = 0; k < 64; ++k) { const float w = wp[(size_t)k * NMOD];
#pragma unroll
            for (int b = 0; b < 8; ++b) acc[b] += ca[b * 64 + k] * w; }
#pragma unroll
        for (int b = 0; b < 8; ++b) MODP[((size_t)(kc * 4 + l) * 8 + b) * NMOD + n] = acc[b];
        __syncthreads();
    }
}
__device__ __forceinline__ void p0c_phase(const Args& a, int bid, int G) {
    const float* MODP = (const float*)(a.ws + WS_MODP); float* MOD = (float*)(a.ws + WS_MOD); const float* modb = a.in[3];
    int tid0 = threadIdx.x; asm volatile("" : "+v"(tid0));
    for (int i = bid * 512 + tid0; i < 4 * 8 * NMOD; i += G * 512) { const int l = i / (8 * NMOD), n = i % NMOD; float s = modb[l * NMOD + n];
#pragma unroll
        for (int kc = 0; kc < 16; ++kc) s += MODP[(size_t)kc * (4 * 8 * NMOD) + i];
        MOD[i] = s; }
}

__device__ __forceinline__ void norm_mod_phase(const float* x, const float* gain, const float* sh, const float* sc, bf16_t* H, int bid, int G) {
    int tid = threadIdx.x; asm volatile("" : "+v"(tid));
    const int lane = tid & 63, wave = tid >> 6;
    for (int rb = (bid * 8 + wave) * 16; rb < M; rb += G * 8 * 16) {
        const int b = rb / T; f32x4 gs[4], sv[4];
#pragma unroll
        for (int j = 0; j < 4; ++j) { const int c = 4 * lane + 256 * j; const f32x4 g4 = *(const f32x4*)(gain + c), s4 = *(const f32x4*)(sc + (size_t)b * NMOD + c); gs[j] = g4 * (s4 + 1.0f); sv[j] = *(const f32x4*)(sh + (size_t)b * NMOD + c); }
        for (int r = rb; r < rb + 16; ++r) {
            const f32x4* xr = (const f32x4*)(x + (size_t)r * D) + lane; f32x4 v[4]; float ss = 0.f;
#pragma unroll
            for (int j = 0; j < 4; ++j) { v[j] = xr[64 * j]; ss += (v[j][0] * v[j][0] + v[j][1] * v[j][1]) + (v[j][2] * v[j][2] + v[j][3] * v[j][3]); }
            const float rstd = rsqrtf(wave_sum(ss) * (1.0f / D) + EPS);
            u32x2* o = (u32x2*)(H + (size_t)r * D) + lane;
#pragma unroll
            for (int j = 0; j < 4; ++j) { const f32x4 y = v[j] * rstd * gs[j] + sv[j]; u32x2 w; w.x = cvt_pk_bf16(y[0], y[1]); w.y = cvt_pk_bf16(y[2], y[3]); o[64 * j] = w; }
        }
    }
}
__device__ __forceinline__ void final_norm_phase(const float* x, const float* gain, float* out, int bid, int G) {
    int tid = threadIdx.x; asm volatile("" : "+v"(tid));
    const int lane = tid & 63, wave = tid >> 6;
    f32x4 gs[4];
#pragma unroll
    for (int j = 0; j < 4; ++j) gs[j] = *(const f32x4*)(gain + 4 * lane + 256 * j);
    for (int r = bid * 8 + wave; r < M; r += G * 8) {
        const f32x4* xr = (const f32x4*)(x + (size_t)r * D) + lane; f32x4 v[4]; float ss = 0.f;
#pragma unroll
        for (int j = 0; j < 4; ++j) { v[j] = xr[64 * j]; ss += (v[j][0] * v[j][0] + v[j][1] * v[j][1]) + (v[j][2] * v[j][2] + v[j][3] * v[j][3]); }
        const float rstd = rsqrtf(wave_sum(ss) * (1.0f / D) + EPS);
        f32x4* o = (f32x4*)(out + (size_t)r * D) + lane;
#pragma unroll
        for (int j = 0; j < 4; ++j) o[64 * j] = v[j] * rstd * gs[j];
    }
}
__device__ __forceinline__ void dsa_rows_phase(const float* CKVR, const float* KRAW, const float* gkv, const float* gk, const float* bk, bf16_t* CKV, bf16_t* KIDX, float* WIDX, int bid, int G) {
    int tid = threadIdx.x; asm volatile("" : "+v"(tid));
    const int lane = tid & 63, wave = tid >> 6;
    const f32x4 g4 = *(const f32x4*)(gkv + 4 * lane);
    f32x4 gk4 = (f32x4){0.f, 0.f, 0.f, 0.f}, bk4 = gk4;
    if (lane < 16) { gk4 = *(const f32x4*)(gk + 4 * lane); bk4 = *(const f32x4*)(bk + 4 * lane); }
    for (int r = bid * 8 + wave; r < M; r += G * 8) {
        const f32x4 v = *(const f32x4*)(CKVR + (size_t)r * 256 + 4 * lane);
        f32x4 kv = (f32x4){0.f, 0.f, 0.f, 0.f}; if (lane < 32) kv = *(const f32x4*)(KRAW + (size_t)r * 128 + 4 * lane);
        const float ss = wave_sum((v[0] * v[0] + v[1] * v[1]) + (v[2] * v[2] + v[3] * v[3]));
        const float rstd = rsqrtf(ss * (1.0f / 256.0f) + EPS);
        { const f32x4 y = v * rstd * g4; u32x2 w; w.x = cvt_pk_bf16(y[0], y[1]); w.y = cvt_pk_bf16(y[2], y[3]); *(u32x2*)(CKV + (size_t)r * 256 + 4 * lane) = w; }
        const float ks = (lane < 16) ? (kv[0] + kv[1]) + (kv[2] + kv[3]) : 0.f;
        const float mean = wave_sum(ks) * (1.0f / 64.0f);
        const f32x4 dv = kv - mean;
        const float kq = (lane < 16) ? (dv[0] * dv[0] + dv[1] * dv[1]) + (dv[2] * dv[2] + dv[3] * dv[3]) : 0.f;
        const float krstd = rsqrtf(wave_sum(kq) * (1.0f / 64.0f) + EPS);
        if (lane < 16) { const f32x4 y = dv * krstd * gk4 + bk4; u32x2 w; w.x = cvt_pk_bf16(y[0], y[1]); w.y = cvt_pk_bf16(y[2], y[3]); *(u32x2*)(KIDX + (size_t)r * 64 + 4 * lane) = w; }
        else if (lane < 18) { *(f32x4*)(WIDX + (size_t)r * 8 + 4 * (lane - 16)) = kv * 0.04419417382f; }
    }
}

__device__ __forceinline__ unsigned long long idx_comp(float v, float lo, float scale, int s) {
    const unsigned key = (unsigned)((v - lo) * scale);
    return ((unsigned long long)key << 12) | (unsigned)(4095 - s);
}
__device__ __forceinline__ void indexer_phase(LAS unsigned char* lds, const bf16_t* QIDX, const bf16_t* KIDX, const float* WIDX, unsigned short* IDX, int bid, int G) {
    int tid = threadIdx.x; asm volatile("" : "+v"(tid));
    const int lane = tid & 63, wave = __builtin_amdgcn_readfirstlane(tid >> 6);
    LAS float* SC = (LAS float*)lds;
    LAS unsigned* HIST = (LAS unsigned*)(lds + 131072) + wave * 256;
    const int hf = lane >> 5, col = lane & 31;
    for (int it = bid; it < 4096; it += G) {
        const int b = it & 7, qb = it >> 3, t0 = qb * 8; const size_t mb = (size_t)b * T;
        const int t = t0 + wave, N = t + 1;
        unsigned short* out = IDX + (mb + t) * 256;
        if (t0 + 8 <= 256) { for (int j = lane; j < N; j += 64) out[j] = (unsigned short)j; continue; }
        bf16x8 af[2][4]; float w[2][4][4];
#pragma unroll
        for (int rg = 0; rg < 2; ++rg) {
            const bf16_t* qp = QIDX + (mb + t0 + 4 * rg + (col >> 3)) * 512 + (col & 7) * 64 + 8 * hf;
#pragma unroll
            for (int ks = 0; ks < 4; ++ks) af[rg][ks] = *(const bf16x8*)(qp + 16 * ks);
#pragma unroll
            for (int qq = 0; qq < 4; ++qq) { const f32x4 wv = *(const f32x4*)(WIDX + (mb + t0 + 4 * rg + qq) * 8 + 4 * hf);
                w[rg][qq][0] = wv[0]; w[rg][qq][1] = wv[1]; w[rg][qq][2] = wv[2]; w[rg][qq][3] = wv[3]; }
        }
        const int ntile = (t0 + 8 + 31) >> 5;
        for (int kt = wave; kt < ntile; kt += 8) {
            const int s = 32 * kt + col; bf16x8 bfr[4];
            const bf16_t* kp = KIDX + (mb + s) * 64 + 8 * hf;
#pragma unroll
            for (int ks = 0; ks < 4; ++ks) bfr[ks] = *(const bf16x8*)(kp + 16 * ks);
#pragma unroll
            for (int rg = 0; rg < 2; ++rg) {
                f32x16 acc;
#pragma unroll
                for (int i = 0; i < 16; ++i) acc[i] = 0.f;
#pragma unroll
                for (int ks = 0; ks < 4; ++ks) acc = __builtin_amdgcn_mfma_f32_32x32x16_bf16(af[rg][ks], bfr[ks], acc, 0, 0, 0);
#pragma unroll
                for (int qq = 0; qq < 4; ++qq) {
                    float p = 0.f;
#pragma unroll
                    for (int ii = 0; ii < 4; ++ii) p += fmaxf(acc[4 * qq + ii], 0.f) * w[rg][qq][ii];
                    const float tot = p + __shfl_xor(p, 32);
                    if ((qq >> 1) == hf) SC[(4 * rg + qq) * 4096 + s] = tot;
                }
            }
        }
        __syncthreads();
        const LAS float* sc = SC + wave * 4096;
        float lo = 3.0e38f, hi = -3.0e38f;
        for (int s = lane; s < N; s += 64) { const float v = sc[s]; lo = fminf(lo, v); hi = fmaxf(hi, v); }
#pragma unroll
        for (int o = 1; o < 64; o <<= 1) { lo = fminf(lo, __shfl_xor(lo, o)); hi = fmaxf(hi, __shfl_xor(hi, o)); }
        const float scale = 4.0e9f / fmaxf(hi - lo, 1e-30f);
        unsigned long long prefix = 0ull; unsigned need = 256u;
#pragma unroll 1
        for (int p = 0; p < 6; ++p) {
            const int shift = (p == 5) ? 0 : 36 - 8 * p, width = (p == 5) ? 4 : 8; const unsigned dmask = (1u << width) - 1u;
            for (int i = lane; i < 256; i += 64) HIST[i] = 0u;
            __syncthreads();
            for (int s = lane; s < N; s += 64) { const unsigned long long c = idx_comp(sc[s], lo, scale, s);
                if ((c >> (shift + width)) == prefix) __hip_atomic_fetch_add(HIST + ((unsigned)(c >> shift) & dmask), 1u, __ATOMIC_RELAXED, __HIP_MEMORY_SCOPE_WORKGROUP); }
            __syncthreads();
            unsigned hb[4];
#pragma unroll
            for (int j = 0; j < 4; ++j) hb[j] = HIST[4 * lane + j];
            const unsigned ls = hb[0] + hb[1] + hb[2] + hb[3];
            unsigned incl = ls;
#pragma unroll
            for (int o = 1; o < 64; o <<= 1) { const unsigned v = __shfl_down(incl, o); if (lane + o < 64) incl += v; }
            unsigned cnt = incl - ls; bool found = false; unsigned dsel = 0u, nn = 0u;
#pragma unroll
            for (int j = 3; j >= 0; --j) { if (!found && cnt < need && need <= cnt + hb[j]) { found = true; dsel = 4u * lane + j; nn = need - cnt; } cnt += hb[j]; }
            const unsigned long long fm = __ballot(found);
            const int src = (fm != 0ull) ? (__ffsll((long long)fm) - 1) : 0;
            dsel = __shfl(dsel, src); need = __shfl(nn, src);
            prefix = (prefix << width) | dsel;
            __syncthreads();
        }
        int base = 0;
        for (int s0 = 0; s0 < N; s0 += 64) { const int s = s0 + lane; const bool sel = (s < N) && (idx_comp(sc[s < N ? s : 0], lo, scale, s) >= prefix);
            const unsigned long long mk = __ballot(sel); const int pos = base + __popcll(mk & ((1ull << lane) - 1ull));
            if (sel && pos < 256) out[pos] = (unsigned short)s; base += __popcll(mk); }
        __syncthreads();
    }
}

__device__ __forceinline__ void attn_phase(LAS unsigned char* lds, const bf16_t* QLAT, const bf16_t* CKV, const unsigned short* IDX, bf16_t* OLAT, int bid, int G) {
    int tid = threadIdx.x; asm volatile("" : "+v"(tid));
    const int lane = tid & 63, wave = __builtin_amdgcn_readfirstlane(tid >> 6);
    const int g = lane >> 4, c16 = lane & 15, hd = c16 & 7, q4 = c16 >> 2, p4 = c16 & 3;
    LAS unsigned char* tile = lds + wave * 16896;
    constexpr float L2E = 1.4426950408889634f;
    for (int it = bid; it < 4096; it += G) {
        const int b = it & 7, t = (it >> 3) * 8 + wave; const size_t m = (size_t)b * T + t; const int cnt = (t + 1 < 256) ? t + 1 : 256;
        bf16x8 qf[8];
        { const bf16_t* qp = QLAT + m * 2048 + hd * 256 + 8 * g;
#pragma unroll
          for (int ks = 0; ks < 8; ++ks) qf[ks] = *(const bf16x8*)(qp + 32 * ks); }
        f32x4 o[16];
#pragma unroll
        for (int nt = 0; nt < 16; ++nt) o[nt] = (f32x4){0.f, 0.f, 0.f, 0.f};
        float mrun = -INFINITY, lrun = 0.f;
        const unsigned short* ip = IDX + m * 256;
#pragma unroll 1
        for (int ch = 0; ch < 8; ++ch) {
            const int j0 = 32 * ch + c16, j1 = j0 + 16;
            const int k0 = (j0 < cnt) ? (int)ip[j0] : 0, k1 = (j1 < cnt) ? (int)ip[j1] : 0;
            const bf16_t* r0 = CKV + ((size_t)b * T + k0) * 256 + 8 * g; const bf16_t* r1 = CKV + ((size_t)b * T + k1) * 256 + 8 * g;
            bf16x8 a0[8], a1[8];
#pragma unroll
            for (int ks = 0; ks < 8; ++ks) { a0[ks] = *(const bf16x8*)(r0 + 32 * ks); a1[ks] = *(const bf16x8*)(r1 + 32 * ks); }
            f32x4 s0 = (f32x4){0.f, 0.f, 0.f, 0.f}, s1 = s0;
#pragma unroll
            for (int ks = 0; ks < 8; ++ks) { s0 = __builtin_amdgcn_mfma_f32_16x16x32_bf16(a0[ks], qf[ks], s0, 0, 0, 0); s1 = __builtin_amdgcn_mfma_f32_16x16x32_bf16(a1[ks], qf[ks], s1, 0, 0, 0); }
#pragma unroll
            for (int ks = 0; ks < 8; ++ks) { *(LAS bf16x8*)(tile + c16 * 528 + (32 * ks + 8 * g) * 2) = a0[ks]; *(LAS bf16x8*)(tile + (16 + c16) * 528 + (32 * ks + 8 * g) * 2) = a1[ks]; }
            float cm = -INFINITY;
#pragma unroll
            for (int i = 0; i < 4; ++i) { if (32 * ch + 4 * g + i >= cnt) s0[i] = -INFINITY; if (32 * ch + 16 + 4 * g + i >= cnt) s1[i] = -INFINITY; cm = fmaxf(cm, fmaxf(s0[i], s1[i])); }
            cm = fmaxf(cm, __shfl_xor(cm, 16)); cm = fmaxf(cm, __shfl_xor(cm, 32));
            const float mnew = fmaxf(mrun, cm), alpha = __builtin_amdgcn_exp2f((mrun - mnew) * L2E);
            float p0[4], p1[4], ps = 0.f;
#pragma unroll
            for (int i = 0; i < 4; ++i) { p0[i] = __builtin_amdgcn_exp2f((s0[i] - mnew) * L2E); p1[i] = __builtin_amdgcn_exp2f((s1[i] - mnew) * L2E); ps += p0[i] + p1[i]; }
            lrun = lrun * alpha + ps; mrun = mnew;
#pragma unroll
            for (int nt = 0; nt < 16; ++nt) o[nt] = o[nt] * alpha;
            u32x4 pw; pw.x = cvt_pk_bf16(p0[0], p0[1]); pw.y = cvt_pk_bf16(p0[2], p0[3]); pw.z = cvt_pk_bf16(p1[0], p1[1]); pw.w = cvt_pk_bf16(p1[2], p1[3]);
            const bf16x8 pb = __builtin_bit_cast(bf16x8, pw);
            LDS_WAIT();
#pragma unroll
            for (int nt = 0; nt < 16; ++nt) {
                const s16x4 t0v = __builtin_amdgcn_ds_read_tr16_b64_v4i16((LAS s16x4*)(tile + (4 * g + q4) * 528 + (16 * nt + 4 * p4) * 2));
                const s16x4 t1v = __builtin_amdgcn_ds_read_tr16_b64_v4i16((LAS s16x4*)(tile + (16 + 4 * g + q4) * 528 + (16 * nt + 4 * p4) * 2));
                const bf16x8 cf = __builtin_shufflevector(t0v, t1v, 0, 1, 2, 3, 4, 5, 6, 7);
                o[nt] = __builtin_amdgcn_mfma_f32_16x16x32_bf16(cf, pb, o[nt], 0, 0, 0);
            }
            LDS_WAIT();
        }
        float lt = lrun + __shfl_xor(lrun, 16); lt += __shfl_xor(lt, 32);
        const float inv = 1.0f / lt;
        if (c16 < 8) { bf16_t* op = OLAT + m * 2048 + c16 * 256 + 4 * g;
#pragma unroll
            for (int nt = 0; nt < 16; ++nt) { const f32x4 y = o[nt] * inv; u32x2 wv; wv.x = cvt_pk_bf16(y[0], y[1]); wv.y = cvt_pk_bf16(y[2], y[3]); *(u32x2*)(op + 16 * nt) = wv; } }
    }
}

__device__ __forceinline__ void smix_phase(LAS unsigned char* lds, bf16_t* UY, const bf16_t* V, const f32x2* STATS, const float* Wc, const float* bsp, const float* lng, const float* lnb, int bid, int G) {
    int tid = threadIdx.x; asm volatile("" : "+v"(tid));
    const int lane = tid & 63, wave = __builtin_amdgcn_readfirstlane(tid >> 6);
    const int gq = lane >> 4, c16 = lane & 15, q4 = c16 >> 2, p4 = c16 & 3;
    LAS unsigned char* VT = lds;
    LAS unsigned char* AP = lds + 67584;
    LAS float* MU = (LAS float*)(lds + 102400); LAS float* RSTD = MU + 128; LAS float* R1 = MU + 256; LAS float* R2 = MU + 384;
    for (int it = bid; it < 2048; it += G) {
        const int gi = it & 7, rem = it >> 3, b = rem >> 5, ck = rem & 31; const size_t m0 = (size_t)b * T + ck * 128;
        if (tid < 128) { const f32x2* sp = STATS + (m0 + tid) * 32; float s = 0.f, ss = 0.f;
#pragma unroll 8
            for (int p = 0; p < 32; ++p) { const f32x2 v = sp[p]; s += v.x; ss += v.y; }
            const float mu = s * (1.0f / 2048.0f), var = ss * (1.0f / 2048.0f) - mu * mu; MU[tid] = mu; RSTD[tid] = rsqrtf(fmaxf(var, 0.f) + EPS); }
#pragma unroll
        for (int i = 0; i < 8; ++i) { const int cidx = tid + 512 * i, s = cidx >> 5, ch = cidx & 31;
            *(LAS u32x4*)(VT + s * 528 + ch * 16) = *(const u32x4*)(V + (m0 + s) * 2048 + gi * 256 + ch * 8); }
        __syncthreads();
        { const int t = tid >> 2, qd = tid & 3; const float* wp = Wc + ((size_t)gi * 128 + t) * 128 + 32 * qd; float r1 = 0.f, r2 = 0.f;
#pragma unroll
          for (int s8 = 0; s8 < 4; ++s8) { const f32x4 wa = *(const f32x4*)(wp + 8 * s8), wb = *(const f32x4*)(wp + 8 * s8 + 4); float av[8];
#pragma unroll
              for (int e = 0; e < 8; ++e) { const int s = 32 * qd + 8 * s8 + e; const float wv = (s <= t) ? (e < 4 ? wa[e] : wb[e - 4]) : 0.f; const float ab = bf_round(wv * RSTD[s]); av[e] = ab; r1 += ab * MU[s]; r2 += wv; }
              u32x4 o; o.x = cvt_pk_bf16(av[0], av[1]); o.y = cvt_pk_bf16(av[2], av[3]); o.z = cvt_pk_bf16(av[4], av[5]); o.w = cvt_pk_bf16(av[6], av[7]);
              *(LAS u32x4*)(AP + t * 272 + (32 * qd + 8 * s8) * 2) = o; }
          r1 += __shfl_xor(r1, 1); r2 += __shfl_xor(r2, 1); r1 += __shfl_xor(r1, 2); r2 += __shfl_xor(r2, 2);
          if (qd == 0) { R1[t] = r1; R2[t] = r2; } }
        __syncthreads();
        f32x4 acc[8][2];
#pragma unroll
        for (int mt = 0; mt < 8; ++mt) { acc[mt][0] = (f32x4){0.f, 0.f, 0.f, 0.f}; acc[mt][1] = acc[mt][0]; }
#pragma unroll
        for (int ks = 0; ks < 4; ++ks) {
            bf16x8 vf[2];
#pragma unroll
            for (int n2 = 0; n2 < 2; ++n2) { const int nt = 2 * wave + n2;
                const s16x4 t0v = __builtin_amdgcn_ds_read_tr16_b64_v4i16((LAS s16x4*)(VT + (32 * ks + 8 * gq + q4) * 528 + (16 * nt + 4 * p4) * 2));
                const s16x4 t1v = __builtin_amdgcn_ds_read_tr16_b64_v4i16((LAS s16x4*)(VT + (32 * ks + 8 * gq + 4 + q4) * 528 + (16 * nt + 4 * p4) * 2));
                vf[n2] = __builtin_shufflevector(t0v, t1v, 0, 1, 2, 3, 4, 5, 6, 7); }
#pragma unroll
            for (int mt = 0; mt < 8; ++mt) if (mt >= 2 * ks) {
                const bf16x8 afr = *(const LAS bf16x8*)(AP + (16 * mt + c16) * 272 + (32 * ks + 8 * gq) * 2);
                acc[mt][0] = __builtin_amdgcn_mfma_f32_16x16x32_bf16(vf[0], afr, acc[mt][0], 0, 0, 0);
                acc[mt][1] = __builtin_amdgcn_mfma_f32_16x16x32_bf16(vf[1], afr, acc[mt][1], 0, 0, 0); }
        }
#pragma unroll
        for (int n2 = 0; n2 < 2; ++n2) { const int e0 = 16 * (2 * wave + n2) + 4 * gq; const f32x4 lg4 = *(const f32x4*)(lng + gi * 256 + e0), lb4 = *(const f32x4*)(lnb + gi * 256 + e0);
#pragma unroll
            for (int mt = 0; mt < 8; ++mt) { const int t = 16 * mt + c16; const float r1 = R1[t], r2 = R2[t], bsv = bsp[gi * 128 + t];
                bf16_t* up = UY + (m0 + t) * 2048 + gi * 256 + e0; const u32x2 uw = *(const u32x2*)up;
                const f32x4 mixed = lg4 * (acc[mt][n2] - r1) + lb4 * r2 + bsv;
                const float y0 = bf2f(uw.x & 0xffffu) * mixed[0], y1 = bf2f(uw.x >> 16) * mixed[1], y2 = bf2f(uw.y & 0xffffu) * mixed[2], y3 = bf2f(uw.y >> 16) * mixed[3];
                u32x2 yw; yw.x = cvt_pk_bf16(y0, y1); yw.y = cvt_pk_bf16(y2, y3); *(u32x2*)up = yw; } }
        __syncthreads();
    }
}

__global__ void __launch_bounds__(512, 2) mk_fwd(Args a) {
    extern __shared__ __attribute__((aligned(16))) unsigned char lds_raw[];
    LAS unsigned char* lds = (LAS unsigned char*)lds_raw;
    cg::grid_group grid = cg::this_grid();
    const int bid = blockIdx.x, G = gridDim.x;
    unsigned char* ws = a.ws;
    float* MOD = (float*)(ws + WS_MOD);
    bf16_t* H = (bf16_t*)(ws + WS_H);
    float* X = a.out;
    volatile LAS unsigned* misc = (volatile LAS unsigned*)(lds + LDS_MISC);
    if (threadIdx.x < 2) misc[threadIdx.x] = 0u;
    __syncthreads();
    const XcdBarrier xbar = xcd_barrier_post((unsigned*)(ws + WS_BAR), misc);
    int ph = 0;
#ifndef PROBE
#define PROBE 0
#endif
#define PHASE_BEGIN if (ph >= a.ph_lo && ph < a.ph_hi) {
#define REP(k) for (int rep_ = 0; rep_ < ((PROBE == (k)) ? 2 : 1); ++rep_)
#define PHASE_END(dosync) if ((dosync) && ph + 1 < a.ph_hi) { if (ph == 0) grid.sync(); else xcd_barrier(xbar); } } ++ph;

    PHASE_BEGIN REP(4) { p0_phase(a, lds, bid, G); __syncthreads(); } PHASE_END(true)
    PHASE_BEGIN p0c_phase(a, bid, G); PHASE_END(true)

#pragma unroll 1
    for (int layer = 0; layer < 4; ++layer) {
        const int j = layer >> 1; const float* xin = (layer == 0) ? a.in[0] : X;
        const float* modl = MOD + (size_t)layer * 8 * NMOD;
        PHASE_BEGIN REP(3) norm_mod_phase(xin, a.in[4] + layer * D, modl + 0 * D, modl + 1 * D, H, bid, G); PHASE_END(true)
        if ((layer & 1) == 0) {
            bf16_t* Q = (bf16_t*)(ws + WS_Q); float* CKVR = (float*)(ws + WS_CKVR); bf16_t* QIDX = (bf16_t*)(ws + WS_QIDX); float* KRAW = (float*)(ws + WS_KRAW);
            bf16_t* CKV = (bf16_t*)(ws + WS_CKV); bf16_t* KIDX = (bf16_t*)(ws + WS_KIDX); float* WIDX = (float*)(ws + WS_WIDX); unsigned short* IDX = (unsigned short*)(ws + WS_IDX);
            bf16_t* QLAT = (bf16_t*)(ws + WS_QLAT); bf16_t* OLAT = (bf16_t*)(ws + WS_OLAT); bf16_t* O = (bf16_t*)(ws + WS_O);
            PHASE_BEGIN { pg8::Gemm g{H, (const bf16_t*)(ws + W_AIN) + (size_t)j * 2048 * 1024, M, 2048, 1024, 1024, 0, 0}; pg8::StaticOrder S; S.init(M, 2048, G, bid);
                pg8::EpiInproj E{Q, CKVR, QIDX, KRAW}; REP(5) pg8::gemm_phase(lds, g, S, E); } PHASE_END(true)
            PHASE_BEGIN { dsa_rows_phase(CKVR, KRAW, a.in[7] + j * 256, a.in[8] + j * 64, a.in[9] + j * 64, CKV, KIDX, WIDX, bid, G);
                __syncthreads();
                pg8::Gemm g{Q, (const bf16_t*)(ws + W_UK) + (size_t)j * 2048 * 256, M, 2048, 256, 1024, 1, 256}; pg8::StaticOrder S; S.init(M, 2048, G, bid);
                pg8::EpiBf16 E{QLAT, 2048, 0.08838834764831845f}; pg8::gemm_phase(lds, g, S, E); } PHASE_END(true)
            PHASE_BEGIN REP(1) indexer_phase(lds, QIDX, KIDX, WIDX, IDX, bid, G); PHASE_END(true)
            PHASE_BEGIN REP(2) attn_phase(lds, QLAT, CKV, IDX, OLAT, bid, G); PHASE_END(true)
            PHASE_BEGIN { pg8::Gemm g{OLAT, (const bf16_t*)(ws + W_UV) + (size_t)j * 1024 * 512, M, 1024, 512, 2048, 0, 512}; pg8::StaticOrder S; S.init(M, 1024, G, bid);
                pg8::EpiBf16 E{O, 1024, 1.0f}; pg8::gemm_phase(lds, g, S, E); } PHASE_END(true)
            PHASE_BEGIN { pg8::Gemm g{O, (const bf16_t*)(ws + W_O) + (size_t)j * 1024 * 1024, M, 1024, 1024, 1024, 0, 0}; pg8::StaticOrder S; S.init(M, 1024, G, bid);
                pg8::EpiResid E{xin, X, modl + 2 * D}; pg8::gemm_phase(lds, g, S, E); } PHASE_END(true)
        } else {
            bf16_t* U = (bf16_t*)(ws + WS_U); bf16_t* V = (bf16_t*)(ws + WS_V); f32x2* STATS = (f32x2*)(ws + WS_STATS);
            PHASE_BEGIN { pg8::Gemm g{H, (const bf16_t*)(ws + W_BIN) + (size_t)j * 4096 * 1024, M, 4096, 1024, 1024, 0, 0}; pg8::StaticOrder S; S.init(M, 4096, G, bid);
                pg8::EpiGelu E{U, V, STATS}; REP(7) pg8::gemm_phase(lds, g, S, E); } PHASE_END(true)
            PHASE_BEGIN smix_phase(lds, U, V, STATS, a.in[16] + (size_t)j * 8 * 128 * 128, a.in[17] + (size_t)j * 8 * 128, a.in[14] + (size_t)j * 2048, a.in[15] + (size_t)j * 2048, bid, G); PHASE_END(true)
            PHASE_BEGIN { pg8::Gemm g{U, (const bf16_t*)(ws + W_BOUT) + (size_t)j * 1024 * 2048, M, 1024, 2048, 2048, 0, 0}; pg8::StaticOrder S; S.init(M, 1024, G, bid);
                pg8::EpiResid E{xin, X, modl + 2 * D}; pg8::gemm_phase(lds, g, S, E); } PHASE_END(true)
        }
        PHASE_BEGIN REP(3) norm_mod_phase(X, a.in[5] + layer * D, modl + 3 * D, modl + 4 * D, H, bid, G); PHASE_END(true)
        PHASE_BEGIN { pg8::Gemm g{H, (const bf16_t*)(ws + W_GU) + (size_t)layer * 5632 * 1024, M, 5632, 1024, 1024, 0, 0}; pg8::StaticOrder S; S.init(M, 5632, G, bid);
            pg8::EpiSwiglu E{(bf16_t*)(ws + WS_HID)}; REP(6) pg8::gemm_phase(lds, g, S, E); } PHASE_END(true)
        PHASE_BEGIN { pg8::Gemm g{(const bf16_t*)(ws + WS_HID), (const bf16_t*)(ws + W_DN) + (size_t)layer * 1024 * DFF, M, 1024, DFF, DFF, 0, 0}; pg8::StaticOrder S; S.init(M, 1024, G, bid);
            pg8::EpiResid E{X, X, modl + 5 * D}; pg8::gemm_phase(lds, g, S, E); } PHASE_END(true)
    }
    PHASE_BEGIN final_norm_phase(X, a.in[22], a.out, bid, G); PHASE_END(false)
}

extern "C" void kernel_launch(void* const* d_in, const int* in_sizes, int n_in, void* d_out, int out_size, void* d_ws, size_t ws_size, hipStream_t stream) {
    static int grid_blocks = 0;
    if (grid_blocks == 0) {
        int dev = 0, cus = 0, per_cu = 0;
        if (n_in != 23 || out_size != M * D || ws_size < WS_END) { fprintf(stderr, "kernel_launch: unexpected problem (n_in %d out %d ws %zu, need ws >= %zu)\n", n_in, out_size, ws_size, (size_t)WS_END); grid_blocks = -1; return; }
        (void)hipGetDevice(&dev);
        (void)hipDeviceGetAttribute(&cus, hipDeviceAttributeMultiprocessorCount, dev);
        (void)hipFuncSetAttribute((const void*)mk_fwd, hipFuncAttributeMaxDynamicSharedMemorySize, LDS_BYTES);
        (void)hipOccupancyMaxActiveBlocksPerMultiprocessor(&per_cu, (const void*)mk_fwd, 512, LDS_BYTES);
        fprintf(stderr, "kernel_launch: cus %d per_cu %d ws %zu\n", cus, per_cu, ws_size);
        if (per_cu < 1) { fprintf(stderr, "kernel_launch: kernel does not fit a CU\n"); grid_blocks = -1; return; }
        grid_blocks = cus;
    }
    if (grid_blocks < 0) return;
    if (hipMemsetAsync((char*)d_ws + WS_BAR, 0, 16384, stream) != hipSuccess) { fprintf(stderr, "kernel_launch: memset failed\n"); return; }
    Args a{};
    for (int i = 0; i < 23; ++i) a.in[i] = (const float*)d_in[i];
    a.out = (float*)d_out; a.ws = (unsigned char*)d_ws; a.ph_lo = 0; a.ph_hi = 1000;
    void* args[] = {&a};
    hipError_t e = hipLaunchCooperativeKernel((const void*)mk_fwd, dim3(grid_blocks), dim3(512), args, LDS_BYTES, stream);
    if (e != hipSuccess) fprintf(stderr, "cooperative launch failed: %s (grid %d)\n", hipGetErrorString(e), grid_blocks);
}
```

```cpp
#include <hip/hip_runtime.h>
#include <hip/hip_cooperative_groups.h>
#include <cstdio>
#include <cstdint>
namespace cg = cooperative_groups;

#define LAS __attribute__((address_space(3)))
typedef unsigned short bf16_t;
typedef short bf16x8 __attribute__((ext_vector_type(8)));
typedef short s16x4 __attribute__((ext_vector_type(4)));
typedef float f32x4 __attribute__((ext_vector_type(4)));
typedef float f32x16 __attribute__((ext_vector_type(16)));
typedef float f32x2 __attribute__((ext_vector_type(2)));
typedef unsigned u32x4 __attribute__((ext_vector_type(4)));
typedef unsigned u32x2 __attribute__((ext_vector_type(2)));

constexpr int D = 1024, NB = 8, T = 4096, M = NB * T, DFF = 2816, NMOD = 6 * D;
constexpr float EPS = 1e-6f;
constexpr int AIN = 1864;
constexpr size_t MiB = 1u << 20;
constexpr size_t WS_MOD = 0;
constexpr size_t WS_MODP = 1 * MiB;
constexpr size_t WS_W = 13 * MiB;
constexpr size_t W_AIN = WS_W;
constexpr size_t W_UK = W_AIN + 8 * MiB;
constexpr size_t W_UV = W_UK + 2 * MiB;
constexpr size_t W_O = W_UV + 2 * MiB;
constexpr size_t W_BIN = W_O + 4 * MiB;
constexpr size_t W_BOUT = W_BIN + 16 * MiB;
constexpr size_t W_GU = W_BOUT + 8 * MiB;
constexpr size_t W_DN = W_GU + 44 * MiB;
constexpr size_t WS_R1 = W_DN + 22 * MiB;
constexpr size_t WS_H = WS_R1;
constexpr size_t WS_Q = WS_R1 + 64 * MiB;
constexpr size_t WS_OLAT = WS_R1;
constexpr size_t WS_R2 = WS_R1 + 128 * MiB;
constexpr size_t WS_QLAT = WS_R2;
constexpr size_t WS_O = WS_R2;
constexpr size_t WS_R3 = WS_R2 + 128 * MiB;
constexpr size_t WS_CKVR = WS_R3;
constexpr size_t WS_CKV = WS_CKVR + 32 * MiB;
constexpr size_t WS_QIDX = WS_CKV + 16 * MiB;
constexpr size_t WS_KRAW = WS_QIDX + 32 * MiB;
constexpr size_t WS_KIDX = WS_KRAW + 16 * MiB;
constexpr size_t WS_WIDX = WS_KIDX + 4 * MiB;
constexpr size_t WS_IDX = WS_WIDX + 1 * MiB;
constexpr size_t WS_END = WS_IDX + 16 * MiB;
constexpr size_t WS_HID = WS_R1 + 64 * MiB;
constexpr size_t WS_U = WS_R1 + 64 * MiB;
constexpr size_t WS_V = WS_U + 128 * MiB;
constexpr size_t WS_STATS = WS_V + 128 * MiB;
static_assert(WS_STATS + 8 * MiB <= WS_END && WS_HID + 176 * MiB <= WS_R3, "ws map");
constexpr int LDS_BYTES = 147456;
constexpr int LDS_MISC = LDS_BYTES - 256;
constexpr size_t WS_BAR = 1 * MiB - 16384;

__device__ __forceinline__ unsigned cvt_pk_bf16(float lo, float hi) { unsigned r; asm volatile("v_cvt_pk_bf16_f32 %0, %1, %2" : "=v"(r) : "v"(lo), "v"(hi)); return r; }
__device__ __forceinline__ float bf2f(unsigned b) { return __uint_as_float(b << 16); }
__device__ __forceinline__ float bf_round(float f) { unsigned u = __float_as_uint(f); u = (u + 0x7fffu + ((u >> 16) & 1u)) & 0xffff0000u; return __uint_as_float(u); }
__device__ __forceinline__ float wave_sum(float v) {
#pragma unroll
    for (int o = 1; o < 64; o <<= 1) v += __shfl_xor(v, o);
    return v;
}
#define LDS_WAIT() asm volatile("s_waitcnt lgkmcnt(0)" ::: "memory")


#define XB_TMO      128
#define XB_XCNT(j)  (256  + 64 * (j))
#define XB_XSUB(j)  (1280 + 64 * (j))
#define XB_XGEN(j)  (2304 + 64 * (j))
#define XB_TOP      3328
#define XB_TOPGEN   3392
#define XCD_BAR_WORDS 3456
#define XB_SPIN_CAP (1u << 22)
__device__ __forceinline__ unsigned xb_ld(unsigned* p)              { return __hip_atomic_load(p, __ATOMIC_RELAXED, __HIP_MEMORY_SCOPE_AGENT); }
__device__ __forceinline__ unsigned xb_add(unsigned* p, unsigned v) { return __hip_atomic_fetch_add(p, v, __ATOMIC_RELAXED, __HIP_MEMORY_SCOPE_AGENT); }
__device__ __forceinline__ unsigned xb_xcc_id() { return (unsigned)__builtin_amdgcn_s_getreg((3 << 11) | 20) & 0xFu; }
#define XB_SPIN(cond, bar) do { unsigned _sp = 0; while (cond) { __builtin_amdgcn_s_sleep(1); \
    if ((++_sp & 255u) == 0u) { if (xb_ld(&(bar)[XB_TMO])) break; if (_sp > XB_SPIN_CAP) { atomicAdd(&(bar)[XB_TMO], 1u); break; } } } } while (0)
struct XcdBarrier { unsigned* bar; unsigned x; volatile LAS unsigned* st; };
__device__ __forceinline__ XcdBarrier xcd_barrier_post(unsigned* bar, volatile LAS unsigned* st) {
    XcdBarrier b; b.bar = bar; b.x = xb_xcc_id(); b.st = st;
    if (threadIdx.x == 0) (void)xb_add(&bar[XB_XCNT(b.x)], 1u);
    return b;
}
__device__ __forceinline__ void xcd_barrier_complete(unsigned* bar, unsigned x, unsigned& nloc, unsigned& nx) {
    const unsigned G = gridDim.x * gridDim.y * gridDim.z;
    unsigned sum, cnt, mine, sp = 0u;
    for (;;) {
        sum = 0u; cnt = 0u; mine = 0u;
#pragma unroll
        for (unsigned j = 0; j < 16; ++j) { const unsigned c = xb_ld(&bar[XB_XCNT(j)]); sum += c; cnt += (c > 0u) ? 1u : 0u; mine = (j == x) ? c : mine; }
        if (sum == G) break;
        __builtin_amdgcn_s_sleep(1);
        if ((++sp & 255u) == 0u) { if (xb_ld(&bar[XB_TMO])) break; if (sp > XB_SPIN_CAP) { atomicAdd(&bar[XB_TMO], 1u); break; } }
    }
    nloc = mine > 0u ? mine : 1u; nx = cnt > 0u ? cnt : 1u;
}
__device__ __forceinline__ void xcd_barrier(const XcdBarrier& b) {
    asm volatile("s_waitcnt vmcnt(0)" ::: "memory");
    __syncthreads();
    if (threadIdx.x == 0) {
        unsigned* bar = b.bar;
        __builtin_amdgcn_s_waitcnt(0);
        unsigned nloc = b.st[0], nx = b.st[1];
        if (nloc == 0u) { xcd_barrier_complete(bar, b.x, nloc, nx); b.st[0] = nloc; b.st[1] = nx; }
        const unsigned old = xb_add(&bar[XB_XSUB(b.x)], 1u);
        const unsigned gen = old / nloc;
        if (old + 1u == (gen + 1u) * nloc) {
            __builtin_amdgcn_fence(__ATOMIC_RELEASE, "agent");
            asm volatile("s_waitcnt vmcnt(0)" ::: "memory");
            const unsigned og = xb_add(&bar[XB_TOP], 1u);
            const unsigned tg = og / nx;
            if (og + 1u == (tg + 1u) * nx) xb_add(&bar[XB_TOPGEN], 1u);
            else XB_SPIN(xb_ld(&bar[XB_TOPGEN]) == tg, bar);
            __builtin_amdgcn_fence(__ATOMIC_ACQUIRE, "agent");
            xb_add(&bar[XB_XGEN(b.x)], 1u);
            asm volatile("s_waitcnt vmcnt(0)" ::: "memory");
        } else {
            XB_SPIN(xb_ld(&bar[XB_XGEN(b.x)]) == gen, bar);
            __builtin_amdgcn_fence(__ATOMIC_ACQUIRE, "agent");
            asm volatile("s_waitcnt vmcnt(0)" ::: "memory");
        }
    }
    __syncthreads();
}

namespace pg8 {
constexpr int BM = 256, BK = 64, HALF = 128, HTB = HALF * BK * 2, STAGE_BYTES = 8 * HTB, NXCD = 8, WGM = 8;
__host__ __device__ __forceinline__ int lds_byte(int r, int c) { const int st = (r >> 4) * 2 + (c >> 5), rr = r & 15, cc = c & 31, ob = rr * 64 + cc * 2; return st * 1024 + (ob ^ (((ob >> 9) & 1) << 5)); }
__host__ __device__ __forceinline__ void stage_rc(int b, int& R, int& C) { const int st = b / 1024, sb = b % 1024, swz = sb ^ (((sb >> 9) & 1) << 5); R = (st >> 1) * 16 + swz / 64; C = (st & 1) * 32 + (swz % 64) / 2; }
__host__ __device__ __forceinline__ int perm32(int rho) { const int n = rho >> 4, i = rho & 15; return 8 * (i >> 2) + 4 * n + (i & 3); }

struct Unit { int pm, pn; };
struct Gemm { const bf16_t* A; const bf16_t* Bt; int M, N, K, lda, agrp_shift, agrp_stride; };

struct StaticOrder {
    int nM, nN, nwg, G, c;
    __device__ void init(int M_, int N_, int G_, int c_) { nM = M_ / BM; nN = N_ / BM; nwg = nM * nN; G = G_; c = c_; }
    __device__ bool next(int i, Unit& u) const {
        const long L = (long)i * G + c; if (L >= nwg) return false;
        int wgid = (int)L; { const int q = nwg / NXCD, r = nwg % NXCD, xcd = wgid % NXCD, off = wgid / NXCD; wgid = (xcd < r ? xcd * (q + 1) : r * (q + 1) + (xcd - r) * q) + off; }
        const int nig = WGM * nN, gid = wgid / nig, fm = gid * WGM, gsz = (nM - fm) < WGM ? (nM - fm) : WGM;
        u.pm = fm + ((wgid % nig) % gsz); u.pn = (wgid % nig) / gsz; return true;
    }
};

typedef f32x4 Acc[2][2][4][2];

__device__ __forceinline__ f32x2 gelu_pk(f32x2 v) {
    const f32x2 av = __builtin_elementwise_abs(v), d = av * 0.2316418882f + 1.0f;
    f32x2 t; t.x = __builtin_amdgcn_rcpf(d.x); t.y = __builtin_amdgcn_rcpf(d.y);
    f32x2 q = t * 0.5307027145f + (-0.7265760135f); q = q * t + 0.7107068705f; q = q * t + (-0.142248368f); q = q * t + 0.127414796f; q = q * t;
    const f32x2 s = (v * v) * (-0.72134752044f);
    f32x2 e; e.x = __builtin_amdgcn_exp2f(s.x); e.y = __builtin_amdgcn_exp2f(s.y);
    const f32x2 m = v * (q * e), r = v - m;
    f32x2 o; o.x = v.x < 0.f ? m.x : r.x; o.y = v.y < 0.f ? m.y : r.y; return o;
}
__device__ __forceinline__ f32x4 gelu4(f32x4 v) { f32x2 a = gelu_pk((f32x2){v[0], v[1]}), b = gelu_pk((f32x2){v[2], v[3]}); return (f32x4){a.x, a.y, b.x, b.y}; }
__device__ __forceinline__ u32x4 pack8(f32x4 v0, f32x4 v1) { u32x4 w; w.x = cvt_pk_bf16(v0[0], v0[1]); w.y = cvt_pk_bf16(v0[2], v0[3]); w.z = cvt_pk_bf16(v1[0], v1[1]); w.w = cvt_pk_bf16(v1[2], v1[3]); return w; }

struct EpiInproj {
    bf16_t* Q; float* CKVR; bf16_t* QIDX; float* KRAW;
    __device__ __forceinline__ void operator()(const Acc& acc, const Unit& u, int wr, int wc, int fr, int fq) const {
        const int row0 = u.pm * BM + wr * 64 + fr, cl = wc * 32 + 8 * fq;
#pragma unroll
        for (int ai = 0; ai < 2; ++ai)
#pragma unroll
            for (int m = 0; m < 4; ++m) { const size_t row = (size_t)(row0 + ai * HALF + m * 16);
#pragma unroll
                for (int bj = 0; bj < 2; ++bj) { const f32x4 v0 = acc[ai][bj][m][0], v1 = acc[ai][bj][m][1]; const int c = bj * HALF + cl;
                    if (u.pn < 4) *(u32x4*)(Q + row * 1024 + u.pn * 256 + c) = pack8(v0, v1);
                    else if (u.pn == 4) { float* p = CKVR + row * 256 + c; *(f32x4*)p = v0; *(f32x4*)(p + 4) = v1; }
                    else if (u.pn < 7) *(u32x4*)(QIDX + row * 512 + (u.pn - 5) * 256 + c) = pack8(v0, v1);
                    else if (bj == 0) { float* p = KRAW + row * 128 + c; *(f32x4*)p = v0; *(f32x4*)(p + 4) = v1; } } }
    }
};
struct EpiBf16 {
    bf16_t* O; int ldc; float scale; int fp8;
    __device__ __forceinline__ void operator()(const Acc& acc, const Unit& u, int wr, int wc, int fr, int fq) const {
        const int row0 = u.pm * BM + wr * 64 + fr, col0 = u.pn * BM + wc * 32 + 8 * fq;
        if (fp8) {
#pragma unroll
            for (int ai = 0; ai < 2; ++ai)
#pragma unroll
                for (int m = 0; m < 4; ++m) { unsigned char* rowp = (unsigned char*)O + (size_t)(row0 + ai * HALF + m * 16) * ldc + col0;
#pragma unroll
                    for (int bj = 0; bj < 2; ++bj) { const f32x4 v0 = acc[ai][bj][m][0] * scale, v1 = acc[ai][bj][m][1] * scale; int w0 = 0, w1 = 0;
                        w0 = __builtin_amdgcn_cvt_pk_fp8_f32(v0[0], v0[1], w0, false); w0 = __builtin_amdgcn_cvt_pk_fp8_f32(v0[2], v0[3], w0, true);
                        w1 = __builtin_amdgcn_cvt_pk_fp8_f32(v1[0], v1[1], w1, false); w1 = __builtin_amdgcn_cvt_pk_fp8_f32(v1[2], v1[3], w1, true);
                        *(u32x2*)(rowp + bj * HALF) = (u32x2){(unsigned)w0, (unsigned)w1}; } }
            return; }
#pragma unroll
        for (int ai = 0; ai < 2; ++ai)
#pragma unroll
            for (int m = 0; m < 4; ++m) { bf16_t* rowp = O + (size_t)(row0 + ai * HALF + m * 16) * ldc + col0;
#pragma unroll
                for (int bj = 0; bj < 2; ++bj) *(u32x4*)(rowp + bj * HALF) = pack8(acc[ai][bj][m][0] * scale, acc[ai][bj][m][1] * scale); }
    }
};
struct EpiResid {
    const float* xin; float* xout; const float* gate;
    __device__ __forceinline__ void operator()(const Acc& acc, const Unit& u, int wr, int wc, int fr, int fq) const {
        const int row0 = u.pm * BM + wr * 64 + fr, col0 = u.pn * BM + wc * 32 + 8 * fq;
        const float* gp = gate + (size_t)(u.pm >> 4) * NMOD + col0;
        f32x4 gv[2][2];
#pragma unroll
        for (int bj = 0; bj < 2; ++bj)
#pragma unroll
            for (int n = 0; n < 2; ++n) gv[bj][n] = *(const f32x4*)(gp + bj * HALF + 4 * n);
#pragma unroll
        for (int ai = 0; ai < 2; ++ai)
#pragma unroll
            for (int m = 0; m < 4; ++m) { const size_t off = (size_t)(row0 + ai * HALF + m * 16) * D + col0;
#pragma unroll
                for (int bj = 0; bj < 2; ++bj)
#pragma unroll
                    for (int n = 0; n < 2; ++n) { const f32x4 xo = *(const f32x4*)(xin + off + bj * HALF + 4 * n);
                        *(f32x4*)(xout + off + bj * HALF + 4 * n) = xo + gv[bj][n] * acc[ai][bj][m][n]; } }
    }
};
struct EpiGelu {
    bf16_t* U; bf16_t* V; f32x2* STATS;
    __device__ __forceinline__ void operator()(const Acc& acc, const Unit& u, int wr, int wc, int fr, int fq) const {
        const int row0 = u.pm * BM + wr * 64 + fr, cl = wc * 32 + 8 * fq;
        const bool isv = u.pn >= 8; bf16_t* base = isv ? V + (u.pn - 8) * 256 : U + u.pn * 256;
#pragma unroll
        for (int ai = 0; ai < 2; ++ai)
#pragma unroll
            for (int m = 0; m < 4; ++m) { const size_t row = (size_t)(row0 + ai * HALF + m * 16); float s = 0.f, ss = 0.f;
#pragma unroll
                for (int bj = 0; bj < 2; ++bj) { const f32x4 v0 = gelu4(acc[ai][bj][m][0]), v1 = gelu4(acc[ai][bj][m][1]);
                    *(u32x4*)(base + row * 2048 + bj * HALF + cl) = pack8(v0, v1);
                    s += (v0[0] + v0[1]) + (v0[2] + v0[3]) + (v1[0] + v1[1]) + (v1[2] + v1[3]);
                    ss += (v0[0] * v0[0] + v0[1] * v0[1]) + (v0[2] * v0[2] + v0[3] * v0[3]) + (v1[0] * v1[0] + v1[1] * v1[1]) + (v1[2] * v1[2] + v1[3] * v1[3]); }
                if (isv) { s += __shfl_xor(s, 16); ss += __shfl_xor(ss, 16); s += __shfl_xor(s, 32); ss += __shfl_xor(ss, 32);
                    if (fq == 0) STATS[row * 32 + (u.pn - 8) * 4 + wc] = (f32x2){s, ss}; } }
    }
};
struct EpiSwiglu {
    bf16_t* HID;
    __device__ __forceinline__ void operator()(const Acc& acc, const Unit& u, int wr, int wc, int fr, int fq) const {
        const int row0 = u.pm * BM + wr * 64 + fr, col0 = u.pn * 128 + wc * 32 + 8 * fq;
#pragma unroll
        for (int ai = 0; ai < 2; ++ai)
#pragma unroll
            for (int m = 0; m < 4; ++m) { f32x4 h[2];
#pragma unroll
                for (int n = 0; n < 2; ++n) { const f32x4 g = acc[ai][0][m][n], up = acc[ai][1][m][n];
#pragma unroll
                    for (int j = 0; j < 4; ++j) h[n][j] = g[j] * __builtin_amdgcn_rcpf(1.0f + __expf(-g[j])) * up[j]; }
                *(u32x4*)(HID + (size_t)(row0 + ai * HALF + m * 16) * DFF + col0) = pack8(h[0], h[1]); }
    }
};

template <class Epi>
__device__ __forceinline__ void gemm_phase(LAS unsigned char* lds, const Gemm g, const StaticOrder& S, const Epi& E) {
    int tid = threadIdx.x; asm volatile("" : "+v"(tid));
    const int wid = __builtin_amdgcn_readfirstlane(tid >> 6), lane = tid & 63, wr = wid >> 2, wc = wid & 3, fr = lane & 15, fq = lane >> 4;
    const int K = g.K, nt = K / BK, lda = g.lda;
    unsigned voffA[2], voffB[2];
#pragma unroll
    for (int i = 0; i < 2; ++i) { int R, C; stage_rc(tid * 16 + i * 8192, R, C); const int Rb = (R & ~31) + perm32(R & 31);
        voffA[i] = (unsigned)(R * lda + C) * 2u; voffB[i] = (unsigned)(Rb * K + C) * 2u; }
    const size_t kstep = (size_t)(BK * 2);
    const size_t hstepA = (size_t)HALF * lda * 2, hstepB = (size_t)HALF * K * 2;
    const unsigned ldsw = (unsigned)wid * 1024u;
    const int aoff = lds_byte(wr * 64 + fr, fq * 8), boff = lds_byte(wc * 32 + fr, fq * 8);
#define PG8_SA(b, h) (((b) * 2 + (h)) * HTB)
#define PG8_SB(b, h) ((4 + (b) * 2 + (h)) * HTB)
#define PG8_STAGE(bufoff, gbase, voff) do { _Pragma("unroll") for (int _i = 0; _i < 2; ++_i) \
        __builtin_amdgcn_global_load_lds((const unsigned*)((const char*)(gbase) + (voff)[_i]), (LAS unsigned*)(lds + (bufoff) + ldsw + _i * 8192), 16, 0, 0); } while (0)
#define PG8_LDA(dst, b, h) do { _Pragma("unroll") for (int m = 0; m < 4; ++m) _Pragma("unroll") for (int k = 0; k < 2; ++k) dst[m][k] = *(const LAS bf16x8*)(lds + PG8_SA(b, h) + aoff + m * 2048 + k * 1024); } while (0)
#define PG8_LDB(dst, b, h) do { _Pragma("unroll") for (int n = 0; n < 2; ++n) _Pragma("unroll") for (int k = 0; k < 2; ++k) dst[n][k] = *(const LAS bf16x8*)(lds + PG8_SB(b, h) + boff + n * 2048 + k * 1024); } while (0)
#define PG8_MMA(ai, bj, At, Bt) do { __builtin_amdgcn_s_setprio(1); _Pragma("unroll") for (int m = 0; m < 4; ++m) _Pragma("unroll") for (int n = 0; n < 2; ++n) _Pragma("unroll") for (int k = 0; k < 2; ++k) \
        acc[ai][bj][m][n] = __builtin_amdgcn_mfma_f32_16x16x32_bf16(Bt[n][k], At[m][k], acc[ai][bj][m][n], 0, 0, 0); __builtin_amdgcn_s_setprio(0); } while (0)
#define PG8_WAIT_V(n) asm volatile("s_waitcnt vmcnt(" #n ")" ::: "memory")
#define PG8_WAIT_L(n) asm volatile("s_waitcnt lgkmcnt(" #n ")" ::: "memory")
#define PG8_BAR __builtin_amdgcn_s_barrier()
#define PG8_SCHED __builtin_amdgcn_sched_barrier(0)
#define PG8_ABASE(u) ((const char*)g.A + ((size_t)(u).pm * BM * lda + (size_t)((u).pn >> g.agrp_shift) * g.agrp_stride) * 2)
#define PG8_BBASE(u) ((const char*)g.Bt + (size_t)(u).pn * 2 * hstepB)
    Unit cur, nxt; int ui = 0;
    if (!S.next(0, cur)) return;
    Acc acc;
#pragma unroll
    for (int a = 0; a < 2; ++a)
#pragma unroll
        for (int b = 0; b < 2; ++b)
#pragma unroll
            for (int m = 0; m < 4; ++m)
#pragma unroll
                for (int n = 0; n < 2; ++n) acc[a][b][m][n] = (f32x4){0.f, 0.f, 0.f, 0.f};
    bf16x8 At[4][2], B0[2][2], B1[2][2];
    const char* cA = PG8_ABASE(cur); const char* cB = PG8_BBASE(cur);
    PG8_STAGE(PG8_SB(0, 0), cB, voffB); PG8_STAGE(PG8_SB(0, 1), cB + hstepB, voffB); PG8_STAGE(PG8_SA(0, 0), cA, voffA); PG8_STAGE(PG8_SA(0, 1), cA + hstepA, voffA);
    if (wr == 1) PG8_BAR;
    PG8_WAIT_V(2); PG8_BAR;
    PG8_STAGE(PG8_SB(1, 0), cB + kstep, voffB); PG8_STAGE(PG8_SA(1, 0), cA + kstep, voffA); PG8_STAGE(PG8_SB(1, 1), cB + hstepB + kstep, voffB);
    PG8_WAIT_V(6); PG8_BAR;
    for (;;) {
        const bool has_next = S.next(ui + 1, nxt);
        const char* nA = has_next ? PG8_ABASE(nxt) : cA; const char* nB = has_next ? PG8_BBASE(nxt) : cB;
        for (int t = 0; t < nt; t += 2) {
            const bool last = (t == nt - 2);
            const char* a1 = cA + (size_t)(t + 1) * kstep;
            const char* a2 = last ? nA : cA + (size_t)(t + 2) * kstep; const char* b2 = last ? nB : cB + (size_t)(t + 2) * kstep;
            const char* a3 = a2 + kstep; const char* b3 = b2 + kstep;
            PG8_LDB(B0, 0, 0); PG8_LDB(B1, 0, 1); PG8_SCHED; PG8_LDA(At, 0, 0); PG8_STAGE(PG8_SA(1, 1), a1 + hstepA, voffA);
            PG8_WAIT_V(8); PG8_WAIT_L(0); PG8_BAR; PG8_MMA(0, 0, At, B0); PG8_MMA(0, 1, At, B1); PG8_BAR; PG8_SCHED;
            PG8_LDA(At, 0, 1); PG8_STAGE(PG8_SB(0, 0), b2, voffB); PG8_STAGE(PG8_SB(0, 1), b2 + hstepB, voffB); PG8_STAGE(PG8_SA(0, 0), a2, voffA);
            PG8_WAIT_V(8); PG8_WAIT_L(0); PG8_BAR; PG8_MMA(1, 0, At, B0); PG8_MMA(1, 1, At, B1); PG8_BAR; PG8_SCHED;
            PG8_LDB(B0, 1, 0); PG8_LDB(B1, 1, 1); PG8_SCHED; PG8_LDA(At, 1, 0); PG8_STAGE(PG8_SA(0, 1), a2 + hstepA, voffA);
            PG8_WAIT_V(8); PG8_WAIT_L(0); PG8_BAR; PG8_MMA(0, 0, At, B0); PG8_MMA(0, 1, At, B1); PG8_BAR; PG8_SCHED;
            PG8_LDA(At, 1, 1); PG8_STAGE(PG8_SB(1, 0), b3, voffB); PG8_STAGE(PG8_SB(1, 1), b3 + hstepB, voffB); PG8_STAGE(PG8_SA(1, 0), a3, voffA);
            PG8_WAIT_V(8); PG8_WAIT_L(0); PG8_BAR; PG8_MMA(1, 0, At, B0); PG8_MMA(1, 1, At, B1); PG8_BAR; PG8_SCHED;
        }
        if (wr == 0) PG8_BAR;
        E(acc, cur, wr, wc, fr, fq);
        if (!has_next) break;
#pragma unroll
        for (int a = 0; a < 2; ++a)
#pragma unroll
            for (int b = 0; b < 2; ++b)
#pragma unroll
                for (int m = 0; m < 4; ++m)
#pragma unroll
                    for (int n = 0; n < 2; ++n) acc[a][b][m][n] = (f32x4){0.f, 0.f, 0.f, 0.f};
        cur = nxt; cA = nA; cB = nB; ++ui;
        if (wr == 1) PG8_BAR;
    }
    PG8_WAIT_V(0);
    PG8_BAR;
#undef PG8_SA
#undef PG8_SB
#undef PG8_STAGE
#undef PG8_LDA
#undef PG8_LDB
#undef PG8_MMA
#undef PG8_WAIT_V
#undef PG8_WAIT_L
#undef PG8_BAR
#undef PG8_SCHED
#undef PG8_ABASE
#undef PG8_BBASE
}
}

struct Args { const float* in[23]; float* out; unsigned char* ws; int ph_lo, ph_hi; };

__device__ __forceinline__ void cvt_item(const float* src, int K, int N, bf16_t* dst, int ldd, int mode, int r0, int c0, LAS float* scr, int li, int lane) {
    const int nblk = (N + 31) >> 5, kb = li / nblk, nb = li % nblk, k0 = 64 * kb, n0 = 32 * nb;
    { const int n = n0 + (lane & 31);
#pragma unroll 8
      for (int i = 0; i < 32; ++i) { const int kk = 2 * i + (lane >> 5); scr[kk * 33 + (lane & 31)] = (n < N) ? src[(size_t)(k0 + kk) * N + n] : 0.f; } }
    LDS_WAIT();
    const int c = lane & 7;
#pragma unroll
    for (int j = 0; j < 4; ++j) { const int nl = (lane >> 3) + 8 * j, n = n0 + nl; const LAS float* s = scr + (8 * c) * 33 + nl;
        u32x4 o; o.x = cvt_pk_bf16(s[0 * 33], s[1 * 33]); o.y = cvt_pk_bf16(s[2 * 33], s[3 * 33]); o.z = cvt_pk_bf16(s[4 * 33], s[5 * 33]); o.w = cvt_pk_bf16(s[6 * 33], s[7 * 33]);
        if (n < N) { const int drow = mode ? ((n >> 7) * 256 + (n & 127) + r0) : (r0 + n); *(u32x4*)(dst + (size_t)drow * ldd + c0 + k0 + 8 * c) = o; } }
    LDS_WAIT();
}

__device__ __forceinline__ void p0_phase(const Args& a, LAS unsigned char* lds, int bid, int G) {
    int tid = threadIdx.x; asm volatile("" : "+v"(tid));
    const int lane = tid & 63, wave = __builtin_amdgcn_readfirstlane(tid >> 6);
    unsigned char* ws = a.ws;
    LAS float* scr = (LAS float*)(lds + wave * 8704);
    const int gw = bid * 8 + wave, NGW = G * 8;
    constexpr int NITEMS = 1888 + 256 + 256 + 1024 + 4096 + 2048 + 11264 + 5632;
    for (int it = gw; it < NITEMS; it += NGW) {
        int r = it;
        if (r < 1888) { const int j = r / 944; cvt_item(a.in[6] + (size_t)j * 1024 * AIN, 1024, AIN, (bf16_t*)(ws + W_AIN) + (size_t)j * 2048 * 1024, 1024, 0, 0, 0, scr, r % 944, lane); continue; } r -= 1888;
        if (r < 256) { const int jj = r >> 4, la = jj >> 3, h = jj & 7; cvt_item(a.in[10] + (size_t)(la * 8 + h) * 128 * 256, 128, 256, (bf16_t*)(ws + W_UK) + (size_t)la * 2048 * 256, 256, 0, h * 256, (h & 1) * 128, scr, r & 15, lane); continue; } r -= 256;
        if (r < 256) { const int jj = r >> 4, la = jj >> 3, h = jj & 7; cvt_item(a.in[11] + (size_t)(la * 8 + h) * 256 * 128, 256, 128, (bf16_t*)(ws + W_UV) + (size_t)la * 1024 * 512, 512, 0, (h >> 1) * 256 + (h & 1) * 128, (h & 1) * 256, scr, r & 15, lane); continue; } r -= 256;
        if (r < 1024) { const int la = r >> 9; cvt_item(a.in[12] + (size_t)la * 1024 * 1024, 1024, 1024, (bf16_t*)(ws + W_O) + (size_t)la * 1024 * 1024, 1024, 0, 0, 0, scr, r & 511, lane); continue; } r -= 1024;
        if (r < 4096) { const int la = r >> 11; cvt_item(a.in[13] + (size_t)la * 1024 * 4096, 1024, 4096, (bf16_t*)(ws + W_BIN) + (size_t)la * 4096 * 1024, 1024, 0, 0, 0, scr, r & 2047, lane); continue; } r -= 4096;
        if (r < 2048) { const int la = r >> 10; cvt_item(a.in[18] + (size_t)la * 2048 * 1024, 2048, 1024, (bf16_t*)(ws + W_BOUT) + (size_t)la * 1024 * 2048, 2048, 0, 0, 0, scr, r & 1023, lane); continue; } r -= 2048;
        if (r < 11264) { const int jj = r / 1408, l = jj & 3, isup = jj >> 2; cvt_item(a.in[isup ? 20 : 19] + (size_t)l * 1024 * DFF, 1024, DFF, (bf16_t*)(ws + W_GU) + (size_t)l * 5632 * 1024, 1024, 1, isup * 128, 0, scr, r % 1408, lane); continue; } r -= 11264;
        { const int l = r / 1408; cvt_item(a.in[21] + (size_t)l * DFF * 1024, DFF, 1024, (bf16_t*)(ws + W_DN) + (size_t)l * 1024 * DFF, DFF, 0, 0, 0, scr, r % 1408, lane); }
    }
    const size_t gt = (size_t)bid * 512 + tid, NT = (size_t)G * 512;
    const u32x4 z = (u32x4){0u, 0u, 0u, 0u};
    for (size_t i = gt; i < 2 * 184 * 128; i += NT) { const int j = (int)(i / (184 * 128)), rem = (int)(i % (184 * 128)), rr = AIN + rem / 128, ch = rem % 128;
        *(u32x4*)((bf16_t*)(ws + W_AIN) + ((size_t)j * 2048 + rr) * 1024 + ch * 8) = z; }
    for (size_t i = gt; i < 2 * 2048 * 16; i += NT) { const int j = (int)(i / (2048 * 16)), rem = (int)(i % (2048 * 16)), rr = rem >> 4, ch = rem & 15, h = rr >> 8;
        *(u32x4*)((bf16_t*)(ws + W_UK) + ((size_t)j * 2048 + rr) * 256 + (1 - (h & 1)) * 128 + ch * 8) = z; }
    for (size_t i = gt; i < 2 * 1024 * 32; i += NT) { const int j = (int)(i / (1024 * 32)), rem = (int)(i % (1024 * 32)), rr = rem >> 5, ch = rem & 31, hh = (rr >> 7) & 1;
        *(u32x4*)((bf16_t*)(ws + W_UV) + ((size_t)j * 1024 + rr) * 512 + (1 - hh) * 256 + ch * 8) = z; }
    __syncthreads();
    LAS float* ca = (LAS float*)lds;
    const float* cvec = a.in[1]; const float* modw = a.in[2]; float* MODP = (float*)(ws + WS_MODP);
    for (int it = bid; it < 768; it += G) {
        const int l = it / 192, rem = it % 192, ng = rem >> 4, kc = rem & 15;
        { const int b = tid >> 6, k = tid & 63; const float cv = cvec[b * 1024 + kc * 64 + k]; ca[b * 64 + k] = cv / (1.0f + __expf(-cv)); }
        __syncthreads();
        const int n = ng * 512 + tid; float acc[8];
#pragma unroll
        for (int b = 0; b < 8; ++b) acc[b] = 0.f;
        const float* wp = modw + ((size_t)l * 1024 + kc * 64) * NMOD + n;
#pragma unroll 8
        for (int k = 0; k < 64; ++k) { const float w = wp[(size_t)k * NMOD];
#pragma unroll
            for (int b = 0; b < 8; ++b) acc[b] += ca[b * 64 + k] * w; }
#pragma unroll
        for (int b = 0; b < 8; ++b) MODP[((size_t)(kc * 4 + l) * 8 + b) * NMOD + n] = acc[b];
        __syncthreads();
    }
}
__device__ __forceinline__ void p0c_phase(const Args& a, int bid, int G) {
    const float* MODP = (const float*)(a.ws + WS_MODP); float* MOD = (float*)(a.ws + WS_MOD); const float* modb = a.in[3];
    int tid0 = threadIdx.x; asm volatile("" : "+v"(tid0));
    for (int i = bid * 512 + tid0; i < 4 * 8 * NMOD; i += G * 512) { const int l = i / (8 * NMOD), n = i % NMOD; float s = modb[l * NMOD + n];
#pragma unroll
        for (int kc = 0; kc < 16; ++kc) s += MODP[(size_t)kc * (4 * 8 * NMOD) + i];
        MOD[i] = s; }
}

__device__ __forceinline__ void norm_mod_phase(const float* x, const float* gain, const float* sh, const float* sc, bf16_t* H, int bid, int G) {
    int tid = threadIdx.x; asm volatile("" : "+v"(tid));
    const int lane = tid & 63, wave = tid >> 6;
    for (int rb = (bid * 8 + wave) * 16; rb < M; rb += G * 8 * 16) {
        const int b = rb / T; f32x4 gs[4], sv[4];
#pragma unroll
        for (int j = 0; j < 4; ++j) { const int c = 4 * lane + 256 * j; const f32x4 g4 = *(const f32x4*)(gain + c), s4 = *(const f32x4*)(sc + (size_t)b * NMOD + c); gs[j] = g4 * (s4 + 1.0f); sv[j] = *(const f32x4*)(sh + (size_t)b * NMOD + c); }
        for (int r = rb; r < rb + 16; ++r) {
            const f32x4* xr = (const f32x4*)(x + (size_t)r * D) + lane; f32x4 v[4]; float ss = 0.f;
#pragma unroll
            for (int j = 0; j < 4; ++j) { v[j] = xr[64 * j]; ss += (v[j][0] * v[j][0] + v[j][1] * v[j][1]) + (v[j][2] * v[j][2] + v[j][3] * v[j][3]); }
            const float rstd = rsqrtf(wave_sum(ss) * (1.0f / D) + EPS);
            u32x2* o = (u32x2*)(H + (size_t)r * D) + lane;
#pragma unroll
            for (int j = 0; j < 4; ++j) { const f32x4 y = v[j] * rstd * gs[j] + sv[j]; u32x2 w; w.x = cvt_pk_bf16(y[0], y[1]); w.y = cvt_pk_bf16(y[2], y[3]); o[64 * j] = w; }
        }
    }
}
__device__ __forceinline__ void final_norm_phase(const float* x, const float* gain, float* out, int bid, int G) {
    int tid = threadIdx.x; asm volatile("" : "+v"(tid));
    const int lane = tid & 63, wave = tid >> 6;
    f32x4 gs[4];
#pragma unroll
    for (int j = 0; j < 4; ++j) gs[j] = *(const f32x4*)(gain + 4 * lane + 256 * j);
    for (int r = bid * 8 + wave; r < M; r += G * 8) {
        const f32x4* xr = (const f32x4*)(x + (size_t)r * D) + lane; f32x4 v[4]; float ss = 0.f;
#pragma unroll
        for (int j = 0; j < 4; ++j) { v[j] = xr[64 * j]; ss += (v[j][0] * v[j][0] + v[j][1] * v[j][1]) + (v[j][2] * v[j][2] + v[j][3] * v[j][3]); }
        const float rstd = rsqrtf(wave_sum(ss) * (1.0f / D) + EPS);
        f32x4* o = (f32x4*)(out + (size_t)r * D) + lane;
#pragma unroll
        for (int j = 0; j < 4; ++j) o[64 * j] = v[j] * rstd * gs[j];
    }
}
__device__ __forceinline__ void dsa_rows_phase(const float* CKVR, const float* KRAW, const float* gkv, const float* gk, const float* bk, bf16_t* CKV, bf16_t* KIDX, float* WIDX, int bid, int G) {
    int tid = threadIdx.x; asm volatile("" : "+v"(tid));
    const int lane = tid & 63, wave = tid >> 6;
    const f32x4 g4 = *(const f32x4*)(gkv + 4 * lane);
    f32x4 gk4 = (f32x4){0.f, 0.f, 0.f, 0.f}, bk4 = gk4;
    if (lane < 16) { gk4 = *(const f32x4*)(gk + 4 * lane); bk4 = *(const f32x4*)(bk + 4 * lane); }
    for (int r = bid * 8 + wave; r < M; r += G * 8) {
        const f32x4 v = *(const f32x4*)(CKVR + (size_t)r * 256 + 4 * lane);
        f32x4 kv = (f32x4){0.f, 0.f, 0.f, 0.f}; if (lane < 32) kv = *(const f32x4*)(KRAW + (size_t)r * 128 + 4 * lane);
        const float ss = wave_sum((v[0] * v[0] + v[1] * v[1]) + (v[2] * v[2] + v[3] * v[3]));
        const float rstd = rsqrtf(ss * (1.0f / 256.0f) + EPS);
        { const f32x4 y = v * rstd * g4; int w = 0; w = __builtin_amdgcn_cvt_pk_fp8_f32(y[0], y[1], w, false); w = __builtin_amdgcn_cvt_pk_fp8_f32(y[2], y[3], w, true); *(int*)((unsigned char*)CKV + (size_t)r * 256 + 4 * lane) = w; }
        const float ks = (lane < 16) ? (kv[0] + kv[1]) + (kv[2] + kv[3]) : 0.f;
        const float mean = wave_sum(ks) * (1.0f / 64.0f);
        const f32x4 dv = kv - mean;
        const float kq = (lane < 16) ? (dv[0] * dv[0] + dv[1] * dv[1]) + (dv[2] * dv[2] + dv[3] * dv[3]) : 0.f;
        const float krstd = rsqrtf(wave_sum(kq) * (1.0f / 64.0f) + EPS);
        if (lane < 16) { const f32x4 y = dv * krstd * gk4 + bk4; u32x2 w; w.x = cvt_pk_bf16(y[0], y[1]); w.y = cvt_pk_bf16(y[2], y[3]); *(u32x2*)(KIDX + (size_t)r * 64 + 4 * lane) = w; }
        else if (lane < 18) { *(f32x4*)(WIDX + (size_t)r * 8 + 4 * (lane - 16)) = kv * 0.04419417382f; }
    }
}

__device__ __forceinline__ float relu_mul(float x, float w) { return __builtin_amdgcn_fmed3f(x, 0.f, __builtin_inff()) * w; }
__device__ __forceinline__ float relu_fma(float x, float w, float acc) { return __builtin_fmaf(__builtin_amdgcn_fmed3f(x, 0.f, __builtin_inff()), w, acc); }
__device__ __forceinline__ float fmin_raw(float a, float b) { return __builtin_amdgcn_fmed3f(a, b, -__builtin_inff()); }
__device__ __forceinline__ float fmax_raw(float a, float b) { return __builtin_amdgcn_fmed3f(a, b, __builtin_inff()); }
__device__ __forceinline__ unsigned mbcnt64(unsigned long long m) { return __builtin_amdgcn_mbcnt_hi((unsigned)(m >> 32), __builtin_amdgcn_mbcnt_lo((unsigned)m, 0u)); }

template <int SHIFT, int WIDTH>
__device__ __forceinline__ void sel_level(const unsigned (&k)[64], int N, LAS unsigned* hist, int lane, unsigned& prefix, unsigned& need) {
    LAS u32x4* hz = (LAS u32x4*)(hist + 32 * lane);
#pragma unroll
    for (int j = 0; j < 8; ++j) hz[j] = (u32x4){0u, 0u, 0u, 0u};
    LDS_WAIT();
#pragma unroll
    for (int gi = 0; gi < 8; ++gi) if (512 * gi < N) {
#pragma unroll
        for (int ii = 0; ii < 8; ++ii) { const unsigned key = k[8 * gi + ii]; const bool ok = (key >> (SHIFT + WIDTH)) == prefix;
            LAS unsigned* p = ok ? hist + ((key >> SHIFT) & ((1u << WIDTH) - 1u)) : hist + 2048 + lane;
            __hip_atomic_fetch_add(p, 1u, __ATOMIC_RELAXED, __HIP_MEMORY_SCOPE_WORKGROUP); } }
    LDS_WAIT();
    u32x4 hv[8]; unsigned ls = 0u;
#pragma unroll
    for (int j = 0; j < 8; ++j) { hv[j] = hz[j]; ls += (hv[j][0] + hv[j][1]) + (hv[j][2] + hv[j][3]); }
    unsigned incl = ls;
#pragma unroll
    for (int o = 1; o < 64; o <<= 1) { const unsigned v = __shfl_down(incl, o); if (lane + o < 64) incl += v; }
    const unsigned above = incl - ls;
    unsigned cnt = above, d = 0u, nn = 0u;
#pragma unroll
    for (int j = 31; j >= 0; --j) { const unsigned h = hv[j >> 2][j & 3]; const bool hit = (cnt < need) && (need <= cnt + h); d = hit ? (unsigned)(32 * lane + j) : d; nn = hit ? need - cnt : nn; cnt += h; }
    const bool found = (above < need) && (need <= above + ls);
    const unsigned long long fm = __ballot(found);
    const int src = (fm != 0ull) ? (__ffsll((long long)fm) - 1) : 0;
    d = __shfl(d, src); need = __shfl(nn, src);
    prefix = (prefix << WIDTH) | d;
}

__device__ __forceinline__ void dsa_select_phase(LAS unsigned char* lds, const bf16_t* QIDX, const bf16_t* KIDX, const float* WIDX, unsigned short* IDX, int bid, int G) {
    int tid0 = threadIdx.x; asm volatile("" : "+v"(tid0));
    const int wave = __builtin_amdgcn_readfirstlane(tid0 >> 6);
    LAS float* SC = (LAS float*)lds;
    LAS unsigned short* IDXL = (LAS unsigned short*)(lds + 135168) + wave * 256;
    LAS float* MM = (LAS float*)(lds + 139264);
    bf16x8 af[2][4]; bf16x8 kb[4][4];
#define DSA_UNIT(itx, b_, t0_, mb_, ntile_, nj_) const int b_ = (itx) & 7, t0_ = ((itx) >> 3) * 8; const size_t mb_ = (size_t)b_ * T; \
    const int ntile_ = (t0_ + 8 + 31) >> 5; const int nj_ = (wave < ntile_) ? ((ntile_ - wave + 7) >> 3) : 0;
#define DSA_KLOAD(buf, j, kbase_, nj_) do { const int jc_ = ((j) < (nj_)) ? (j) : ((nj_) > 0 ? (nj_) - 1 : 0); const bf16_t* kp_ = (kbase_) + (size_t)(32 * (wave + 8 * jc_)) * 64; \
    _Pragma("unroll") for (int ks = 0; ks < 4; ++ks) kb[buf][ks] = *(const bf16x8*)(kp_ + 16 * ks); } while (0)
#define DSA_PRELOAD(t0_, mb_, nj_) do { \
    _Pragma("unroll") for (int rg = 0; rg < 2; ++rg) { const bf16_t* qp = QIDX + ((mb_) + (t0_) + 4 * rg + (col >> 3)) * 512 + (col & 7) * 64 + 8 * hf; \
        _Pragma("unroll") for (int ks = 0; ks < 4; ++ks) af[rg][ks] = *(const bf16x8*)(qp + 16 * ks); } \
    (void)(nj_); } while (0)
    { int tid = tid0; asm volatile("" : "+v"(tid)); const int lane = tid & 63, hf = lane >> 5, col = lane & 31;
      if (bid < 4096) { DSA_UNIT(bid, b, t0, mb, ntile, nj) (void)b; (void)ntile; if (t0 + 8 > 256) DSA_PRELOAD(t0, mb, nj); } }
    for (int it = bid; it < 4096; it += G) {
        int tid = tid0; asm volatile("" : "+v"(tid));
        const int lane = tid & 63, hf = lane >> 5, col = lane & 31;
        DSA_UNIT(it, b, t0, mb, ntile, nj) (void)b; (void)ntile;
        const int t = t0 + wave, N = t + 1;
        unsigned short* outp = IDX + (mb + t) * 256;
        const int itn = it + G; const bool hasn = itn < 4096;
        DSA_UNIT(hasn ? itn : it, bn, t0n, mbn, ntilen, njn) (void)bn; (void)ntilen;
        if (t0 + 8 <= 256) {
            *(u32x2*)(outp + 4 * lane) = (u32x2){(unsigned)(4 * lane) | ((unsigned)(4 * lane + 1) << 16), (unsigned)(4 * lane + 2) | ((unsigned)(4 * lane + 3) << 16)};
            if (hasn && t0n + 8 > 256) DSA_PRELOAD(t0n, mbn, njn);
            continue;
        }
        float w[2][4][4]; float mn[2][2], mx[2][2];
#pragma unroll
        for (int rg = 0; rg < 2; ++rg)
#pragma unroll
            for (int e = 0; e < 2; ++e) { mn[rg][e] = 3.0e38f; mx[rg][e] = -3.0e38f; }
        const bf16_t* kbase = KIDX + (mb + col) * 64 + 8 * hf;
        DSA_KLOAD(0, 0, kbase, nj); DSA_KLOAD(1, 1, kbase, nj); DSA_KLOAD(2, 2, kbase, nj); DSA_KLOAD(3, 3, kbase, nj);
#pragma unroll
        for (int rg = 0; rg < 2; ++rg)
#pragma unroll
            for (int qq = 0; qq < 4; ++qq) { const f32x4 wv = *(const f32x4*)(WIDX + (mb + t0 + 4 * rg + qq) * 8 + 4 * hf);
                w[rg][qq][0] = wv[0]; w[rg][qq][1] = wv[1]; w[rg][qq][2] = wv[2]; w[rg][qq][3] = wv[3]; }
#define DSA_KCOMP(buf, j) do { const int s_ = 32 * (wave + 8 * (j)) + col; f32x16 acc0, acc1; \
    _Pragma("unroll") for (int i = 0; i < 16; ++i) { acc0[i] = 0.f; acc1[i] = 0.f; } \
    _Pragma("unroll") for (int ks = 0; ks < 4; ++ks) { acc0 = __builtin_amdgcn_mfma_f32_32x32x16_bf16(af[0][ks], kb[buf][ks], acc0, 0, 0, 0); acc1 = __builtin_amdgcn_mfma_f32_32x32x16_bf16(af[1][ks], kb[buf][ks], acc1, 0, 0, 0); } \
    _Pragma("unroll") for (int rg = 0; rg < 2; ++rg) { float p[4]; \
        _Pragma("unroll") for (int qq = 0; qq < 4; ++qq) { p[qq] = relu_mul(rg ? acc1[4 * qq] : acc0[4 * qq], w[rg][qq][0]); _Pragma("unroll") for (int ii = 1; ii < 4; ++ii) p[qq] = relu_fma(rg ? acc1[4 * qq + ii] : acc0[4 * qq + ii], w[rg][qq][ii], p[qq]); } \
        _Pragma("unroll") for (int e = 0; e < 2; ++e) { const auto r = __builtin_amdgcn_permlane32_swap(__float_as_uint(p[e]), __float_as_uint(p[2 + e]), false, false); \
            const float tot = __uint_as_float(r[0]) + __uint_as_float(r[1]); SC[(4 * rg + 2 * hf + e) * 4096 + s_] = tot; mn[rg][e] = fmin_raw(mn[rg][e], tot); mx[rg][e] = fmax_raw(mx[rg][e], tot); } } } while (0)
        for (int j = 0; j < nj; j += 4) {
            DSA_KCOMP(0, j); if (j + 4 < nj) DSA_KLOAD(0, j + 4, kbase, nj);
            if (j + 1 < nj) DSA_KCOMP(1, j + 1);
            if (j + 5 < nj) DSA_KLOAD(1, j + 5, kbase, nj);
            if (j + 2 < nj) DSA_KCOMP(2, j + 2);
            if (j + 6 < nj) DSA_KLOAD(2, j + 6, kbase, nj);
            if (j + 3 < nj) DSA_KCOMP(3, j + 3);
            if (j + 7 < nj) DSA_KLOAD(3, j + 7, kbase, nj);
        }
#pragma unroll
        for (int rg = 0; rg < 2; ++rg)
#pragma unroll
            for (int e = 0; e < 2; ++e) {
#pragma unroll
                for (int o = 1; o < 32; o <<= 1) { mn[rg][e] = fminf(mn[rg][e], __shfl_xor(mn[rg][e], o)); mx[rg][e] = fmaxf(mx[rg][e], __shfl_xor(mx[rg][e], o)); }
                if (col == 0) { MM[(wave * 8 + 4 * rg + 2 * hf + e) * 2] = mn[rg][e]; MM[(wave * 8 + 4 * rg + 2 * hf + e) * 2 + 1] = mx[rg][e]; } }
        if (hasn && t0n + 8 > 256) DSA_PRELOAD(t0n, mbn, njn);
        __syncthreads();
        {
            const LAS float* scl = SC + wave * 4096 + lane;
            LAS unsigned* hist = (LAS unsigned*)(lds + wave * 16384);
            float lo = 3.0e38f, hi = -3.0e38f;
#pragma unroll
            for (int wv = 0; wv < 8; ++wv) { lo = fminf(lo, MM[(wv * 8 + wave) * 2]); hi = fmaxf(hi, MM[(wv * 8 + wave) * 2 + 1]); }
            const float scale = 4.0e9f / fmaxf(hi - lo, 1e-30f);
            unsigned k[64];
#pragma unroll
            for (int gi = 0; gi < 8; ++gi) { if (512 * gi < N) {
#pragma unroll
                for (int ii = 0; ii < 8; ++ii) k[8 * gi + ii] = __float_as_uint(scl[64 * (8 * gi + ii)]); } else {
#pragma unroll
                for (int ii = 0; ii < 8; ++ii) k[8 * gi + ii] = 0u; } }
            LDS_WAIT();
            { LAS u32x4* hz = (LAS u32x4*)(hist + 16 * lane);
#pragma unroll
              for (int j = 0; j < 4; ++j) hz[j] = (u32x4){0u, 0u, 0u, 0u}; }
            LDS_WAIT();
#pragma unroll
            for (int gi = 0; gi < 8; ++gi) if (512 * gi < N) {
#pragma unroll
                for (int ii = 0; ii < 8; ++ii) { const int i = 8 * gi + ii; const bool valid = lane < N - 64 * i;
                    const unsigned key = valid ? 1u + (unsigned)((__uint_as_float(k[i]) - lo) * scale) : 0u; k[i] = key;
                    LAS unsigned* p = valid ? hist + (key >> 22) : hist + 1024 + lane;
                    __hip_atomic_fetch_add(p, 1u, __ATOMIC_RELAXED, __HIP_MEMORY_SCOPE_WORKGROUP); } }
            LDS_WAIT();
            unsigned d0, need1;
            { const LAS u32x4* hz = (const LAS u32x4*)(hist + 16 * lane); u32x4 hv[4]; unsigned ls = 0u;
#pragma unroll
              for (int j = 0; j < 4; ++j) { hv[j] = hz[j]; ls += (hv[j][0] + hv[j][1]) + (hv[j][2] + hv[j][3]); }
              unsigned incl = ls;
#pragma unroll
              for (int o = 1; o < 64; o <<= 1) { const unsigned v = __shfl_down(incl, o); if (lane + o < 64) incl += v; }
              const unsigned above = incl - ls; unsigned cnt = above, d = 0u, nn = 0u;
#pragma unroll
              for (int j = 15; j >= 0; --j) { const unsigned h = hv[j >> 2][j & 3]; const bool hit = (cnt < 256u) && (256u <= cnt + h); d = hit ? (unsigned)(16 * lane + j) : d; nn = hit ? 256u - cnt : nn; cnt += h; }
              const bool found = (above < 256u) && (256u <= above + ls);
              const unsigned long long fm = __ballot(found);
              const int src = (fm != 0ull) ? (__ffsll((long long)fm) - 1) : 0;
              d0 = __shfl(d, src); need1 = __shfl(nn, src); }
            LAS unsigned* CK = hist + 1100; LAS unsigned short* CS = (LAS unsigned short*)(hist + 1170);
            unsigned base = 0u, cbase = 0u;
#pragma unroll
            for (int gi = 0; gi < 8; ++gi) if (512 * gi < N) {
#pragma unroll
                for (int ii = 0; ii < 8; ++ii) { const int i = 8 * gi + ii; const unsigned key = k[i], dg = key >> 22;
                    const bool gt = dg > d0, eq = (dg == d0) && (key != 0u);
                    const unsigned long long mgt = __ballot(gt), meq = __ballot(eq);
                    if (gt) IDXL[base + mbcnt64(mgt)] = (unsigned short)(64 * i + lane);
                    base += (unsigned)__popcll(mgt);
                    if (meq != 0ull) { const unsigned cp = cbase + mbcnt64(meq); if (eq && cp < 64u) { CK[cp] = key; CS[cp] = (unsigned short)(64 * i + lane); } cbase += (unsigned)__popcll(meq); } } }
            LDS_WAIT();
            if (cbase <= 64u) {
                const unsigned mykey = (lane < (int)cbase) ? CK[lane] : 0u; unsigned rank = 0u;
                for (unsigned j = 0; j < cbase; ++j) { const unsigned kj = CK[j]; rank += ((kj > mykey) || (kj == mykey && j < (unsigned)lane)) ? 1u : 0u; }
                const bool sel = (lane < (int)cbase) && (rank < need1);
                const unsigned long long ms = __ballot(sel);
                if (sel) IDXL[base + mbcnt64(ms)] = CS[lane];
            } else {
                unsigned prefix = d0, need = need1;
                LDS_WAIT();
                sel_level<11, 11>(k, N, hist, lane, prefix, need);
                sel_level<0, 11>(k, N, hist, lane, prefix, need);
                unsigned eb = 0u, eqb = 0u;
#pragma unroll
                for (int gi = 0; gi < 8; ++gi) if (512 * gi < N) {
#pragma unroll
                    for (int ii = 0; ii < 8; ++ii) { const int i = 8 * gi + ii; const unsigned key = k[i]; const bool gt = key > prefix, eq = key == prefix;
                        const unsigned long long meq = __ballot(eq); const bool sel = gt || (eq && (eqb + mbcnt64(meq) < need));
                        const unsigned long long msel = __ballot(sel); const unsigned pos = eb + mbcnt64(msel);
                        if (sel && pos < 256u) IDXL[pos] = (unsigned short)(64 * i + lane);
                        eb += (unsigned)__popcll(msel); eqb += (unsigned)__popcll(meq); } }
            }
            LDS_WAIT();
            *(u32x2*)(outp + 4 * lane) = *(const LAS u32x2*)(IDXL + 4 * lane);
        }
        __syncthreads();
    }
#undef DSA_UNIT
#undef DSA_KLOAD
#undef DSA_PRELOAD
#undef DSA_KCOMP
}

__device__ __forceinline__ void dsa_attn_phase(LAS unsigned char* lds, const unsigned char* QLAT8, const unsigned char* CKV8, const unsigned short* IDX, bf16_t* OLAT, int bid, int G) {
    int tid0 = threadIdx.x; asm volatile("" : "+v"(tid0));
    const int wave = __builtin_amdgcn_readfirstlane(tid0 >> 6);
    LAS unsigned char* tile = lds + wave * 9216;
    constexpr float SCL = 1.4426950408889634f / 16.0f;
    unsigned ixw[8], ixn[8]; u32x4 qf[4], qfn[4]; u32x4 ra[2][2][4];
#define ATT_Q(itx, b_, t_, m_, cnt_) const int b_ = (itx) & 7, t_ = ((itx) >> 3) * 8 + wave; const size_t m_ = (size_t)b_ * T + t_; const int cnt_ = (t_ + 1 < 256) ? t_ + 1 : 256;
#define ATT_LOAD_IX(dst, m_) do { const u32x4 xa_ = *(const u32x4*)(IDX + (m_) * 256 + 16 * c16), xb_ = *(const u32x4*)(IDX + (m_) * 256 + 16 * c16 + 8); \
    dst[0] = xa_[0]; dst[1] = xa_[1]; dst[2] = xa_[2]; dst[3] = xa_[3]; dst[4] = xb_[0]; dst[5] = xb_[1]; dst[6] = xb_[2]; dst[7] = xb_[3]; } while (0)
#define ATT_LOAD_QF(dst, m_) do { const unsigned char* qp_ = QLAT8 + (m_) * 2048 + hd * 256 + 16 * g; _Pragma("unroll") for (int kk = 0; kk < 4; ++kk) dst[kk] = *(const u32x4*)(qp_ + 64 * kk); } while (0)
#define ATT_LOAD_ROWS(buf, ix_, n0_, b_, cnt_) do { const int n1_ = (n0_) + 1; \
    const int k0_ = (16 * c16 + (n0_) < (cnt_)) ? (int)(ix_[(n0_) >> 1] & 0xffffu) : 0, k1_ = (16 * c16 + n1_ < (cnt_)) ? (int)(ix_[n1_ >> 1] >> 16) : 0; \
    const unsigned char* cb_ = CKV8 + (size_t)(b_) * T * 256 + 16 * g; \
    _Pragma("unroll") for (int kk = 0; kk < 4; ++kk) { ra[buf][0][kk] = *(const u32x4*)(cb_ + (size_t)k0_ * 256 + 64 * kk); ra[buf][1][kk] = *(const u32x4*)(cb_ + (size_t)k1_ * 256 + 64 * kk); } } while (0)
    { int tid = tid0; asm volatile("" : "+v"(tid)); const int lane = tid & 63, g = lane >> 4, c16 = lane & 15, hd = c16 & 7;
      if (bid < 4096) { ATT_Q(bid, b, t, m, cnt) (void)t; ATT_LOAD_IX(ixw, m); ATT_LOAD_QF(qf, m); ATT_LOAD_ROWS(0, ixw, 0, b, cnt); ATT_LOAD_ROWS(1, ixw, 2, b, cnt); } }
    for (int it = bid; it < 4096; it += G) {
        int tid = tid0; asm volatile("" : "+v"(tid));
        const int lane = tid & 63, g = lane >> 4, c16 = lane & 15, hd = c16 & 7, q4 = c16 >> 2, p4 = c16 & 3;
        ATT_Q(it, b, t, m, cnt) (void)t;
        const int itn = it + G; const bool hasn = itn < 4096;
        ATT_Q(hasn ? itn : it, bn, tn, mn, cntn) (void)tn;
        f32x4 oe[8], oo[8];
#pragma unroll
        for (int ub = 0; ub < 8; ++ub) { oe[ub] = (f32x4){0.f, 0.f, 0.f, 0.f}; oo[ub] = oe[ub]; }
        float mrun = -INFINITY, lrun = 0.f;
#pragma unroll
        for (int ch = 0; ch < 8; ++ch) {
            constexpr int dummy = 0; (void)dummy;
            const int bf = ch & 1;
            f32x4 s0 = (f32x4){0.f, 0.f, 0.f, 0.f}, s1 = s0;
#pragma unroll
            for (int kk = 0; kk < 4; ++kk)
#pragma unroll
                for (int hh = 0; hh < 2; ++hh) {
                    const long qv = (long)(((unsigned long long)qf[kk][2 * hh + 1] << 32) | qf[kk][2 * hh]);
                    const long a0v = (long)(((unsigned long long)ra[bf][0][kk][2 * hh + 1] << 32) | ra[bf][0][kk][2 * hh]);
                    const long a1v = (long)(((unsigned long long)ra[bf][1][kk][2 * hh + 1] << 32) | ra[bf][1][kk][2 * hh]);
                    s0 = __builtin_amdgcn_mfma_f32_16x16x32_fp8_fp8(a0v, qv, s0, 0, 0, 0);
                    s1 = __builtin_amdgcn_mfma_f32_16x16x32_fp8_fp8(a1v, qv, s1, 0, 0, 0); }
#pragma unroll
            for (int kk = 0; kk < 4; ++kk) { *(LAS u32x4*)(tile + c16 * 288 + 64 * kk + 16 * g) = ra[bf][0][kk]; *(LAS u32x4*)(tile + (16 + c16) * 288 + 64 * kk + 16 * g) = ra[bf][1][kk]; }
            if (ch < 6) ATT_LOAD_ROWS(bf, ixw, 2 * ch + 4, b, cnt);
            else if (hasn) ATT_LOAD_ROWS(bf, ixn, 2 * (ch - 6), bn, cntn);
            if (ch == 3 && hasn) ATT_LOAD_IX(ixn, mn);
            if (ch == 5 && hasn) ATT_LOAD_QF(qfn, mn);
            float cm = -INFINITY;
#pragma unroll
            for (int i = 0; i < 4; ++i) { const int jr = 16 * (4 * g + i) + 2 * ch; if (jr >= cnt) s0[i] = -INFINITY; if (jr + 1 >= cnt) s1[i] = -INFINITY; cm = fmaxf(cm, fmaxf(s0[i], s1[i])); }
            cm = fmaxf(cm, __shfl_xor(cm, 16)); cm = fmaxf(cm, __shfl_xor(cm, 32));
            const float mnew = fmaxf(mrun, cm), alpha = __builtin_amdgcn_exp2f((mrun - mnew) * SCL);
            float p0[4], p1[4], ps = 0.f;
#pragma unroll
            for (int i = 0; i < 4; ++i) { p0[i] = __builtin_amdgcn_exp2f((s0[i] - mnew) * SCL); p1[i] = __builtin_amdgcn_exp2f((s1[i] - mnew) * SCL); ps += p0[i] + p1[i]; }
            lrun = lrun * alpha + ps; mrun = mnew;
            asm volatile("" : "+v"(lrun));
#pragma unroll
            for (int ub = 0; ub < 8; ++ub) { oe[ub] = oe[ub] * alpha; oo[ub] = oo[ub] * alpha; }
            int pl = 0, ph = 0;
            pl = __builtin_amdgcn_cvt_pk_fp8_f32(p0[0], p0[1], pl, false); pl = __builtin_amdgcn_cvt_pk_fp8_f32(p0[2], p0[3], pl, true);
            ph = __builtin_amdgcn_cvt_pk_fp8_f32(p1[0], p1[1], ph, false); ph = __builtin_amdgcn_cvt_pk_fp8_f32(p1[2], p1[3], ph, true);
            const long pb = (long)(((unsigned long long)(unsigned)ph << 32) | (unsigned)pl);
#pragma unroll
            for (int ub = 0; ub < 8; ++ub) {
                const s16x4 t0v = __builtin_amdgcn_ds_read_tr16_b64_v4i16((LAS s16x4*)(tile + (4 * g + q4) * 288 + 32 * ub + 8 * p4));
                const s16x4 t1v = __builtin_amdgcn_ds_read_tr16_b64_v4i16((LAS s16x4*)(tile + (16 + 4 * g + q4) * 288 + 32 * ub + 8 * p4));
                const u32x2 w0 = __builtin_bit_cast(u32x2, t0v), w1 = __builtin_bit_cast(u32x2, t1v);
                const unsigned e0 = __builtin_amdgcn_perm(w0.y, w0.x, 0x06040200u), o0 = __builtin_amdgcn_perm(w0.y, w0.x, 0x07050301u);
                const unsigned e1 = __builtin_amdgcn_perm(w1.y, w1.x, 0x06040200u), o1 = __builtin_amdgcn_perm(w1.y, w1.x, 0x07050301u);
                const long ae = (long)(((unsigned long long)e1 << 32) | e0), ao = (long)(((unsigned long long)o1 << 32) | o0);
                oe[ub] = __builtin_amdgcn_mfma_f32_16x16x32_fp8_fp8(ae, pb, oe[ub], 0, 0, 0);
                oo[ub] = __builtin_amdgcn_mfma_f32_16x16x32_fp8_fp8(ao, pb, oo[ub], 0, 0, 0);
            }
        }
        float lt = lrun + __shfl_xor(lrun, 16); lt += __shfl_xor(lt, 32);
        const float inv = 1.0f / lt;
        if (c16 < 8) { bf16_t* op = OLAT + m * 2048 + c16 * 256 + 8 * g;
#pragma unroll
            for (int ub = 0; ub < 8; ++ub) { const f32x4 ye = oe[ub] * inv, yo = oo[ub] * inv; u32x4 wv;
                wv.x = cvt_pk_bf16(ye[0], yo[0]); wv.y = cvt_pk_bf16(ye[1], yo[1]); wv.z = cvt_pk_bf16(ye[2], yo[2]); wv.w = cvt_pk_bf16(ye[3], yo[3]); *(u32x4*)(op + 32 * ub) = wv; } }
        if (hasn) {
#pragma unroll
            for (int i = 0; i < 8; ++i) ixw[i] = ixn[i];
#pragma unroll
            for (int kk = 0; kk < 4; ++kk) qf[kk] = qfn[kk]; }
    }
#undef ATT_Q
#undef ATT_LOAD_IX
#undef ATT_LOAD_QF
#undef ATT_LOAD_ROWS
}

__device__ __forceinline__ void smix_phase(LAS unsigned char* lds, bf16_t* UY, const bf16_t* V, const f32x2* STATS, const float* Wc, const float* bsp, const float* lng, const float* lnb, int bid, int G) {
    int tid = threadIdx.x; asm volatile("" : "+v"(tid));
    const int lane = tid & 63, wave = __builtin_amdgcn_readfirstlane(tid >> 6);
    const int gq = lane >> 4, c16 = lane & 15, q4 = c16 >> 2, p4 = c16 & 3;
    LAS unsigned char* VT = lds;
    LAS unsigned char* AP = lds + 67584;
    LAS float* MU = (LAS float*)(lds + 102400); LAS float* RSTD = MU + 128; LAS float* R1 = MU + 256; LAS float* R2 = MU + 384;
    for (int it = bid; it < 2048; it += G) {
        const int gi = it & 7, rem = it >> 3, b = rem >> 5, ck = rem & 31; const size_t m0 = (size_t)b * T + ck * 128;
        if (tid < 128) { const f32x2* sp = STATS + (m0 + tid) * 32; float s = 0.f, ss = 0.f;
#pragma unroll 8
            for (int p = 0; p < 32; ++p) { const f32x2 v = sp[p]; s += v.x; ss += v.y; }
            const float mu = s * (1.0f / 2048.0f), var = ss * (1.0f / 2048.0f) - mu * mu; MU[tid] = mu; RSTD[tid] = rsqrtf(fmaxf(var, 0.f) + EPS); }
#pragma unroll
        for (int i = 0; i < 8; ++i) { const int cidx = tid + 512 * i, s = cidx >> 5, ch = cidx & 31;
            *(LAS u32x4*)(VT + s * 528 + ch * 16) = *(const u32x4*)(V + (m0 + s) * 2048 + gi * 256 + ch * 8); }
        __syncthreads();
        { const int t = tid >> 2, qd = tid & 3; const float* wp = Wc + ((size_t)gi * 128 + t) * 128 + 32 * qd; float r1 = 0.f, r2 = 0.f;
#pragma unroll
          for (int s8 = 0; s8 < 4; ++s8) { const f32x4 wa = *(const f32x4*)(wp + 8 * s8), wb = *(const f32x4*)(wp + 8 * s8 + 4); float av[8];
#pragma unroll
              for (int e = 0; e < 8; ++e) { const int s = 32 * qd + 8 * s8 + e; const float wv = (s <= t) ? (e < 4 ? wa[e] : wb[e - 4]) : 0.f; const float ab = bf_round(wv * RSTD[s]); av[e] = ab; r1 += ab * MU[s]; r2 += wv; }
              u32x4 o; o.x = cvt_pk_bf16(av[0], av[1]); o.y = cvt_pk_bf16(av[2], av[3]); o.z = cvt_pk_bf16(av[4], av[5]); o.w = cvt_pk_bf16(av[6], av[7]);
              *(LAS u32x4*)(AP + t * 272 + (32 * qd + 8 * s8) * 2) = o; }
          r1 += __shfl_xor(r1, 1); r2 += __shfl_xor(r2, 1); r1 += __shfl_xor(r1, 2); r2 += __shfl_xor(r2, 2);
          if (qd == 0) { R1[t] = r1; R2[t] = r2; } }
        __syncthreads();
        f32x4 acc[8][2];
#pragma unroll
        for (int mt = 0; mt < 8; ++mt) { acc[mt][0] = (f32x4){0.f, 0.f, 0.f, 0.f}; acc[mt][1] = acc[mt][0]; }
#pragma unroll
        for (int ks = 0; ks < 4; ++ks) {
            bf16x8 vf[2];
#pragma unroll
            for (int n2 = 0; n2 < 2; ++n2) { const int nt = 2 * wave + n2;
                const s16x4 t0v = __builtin_amdgcn_ds_read_tr16_b64_v4i16((LAS s16x4*)(VT + (32 * ks + 8 * gq + q4) * 528 + (16 * nt + 4 * p4) * 2));
                const s16x4 t1v = __builtin_amdgcn_ds_read_tr16_b64_v4i16((LAS s16x4*)(VT + (32 * ks + 8 * gq + 4 + q4) * 528 + (16 * nt + 4 * p4) * 2));
                vf[n2] = __builtin_shufflevector(t0v, t1v, 0, 1, 2, 3, 4, 5, 6, 7); }
#pragma unroll
            for (int mt = 0; mt < 8; ++mt) if (mt >= 2 * ks) {
                const bf16x8 afr = *(const LAS bf16x8*)(AP + (16 * mt + c16) * 272 + (32 * ks + 8 * gq) * 2);
                acc[mt][0] = __builtin_amdgcn_mfma_f32_16x16x32_bf16(vf[0], afr, acc[mt][0], 0, 0, 0);
                acc[mt][1] = __builtin_amdgcn_mfma_f32_16x16x32_bf16(vf[1], afr, acc[mt][1], 0, 0, 0); }
        }
#pragma unroll
        for (int n2 = 0; n2 < 2; ++n2) { const int e0 = 16 * (2 * wave + n2) + 4 * gq; const f32x4 lg4 = *(const f32x4*)(lng + gi * 256 + e0), lb4 = *(const f32x4*)(lnb + gi * 256 + e0);
#pragma unroll
            for (int mt = 0; mt < 8; ++mt) { const int t = 16 * mt + c16; const float r1 = R1[t], r2 = R2[t], bsv = bsp[gi * 128 + t];
                bf16_t* up = UY + (m0 + t) * 2048 + gi * 256 + e0; const u32x2 uw = *(const u32x2*)up;
                const f32x4 mixed = lg4 * (acc[mt][n2] - r1) + lb4 * r2 + bsv;
                const float y0 = bf2f(uw.x & 0xffffu) * mixed[0], y1 = bf2f(uw.x >> 16) * mixed[1], y2 = bf2f(uw.y & 0xffffu) * mixed[2], y3 = bf2f(uw.y >> 16) * mixed[3];
                u32x2 yw; yw.x = cvt_pk_bf16(y0, y1); yw.y = cvt_pk_bf16(y2, y3); *(u32x2*)up = yw; } }
        __syncthreads();
    }
}

__global__ void __launch_bounds__(512, 2) mk_fwd(Args a) {
    extern __shared__ __attribute__((aligned(16))) unsigned char lds_raw[];
    LAS unsigned char* lds = (LAS unsigned char*)lds_raw;
    cg::grid_group grid = cg::this_grid();
    const int bid = blockIdx.x, G = gridDim.x;
    unsigned char* ws = a.ws;
    float* MOD = (float*)(ws + WS_MOD);
    bf16_t* H = (bf16_t*)(ws + WS_H);
    float* X = a.out;
    volatile LAS unsigned* misc = (volatile LAS unsigned*)(lds + LDS_MISC);
    if (threadIdx.x < 2) misc[threadIdx.x] = 0u;
    __syncthreads();
    const XcdBarrier xbar = xcd_barrier_post((unsigned*)(ws + WS_BAR), misc);
    int ph = 0;
#ifndef PROBE
#define PROBE 0
#endif
#define PHASE_BEGIN if (ph >= a.ph_lo && ph < a.ph_hi) {
#define REP(k) for (int rep_ = 0; rep_ < ((PROBE == (k)) ? 2 : 1); ++rep_)
#define PHASE_END(dosync) if ((dosync) && ph + 1 < a.ph_hi) { if (ph == 0) grid.sync(); else xcd_barrier(xbar); } } ++ph;

    PHASE_BEGIN REP(4) { p0_phase(a, lds, bid, G); __syncthreads(); } PHASE_END(true)
    PHASE_BEGIN p0c_phase(a, bid, G); PHASE_END(true)

#pragma unroll 1
    for (int layer = 0; layer < 4; ++layer) {
        const int j = layer >> 1; const float* xin = (layer == 0) ? a.in[0] : X;
        const float* modl = MOD + (size_t)layer * 8 * NMOD;
        PHASE_BEGIN REP(3) norm_mod_phase(xin, a.in[4] + layer * D, modl + 0 * D, modl + 1 * D, H, bid, G); PHASE_END(true)
        if ((layer & 1) == 0) {
            bf16_t* Q = (bf16_t*)(ws + WS_Q); float* CKVR = (float*)(ws + WS_CKVR); bf16_t* QIDX = (bf16_t*)(ws + WS_QIDX); float* KRAW = (float*)(ws + WS_KRAW);
            bf16_t* CKV = (bf16_t*)(ws + WS_CKV); bf16_t* KIDX = (bf16_t*)(ws + WS_KIDX); float* WIDX = (float*)(ws + WS_WIDX); unsigned short* IDX = (unsigned short*)(ws + WS_IDX);
            bf16_t* QLAT = (bf16_t*)(ws + WS_QLAT); bf16_t* OLAT = (bf16_t*)(ws + WS_OLAT); bf16_t* O = (bf16_t*)(ws + WS_O);
            PHASE_BEGIN { pg8::Gemm g{H, (const bf16_t*)(ws + W_AIN) + (size_t)j * 2048 * 1024, M, 2048, 1024, 1024, 0, 0}; pg8::StaticOrder S; S.init(M, 2048, G, bid);
                pg8::EpiInproj E{Q, CKVR, QIDX, KRAW}; REP(5) pg8::gemm_phase(lds, g, S, E); } PHASE_END(true)
            PHASE_BEGIN { dsa_rows_phase(CKVR, KRAW, a.in[7] + j * 256, a.in[8] + j * 64, a.in[9] + j * 64, CKV, KIDX, WIDX, bid, G);
                __syncthreads();
                pg8::Gemm g{Q, (const bf16_t*)(ws + W_UK) + (size_t)j * 2048 * 256, M, 2048, 256, 1024, 1, 256}; pg8::StaticOrder S; S.init(M, 2048, G, bid);
                pg8::EpiBf16 E{QLAT, 2048, 1.4142135623730951f, 1}; pg8::gemm_phase(lds, g, S, E); } PHASE_END(true)
            PHASE_BEGIN REP(1) dsa_select_phase(lds, QIDX, KIDX, WIDX, IDX, bid, G); PHASE_END(true)
            PHASE_BEGIN REP(2) dsa_attn_phase(lds, (const unsigned char*)QLAT, (const unsigned char*)CKV, IDX, OLAT, bid, G); PHASE_END(true)
            PHASE_BEGIN { pg8::Gemm g{OLAT, (const bf16_t*)(ws + W_UV) + (size_t)j * 1024 * 512, M, 1024, 512, 2048, 0, 512}; pg8::StaticOrder S; S.init(M, 1024, G, bid);
                pg8::EpiBf16 E{O, 1024, 1.0f, 0}; pg8::gemm_phase(lds, g, S, E); } PHASE_END(true)
            PHASE_BEGIN { pg8::Gemm g{O, (const bf16_t*)(ws + W_O) + (size_t)j * 1024 * 1024, M, 1024, 1024, 1024, 0, 0}; pg8::StaticOrder S; S.init(M, 1024, G, bid);
                pg8::EpiResid E{xin, X, modl + 2 * D}; pg8::gemm_phase(lds, g, S, E); } PHASE_END(true)
        } else {
            bf16_t* U = (bf16_t*)(ws + WS_U); bf16_t* V = (bf16_t*)(ws + WS_V); f32x2* STATS = (f32x2*)(ws + WS_STATS);
            PHASE_BEGIN { pg8::Gemm g{H, (const bf16_t*)(ws + W_BIN) + (size_t)j * 4096 * 1024, M, 4096, 1024, 1024, 0, 0}; pg8::StaticOrder S; S.init(M, 4096, G, bid);
                pg8::EpiGelu E{U, V, STATS}; REP(7) pg8::gemm_phase(lds, g, S, E); } PHASE_END(true)
            PHASE_BEGIN smix_phase(lds, U, V, STATS, a.in[16] + (size_t)j * 8 * 128 * 128, a.in[17] + (size_t)j * 8 * 128, a.in[14] + (size_t)j * 2048, a.in[15] + (size_t)j * 2048, bid, G); PHASE_END(true)
            PHASE_BEGIN { pg8::Gemm g{U, (const bf16_t*)(ws + W_BOUT) + (size_t)j * 1024 * 2048, M, 1024, 2048, 2048, 0, 0}; pg8::StaticOrder S; S.init(M, 1024, G, bid);
                pg8::EpiResid E{xin, X, modl + 2 * D}; pg8::gemm_phase(lds, g, S, E); } PHASE_END(true)
        }
        PHASE_BEGIN REP(3) norm_mod_phase(X, a.in[5] + layer * D, modl + 3 * D, modl + 4 * D, H, bid, G); PHASE_END(true)
        PHASE_BEGIN { pg8::Gemm g{H, (const bf16_t*)(ws + W_GU) + (size_t)layer * 5632 * 1024, M, 5632, 1024, 1024, 0, 0}; pg8::StaticOrder S; S.init(M, 5632, G, bid);
            pg8::EpiSwiglu E{(bf16_t*)(ws + WS_HID)}; REP(6) pg8::gemm_phase(lds, g, S, E); } PHASE_END(true)
        PHASE_BEGIN { pg8::Gemm g{(const bf16_t*)(ws + WS_HID), (const bf16_t*)(ws + W_DN) + (size_t)layer * 1024 * DFF, M, 1024, DFF, DFF, 0, 0}; pg8::StaticOrder S; S.init(M, 1024, G, bid);
            pg8::EpiResid E{X, X, modl + 5 * D}; pg8::gemm_phase(lds, g, S, E); } PHASE_END(true)
    }
    PHASE_BEGIN final_norm_phase(X, a.in[22], a.out, bid, G); PHASE_END(false)
}

extern "C" void kernel_launch(void* const* d_in, const int* in_sizes, int n_in, void* d_out, int out_size, void* d_ws, size_t ws_size, hipStream_t stream) {
    static int grid_blocks = 0;
    if (grid_blocks == 0) {
        int dev = 0, cus = 0, per_cu = 0;
        if (n_in != 23 || out_size != M * D || ws_size < WS_END) { fprintf(stderr, "kernel_launch: unexpected problem (n_in %d out %d ws %zu, need ws >= %zu)\n", n_in, out_size, ws_size, (size_t)WS_END); grid_blocks = -1; return; }
        (void)hipGetDevice(&dev);
        (void)hipDeviceGetAttribute(&cus, hipDeviceAttributeMultiprocessorCount, dev);
        (void)hipFuncSetAttribute((const void*)mk_fwd, hipFuncAttributeMaxDynamicSharedMemorySize, LDS_BYTES);
        (void)hipOccupancyMaxActiveBlocksPerMultiprocessor(&per_cu, (const void*)mk_fwd, 512, LDS_BYTES);
        fprintf(stderr, "kernel_launch: cus %d per_cu %d ws %zu\n", cus, per_cu, ws_size);
        if (per_cu < 1) { fprintf(stderr, "kernel_launch: kernel does not fit a CU\n"); grid_blocks = -1; return; }
        grid_blocks = cus;
    }
    if (grid_blocks < 0) return;
    if (hipMemsetAsync((char*)d_ws + WS_BAR, 0, 16384, stream) != hipSuccess) { fprintf(stderr, "kernel_launch: memset failed\n"); return; }
    Args a{};
    for (int i = 0; i < 23; ++i) a.in[i] = (const float*)d_in[i];
    a.out = (float*)d_out; a.ws = (unsigned char*)d_ws; a.ph_lo = 0; a.ph_hi = 1000;
    void* args[] = {&a};
    hipError_t e = hipLaunchCooperativeKernel((const void*)mk_fwd, dim3(grid_blocks), dim3(512), args, LDS_BYTES, stream);
    if (e != hipSuccess) fprintf(stderr, "cooperative launch failed: %s (grid %d)\n", hipGetErrorString(e), grid_blocks);
}
```

```cpp
#include <hip/hip_runtime.h>
#include <hip/hip_cooperative_groups.h>
#include <cstdio>
#include <cstdint>
namespace cg = cooperative_groups;

#define LAS __attribute__((address_space(3)))
typedef unsigned short bf16_t;
typedef short bf16x8 __attribute__((ext_vector_type(8)));
typedef short s16x4 __attribute__((ext_vector_type(4)));
typedef float f32x4 __attribute__((ext_vector_type(4)));
typedef float f32x16 __attribute__((ext_vector_type(16)));
typedef float f32x2 __attribute__((ext_vector_type(2)));
typedef unsigned u32x4 __attribute__((ext_vector_type(4)));
typedef unsigned u32x2 __attribute__((ext_vector_type(2)));

constexpr int D = 1024, NB = 8, T = 4096, M = NB * T, DFF = 2816, NMOD = 6 * D;
constexpr float EPS = 1e-6f;
constexpr int AIN = 1864;
constexpr size_t MiB = 1u << 20;
constexpr size_t WS_MOD = 0;
constexpr size_t WS_MODP = 1 * MiB;
constexpr size_t WS_W = 13 * MiB;
constexpr size_t W_AIN = WS_W;
constexpr size_t W_UK = W_AIN + 8 * MiB;
constexpr size_t W_UV = W_UK + 2 * MiB;
constexpr size_t W_O = W_UV + 2 * MiB;
constexpr size_t W_BIN = W_O + 4 * MiB;
constexpr size_t W_BOUT = W_BIN + 16 * MiB;
constexpr size_t W_GU = W_BOUT + 8 * MiB;
constexpr size_t W_DN = W_GU + 44 * MiB;
constexpr size_t WS_R1 = W_DN + 22 * MiB;
constexpr size_t WS_H = WS_R1;
constexpr size_t WS_Q = WS_R1 + 64 * MiB;
constexpr size_t WS_OLAT = WS_R1;
constexpr size_t WS_R2 = WS_R1 + 128 * MiB;
constexpr size_t WS_QLAT = WS_R2;
constexpr size_t WS_O = WS_R2;
constexpr size_t WS_R3 = WS_R2 + 128 * MiB;
constexpr size_t WS_CKVR = WS_R3;
constexpr size_t WS_CKV = WS_CKVR + 32 * MiB;
constexpr size_t WS_QIDX = WS_CKV + 16 * MiB;
constexpr size_t WS_KRAW = WS_QIDX + 32 * MiB;
constexpr size_t WS_KIDX = WS_KRAW + 16 * MiB;
constexpr size_t WS_WIDX = WS_KIDX + 4 * MiB;
constexpr size_t WS_IDX = WS_WIDX + 1 * MiB;
constexpr size_t WS_END = WS_IDX + 16 * MiB;
constexpr size_t WS_HID = WS_R1 + 64 * MiB;
constexpr size_t WS_U = WS_R1 + 64 * MiB;
constexpr size_t WS_V = WS_U + 128 * MiB;
constexpr size_t WS_STATS = WS_V + 128 * MiB;
static_assert(WS_STATS + 8 * MiB <= WS_END && WS_HID + 176 * MiB <= WS_R3, "ws map");
constexpr int LDS_BYTES = 147456;
constexpr int LDS_MISC = LDS_BYTES - 256;
constexpr size_t WS_BAR = 1 * MiB - 16384;

__device__ __forceinline__ unsigned cvt_pk_bf16(float lo, float hi) { unsigned r; asm volatile("v_cvt_pk_bf16_f32 %0, %1, %2" : "=v"(r) : "v"(lo), "v"(hi)); return r; }
__device__ __forceinline__ float bf2f(unsigned b) { return __uint_as_float(b << 16); }
__device__ __forceinline__ float bf_round(float f) { unsigned u = __float_as_uint(f); u = (u + 0x7fffu + ((u >> 16) & 1u)) & 0xffff0000u; return __uint_as_float(u); }
__device__ __forceinline__ float wave_sum(float v) {
#pragma unroll
    for (int o = 1; o < 64; o <<= 1) v += __shfl_xor(v, o);
    return v;
}
#define LDS_WAIT() asm volatile("s_waitcnt lgkmcnt(0)" ::: "memory")


#define XB_TMO      128
#define XB_XCNT(j)  (256  + 64 * (j))
#define XB_XSUB(j)  (1280 + 64 * (j))
#define XB_XGEN(j)  (2304 + 64 * (j))
#define XB_TOP      3328
#define XB_TOPGEN   3392
#define XCD_BAR_WORDS 3456
#define XB_SPIN_CAP (1u << 22)
__device__ __forceinline__ unsigned xb_ld(unsigned* p)              { return __hip_atomic_load(p, __ATOMIC_RELAXED, __HIP_MEMORY_SCOPE_AGENT); }
__device__ __forceinline__ unsigned xb_add(unsigned* p, unsigned v) { return __hip_atomic_fetch_add(p, v, __ATOMIC_RELAXED, __HIP_MEMORY_SCOPE_AGENT); }
__device__ __forceinline__ unsigned xb_xcc_id() { return (unsigned)__builtin_amdgcn_s_getreg((3 << 11) | 20) & 0xFu; }
#define XB_SPIN(cond, bar) do { unsigned _sp = 0; while (cond) { __builtin_amdgcn_s_sleep(1); \
    if ((++_sp & 255u) == 0u) { if (xb_ld(&(bar)[XB_TMO])) break; if (_sp > XB_SPIN_CAP) { atomicAdd(&(bar)[XB_TMO], 1u); break; } } } } while (0)
struct XcdBarrier { unsigned* bar; unsigned x; volatile LAS unsigned* st; };
__device__ __forceinline__ XcdBarrier xcd_barrier_post(unsigned* bar, volatile LAS unsigned* st) {
    XcdBarrier b; b.bar = bar; b.x = xb_xcc_id(); b.st = st;
    if (threadIdx.x == 0) (void)xb_add(&bar[XB_XCNT(b.x)], 1u);
    return b;
}
__device__ __forceinline__ void xcd_barrier_complete(unsigned* bar, unsigned x, unsigned& nloc, unsigned& nx) {
    const unsigned G = gridDim.x * gridDim.y * gridDim.z;
    unsigned sum, cnt, mine, sp = 0u;
    for (;;) {
        sum = 0u; cnt = 0u; mine = 0u;
#pragma unroll
        for (unsigned j = 0; j < 16; ++j) { const unsigned c = xb_ld(&bar[XB_XCNT(j)]); sum += c; cnt += (c > 0u) ? 1u : 0u; mine = (j == x) ? c : mine; }
        if (sum == G) break;
        __builtin_amdgcn_s_sleep(1);
        if ((++sp & 255u) == 0u) { if (xb_ld(&bar[XB_TMO])) break; if (sp > XB_SPIN_CAP) { atomicAdd(&bar[XB_TMO], 1u); break; } }
    }
    nloc = mine > 0u ? mine : 1u; nx = cnt > 0u ? cnt : 1u;
}
__device__ __forceinline__ void xcd_barrier(const XcdBarrier& b) {
    asm volatile("s_waitcnt vmcnt(0)" ::: "memory");
    __syncthreads();
    if (threadIdx.x == 0) {
        unsigned* bar = b.bar;
        __builtin_amdgcn_s_waitcnt(0);
        unsigned nloc = b.st[0], nx = b.st[1];
        if (nloc == 0u) { xcd_barrier_complete(bar, b.x, nloc, nx); b.st[0] = nloc; b.st[1] = nx; }
        const unsigned old = xb_add(&bar[XB_XSUB(b.x)], 1u);
        const unsigned gen = old / nloc;
        if (old + 1u == (gen + 1u) * nloc) {
            __builtin_amdgcn_fence(__ATOMIC_RELEASE, "agent");
            asm volatile("s_waitcnt vmcnt(0)" ::: "memory");
            const unsigned og = xb_add(&bar[XB_TOP], 1u);
            const unsigned tg = og / nx;
            if (og + 1u == (tg + 1u) * nx) xb_add(&bar[XB_TOPGEN], 1u);
            else XB_SPIN(xb_ld(&bar[XB_TOPGEN]) == tg, bar);
            __builtin_amdgcn_fence(__ATOMIC_ACQUIRE, "agent");
            xb_add(&bar[XB_XGEN(b.x)], 1u);
            asm volatile("s_waitcnt vmcnt(0)" ::: "memory");
        } else {
            XB_SPIN(xb_ld(&bar[XB_XGEN(b.x)]) == gen, bar);
            __builtin_amdgcn_fence(__ATOMIC_ACQUIRE, "agent");
            asm volatile("s_waitcnt vmcnt(0)" ::: "memory");
        }
    }
    __syncthreads();
}

namespace pg8 {
constexpr int BM = 256, BK = 64, HALF = 128, HTB = HALF * BK * 2, STAGE_BYTES = 8 * HTB, NXCD = 8, WGM = 8;
__host__ __device__ __forceinline__ int lds_byte(int r, int c) { const int st = (r >> 4) * 2 + (c >> 5), rr = r & 15, cc = c & 31, ob = rr * 64 + cc * 2; return st * 1024 + (ob ^ (((ob >> 9) & 1) << 5)); }
__host__ __device__ __forceinline__ void stage_rc(int b, int& R, int& C) { const int st = b / 1024, sb = b % 1024, swz = sb ^ (((sb >> 9) & 1) << 5); R = (st >> 1) * 16 + swz / 64; C = (st & 1) * 32 + (swz % 64) / 2; }
__host__ __device__ __forceinline__ int perm32(int rho) { const int n = rho >> 4, i = rho & 15; return 8 * (i >> 2) + 4 * n + (i & 3); }

struct Unit { int pm, pn; };
struct Gemm { const bf16_t* A; const bf16_t* Bt; int M, N, K, lda, agrp_shift, agrp_stride; };

struct StaticOrder {
    int nM, nN, nwg, G, c;
    __device__ void init(int M_, int N_, int G_, int c_) { nM = M_ / BM; nN = N_ / BM; nwg = nM * nN; G = G_; c = c_; }
    __device__ bool next(int i, Unit& u) const {
        const long L = (long)i * G + c; if (L >= nwg) return false;
        int wgid = (int)L; { const int q = nwg / NXCD, r = nwg % NXCD, xcd = wgid % NXCD, off = wgid / NXCD; wgid = (xcd < r ? xcd * (q + 1) : r * (q + 1) + (xcd - r) * q) + off; }
        const int nig = WGM * nN, gid = wgid / nig, fm = gid * WGM, gsz = (nM - fm) < WGM ? (nM - fm) : WGM;
        u.pm = fm + ((wgid % nig) % gsz); u.pn = (wgid % nig) / gsz; return true;
    }
};

typedef f32x4 Acc[2][2][4][2];

__device__ __forceinline__ f32x2 gelu_pk(f32x2 v) {
    const f32x2 av = __builtin_elementwise_abs(v), d = av * 0.2316418882f + 1.0f;
    f32x2 t; t.x = __builtin_amdgcn_rcpf(d.x); t.y = __builtin_amdgcn_rcpf(d.y);
    f32x2 q = t * 0.5307027145f + (-0.7265760135f); q = q * t + 0.7107068705f; q = q * t + (-0.142248368f); q = q * t + 0.127414796f; q = q * t;
    const f32x2 s = (v * v) * (-0.72134752044f);
    f32x2 e; e.x = __builtin_amdgcn_exp2f(s.x); e.y = __builtin_amdgcn_exp2f(s.y);
    const f32x2 m = v * (q * e), r = v - m;
    f32x2 o; o.x = v.x < 0.f ? m.x : r.x; o.y = v.y < 0.f ? m.y : r.y; return o;
}
__device__ __forceinline__ f32x4 gelu4(f32x4 v) { f32x2 a = gelu_pk((f32x2){v[0], v[1]}), b = gelu_pk((f32x2){v[2], v[3]}); return (f32x4){a.x, a.y, b.x, b.y}; }
__device__ __forceinline__ u32x4 pack8(f32x4 v0, f32x4 v1) { u32x4 w; w.x = cvt_pk_bf16(v0[0], v0[1]); w.y = cvt_pk_bf16(v0[2], v0[3]); w.z = cvt_pk_bf16(v1[0], v1[1]); w.w = cvt_pk_bf16(v1[2], v1[3]); return w; }

struct EpiInproj {
    bf16_t* Q; float* CKVR; bf16_t* QIDX; float* KRAW;
    __device__ __forceinline__ void operator()(const Acc& acc, const Unit& u, int wr, int wc, int fr, int fq) const {
        const int row0 = u.pm * BM + wr * 64 + fr, cl = wc * 32 + 8 * fq;
#pragma unroll
        for (int ai = 0; ai < 2; ++ai)
#pragma unroll
            for (int m = 0; m < 4; ++m) { const size_t row = (size_t)(row0 + ai * HALF + m * 16);
#pragma unroll
                for (int bj = 0; bj < 2; ++bj) { const f32x4 v0 = acc[ai][bj][m][0], v1 = acc[ai][bj][m][1]; const int c = bj * HALF + cl;
                    if (u.pn < 4) *(u32x4*)(Q + row * 1024 + u.pn * 256 + c) = pack8(v0, v1);
                    else if (u.pn == 4) { float* p = CKVR + row * 256 + c; *(f32x4*)p = v0; *(f32x4*)(p + 4) = v1; }
                    else if (u.pn < 7) *(u32x4*)(QIDX + row * 512 + (u.pn - 5) * 256 + c) = pack8(v0, v1);
                    else if (bj == 0) { float* p = KRAW + row * 128 + c; *(f32x4*)p = v0; *(f32x4*)(p + 4) = v1; } } }
    }
};
struct EpiBf16 {
    bf16_t* O; int ldc; float scale; int fp8;
    __device__ __forceinline__ void operator()(const Acc& acc, const Unit& u, int wr, int wc, int fr, int fq) const {
        const int row0 = u.pm * BM + wr * 64 + fr, col0 = u.pn * BM + wc * 32 + 8 * fq;
        if (fp8) {
#pragma unroll
            for (int ai = 0; ai < 2; ++ai)
#pragma unroll
                for (int m = 0; m < 4; ++m) { unsigned char* rowp = (unsigned char*)O + (size_t)(row0 + ai * HALF + m * 16) * ldc + col0;
#pragma unroll
                    for (int bj = 0; bj < 2; ++bj) { const f32x4 v0 = acc[ai][bj][m][0] * scale, v1 = acc[ai][bj][m][1] * scale; int w0 = 0, w1 = 0;
                        w0 = __builtin_amdgcn_cvt_pk_fp8_f32(v0[0], v0[1], w0, false); w0 = __builtin_amdgcn_cvt_pk_fp8_f32(v0[2], v0[3], w0, true);
                        w1 = __builtin_amdgcn_cvt_pk_fp8_f32(v1[0], v1[1], w1, false); w1 = __builtin_amdgcn_cvt_pk_fp8_f32(v1[2], v1[3], w1, true);
                        *(u32x2*)(rowp + bj * HALF) = (u32x2){(unsigned)w0, (unsigned)w1}; } }
            return; }
#pragma unroll
        for (int ai = 0; ai < 2; ++ai)
#pragma unroll
            for (int m = 0; m < 4; ++m) { bf16_t* rowp = O + (size_t)(row0 + ai * HALF + m * 16) * ldc + col0;
#pragma unroll
                for (int bj = 0; bj < 2; ++bj) *(u32x4*)(rowp + bj * HALF) = pack8(acc[ai][bj][m][0] * scale, acc[ai][bj][m][1] * scale); }
    }
};
struct EpiResid {
    const float* xin; float* xout; const float* gate;
    __device__ __forceinline__ void operator()(const Acc& acc, const Unit& u, int wr, int wc, int fr, int fq) const {
        const int row0 = u.pm * BM + wr * 64 + fr, col0 = u.pn * BM + wc * 32 + 8 * fq;
        const float* gp = gate + (size_t)(u.pm >> 4) * NMOD + col0;
        f32x4 gv[2][2];
#pragma unroll
        for (int bj = 0; bj < 2; ++bj)
#pragma unroll
            for (int n = 0; n < 2; ++n) gv[bj][n] = *(const f32x4*)(gp + bj * HALF + 4 * n);
#pragma unroll
        for (int ai = 0; ai < 2; ++ai)
#pragma unroll
            for (int m = 0; m < 4; ++m) { const size_t off = (size_t)(row0 + ai * HALF + m * 16) * D + col0;
#pragma unroll
                for (int bj = 0; bj < 2; ++bj)
#pragma unroll
                    for (int n = 0; n < 2; ++n) { const f32x4 xo = *(const f32x4*)(xin + off + bj * HALF + 4 * n);
                        *(f32x4*)(xout + off + bj * HALF + 4 * n) = xo + gv[bj][n] * acc[ai][bj][m][n]; } }
    }
};
struct EpiGelu {
    bf16_t* U; bf16_t* V; f32x2* STATS;
    __device__ __forceinline__ void operator()(const Acc& acc, const Unit& u, int wr, int wc, int fr, int fq) const {
        const int row0 = u.pm * BM + wr * 64 + fr, cl = wc * 32 + 8 * fq;
        const bool isv = u.pn >= 8; bf16_t* base = isv ? V + (u.pn - 8) * 256 : U + u.pn * 256;
#pragma unroll
        for (int ai = 0; ai < 2; ++ai)
#pragma unroll
            for (int m = 0; m < 4; ++m) { const size_t row = (size_t)(row0 + ai * HALF + m * 16); float s = 0.f, ss = 0.f;
#pragma unroll
                for (int bj = 0; bj < 2; ++bj) { const f32x4 v0 = gelu4(acc[ai][bj][m][0]), v1 = gelu4(acc[ai][bj][m][1]);
                    *(u32x4*)(base + row * 2048 + bj * HALF + cl) = pack8(v0, v1);
                    s += (v0[0] + v0[1]) + (v0[2] + v0[3]) + (v1[0] + v1[1]) + (v1[2] + v1[3]);
                    ss += (v0[0] * v0[0] + v0[1] * v0[1]) + (v0[2] * v0[2] + v0[3] * v0[3]) + (v1[0] * v1[0] + v1[1] * v1[1]) + (v1[2] * v1[2] + v1[3] * v1[3]); }
                if (isv) { s += __shfl_xor(s, 16); ss += __shfl_xor(ss, 16); s += __shfl_xor(s, 32); ss += __shfl_xor(ss, 32);
                    if (fq == 0) STATS[row * 32 + (u.pn - 8) * 4 + wc] = (f32x2){s, ss}; } }
    }
};
struct EpiSwiglu {
    bf16_t* HID;
    __device__ __forceinline__ void operator()(const Acc& acc, const Unit& u, int wr, int wc, int fr, int fq) const {
        const int row0 = u.pm * BM + wr * 64 + fr, col0 = u.pn * 128 + wc * 32 + 8 * fq;
#pragma unroll
        for (int ai = 0; ai < 2; ++ai)
#pragma unroll
            for (int m = 0; m < 4; ++m) { f32x4 h[2];
#pragma unroll
                for (int n = 0; n < 2; ++n) { const f32x4 g = acc[ai][0][m][n], up = acc[ai][1][m][n];
#pragma unroll
                    for (int j = 0; j < 4; ++j) h[n][j] = g[j] * __builtin_amdgcn_rcpf(1.0f + __expf(-g[j])) * up[j]; }
                *(u32x4*)(HID + (size_t)(row0 + ai * HALF + m * 16) * DFF + col0) = pack8(h[0], h[1]); }
    }
};

template <class Epi>
__device__ __forceinline__ void gemm_phase(LAS unsigned char* lds, const Gemm g, const StaticOrder& S, const Epi& E) {
    int tid = threadIdx.x; asm volatile("" : "+v"(tid));
    const int wid = __builtin_amdgcn_readfirstlane(tid >> 6), lane = tid & 63, wr = wid >> 2, wc = wid & 3, fr = lane & 15, fq = lane >> 4;
    const int K = g.K, nt = K / BK, lda = g.lda;
    unsigned voffA[2], voffB[2];
#pragma unroll
    for (int i = 0; i < 2; ++i) { int R, C; stage_rc(tid * 16 + i * 8192, R, C); const int Rb = (R & ~31) + perm32(R & 31);
        voffA[i] = (unsigned)(R * lda + C) * 2u; voffB[i] = (unsigned)(Rb * K + C) * 2u; }
    const size_t kstep = (size_t)(BK * 2);
    const size_t hstepA = (size_t)HALF * lda * 2, hstepB = (size_t)HALF * K * 2;
    const unsigned ldsw = (unsigned)wid * 1024u;
    const int aoff = lds_byte(wr * 64 + fr, fq * 8), boff = lds_byte(wc * 32 + fr, fq * 8);
#define PG8_SA(b, h) (((b) * 2 + (h)) * HTB)
#define PG8_SB(b, h) ((4 + (b) * 2 + (h)) * HTB)
#define PG8_STAGE(bufoff, gbase, voff) do { _Pragma("unroll") for (int _i = 0; _i < 2; ++_i) \
        __builtin_amdgcn_global_load_lds((const unsigned*)((const char*)(gbase) + (voff)[_i]), (LAS unsigned*)(lds + (bufoff) + ldsw + _i * 8192), 16, 0, 0); } while (0)
#define PG8_LDA(dst, b, h) do { _Pragma("unroll") for (int m = 0; m < 4; ++m) _Pragma("unroll") for (int k = 0; k < 2; ++k) dst[m][k] = *(const LAS bf16x8*)(lds + PG8_SA(b, h) + aoff + m * 2048 + k * 1024); } while (0)
#define PG8_LDB(dst, b, h) do { _Pragma("unroll") for (int n = 0; n < 2; ++n) _Pragma("unroll") for (int k = 0; k < 2; ++k) dst[n][k] = *(const LAS bf16x8*)(lds + PG8_SB(b, h) + boff + n * 2048 + k * 1024); } while (0)
#define PG8_MMA(ai, bj, At, Bt) do { __builtin_amdgcn_s_setprio(1); _Pragma("unroll") for (int m = 0; m < 4; ++m) _Pragma("unroll") for (int n = 0; n < 2; ++n) _Pragma("unroll") for (int k = 0; k < 2; ++k) \
        acc[ai][bj][m][n] = __builtin_amdgcn_mfma_f32_16x16x32_bf16(Bt[n][k], At[m][k], acc[ai][bj][m][n], 0, 0, 0); __builtin_amdgcn_s_setprio(0); } while (0)
#define PG8_WAIT_V(n) asm volatile("s_waitcnt vmcnt(" #n ")" ::: "memory")
#define PG8_WAIT_L(n) asm volatile("s_waitcnt lgkmcnt(" #n ")" ::: "memory")
#define PG8_BAR __builtin_amdgcn_s_barrier()
#define PG8_SCHED __builtin_amdgcn_sched_barrier(0)
#define PG8_ABASE(u) ((const char*)g.A + ((size_t)(u).pm * BM * lda + (size_t)((u).pn >> g.agrp_shift) * g.agrp_stride) * 2)
#define PG8_BBASE(u) ((const char*)g.Bt + (size_t)(u).pn * 2 * hstepB)
    Unit cur, nxt; int ui = 0;
    if (!S.next(0, cur)) return;
    Acc acc;
#pragma unroll
    for (int a = 0; a < 2; ++a)
#pragma unroll
        for (int b = 0; b < 2; ++b)
#pragma unroll
            for (int m = 0; m < 4; ++m)
#pragma unroll
                for (int n = 0; n < 2; ++n) acc[a][b][m][n] = (f32x4){0.f, 0.f, 0.f, 0.f};
    bf16x8 At[4][2], B0[2][2], B1[2][2];
    const char* cA = PG8_ABASE(cur); const char* cB = PG8_BBASE(cur);
    PG8_STAGE(PG8_SB(0, 0), cB, voffB); PG8_STAGE(PG8_SB(0, 1), cB + hstepB, voffB); PG8_STAGE(PG8_SA(0, 0), cA, voffA); PG8_STAGE(PG8_SA(0, 1), cA + hstepA, voffA);
    if (wr == 1) PG8_BAR;
    PG8_WAIT_V(2); PG8_BAR;
    PG8_STAGE(PG8_SB(1, 0), cB + kstep, voffB); PG8_STAGE(PG8_SA(1, 0), cA + kstep, voffA); PG8_STAGE(PG8_SB(1, 1), cB + hstepB + kstep, voffB);
    PG8_WAIT_V(6); PG8_BAR;
    for (;;) {
        const bool has_next = S.next(ui + 1, nxt);
        const char* nA = has_next ? PG8_ABASE(nxt) : cA; const char* nB = has_next ? PG8_BBASE(nxt) : cB;
        for (int t = 0; t < nt; t += 2) {
            const bool last = (t == nt - 2);
            const char* a1 = cA + (size_t)(t + 1) * kstep;
            const char* a2 = last ? nA : cA + (size_t)(t + 2) * kstep; const char* b2 = last ? nB : cB + (size_t)(t + 2) * kstep;
            const char* a3 = a2 + kstep; const char* b3 = b2 + kstep;
            PG8_LDB(B0, 0, 0); PG8_LDB(B1, 0, 1); PG8_SCHED; PG8_LDA(At, 0, 0); PG8_STAGE(PG8_SA(1, 1), a1 + hstepA, voffA);
            PG8_WAIT_V(8); PG8_WAIT_L(0); PG8_BAR; PG8_MMA(0, 0, At, B0); PG8_MMA(0, 1, At, B1); PG8_BAR; PG8_SCHED;
            PG8_LDA(At, 0, 1); PG8_STAGE(PG8_SB(0, 0), b2, voffB); PG8_STAGE(PG8_SB(0, 1), b2 + hstepB, voffB); PG8_STAGE(PG8_SA(0, 0), a2, voffA);
            PG8_WAIT_V(8); PG8_WAIT_L(0); PG8_BAR; PG8_MMA(1, 0, At, B0); PG8_MMA(1, 1, At, B1); PG8_BAR; PG8_SCHED;
            PG8_LDB(B0, 1, 0); PG8_LDB(B1, 1, 1); PG8_SCHED; PG8_LDA(At, 1, 0); PG8_STAGE(PG8_SA(0, 1), a2 + hstepA, voffA);
            PG8_WAIT_V(8); PG8_WAIT_L(0); PG8_BAR; PG8_MMA(0, 0, At, B0); PG8_MMA(0, 1, At, B1); PG8_BAR; PG8_SCHED;
            PG8_LDA(At, 1, 1); PG8_STAGE(PG8_SB(1, 0), b3, voffB); PG8_STAGE(PG8_SB(1, 1), b3 + hstepB, voffB); PG8_STAGE(PG8_SA(1, 0), a3, voffA);
            PG8_WAIT_V(8); PG8_WAIT_L(0); PG8_BAR; PG8_MMA(1, 0, At, B0); PG8_MMA(1, 1, At, B1); PG8_BAR; PG8_SCHED;
        }
        if (wr == 0) PG8_BAR;
        E(acc, cur, wr, wc, fr, fq);
        if (!has_next) break;
#pragma unroll
        for (int a = 0; a < 2; ++a)
#pragma unroll
            for (int b = 0; b < 2; ++b)
#pragma unroll
                for (int m = 0; m < 4; ++m)
#pragma unroll
                    for (int n = 0; n < 2; ++n) acc[a][b][m][n] = (f32x4){0.f, 0.f, 0.f, 0.f};
        cur = nxt; cA = nA; cB = nB; ++ui;
        if (wr == 1) PG8_BAR;
    }
    PG8_WAIT_V(0);
    PG8_BAR;
#undef PG8_SA
#undef PG8_SB
#undef PG8_STAGE
#undef PG8_LDA
#undef PG8_LDB
#undef PG8_MMA
#undef PG8_WAIT_V
#undef PG8_WAIT_L
#undef PG8_BAR
#undef PG8_SCHED
#undef PG8_ABASE
#undef PG8_BBASE
}
}

struct Args { const float* in[23]; float* out; unsigned char* ws; int ph_lo, ph_hi; };

__device__ __forceinline__ void cvt_item(const float* src, int K, int N, bf16_t* dst, int ldd, int mode, int r0, int c0, LAS float* scr, int li, int lane) {
    const int nblk = (N + 31) >> 5, kb = li / nblk, nb = li % nblk, k0 = 64 * kb, n0 = 32 * nb;
    { const int n = n0 + (lane & 31);
#pragma unroll 8
      for (int i = 0; i < 32; ++i) { const int kk = 2 * i + (lane >> 5); scr[kk * 33 + (lane & 31)] = (n < N) ? src[(size_t)(k0 + kk) * N + n] : 0.f; } }
    LDS_WAIT();
    const int c = lane & 7;
#pragma unroll
    for (int j = 0; j < 4; ++j) { const int nl = (lane >> 3) + 8 * j, n = n0 + nl; const LAS float* s = scr + (8 * c) * 33 + nl;
        u32x4 o; o.x = cvt_pk_bf16(s[0 * 33], s[1 * 33]); o.y = cvt_pk_bf16(s[2 * 33], s[3 * 33]); o.z = cvt_pk_bf16(s[4 * 33], s[5 * 33]); o.w = cvt_pk_bf16(s[6 * 33], s[7 * 33]);
        if (n < N) { const int drow = mode ? ((n >> 7) * 256 + (n & 127) + r0) : (r0 + n); *(u32x4*)(dst + (size_t)drow * ldd + c0 + k0 + 8 * c) = o; } }
    LDS_WAIT();
}

__device__ __forceinline__ void p0_phase(const Args& a, LAS unsigned char* lds, int bid, int G) {
    int tid = threadIdx.x; asm volatile("" : "+v"(tid));
    const int lane = tid & 63, wave = __builtin_amdgcn_readfirstlane(tid >> 6);
    unsigned char* ws = a.ws;
    LAS float* scr = (LAS float*)(lds + wave * 8704);
    const int gw = bid * 8 + wave, NGW = G * 8;
    constexpr int NITEMS = 1888 + 256 + 256 + 1024 + 4096 + 2048 + 11264 + 5632;
    for (int it = gw; it < NITEMS; it += NGW) {
        int r = it;
        if (r < 1888) { const int j = r / 944; cvt_item(a.in[6] + (size_t)j * 1024 * AIN, 1024, AIN, (bf16_t*)(ws + W_AIN) + (size_t)j * 2048 * 1024, 1024, 0, 0, 0, scr, r % 944, lane); continue; } r -= 1888;
        if (r < 256) { const int jj = r >> 4, la = jj >> 3, h = jj & 7; cvt_item(a.in[10] + (size_t)(la * 8 + h) * 128 * 256, 128, 256, (bf16_t*)(ws + W_UK) + (size_t)la * 2048 * 256, 256, 0, h * 256, (h & 1) * 128, scr, r & 15, lane); continue; } r -= 256;
        if (r < 256) { const int jj = r >> 4, la = jj >> 3, h = jj & 7; cvt_item(a.in[11] + (size_t)(la * 8 + h) * 256 * 128, 256, 128, (bf16_t*)(ws + W_UV) + (size_t)la * 1024 * 512, 512, 0, (h >> 1) * 256 + (h & 1) * 128, (h & 1) * 256, scr, r & 15, lane); continue; } r -= 256;
        if (r < 1024) { const int la = r >> 9; cvt_item(a.in[12] + (size_t)la * 1024 * 1024, 1024, 1024, (bf16_t*)(ws + W_O) + (size_t)la * 1024 * 1024, 1024, 0, 0, 0, scr, r & 511, lane); continue; } r -= 1024;
        if (r < 4096) { const int la = r >> 11; cvt_item(a.in[13] + (size_t)la * 1024 * 4096, 1024, 4096, (bf16_t*)(ws + W_BIN) + (size_t)la * 4096 * 1024, 1024, 0, 0, 0, scr, r & 2047, lane); continue; } r -= 4096;
        if (r < 2048) { const int la = r >> 10; cvt_item(a.in[18] + (size_t)la * 2048 * 1024, 2048, 1024, (bf16_t*)(ws + W_BOUT) + (size_t)la * 1024 * 2048, 2048, 0, 0, 0, scr, r & 1023, lane); continue; } r -= 2048;
        if (r < 11264) { const int jj = r / 1408, l = jj & 3, isup = jj >> 2; cvt_item(a.in[isup ? 20 : 19] + (size_t)l * 1024 * DFF, 1024, DFF, (bf16_t*)(ws + W_GU) + (size_t)l * 5632 * 1024, 1024, 1, isup * 128, 0, scr, r % 1408, lane); continue; } r -= 11264;
        { const int l = r / 1408; cvt_item(a.in[21] + (size_t)l * DFF * 1024, DFF, 1024, (bf16_t*)(ws + W_DN) + (size_t)l * 1024 * DFF, DFF, 0, 0, 0, scr, r % 1408, lane); }
    }
    const size_t gt = (size_t)bid * 512 + tid, NT = (size_t)G * 512;
    const u32x4 z = (u32x4){0u, 0u, 0u, 0u};
    for (size_t i = gt; i < 2 * 184 * 128; i += NT) { const int j = (int)(i / (184 * 128)), rem = (int)(i % (184 * 128)), rr = AIN + rem / 128, ch = rem % 128;
        *(u32x4*)((bf16_t*)(ws + W_AIN) + ((size_t)j * 2048 + rr) * 1024 + ch * 8) = z; }
    for (size_t i = gt; i < 2 * 2048 * 16; i += NT) { const int j = (int)(i / (2048 * 16)), rem = (int)(i % (2048 * 16)), rr = rem >> 4, ch = rem & 15, h = rr >> 8;
        *(u32x4*)((bf16_t*)(ws + W_UK) + ((size_t)j * 2048 + rr) * 256 + (1 - (h & 1)) * 128 + ch * 8) = z; }
    for (size_t i = gt; i < 2 * 1024 * 32; i += NT) { const int j = (int)(i / (1024 * 32)), rem = (int)(i % (1024 * 32)), rr = rem >> 5, ch = rem & 31, hh = (rr >> 7) & 1;
        *(u32x4*)((bf16_t*)(ws + W_UV) + ((size_t)j * 1024 + rr) * 512 + (1 - hh) * 256 + ch * 8) = z; }
    __syncthreads();
    LAS float* ca = (LAS float*)lds;
    const float* cvec = a.in[1]; const float* modw = a.in[2]; float* MODP = (float*)(ws + WS_MODP);
    for (int it = bid; it < 768; it += G) {
        const int l = it / 192, rem = it % 192, ng = rem >> 4, kc = rem & 15;
        { const int b = tid >> 6, k = tid & 63; const float cv = cvec[b * 1024 + kc * 64 + k]; ca[b * 64 + k] = cv / (1.0f + __expf(-cv)); }
        __syncthreads();
        const int n = ng * 512 + tid; float acc[8];
#pragma unroll
        for (int b = 0; b < 8; ++b) acc[b] = 0.f;
        const float* wp = modw + ((size_t)l * 1024 + kc * 64) * NMOD + n;
#pragma unroll 8
        for (int k = 0; k < 64; ++k) { const float w = wp[(size_t)k * NMOD];
#pragma unroll
            for (int b = 0; b < 8; ++b) acc[b] += ca[b * 64 + k] * w; }
#pragma unroll
        for (int b = 0; b < 8; ++b) MODP[((size_t)(kc * 4 + l) * 8 + b) * NMOD + n] = acc[b];
        __syncthreads();
    }
}
__device__ __forceinline__ void p0c_phase(const Args& a, int bid, int G) {
    const float* MODP = (const float*)(a.ws + WS_MODP); float* MOD = (float*)(a.ws + WS_MOD); const float* modb = a.in[3];
    int tid0 = threadIdx.x; asm volatile("" : "+v"(tid0));
    for (int i = bid * 512 + tid0; i < 4 * 8 * NMOD; i += G * 512) { const int l = i / (8 * NMOD), n = i % NMOD; float s = modb[l * NMOD + n];
#pragma unroll
        for (int kc = 0; kc < 16; ++kc) s += MODP[(size_t)kc * (4 * 8 * NMOD) + i];
        MOD[i] = s; }
}

__device__ __forceinline__ void norm_mod_phase(const float* x, const float* gain, const float* sh, const float* sc, bf16_t* H, int bid, int G) {
    int tid = threadIdx.x; asm volatile("" : "+v"(tid));
    const int lane = tid & 63, wave = tid >> 6;
    for (int rb = (bid * 8 + wave) * 16; rb < M; rb += G * 8 * 16) {
        const int b = rb / T; f32x4 gs[4], sv[4];
#pragma unroll
        for (int j = 0; j < 4; ++j) { const int c = 4 * lane + 256 * j; const f32x4 g4 = *(const f32x4*)(gain + c), s4 = *(const f32x4*)(sc + (size_t)b * NMOD + c); gs[j] = g4 * (s4 + 1.0f); sv[j] = *(const f32x4*)(sh + (size_t)b * NMOD + c); }
        for (int r = rb; r < rb + 16; ++r) {
            const f32x4* xr = (const f32x4*)(x + (size_t)r * D) + lane; f32x4 v[4]; float ss = 0.f;
#pragma unroll
            for (int j = 0; j < 4; ++j) { v[j] = xr[64 * j]; ss += (v[j][0] * v[j][0] + v[j][1] * v[j][1]) + (v[j][2] * v[j][2] + v[j][3] * v[j][3]); }
            const float rstd = rsqrtf(wave_sum(ss) * (1.0f / D) + EPS);
            u32x2* o = (u32x2*)(H + (size_t)r * D) + lane;
#pragma unroll
            for (int j = 0; j < 4; ++j) { const f32x4 y = v[j] * rstd * gs[j] + sv[j]; u32x2 w; w.x = cvt_pk_bf16(y[0], y[1]); w.y = cvt_pk_bf16(y[2], y[3]); o[64 * j] = w; }
        }
    }
}
__device__ __forceinline__ void final_norm_phase(const float* x, const float* gain, float* out, int bid, int G) {
    int tid = threadIdx.x; asm volatile("" : "+v"(tid));
    const int lane = tid & 63, wave = tid >> 6;
    f32x4 gs[4];
#pragma unroll
    for (int j = 0; j < 4; ++j) gs[j] = *(const f32x4*)(gain + 4 * lane + 256 * j);
    for (int r = bid * 8 + wave; r < M; r += G * 8) {
        const f32x4* xr = (const f32x4*)(x + (size_t)r * D) + lane; f32x4 v[4]; float ss = 0.f;
#pragma unroll
        for (int j = 0; j < 4; ++j) { v[j] = xr[64 * j]; ss += (v[j][0] * v[j][0] + v[j][1] * v[j][1]) + (v[j][2] * v[j][2] + v[j][3] * v[j][3]); }
        const float rstd = rsqrtf(wave_sum(ss) * (1.0f / D) + EPS);
        f32x4* o = (f32x4*)(out + (size_t)r * D) + lane;
#pragma unroll
        for (int j = 0; j < 4; ++j) o[64 * j] = v[j] * rstd * gs[j];
    }
}
__device__ __forceinline__ void dsa_rows_phase(const float* CKVR, const float* KRAW, const float* gkv, const float* gk, const float* bk, bf16_t* CKV, bf16_t* KIDX, float* WIDX, int bid, int G) {
    int tid = threadIdx.x; asm volatile("" : "+v"(tid));
    const int lane = tid & 63, wave = tid >> 6;
    const f32x4 g4 = *(const f32x4*)(gkv + 4 * lane);
    f32x4 gk4 = (f32x4){0.f, 0.f, 0.f, 0.f}, bk4 = gk4;
    if (lane < 16) { gk4 = *(const f32x4*)(gk + 4 * lane); bk4 = *(const f32x4*)(bk + 4 * lane); }
    for (int r = bid * 8 + wave; r < M; r += G * 8) {
        const f32x4 v = *(const f32x4*)(CKVR + (size_t)r * 256 + 4 * lane);
        f32x4 kv = (f32x4){0.f, 0.f, 0.f, 0.f}; if (lane < 32) kv = *(const f32x4*)(KRAW + (size_t)r * 128 + 4 * lane);
        const float ss = wave_sum((v[0] * v[0] + v[1] * v[1]) + (v[2] * v[2] + v[3] * v[3]));
        const float rstd = rsqrtf(ss * (1.0f / 256.0f) + EPS);
        { const f32x4 y = v * rstd * g4; int w = 0; w = __builtin_amdgcn_cvt_pk_fp8_f32(y[0], y[1], w, false); w = __builtin_amdgcn_cvt_pk_fp8_f32(y[2], y[3], w, true); *(int*)((unsigned char*)CKV + (size_t)r * 256 + 4 * lane) = w; }
        const float ks = (lane < 16) ? (kv[0] + kv[1]) + (kv[2] + kv[3]) : 0.f;
        const float mean = wave_sum(ks) * (1.0f / 64.0f);
        const f32x4 dv = kv - mean;
        const float kq = (lane < 16) ? (dv[0] * dv[0] + dv[1] * dv[1]) + (dv[2] * dv[2] + dv[3] * dv[3]) : 0.f;
        const float krstd = rsqrtf(wave_sum(kq) * (1.0f / 64.0f) + EPS);
        if (lane < 16) { const f32x4 y = dv * krstd * gk4 + bk4; u32x2 w; w.x = cvt_pk_bf16(y[0], y[1]); w.y = cvt_pk_bf16(y[2], y[3]); *(u32x2*)(KIDX + (size_t)r * 64 + 4 * lane) = w; }
        else if (lane < 18) { *(f32x4*)(WIDX + (size_t)r * 8 + 4 * (lane - 16)) = kv * 0.04419417382f; }
    }
}

__device__ __forceinline__ float relu_i(float x) { const int b = __float_as_int(x); return __int_as_float(b > 0 ? b : 0); }
__device__ __forceinline__ float relu_mul(float x, float w) { return relu_i(x) * w; }
__device__ __forceinline__ float relu_fma(float x, float w, float acc) { return __builtin_fmaf(relu_i(x), w, acc); }
__device__ __forceinline__ float fmin_raw(float a, float b) { return __builtin_amdgcn_fmed3f(a, b, -__builtin_inff()); }
__device__ __forceinline__ float fmax_raw(float a, float b) { return __builtin_amdgcn_fmed3f(a, b, __builtin_inff()); }
__device__ __forceinline__ unsigned mbcnt64(unsigned long long m) { return __builtin_amdgcn_mbcnt_hi((unsigned)(m >> 32), __builtin_amdgcn_mbcnt_lo((unsigned)m, 0u)); }

template <int SHIFT, int WIDTH>
__device__ __forceinline__ void sel_level(const unsigned (&k)[64], int N, LAS unsigned* hist, int lane, unsigned& prefix, unsigned& need) {
    LAS u32x4* hz = (LAS u32x4*)(hist + 32 * lane);
#pragma unroll
    for (int j = 0; j < 8; ++j) hz[j] = (u32x4){0u, 0u, 0u, 0u};
    LDS_WAIT();
#pragma unroll
    for (int gi = 0; gi < 8; ++gi) if (512 * gi < N) {
#pragma unroll
        for (int ii = 0; ii < 8; ++ii) { const unsigned key = k[8 * gi + ii]; const bool ok = (key >> (SHIFT + WIDTH)) == prefix;
            LAS unsigned* p = ok ? hist + ((key >> SHIFT) & ((1u << WIDTH) - 1u)) : hist + 2048 + lane;
            __hip_atomic_fetch_add(p, 1u, __ATOMIC_RELAXED, __HIP_MEMORY_SCOPE_WORKGROUP); } }
    LDS_WAIT();
    u32x4 hv[8]; unsigned ls = 0u;
#pragma unroll
    for (int j = 0; j < 8; ++j) { hv[j] = hz[j]; ls += (hv[j][0] + hv[j][1]) + (hv[j][2] + hv[j][3]); }
    unsigned incl = ls;
#pragma unroll
    for (int o = 1; o < 64; o <<= 1) { const unsigned v = __shfl_down(incl, o); if (lane + o < 64) incl += v; }
    const unsigned above = incl - ls;
    unsigned cnt = above, d = 0u, nn = 0u;
#pragma unroll
    for (int j = 31; j >= 0; --j) { const unsigned h = hv[j >> 2][j & 3]; const bool hit = (cnt < need) && (need <= cnt + h); d = hit ? (unsigned)(32 * lane + j) : d; nn = hit ? need - cnt : nn; cnt += h; }
    const bool found = (above < need) && (need <= above + ls);
    const unsigned long long fm = __ballot(found);
    const int src = (fm != 0ull) ? (__ffsll((long long)fm) - 1) : 0;
    d = __shfl(d, src); need = __shfl(nn, src);
    prefix = (prefix << WIDTH) | d;
}

__device__ __forceinline__ void dsa_select_phase(LAS unsigned char* lds, const bf16_t* QIDX, const bf16_t* KIDX, const float* WIDX, unsigned short* IDX, int bid, int G) {
    int tid0 = threadIdx.x; asm volatile("" : "+v"(tid0));
    const int wave = __builtin_amdgcn_readfirstlane(tid0 >> 6);
    LAS float* SC = (LAS float*)lds;
    LAS unsigned short* IDXL = (LAS unsigned short*)(lds + 135168) + wave * 256;
    LAS float* MM = (LAS float*)(lds + 139264);
    bf16x8 af[2][4]; bf16x8 kb[4][4];
#define DSA_UNIT(itx, b_, t0_, mb_, ntile_, nj_) const int b_ = (itx) & 7, t0_ = ((itx) >> 3) * 8; const size_t mb_ = (size_t)b_ * T; \
    const int ntile_ = (t0_ + 8 + 31) >> 5; const int nj_ = (wave < ntile_) ? ((ntile_ - wave + 7) >> 3) : 0;
#define DSA_KLOAD(buf, j, kbase_, nj_) do { const int jc_ = ((j) < (nj_)) ? (j) : ((nj_) > 0 ? (nj_) - 1 : 0); const bf16_t* kp_ = (kbase_) + (size_t)(32 * (wave + 8 * jc_)) * 64; \
    _Pragma("unroll") for (int ks = 0; ks < 4; ++ks) kb[buf][ks] = *(const bf16x8*)(kp_ + 16 * ks); } while (0)
#define DSA_PRELOAD(t0_, mb_, nj_) do { \
    _Pragma("unroll") for (int rg = 0; rg < 2; ++rg) { const bf16_t* qp = QIDX + ((mb_) + (t0_) + 4 * rg + (col >> 3)) * 512 + (col & 7) * 64 + 8 * hf; \
        _Pragma("unroll") for (int ks = 0; ks < 4; ++ks) af[rg][ks] = *(const bf16x8*)(qp + 16 * ks); } \
    (void)(nj_); } while (0)
    { int tid = tid0; asm volatile("" : "+v"(tid)); const int lane = tid & 63, hf = lane >> 5, col = lane & 31;
      if (bid < 4096) { DSA_UNIT(bid, b, t0, mb, ntile, nj) (void)b; (void)ntile; if (t0 + 8 > 256) DSA_PRELOAD(t0, mb, nj); } }
    for (int it = bid; it < 4096; it += G) {
        int tid = tid0; asm volatile("" : "+v"(tid));
        const int lane = tid & 63, hf = lane >> 5, col = lane & 31;
        DSA_UNIT(it, b, t0, mb, ntile, nj) (void)b; (void)ntile;
        const int t = t0 + wave, N = t + 1;
        unsigned short* outp = IDX + (mb + t) * 256;
        const int itn = it + G; const bool hasn = itn < 4096;
        DSA_UNIT(hasn ? itn : it, bn, t0n, mbn, ntilen, njn) (void)bn; (void)ntilen;
        if (t0 + 8 <= 256) {
            *(u32x2*)(outp + 4 * lane) = (u32x2){(unsigned)(4 * lane) | ((unsigned)(4 * lane + 1) << 16), (unsigned)(4 * lane + 2) | ((unsigned)(4 * lane + 3) << 16)};
            if (hasn && t0n + 8 > 256) DSA_PRELOAD(t0n, mbn, njn);
            continue;
        }
        float w[2][4][4]; float mn[2][2], mx[2][2];
#pragma unroll
        for (int rg = 0; rg < 2; ++rg)
#pragma unroll
            for (int e = 0; e < 2; ++e) { mn[rg][e] = 3.0e38f; mx[rg][e] = -3.0e38f; }
        const bf16_t* kbase = KIDX + (mb + col) * 64 + 8 * hf;
        DSA_KLOAD(0, 0, kbase, nj); DSA_KLOAD(1, 1, kbase, nj); DSA_KLOAD(2, 2, kbase, nj); DSA_KLOAD(3, 3, kbase, nj);
#pragma unroll
        for (int rg = 0; rg < 2; ++rg)
#pragma unroll
            for (int qq = 0; qq < 4; ++qq) { const f32x4 wv = *(const f32x4*)(WIDX + (mb + t0 + 4 * rg + qq) * 8 + 4 * hf);
                w[rg][qq][0] = wv[0]; w[rg][qq][1] = wv[1]; w[rg][qq][2] = wv[2]; w[rg][qq][3] = wv[3]; }
#define DSA_KCOMP(buf, j) do { const int s_ = 32 * (wave + 8 * (j)) + col; f32x16 acc0, acc1; \
    _Pragma("unroll") for (int i = 0; i < 16; ++i) { acc0[i] = 0.f; acc1[i] = 0.f; } \
    _Pragma("unroll") for (int ks = 0; ks < 4; ++ks) { acc0 = __builtin_amdgcn_mfma_f32_32x32x16_bf16(af[0][ks], kb[buf][ks], acc0, 0, 0, 0); acc1 = __builtin_amdgcn_mfma_f32_32x32x16_bf16(af[1][ks], kb[buf][ks], acc1, 0, 0, 0); } \
    _Pragma("unroll") for (int rg = 0; rg < 2; ++rg) { float p[4]; \
        _Pragma("unroll") for (int qq = 0; qq < 4; ++qq) { p[qq] = relu_mul(rg ? acc1[4 * qq] : acc0[4 * qq], w[rg][qq][0]); _Pragma("unroll") for (int ii = 1; ii < 4; ++ii) p[qq] = relu_fma(rg ? acc1[4 * qq + ii] : acc0[4 * qq + ii], w[rg][qq][ii], p[qq]); } \
        _Pragma("unroll") for (int e = 0; e < 2; ++e) { const auto r = __builtin_amdgcn_permlane32_swap(__float_as_uint(p[e]), __float_as_uint(p[2 + e]), false, false); \
            const float tot = __uint_as_float(r[0]) + __uint_as_float(r[1]); SC[(4 * rg + 2 * hf + e) * 4096 + s_] = tot; mn[rg][e] = fmin_raw(mn[rg][e], tot); mx[rg][e] = fmax_raw(mx[rg][e], tot); } } } while (0)
        for (int j = 0; j < nj; j += 4) {
            DSA_KCOMP(0, j); if (j + 4 < nj) DSA_KLOAD(0, j + 4, kbase, nj);
            if (j + 1 < nj) DSA_KCOMP(1, j + 1);
            if (j + 5 < nj) DSA_KLOAD(1, j + 5, kbase, nj);
            if (j + 2 < nj) DSA_KCOMP(2, j + 2);
            if (j + 6 < nj) DSA_KLOAD(2, j + 6, kbase, nj);
            if (j + 3 < nj) DSA_KCOMP(3, j + 3);
            if (j + 7 < nj) DSA_KLOAD(3, j + 7, kbase, nj);
        }
#pragma unroll
        for (int rg = 0; rg < 2; ++rg)
#pragma unroll
            for (int e = 0; e < 2; ++e) {
#pragma unroll
                for (int o = 1; o < 32; o <<= 1) { mn[rg][e] = fminf(mn[rg][e], __shfl_xor(mn[rg][e], o)); mx[rg][e] = fmaxf(mx[rg][e], __shfl_xor(mx[rg][e], o)); }
                if (col == 0) { MM[(wave * 8 + 4 * rg + 2 * hf + e) * 2] = mn[rg][e]; MM[(wave * 8 + 4 * rg + 2 * hf + e) * 2 + 1] = mx[rg][e]; } }
        if (hasn && t0n + 8 > 256) DSA_PRELOAD(t0n, mbn, njn);
        __syncthreads();
        {
            const LAS float* scl = SC + wave * 4096 + lane;
            LAS unsigned* hist = (LAS unsigned*)(lds + wave * 16384);
            float lo = 3.0e38f, hi = -3.0e38f;
#pragma unroll
            for (int wv = 0; wv < 8; ++wv) { lo = fminf(lo, MM[(wv * 8 + wave) * 2]); hi = fmaxf(hi, MM[(wv * 8 + wave) * 2 + 1]); }
            const float scale = 4.0e9f / fmaxf(hi - lo, 1e-30f);
            unsigned k[64];
#pragma unroll
            for (int gi = 0; gi < 8; ++gi) { if (512 * gi < N) {
#pragma unroll
                for (int ii = 0; ii < 8; ++ii) k[8 * gi + ii] = __float_as_uint(scl[64 * (8 * gi + ii)]); } else {
#pragma unroll
                for (int ii = 0; ii < 8; ++ii) k[8 * gi + ii] = 0u; } }
            LDS_WAIT();
            { LAS u32x4* hz = (LAS u32x4*)(hist + 16 * lane);
#pragma unroll
              for (int j = 0; j < 4; ++j) hz[j] = (u32x4){0u, 0u, 0u, 0u}; }
            LDS_WAIT();
#pragma unroll
            for (int gi = 0; gi < 8; ++gi) if (512 * gi < N) {
#pragma unroll
                for (int ii = 0; ii < 8; ++ii) { const int i = 8 * gi + ii; const bool valid = lane < N - 64 * i;
                    const unsigned key = valid ? 1u + (unsigned)((__uint_as_float(k[i]) - lo) * scale) : 0u; k[i] = key;
                    LAS unsigned* p = valid ? hist + (key >> 22) : hist + 1024 + lane;
                    __hip_atomic_fetch_add(p, 1u, __ATOMIC_RELAXED, __HIP_MEMORY_SCOPE_WORKGROUP); } }
            LDS_WAIT();
            unsigned d0, need1;
            { const LAS u32x4* hz = (const LAS u32x4*)(hist + 16 * lane); u32x4 hv[4]; unsigned ls = 0u;
#pragma unroll
              for (int j = 0; j < 4; ++j) { hv[j] = hz[j]; ls += (hv[j][0] + hv[j][1]) + (hv[j][2] + hv[j][3]); }
              unsigned incl = ls;
#pragma unroll
              for (int o = 1; o < 64; o <<= 1) { const unsigned v = __shfl_down(incl, o); if (lane + o < 64) incl += v; }
              const unsigned above = incl - ls; unsigned cnt = above, d = 0u, nn = 0u;
#pragma unroll
              for (int j = 15; j >= 0; --j) { const unsigned h = hv[j >> 2][j & 3]; const bool hit = (cnt < 256u) && (256u <= cnt + h); d = hit ? (unsigned)(16 * lane + j) : d; nn = hit ? 256u - cnt : nn; cnt += h; }
              const bool found = (above < 256u) && (256u <= above + ls);
              const unsigned long long fm = __ballot(found);
              const int src = (fm != 0ull) ? (__ffsll((long long)fm) - 1) : 0;
              d0 = __shfl(d, src); need1 = __shfl(nn, src); }
            LAS unsigned* CK = hist + 1100; LAS unsigned short* CS = (LAS unsigned short*)(hist + 1170);
            unsigned base = 0u, cbase = 0u;
#pragma unroll
            for (int gi = 0; gi < 8; ++gi) if (512 * gi < N) {
#pragma unroll
                for (int ii = 0; ii < 8; ++ii) { const int i = 8 * gi + ii; const unsigned key = k[i], dg = key >> 22;
                    const bool gt = dg > d0, eq = (dg == d0) && (key != 0u);
                    const unsigned long long mgt = __ballot(gt), meq = __ballot(eq);
                    if (gt) IDXL[base + mbcnt64(mgt)] = (unsigned short)(64 * i + lane);
                    base += (unsigned)__popcll(mgt);
                    if (meq != 0ull) { const unsigned cp = cbase + mbcnt64(meq); if (eq && cp < 64u) { CK[cp] = key; CS[cp] = (unsigned short)(64 * i + lane); } cbase += (unsigned)__popcll(meq); } } }
            LDS_WAIT();
            if (cbase <= 64u) {
                const unsigned mykey = (lane < (int)cbase) ? CK[lane] : 0u; unsigned rank = 0u;
                for (unsigned j = 0; j < cbase; ++j) { const unsigned kj = CK[j]; rank += ((kj > mykey) || (kj == mykey && j < (unsigned)lane)) ? 1u : 0u; }
                const bool sel = (lane < (int)cbase) && (rank < need1);
                const unsigned long long ms = __ballot(sel);
                if (sel) IDXL[base + mbcnt64(ms)] = CS[lane];
            } else {
                unsigned prefix = d0, need = need1;
                LDS_WAIT();
                sel_level<11, 11>(k, N, hist, lane, prefix, need);
                sel_level<0, 11>(k, N, hist, lane, prefix, need);
                unsigned eb = 0u, eqb = 0u;
#pragma unroll
                for (int gi = 0; gi < 8; ++gi) if (512 * gi < N) {
#pragma unroll
                    for (int ii = 0; ii < 8; ++ii) { const int i = 8 * gi + ii; const unsigned key = k[i]; const bool gt = key > prefix, eq = key == prefix;
                        const unsigned long long meq = __ballot(eq); const bool sel = gt || (eq && (eqb + mbcnt64(meq) < need));
                        const unsigned long long msel = __ballot(sel); const unsigned pos = eb + mbcnt64(msel);
                        if (sel && pos < 256u) IDXL[pos] = (unsigned short)(64 * i + lane);
                        eb += (unsigned)__popcll(msel); eqb += (unsigned)__popcll(meq); } }
            }
            LDS_WAIT();
            *(u32x2*)(outp + 4 * lane) = *(const LAS u32x2*)(IDXL + 4 * lane);
        }
        __syncthreads();
    }
#undef DSA_UNIT
#undef DSA_KLOAD
#undef DSA_PRELOAD
#undef DSA_KCOMP
}

__device__ __forceinline__ void dsa_attn_phase(LAS unsigned char* lds, const unsigned char* QLAT8, const unsigned char* CKV8, const unsigned short* IDX, bf16_t* OLAT, int bid, int G) {
    int tid0 = threadIdx.x; asm volatile("" : "+v"(tid0));
    const int wave = __builtin_amdgcn_readfirstlane(tid0 >> 6);
    LAS unsigned char* tile0 = lds + wave * 17408;
    constexpr int TS = 8704, RS = 272;
    constexpr float SCL = 1.4426950408889634f / 16.0f;
    unsigned ixw[8]; u32x4 qf[4]; u32x4 ra[2][2][4];
#define ATT_Q(itx, b_, t_, m_, cnt_) const int b_ = (itx) & 7, t_ = ((itx) >> 3) * 8 + wave; const size_t m_ = (size_t)b_ * T + t_; const int cnt_ = (t_ + 1 < 256) ? t_ + 1 : 256;
#define ATT_LOAD_IX(dst, m_) do { const u32x4 xa_ = *(const u32x4*)(IDX + (m_) * 256 + 16 * c16), xb_ = *(const u32x4*)(IDX + (m_) * 256 + 16 * c16 + 8); \
    dst[0] = xa_[0]; dst[1] = xa_[1]; dst[2] = xa_[2]; dst[3] = xa_[3]; dst[4] = xb_[0]; dst[5] = xb_[1]; dst[6] = xb_[2]; dst[7] = xb_[3]; } while (0)
#define ATT_LOAD_QF(dst, m_) do { const unsigned char* qp_ = QLAT8 + (m_) * 2048 + hd * 256 + 16 * g; _Pragma("unroll") for (int kk = 0; kk < 4; ++kk) dst[kk] = *(const u32x4*)(qp_ + 64 * kk); } while (0)
#define ATT_LOAD_ROWS(buf, ix_, n0_, b_, cnt_) do { const int n1_ = (n0_) + 1; \
    const int k0_ = (16 * c16 + (n0_) < (cnt_)) ? (int)(ix_[(n0_) >> 1] & 0xffffu) : 0, k1_ = (16 * c16 + n1_ < (cnt_)) ? (int)(ix_[n1_ >> 1] >> 16) : 0; \
    const unsigned char* cb_ = CKV8 + (size_t)(b_) * T * 256 + 16 * g; \
    _Pragma("unroll") for (int kk = 0; kk < 4; ++kk) { ra[buf][0][kk] = *(const u32x4*)(cb_ + (size_t)k0_ * 256 + 64 * kk); ra[buf][1][kk] = *(const u32x4*)(cb_ + (size_t)k1_ * 256 + 64 * kk); } } while (0)
#define ATT_QK(bf, d0, d1) do { d0 = (f32x4){0.f, 0.f, 0.f, 0.f}; d1 = d0; \
    _Pragma("unroll") for (int kk = 0; kk < 4; ++kk) _Pragma("unroll") for (int hh = 0; hh < 2; ++hh) { \
        const long qv_ = (long)(((unsigned long long)qf[kk][2 * hh + 1] << 32) | qf[kk][2 * hh]); \
        const long a0_ = (long)(((unsigned long long)ra[bf][0][kk][2 * hh + 1] << 32) | ra[bf][0][kk][2 * hh]); \
        const long a1_ = (long)(((unsigned long long)ra[bf][1][kk][2 * hh + 1] << 32) | ra[bf][1][kk][2 * hh]); \
        d0 = __builtin_amdgcn_mfma_f32_16x16x32_fp8_fp8(a0_, qv_, d0, 0, 0, 0); d1 = __builtin_amdgcn_mfma_f32_16x16x32_fp8_fp8(a1_, qv_, d1, 0, 0, 0); } \
    _Pragma("unroll") for (int kk = 0; kk < 4; ++kk) { *(LAS u32x4*)(tile0 + (bf) * TS + c16 * RS + 64 * kk + 16 * g) = ra[bf][0][kk]; *(LAS u32x4*)(tile0 + (bf) * TS + (16 + c16) * RS + 64 * kk + 16 * g) = ra[bf][1][kk]; } } while (0)
    { int tid = tid0; asm volatile("" : "+v"(tid)); const int lane = tid & 63, g = lane >> 4, c16 = lane & 15, hd = c16 & 7;
      if (bid < 4096) { ATT_Q(bid, b, t, m, cnt) (void)t; ATT_LOAD_IX(ixw, m); ATT_LOAD_QF(qf, m); ATT_LOAD_ROWS(0, ixw, 0, b, cnt); ATT_LOAD_ROWS(1, ixw, 2, b, cnt); } }
    for (int it = bid; it < 4096; it += G) {
        int tid = tid0; asm volatile("" : "+v"(tid));
        const int lane = tid & 63, g = lane >> 4, c16 = lane & 15, hd = c16 & 7, q4 = c16 >> 2, p4 = c16 & 3;
        ATT_Q(it, b, t, m, cnt) (void)t;
        const int itn = it + G; const bool hasn = itn < 4096;
        ATT_Q(hasn ? itn : it, bn, tn, mn, cntn) (void)tn;
        f32x4 oe[8], oo[8];
#pragma unroll
        for (int ub = 0; ub < 8; ++ub) { oe[ub] = (f32x4){0.f, 0.f, 0.f, 0.f}; oo[ub] = oe[ub]; }
        float mrun = -INFINITY, lrun = 0.f;
        f32x4 s0, s1, sn0, sn1;
        ATT_QK(0, s0, s1); ATT_LOAD_ROWS(0, ixw, 4, b, cnt);
#pragma unroll
        for (int ch = 0; ch < 8; ++ch) {
            const int bf = ch & 1, bn1 = (ch + 1) & 1;
            if (ch < 7) { ATT_QK(bn1, sn0, sn1);
                if (ch < 5) ATT_LOAD_ROWS(bn1, ixw, 2 * (ch + 3), b, cnt);
                else if (hasn) ATT_LOAD_ROWS(bn1, ixw, 2 * (ch - 5), bn, cntn); }
            if (ch == 4 && hasn) ATT_LOAD_IX(ixw, mn);
            if (ch == 6 && hasn) ATT_LOAD_QF(qf, mn);
            float cm = -INFINITY;
#pragma unroll
            for (int i = 0; i < 4; ++i) { const int jr = 16 * (4 * g + i) + 2 * ch; if (jr >= cnt) s0[i] = -INFINITY; if (jr + 1 >= cnt) s1[i] = -INFINITY; cm = fmaxf(cm, fmaxf(s0[i], s1[i])); }
            cm = fmaxf(cm, __shfl_xor(cm, 16)); cm = fmaxf(cm, __shfl_xor(cm, 32));
            const float mnew = fmaxf(mrun, cm), alpha = __builtin_amdgcn_exp2f((mrun - mnew) * SCL);
            float p0[4], p1[4], ps = 0.f;
#pragma unroll
            for (int i = 0; i < 4; ++i) { p0[i] = __builtin_amdgcn_exp2f((s0[i] - mnew) * SCL); p1[i] = __builtin_amdgcn_exp2f((s1[i] - mnew) * SCL); ps += p0[i] + p1[i]; }
            lrun = lrun * alpha + ps; mrun = mnew;
            asm volatile("" : "+v"(lrun));
#pragma unroll
            for (int ub = 0; ub < 8; ++ub) { oe[ub] = oe[ub] * alpha; oo[ub] = oo[ub] * alpha; }
            int pl = 0, ph = 0;
            pl = __builtin_amdgcn_cvt_pk_fp8_f32(p0[0], p0[1], pl, false); pl = __builtin_amdgcn_cvt_pk_fp8_f32(p0[2], p0[3], pl, true);
            ph = __builtin_amdgcn_cvt_pk_fp8_f32(p1[0], p1[1], ph, false); ph = __builtin_amdgcn_cvt_pk_fp8_f32(p1[2], p1[3], ph, true);
            const long pb = (long)(((unsigned long long)(unsigned)ph << 32) | (unsigned)pl);
#pragma unroll
            for (int ub = 0; ub < 8; ++ub) {
                const s16x4 t0v = __builtin_amdgcn_ds_read_tr16_b64_v4i16((LAS s16x4*)(tile0 + bf * TS + (4 * g + q4) * RS + 32 * ub + 8 * p4));
                const s16x4 t1v = __builtin_amdgcn_ds_read_tr16_b64_v4i16((LAS s16x4*)(tile0 + bf * TS + (16 + 4 * g + q4) * RS + 32 * ub + 8 * p4));
                const u32x2 w0 = __builtin_bit_cast(u32x2, t0v), w1 = __builtin_bit_cast(u32x2, t1v);
                const unsigned e0 = __builtin_amdgcn_perm(w0.y, w0.x, 0x06040200u), o0 = __builtin_amdgcn_perm(w0.y, w0.x, 0x07050301u);
                const unsigned e1 = __builtin_amdgcn_perm(w1.y, w1.x, 0x06040200u), o1 = __builtin_amdgcn_perm(w1.y, w1.x, 0x07050301u);
                const long ae = (long)(((unsigned long long)e1 << 32) | e0), ao = (long)(((unsigned long long)o1 << 32) | o0);
                oe[ub] = __builtin_amdgcn_mfma_f32_16x16x32_fp8_fp8(ae, pb, oe[ub], 0, 0, 0);
                oo[ub] = __builtin_amdgcn_mfma_f32_16x16x32_fp8_fp8(ao, pb, oo[ub], 0, 0, 0);
            }
            if (ch < 7) { s0 = sn0; s1 = sn1; }
        }
        float lt = lrun + __shfl_xor(lrun, 16); lt += __shfl_xor(lt, 32);
        const float inv = 1.0f / lt;
        if (c16 < 8) { bf16_t* op = OLAT + m * 2048 + c16 * 256 + 8 * g;
#pragma unroll
            for (int ub = 0; ub < 8; ++ub) { const f32x4 ye = oe[ub] * inv, yo = oo[ub] * inv; u32x4 wv;
                wv.x = cvt_pk_bf16(ye[0], yo[0]); wv.y = cvt_pk_bf16(ye[1], yo[1]); wv.z = cvt_pk_bf16(ye[2], yo[2]); wv.w = cvt_pk_bf16(ye[3], yo[3]); *(u32x4*)(op + 32 * ub) = wv; } }
    }
#undef ATT_Q
#undef ATT_LOAD_IX
#undef ATT_LOAD_QF
#undef ATT_LOAD_ROWS
#undef ATT_QK
}

__device__ __forceinline__ void smix_phase(LAS unsigned char* lds, bf16_t* UY, const bf16_t* V, const f32x2* STATS, const float* Wc, const float* bsp, const float* lng, const float* lnb, int bid, int G) {
    int tid = threadIdx.x; asm volatile("" : "+v"(tid));
    const int lane = tid & 63, wave = __builtin_amdgcn_readfirstlane(tid >> 6);
    const int gq = lane >> 4, c16 = lane & 15, q4 = c16 >> 2, p4 = c16 & 3;
    LAS unsigned char* VT = lds;
    LAS unsigned char* AP = lds + 67584;
    LAS float* MU = (LAS float*)(lds + 102400); LAS float* RSTD = MU + 128; LAS float* R1 = MU + 256; LAS float* R2 = MU + 384;
    for (int it = bid; it < 2048; it += G) {
        const int gi = it & 7, rem = it >> 3, b = rem >> 5, ck = rem & 31; const size_t m0 = (size_t)b * T + ck * 128;
        if (tid < 128) { const f32x2* sp = STATS + (m0 + tid) * 32; float s = 0.f, ss = 0.f;
#pragma unroll 8
            for (int p = 0; p < 32; ++p) { const f32x2 v = sp[p]; s += v.x; ss += v.y; }
            const float mu = s * (1.0f / 2048.0f), var = ss * (1.0f / 2048.0f) - mu * mu; MU[tid] = mu; RSTD[tid] = rsqrtf(fmaxf(var, 0.f) + EPS); }
#pragma unroll
        for (int i = 0; i < 8; ++i) { const int cidx = tid + 512 * i, s = cidx >> 5, ch = cidx & 31;
            *(LAS u32x4*)(VT + s * 528 + ch * 16) = *(const u32x4*)(V + (m0 + s) * 2048 + gi * 256 + ch * 8); }
        __syncthreads();
        { const int t = tid >> 2, qd = tid & 3; const float* wp = Wc + ((size_t)gi * 128 + t) * 128 + 32 * qd; float r1 = 0.f, r2 = 0.f;
#pragma unroll
          for (int s8 = 0; s8 < 4; ++s8) { const f32x4 wa = *(const f32x4*)(wp + 8 * s8), wb = *(const f32x4*)(wp + 8 * s8 + 4); float av[8];
#pragma unroll
              for (int e = 0; e < 8; ++e) { const int s = 32 * qd + 8 * s8 + e; const float wv = (s <= t) ? (e < 4 ? wa[e] : wb[e - 4]) : 0.f; const float ab = bf_round(wv * RSTD[s]); av[e] = ab; r1 += ab * MU[s]; r2 += wv; }
              u32x4 o; o.x = cvt_pk_bf16(av[0], av[1]); o.y = cvt_pk_bf16(av[2], av[3]); o.z = cvt_pk_bf16(av[4], av[5]); o.w = cvt_pk_bf16(av[6], av[7]);
              *(LAS u32x4*)(AP + t * 272 + (32 * qd + 8 * s8) * 2) = o; }
          r1 += __shfl_xor(r1, 1); r2 += __shfl_xor(r2, 1); r1 += __shfl_xor(r1, 2); r2 += __shfl_xor(r2, 2);
          if (qd == 0) { R1[t] = r1; R2[t] = r2; } }
        __syncthreads();
        f32x4 acc[8][2];
#pragma unroll
        for (int mt = 0; mt < 8; ++mt) { acc[mt][0] = (f32x4){0.f, 0.f, 0.f, 0.f}; acc[mt][1] = acc[mt][0]; }
#pragma unroll
        for (int ks = 0; ks < 4; ++ks) {
            bf16x8 vf[2];
#pragma unroll
            for (int n2 = 0; n2 < 2; ++n2) { const int nt = 2 * wave + n2;
                const s16x4 t0v = __builtin_amdgcn_ds_read_tr16_b64_v4i16((LAS s16x4*)(VT + (32 * ks + 8 * gq + q4) * 528 + (16 * nt + 4 * p4) * 2));
                const s16x4 t1v = __builtin_amdgcn_ds_read_tr16_b64_v4i16((LAS s16x4*)(VT + (32 * ks + 8 * gq + 4 + q4) * 528 + (16 * nt + 4 * p4) * 2));
                vf[n2] = __builtin_shufflevector(t0v, t1v, 0, 1, 2, 3, 4, 5, 6, 7); }
#pragma unroll
            for (int mt = 0; mt < 8; ++mt) if (mt >= 2 * ks) {
                const bf16x8 afr = *(const LAS bf16x8*)(AP + (16 * mt + c16) * 272 + (32 * ks + 8 * gq) * 2);
                acc[mt][0] = __builtin_amdgcn_mfma_f32_16x16x32_bf16(vf[0], afr, acc[mt][0], 0, 0, 0);
                acc[mt][1] = __builtin_amdgcn_mfma_f32_16x16x32_bf16(vf[1], afr, acc[mt][1], 0, 0, 0); }
        }
#pragma unroll
        for (int n2 = 0; n2 < 2; ++n2) { const int e0 = 16 * (2 * wave + n2) + 4 * gq; const f32x4 lg4 = *(const f32x4*)(lng + gi * 256 + e0), lb4 = *(const f32x4*)(lnb + gi * 256 + e0);
#pragma unroll
            for (int mt = 0; mt < 8; ++mt) { const int t = 16 * mt + c16; const float r1 = R1[t], r2 = R2[t], bsv = bsp[gi * 128 + t];
                bf16_t* up = UY + (m0 + t) * 2048 + gi * 256 + e0; const u32x2 uw = *(const u32x2*)up;
                const f32x4 mixed = lg4 * (acc[mt][n2] - r1) + lb4 * r2 + bsv;
                const float y0 = bf2f(uw.x & 0xffffu) * mixed[0], y1 = bf2f(uw.x >> 16) * mixed[1], y2 = bf2f(uw.y & 0xffffu) * mixed[2], y3 = bf2f(uw.y >> 16) * mixed[3];
                u32x2 yw; yw.x = cvt_pk_bf16(y0, y1); yw.y = cvt_pk_bf16(y2, y3); *(u32x2*)up = yw; } }
        __syncthreads();
    }
}

__global__ void __launch_bounds__(512, 2) mk_fwd(Args a) {
    extern __shared__ __attribute__((aligned(16))) unsigned char lds_raw[];
    LAS unsigned char* lds = (LAS unsigned char*)lds_raw;
    cg::grid_group grid = cg::this_grid();
    const int bid = blockIdx.x, G = gridDim.x;
    unsigned char* ws = a.ws;
    float* MOD = (float*)(ws + WS_MOD);
    bf16_t* H = (bf16_t*)(ws + WS_H);
    float* X = a.out;
    volatile LAS unsigned* misc = (volatile LAS unsigned*)(lds + LDS_MISC);
    if (threadIdx.x < 2) misc[threadIdx.x] = 0u;
    __syncthreads();
    const XcdBarrier xbar = xcd_barrier_post((unsigned*)(ws + WS_BAR), misc);
    int ph = 0;
#ifndef PROBE
#define PROBE 0
#endif
#define PHASE_BEGIN if (ph >= a.ph_lo && ph < a.ph_hi) {
#define REP(k) for (int rep_ = 0; rep_ < ((PROBE == (k)) ? 2 : 1); ++rep_)
#define PHASE_END(dosync) if ((dosync) && ph + 1 < a.ph_hi) { if (ph == 0) grid.sync(); else xcd_barrier(xbar); } } ++ph;

    PHASE_BEGIN REP(4) { p0_phase(a, lds, bid, G); __syncthreads(); } PHASE_END(true)
    PHASE_BEGIN p0c_phase(a, bid, G); PHASE_END(true)

#pragma unroll 1
    for (int layer = 0; layer < 4; ++layer) {
        const int j = layer >> 1; const float* xin = (layer == 0) ? a.in[0] : X;
        const float* modl = MOD + (size_t)layer * 8 * NMOD;
        PHASE_BEGIN REP(3) norm_mod_phase(xin, a.in[4] + layer * D, modl + 0 * D, modl + 1 * D, H, bid, G); PHASE_END(true)
        if ((layer & 1) == 0) {
            bf16_t* Q = (bf16_t*)(ws + WS_Q); float* CKVR = (float*)(ws + WS_CKVR); bf16_t* QIDX = (bf16_t*)(ws + WS_QIDX); float* KRAW = (float*)(ws + WS_KRAW);
            bf16_t* CKV = (bf16_t*)(ws + WS_CKV); bf16_t* KIDX = (bf16_t*)(ws + WS_KIDX); float* WIDX = (float*)(ws + WS_WIDX); unsigned short* IDX = (unsigned short*)(ws + WS_IDX);
            bf16_t* QLAT = (bf16_t*)(ws + WS_QLAT); bf16_t* OLAT = (bf16_t*)(ws + WS_OLAT); bf16_t* O = (bf16_t*)(ws + WS_O);
            PHASE_BEGIN { pg8::Gemm g{H, (const bf16_t*)(ws + W_AIN) + (size_t)j * 2048 * 1024, M, 2048, 1024, 1024, 0, 0}; pg8::StaticOrder S; S.init(M, 2048, G, bid);
                pg8::EpiInproj E{Q, CKVR, QIDX, KRAW}; REP(5) pg8::gemm_phase(lds, g, S, E); } PHASE_END(true)
            PHASE_BEGIN { dsa_rows_phase(CKVR, KRAW, a.in[7] + j * 256, a.in[8] + j * 64, a.in[9] + j * 64, CKV, KIDX, WIDX, bid, G);
                __syncthreads();
                pg8::Gemm g{Q, (const bf16_t*)(ws + W_UK) + (size_t)j * 2048 * 256, M, 2048, 256, 1024, 1, 256}; pg8::StaticOrder S; S.init(M, 2048, G, bid);
                pg8::EpiBf16 E{QLAT, 2048, 1.4142135623730951f, 1}; pg8::gemm_phase(lds, g, S, E); } PHASE_END(true)
            PHASE_BEGIN REP(1) dsa_select_phase(lds, QIDX, KIDX, WIDX, IDX, bid, G); PHASE_END(true)
            PHASE_BEGIN REP(2) dsa_attn_phase(lds, (const unsigned char*)QLAT, (const unsigned char*)CKV, IDX, OLAT, bid, G); PHASE_END(true)
            PHASE_BEGIN { pg8::Gemm g{OLAT, (const bf16_t*)(ws + W_UV) + (size_t)j * 1024 * 512, M, 1024, 512, 2048, 0, 512}; pg8::StaticOrder S; S.init(M, 1024, G, bid);
                pg8::EpiBf16 E{O, 1024, 1.0f, 0}; pg8::gemm_phase(lds, g, S, E); } PHASE_END(true)
            PHASE_BEGIN { pg8::Gemm g{O, (const bf16_t*)(ws + W_O) + (size_t)j * 1024 * 1024, M, 1024, 1024, 1024, 0, 0}; pg8::StaticOrder S; S.init(M, 1024, G, bid);
                pg8::EpiResid E{xin, X, modl + 2 * D}; pg8::gemm_phase(lds, g, S, E); } PHASE_END(true)
        } else {
            bf16_t* U = (bf16_t*)(ws + WS_U); bf16_t* V = (bf16_t*)(ws + WS_V); f32x2* STATS = (f32x2*)(ws + WS_STATS);
            PHASE_BEGIN { pg8::Gemm g{H, (const bf16_t*)(ws + W_BIN) + (size_t)j * 4096 * 1024, M, 4096, 1024, 1024, 0, 0}; pg8::StaticOrder S; S.init(M, 4096, G, bid);
                pg8::EpiGelu E{U, V, STATS}; REP(7) pg8::gemm_phase(lds, g, S, E); } PHASE_END(true)
            PHASE_BEGIN smix_phase(lds, U, V, STATS, a.in[16] + (size_t)j * 8 * 128 * 128, a.in[17] + (size_t)j * 8 * 128, a.in[14] + (size_t)j * 2048, a.in[15] + (size_t)j * 2048, bid, G); PHASE_END(true)
            PHASE_BEGIN { pg8::Gemm g{U, (const bf16_t*)(ws + W_BOUT) + (size_t)j * 1024 * 2048, M, 1024, 2048, 2048, 0, 0}; pg8::StaticOrder S; S.init(M, 1024, G, bid);
                pg8::EpiResid E{xin, X, modl + 2 * D}; pg8::gemm_phase(lds, g, S, E); } PHASE_END(true)
        }
        PHASE_BEGIN REP(3) norm_mod_phase(X, a.in[5] + layer * D, modl + 3 * D, modl + 4 * D, H, bid, G); PHASE_END(true)
        PHASE_BEGIN { pg8::Gemm g{H, (const bf16_t*)(ws + W_GU) + (size_t)layer * 5632 * 1024, M, 5632, 1024, 1024, 0, 0}; pg8::StaticOrder S; S.init(M, 5632, G, bid);
            pg8::EpiSwiglu E{(bf16_t*)(ws + WS_HID)}; REP(6) pg8::gemm_phase(lds, g, S, E); } PHASE_END(true)
        PHASE_BEGIN { pg8::Gemm g{(const bf16_t*)(ws + WS_HID), (const bf16_t*)(ws + W_DN) + (size_t)layer * 1024 * DFF, M, 1024, DFF, DFF, 0, 0}; pg8::StaticOrder S; S.init(M, 1024, G, bid);
            pg8::EpiResid E{X, X, modl + 5 * D}; pg8::gemm_phase(lds, g, S, E); } PHASE_END(true)
    }
    PHASE_BEGIN final_norm_phase(X, a.in[22], a.out, bid, G); PHASE_END(false)
}

extern "C" void kernel_launch(void* const* d_in, const int* in_sizes, int n_in, void* d_out, int out_size, void* d_ws, size_t ws_size, hipStream_t stream) {
    static int grid_blocks = 0;
    if (grid_blocks == 0) {
        int dev = 0, cus = 0, per_cu = 0;
        if (n_in != 23 || out_size != M * D || ws_size < WS_END) { fprintf(stderr, "kernel_launch: unexpected problem (n_in %d out %d ws %zu, need ws >= %zu)\n", n_in, out_size, ws_size, (size_t)WS_END); grid_blocks = -1; return; }
        (void)hipGetDevice(&dev);
        (void)hipDeviceGetAttribute(&cus, hipDeviceAttributeMultiprocessorCount, dev);
        (void)hipFuncSetAttribute((const void*)mk_fwd, hipFuncAttributeMaxDynamicSharedMemorySize, LDS_BYTES);
        (void)hipOccupancyMaxActiveBlocksPerMultiprocessor(&per_cu, (const void*)mk_fwd, 512, LDS_BYTES);
        fprintf(stderr, "kernel_launch: cus %d per_cu %d ws %zu\n", cus, per_cu, ws_size);
        if (per_cu < 1) { fprintf(stderr, "kernel_launch: kernel does not fit a CU\n"); grid_blocks = -1; return; }
        grid_blocks = cus;
    }
    if (grid_blocks < 0) return;
    if (hipMemsetAsync((char*)d_ws + WS_BAR, 0, 16384, stream) != hipSuccess) { fprintf(stderr, "kernel_launch: memset failed\n"); return; }
    Args a{};
    for (int i = 0; i < 23; ++i) a.in[i] = (const float*)d_in[i];
    a.out = (float*)d_out; a.ws = (unsigned char*)d_ws; a.ph_lo = 0; a.ph_hi = 1000;
    void* args[] = {&a};
    hipError_t e = hipLaunchCooperativeKernel((const void*)mk_fwd, dim3(grid_blocks), dim3(512), args, LDS_BYTES, stream);
    if (e != hipSuccess) fprintf(stderr, "cooperative launch failed: %s (grid %d)\n", hipGetErrorString(e), grid_blocks);
}
```

```cpp
#include <hip/hip_runtime.h>
#include <hip/hip_cooperative_groups.h>
#include <cstdio>
#include <cstdint>
namespace cg = cooperative_groups;

#define LAS __attribute__((address_space(3)))
typedef unsigned short bf16_t;
typedef short bf16x8 __attribute__((ext_vector_type(8)));
typedef short s16x4 __attribute__((ext_vector_type(4)));
typedef float f32x4 __attribute__((ext_vector_type(4)));
typedef float f32x16 __attribute__((ext_vector_type(16)));
typedef float f32x2 __attribute__((ext_vector_type(2)));
typedef unsigned u32x4 __attribute__((ext_vector_type(4)));
typedef unsigned u32x2 __attribute__((ext_vector_type(2)));

constexpr int D = 1024, NB = 8, T = 4096, M = NB * T, DFF = 2816, NMOD = 6 * D;
constexpr float EPS = 1e-6f;
constexpr int AIN = 1864;
constexpr size_t MiB = 1u << 20;
constexpr size_t WS_MOD = 0;
constexpr size_t WS_MODP = 1 * MiB;
constexpr size_t WS_W = 13 * MiB;
constexpr size_t W_AIN = WS_W;
constexpr size_t W_UK = W_AIN + 8 * MiB;
constexpr size_t W_UV = W_UK + 2 * MiB;
constexpr size_t W_O = W_UV + 2 * MiB;
constexpr size_t W_BIN = W_O + 4 * MiB;
constexpr size_t W_BOUT = W_BIN + 16 * MiB;
constexpr size_t W_GU = W_BOUT + 8 * MiB;
constexpr size_t W_DN = W_GU + 44 * MiB;
constexpr size_t WS_R1 = W_DN + 22 * MiB;
constexpr size_t WS_H = WS_R1;
constexpr size_t WS_Q = WS_R1 + 64 * MiB;
constexpr size_t WS_OLAT = WS_R1;
constexpr size_t WS_R2 = WS_R1 + 128 * MiB;
constexpr size_t WS_QLAT = WS_R2;
constexpr size_t WS_O = WS_R2;
constexpr size_t WS_R3 = WS_R2 + 128 * MiB;
constexpr size_t WS_CKVR = WS_R3;
constexpr size_t WS_CKV = WS_CKVR + 32 * MiB;
constexpr size_t WS_QIDX = WS_CKV + 16 * MiB;
constexpr size_t WS_KRAW = WS_QIDX + 32 * MiB;
constexpr size_t WS_KIDX = WS_KRAW + 16 * MiB;
constexpr size_t WS_WIDX = WS_KIDX + 4 * MiB;
constexpr size_t WS_IDX = WS_WIDX + 1 * MiB;
constexpr size_t WS_END = WS_IDX + 16 * MiB;
constexpr size_t WS_HID = WS_R1 + 64 * MiB;
constexpr size_t WS_U = WS_R1 + 64 * MiB;
constexpr size_t WS_V = WS_U + 128 * MiB;
constexpr size_t WS_STATS = WS_V + 128 * MiB;
static_assert(WS_STATS + 8 * MiB <= WS_END && WS_HID + 176 * MiB <= WS_R3, "ws map");
constexpr int LDS_BYTES = 147456;
constexpr int LDS_MISC = LDS_BYTES - 256;
constexpr size_t WS_BAR = 1 * MiB - 16384;

__device__ __forceinline__ unsigned cvt_pk_bf16(float lo, float hi) { unsigned r; asm volatile("v_cvt_pk_bf16_f32 %0, %1, %2" : "=v"(r) : "v"(lo), "v"(hi)); return r; }
__device__ __forceinline__ float bf2f(unsigned b) { return __uint_as_float(b << 16); }
__device__ __forceinline__ float bf_round(float f) { unsigned u = __float_as_uint(f); u = (u + 0x7fffu + ((u >> 16) & 1u)) & 0xffff0000u; return __uint_as_float(u); }
__device__ __forceinline__ float wave_sum(float v) {
#pragma unroll
    for (int o = 1; o < 64; o <<= 1) v += __shfl_xor(v, o);
    return v;
}
#define LDS_WAIT() asm volatile("s_waitcnt lgkmcnt(0)" ::: "memory")
__device__ __forceinline__ unsigned bperm_u(int srclane, unsigned v) { return (unsigned)__builtin_amdgcn_ds_bpermute(srclane << 2, (int)v); }
__device__ __forceinline__ float bperm_f(int srclane, float v) { return __int_as_float(__builtin_amdgcn_ds_bpermute(srclane << 2, __float_as_int(v))); }


#define XB_TMO      128
#define XB_XCNT(j)  (256  + 64 * (j))
#define XB_XSUB(j)  (1280 + 64 * (j))
#define XB_XGEN(j)  (2304 + 64 * (j))
#define XB_TOP      3328
#define XB_TOPGEN   3392
#define XCD_BAR_WORDS 3456
#define XB_SPIN_CAP (1u << 22)
__device__ __forceinline__ unsigned xb_ld(unsigned* p)              { return __hip_atomic_load(p, __ATOMIC_RELAXED, __HIP_MEMORY_SCOPE_AGENT); }
__device__ __forceinline__ unsigned xb_add(unsigned* p, unsigned v) { return __hip_atomic_fetch_add(p, v, __ATOMIC_RELAXED, __HIP_MEMORY_SCOPE_AGENT); }
__device__ __forceinline__ unsigned xb_xcc_id() { return (unsigned)__builtin_amdgcn_s_getreg((3 << 11) | 20) & 0xFu; }
#define XB_SPIN(cond, bar) do { unsigned _sp = 0; while (cond) { __builtin_amdgcn_s_sleep(1); \
    if ((++_sp & 255u) == 0u) { if (xb_ld(&(bar)[XB_TMO])) break; if (_sp > XB_SPIN_CAP) { atomicAdd(&(bar)[XB_TMO], 1u); break; } } } } while (0)
struct XcdBarrier { unsigned* bar; unsigned x; volatile LAS unsigned* st; };
__device__ __forceinline__ XcdBarrier xcd_barrier_post(unsigned* bar, volatile LAS unsigned* st) {
    XcdBarrier b; b.bar = bar; b.x = xb_xcc_id(); b.st = st;
    if (threadIdx.x == 0) (void)xb_add(&bar[XB_XCNT(b.x)], 1u);
    return b;
}
__device__ __forceinline__ void xcd_barrier_complete(unsigned* bar, unsigned x, unsigned& nloc, unsigned& nx) {
    const unsigned G = gridDim.x * gridDim.y * gridDim.z;
    unsigned sum, cnt, mine, sp = 0u;
    for (;;) {
        sum = 0u; cnt = 0u; mine = 0u;
#pragma unroll
        for (unsigned j = 0; j < 16; ++j) { const unsigned c = xb_ld(&bar[XB_XCNT(j)]); sum += c; cnt += (c > 0u) ? 1u : 0u; mine = (j == x) ? c : mine; }
        if (sum == G) break;
        __builtin_amdgcn_s_sleep(1);
        if ((++sp & 255u) == 0u) { if (xb_ld(&bar[XB_TMO])) break; if (sp > XB_SPIN_CAP) { atomicAdd(&bar[XB_TMO], 1u); break; } }
    }
    nloc = mine > 0u ? mine : 1u; nx = cnt > 0u ? cnt : 1u;
}
__device__ __forceinline__ void xcd_barrier(const XcdBarrier& b) {
    asm volatile("s_waitcnt vmcnt(0)" ::: "memory");
    __syncthreads();
    if (threadIdx.x == 0) {
        unsigned* bar = b.bar;
        __builtin_amdgcn_s_waitcnt(0);
        unsigned nloc = b.st[0], nx = b.st[1];
        if (nloc == 0u) { xcd_barrier_complete(bar, b.x, nloc, nx); b.st[0] = nloc; b.st[1] = nx; }
        const unsigned old = xb_add(&bar[XB_XSUB(b.x)], 1u);
        const unsigned gen = old / nloc;
        if (old + 1u == (gen + 1u) * nloc) {
            __builtin_amdgcn_fence(__ATOMIC_RELEASE, "agent");
            asm volatile("s_waitcnt vmcnt(0)" ::: "memory");
            const unsigned og = xb_add(&bar[XB_TOP], 1u);
            const unsigned tg = og / nx;
            if (og + 1u == (tg + 1u) * nx) xb_add(&bar[XB_TOPGEN], 1u);
            else XB_SPIN(xb_ld(&bar[XB_TOPGEN]) == tg, bar);
            __builtin_amdgcn_fence(__ATOMIC_ACQUIRE, "agent");
            xb_add(&bar[XB_XGEN(b.x)], 1u);
            asm volatile("s_waitcnt vmcnt(0)" ::: "memory");
        } else {
            XB_SPIN(xb_ld(&bar[XB_XGEN(b.x)]) == gen, bar);
            __builtin_amdgcn_fence(__ATOMIC_ACQUIRE, "agent");
            asm volatile("s_waitcnt vmcnt(0)" ::: "memory");
        }
    }
    __syncthreads();
}

namespace pg8 {
constexpr int BM = 256, BK = 64, HALF = 128, HTB = HALF * BK * 2, STAGE_BYTES = 8 * HTB, NXCD = 8, WGM = 8;
__host__ __device__ __forceinline__ int lds_byte(int r, int c) { const int st = (r >> 4) * 2 + (c >> 5), rr = r & 15, cc = c & 31, ob = rr * 64 + cc * 2; return st * 1024 + (ob ^ (((ob >> 9) & 1) << 5)); }
__host__ __device__ __forceinline__ void stage_rc(int b, int& R, int& C) { const int st = b / 1024, sb = b % 1024, swz = sb ^ (((sb >> 9) & 1) << 5); R = (st >> 1) * 16 + swz / 64; C = (st & 1) * 32 + (swz % 64) / 2; }
__host__ __device__ __forceinline__ int perm32(int rho) { const int n = rho >> 4, i = rho & 15; return 8 * (i >> 2) + 4 * n + (i & 3); }

struct Unit { int pm, pn; };
struct Gemm { const bf16_t* A; const bf16_t* Bt; int M, N, K, lda, agrp_shift, agrp_stride; };

struct StaticOrder {
    int nM, nN, nwg, G, c;
    __device__ void init(int M_, int N_, int G_, int c_) { nM = M_ / BM; nN = N_ / BM; nwg = nM * nN; G = G_; c = c_; }
    __device__ bool next(int i, Unit& u) const {
        const long L = (long)i * G + c; if (L >= nwg) return false;
        int wgid = (int)L; { const int q = nwg / NXCD, r = nwg % NXCD, xcd = wgid % NXCD, off = wgid / NXCD; wgid = (xcd < r ? xcd * (q + 1) : r * (q + 1) + (xcd - r) * q) + off; }
        const int nig = WGM * nN, gid = wgid / nig, fm = gid * WGM, gsz = (nM - fm) < WGM ? (nM - fm) : WGM;
        u.pm = fm + ((wgid % nig) % gsz); u.pn = (wgid % nig) / gsz; return true;
    }
};

typedef f32x4 Acc[2][2][4][2];

__device__ __forceinline__ f32x2 gelu_pk(f32x2 v) {
    const f32x2 av = __builtin_elementwise_abs(v), d = av * 0.2316418882f + 1.0f;
    f32x2 t; t.x = __builtin_amdgcn_rcpf(d.x); t.y = __builtin_amdgcn_rcpf(d.y);
    f32x2 q = t * 0.5307027145f + (-0.7265760135f); q = q * t + 0.7107068705f; q = q * t + (-0.142248368f); q = q * t + 0.127414796f; q = q * t;
    const f32x2 s = (v * v) * (-0.72134752044f);
    f32x2 e; e.x = __builtin_amdgcn_exp2f(s.x); e.y = __builtin_amdgcn_exp2f(s.y);
    const f32x2 m = v * (q * e), r = v - m;
    f32x2 o; o.x = v.x < 0.f ? m.x : r.x; o.y = v.y < 0.f ? m.y : r.y; return o;
}
__device__ __forceinline__ f32x4 gelu4(f32x4 v) { f32x2 a = gelu_pk((f32x2){v[0], v[1]}), b = gelu_pk((f32x2){v[2], v[3]}); return (f32x4){a.x, a.y, b.x, b.y}; }
__device__ __forceinline__ u32x4 pack8(f32x4 v0, f32x4 v1) { u32x4 w; w.x = cvt_pk_bf16(v0[0], v0[1]); w.y = cvt_pk_bf16(v0[2], v0[3]); w.z = cvt_pk_bf16(v1[0], v1[1]); w.w = cvt_pk_bf16(v1[2], v1[3]); return w; }

struct EpiInproj {
    bf16_t* Q; float* CKVR; bf16_t* QIDX; float* KRAW;
    __device__ __forceinline__ void operator()(const Acc& acc, const Unit& u, int wr, int wc, int fr, int fq) const {
        const int row0 = u.pm * BM + wr * 64 + fr, cl = wc * 32 + 8 * fq;
#pragma unroll
        for (int ai = 0; ai < 2; ++ai)
#pragma unroll
            for (int m = 0; m < 4; ++m) { const size_t row = (size_t)(row0 + ai * HALF + m * 16);
#pragma unroll
                for (int bj = 0; bj < 2; ++bj) { const f32x4 v0 = acc[ai][bj][m][0], v1 = acc[ai][bj][m][1]; const int c = bj * HALF + cl;
                    if (u.pn < 4) *(u32x4*)(Q + row * 1024 + u.pn * 256 + c) = pack8(v0, v1);
                    else if (u.pn == 4) { float* p = CKVR + row * 256 + c; *(f32x4*)p = v0; *(f32x4*)(p + 4) = v1; }
                    else if (u.pn < 7) *(u32x4*)(QIDX + row * 512 + (u.pn - 5) * 256 + c) = pack8(v0, v1);
                    else if (bj == 0) { float* p = KRAW + row * 128 + c; *(f32x4*)p = v0; *(f32x4*)(p + 4) = v1; } } }
    }
};
struct EpiBf16 {
    bf16_t* O; int ldc; float scale; int fp8;
    __device__ __forceinline__ void operator()(const Acc& acc, const Unit& u, int wr, int wc, int fr, int fq) const {
        const int row0 = u.pm * BM + wr * 64 + fr, col0 = u.pn * BM + wc * 32 + 8 * fq;
        if (fp8) {
#pragma unroll
            for (int ai = 0; ai < 2; ++ai)
#pragma unroll
                for (int m = 0; m < 4; ++m) { unsigned char* rowp = (unsigned char*)O + (size_t)(row0 + ai * HALF + m * 16) * ldc + col0;
#pragma unroll
                    for (int bj = 0; bj < 2; ++bj) { const f32x4 v0 = acc[ai][bj][m][0] * scale, v1 = acc[ai][bj][m][1] * scale; int w0 = 0, w1 = 0;
                        w0 = __builtin_amdgcn_cvt_pk_fp8_f32(v0[0], v0[1], w0, false); w0 = __builtin_amdgcn_cvt_pk_fp8_f32(v0[2], v0[3], w0, true);
                        w1 = __builtin_amdgcn_cvt_pk_fp8_f32(v1[0], v1[1], w1, false); w1 = __builtin_amdgcn_cvt_pk_fp8_f32(v1[2], v1[3], w1, true);
                        *(u32x2*)(rowp + bj * HALF) = (u32x2){(unsigned)w0, (unsigned)w1}; } }
            return; }
#pragma unroll
        for (int ai = 0; ai < 2; ++ai)
#pragma unroll
            for (int m = 0; m < 4; ++m) { bf16_t* rowp = O + (size_t)(row0 + ai * HALF + m * 16) * ldc + col0;
#pragma unroll
                for (int bj = 0; bj < 2; ++bj) *(u32x4*)(rowp + bj * HALF) = pack8(acc[ai][bj][m][0] * scale, acc[ai][bj][m][1] * scale); }
    }
};
struct EpiResid {
    const float* xin; float* xout; const float* gate;
    __device__ __forceinline__ void operator()(const Acc& acc, const Unit& u, int wr, int wc, int fr, int fq) const {
        const int row0 = u.pm * BM + wr * 64 + fr, col0 = u.pn * BM + wc * 32 + 8 * fq;
        const float* gp = gate + (size_t)(u.pm >> 4) * NMOD + col0;
        f32x4 gv[2][2];
#pragma unroll
        for (int bj = 0; bj < 2; ++bj)
#pragma unroll
            for (int n = 0; n < 2; ++n) gv[bj][n] = *(const f32x4*)(gp + bj * HALF + 4 * n);
#pragma unroll
        for (int ai = 0; ai < 2; ++ai)
#pragma unroll
            for (int m = 0; m < 4; ++m) { const size_t off = (size_t)(row0 + ai * HALF + m * 16) * D + col0;
#pragma unroll
                for (int bj = 0; bj < 2; ++bj)
#pragma unroll
                    for (int n = 0; n < 2; ++n) { const f32x4 xo = *(const f32x4*)(xin + off + bj * HALF + 4 * n);
                        *(f32x4*)(xout + off + bj * HALF + 4 * n) = xo + gv[bj][n] * acc[ai][bj][m][n]; } }
    }
};
struct EpiGelu {
    bf16_t* U; bf16_t* V; f32x2* STATS;
    __device__ __forceinline__ void operator()(const Acc& acc, const Unit& u, int wr, int wc, int fr, int fq) const {
        const int row0 = u.pm * BM + wr * 64 + fr, cl = wc * 32 + 8 * fq;
        const bool isv = u.pn >= 8; bf16_t* base = isv ? V + (u.pn - 8) * 256 : U + u.pn * 256;
#pragma unroll
        for (int ai = 0; ai < 2; ++ai)
#pragma unroll
            for (int m = 0; m < 4; ++m) { const size_t row = (size_t)(row0 + ai * HALF + m * 16); float s = 0.f, ss = 0.f;
#pragma unroll
                for (int bj = 0; bj < 2; ++bj) { const f32x4 v0 = gelu4(acc[ai][bj][m][0]), v1 = gelu4(acc[ai][bj][m][1]);
                    *(u32x4*)(base + row * 2048 + bj * HALF + cl) = pack8(v0, v1);
                    s += (v0[0] + v0[1]) + (v0[2] + v0[3]) + (v1[0] + v1[1]) + (v1[2] + v1[3]);
                    ss += (v0[0] * v0[0] + v0[1] * v0[1]) + (v0[2] * v0[2] + v0[3] * v0[3]) + (v1[0] * v1[0] + v1[1] * v1[1]) + (v1[2] * v1[2] + v1[3] * v1[3]); }
                if (isv) { s += __shfl_xor(s, 16); ss += __shfl_xor(ss, 16); s += __shfl_xor(s, 32); ss += __shfl_xor(ss, 32);
                    if (fq == 0) STATS[row * 32 + (u.pn - 8) * 4 + wc] = (f32x2){s, ss}; } }
    }
};
struct EpiSwiglu {
    bf16_t* HID;
    __device__ __forceinline__ void operator()(const Acc& acc, const Unit& u, int wr, int wc, int fr, int fq) const {
        const int row0 = u.pm * BM + wr * 64 + fr, col0 = u.pn * 128 + wc * 32 + 8 * fq;
#pragma unroll
        for (int ai = 0; ai < 2; ++ai)
#pragma unroll
            for (int m = 0; m < 4; ++m) { f32x4 h[2];
#pragma unroll
                for (int n = 0; n < 2; ++n) { const f32x4 g = acc[ai][0][m][n], up = acc[ai][1][m][n];
#pragma unroll
                    for (int j = 0; j < 4; ++j) h[n][j] = g[j] * __builtin_amdgcn_rcpf(1.0f + __expf(-g[j])) * up[j]; }
                *(u32x4*)(HID + (size_t)(row0 + ai * HALF + m * 16) * DFF + col0) = pack8(h[0], h[1]); }
    }
};

template <class Epi>
__device__ __forceinline__ void gemm_phase(LAS unsigned char* lds, const Gemm g, const StaticOrder& S, const Epi& E) {
    int tid = threadIdx.x; asm volatile("" : "+v"(tid));
    const int wid = __builtin_amdgcn_readfirstlane(tid >> 6), lane = tid & 63, wr = wid >> 2, wc = wid & 3, fr = lane & 15, fq = lane >> 4;
    const int K = g.K, nt = K / BK, lda = g.lda;
    unsigned voffA[2], voffB[2];
#pragma unroll
    for (int i = 0; i < 2; ++i) { int R, C; stage_rc(tid * 16 + i * 8192, R, C); const int Rb = (R & ~31) + perm32(R & 31);
        voffA[i] = (unsigned)(R * lda + C) * 2u; voffB[i] = (unsigned)(Rb * K + C) * 2u; }
    const size_t kstep = (size_t)(BK * 2);
    const size_t hstepA = (size_t)HALF * lda * 2, hstepB = (size_t)HALF * K * 2;
    const unsigned ldsw = (unsigned)wid * 1024u;
    const int aoff = lds_byte(wr * 64 + fr, fq * 8), boff = lds_byte(wc * 32 + fr, fq * 8);
#define PG8_SA(b, h) (((b) * 2 + (h)) * HTB)
#define PG8_SB(b, h) ((4 + (b) * 2 + (h)) * HTB)
#define PG8_STAGE(bufoff, gbase, voff) do { _Pragma("unroll") for (int _i = 0; _i < 2; ++_i) \
        __builtin_amdgcn_global_load_lds((const unsigned*)((const char*)(gbase) + (voff)[_i]), (LAS unsigned*)(lds + (bufoff) + ldsw + _i * 8192), 16, 0, 0); } while (0)
#define PG8_LDA(dst, b, h) do { _Pragma("unroll") for (int m = 0; m < 4; ++m) _Pragma("unroll") for (int k = 0; k < 2; ++k) dst[m][k] = *(const LAS bf16x8*)(lds + PG8_SA(b, h) + aoff + m * 2048 + k * 1024); } while (0)
#define PG8_LDB(dst, b, h) do { _Pragma("unroll") for (int n = 0; n < 2; ++n) _Pragma("unroll") for (int k = 0; k < 2; ++k) dst[n][k] = *(const LAS bf16x8*)(lds + PG8_SB(b, h) + boff + n * 2048 + k * 1024); } while (0)
#define PG8_MMA(ai, bj, At, Bt) do { __builtin_amdgcn_s_setprio(1); _Pragma("unroll") for (int m = 0; m < 4; ++m) _Pragma("unroll") for (int n = 0; n < 2; ++n) _Pragma("unroll") for (int k = 0; k < 2; ++k) \
        acc[ai][bj][m][n] = __builtin_amdgcn_mfma_f32_16x16x32_bf16(Bt[n][k], At[m][k], acc[ai][bj][m][n], 0, 0, 0); __builtin_amdgcn_s_setprio(0); } while (0)
#define PG8_WAIT_V(n) asm volatile("s_waitcnt vmcnt(" #n ")" ::: "memory")
#define PG8_WAIT_L(n) asm volatile("s_waitcnt lgkmcnt(" #n ")" ::: "memory")
#define PG8_BAR __builtin_amdgcn_s_barrier()
#define PG8_SCHED __builtin_amdgcn_sched_barrier(0)
#define PG8_ABASE(u) ((const char*)g.A + ((size_t)(u).pm * BM * lda + (size_t)((u).pn >> g.agrp_shift) * g.agrp_stride) * 2)
#define PG8_BBASE(u) ((const char*)g.Bt + (size_t)(u).pn * 2 * hstepB)
    Unit cur, nxt; int ui = 0;
    if (!S.next(0, cur)) return;
    Acc acc;
#pragma unroll
    for (int a = 0; a < 2; ++a)
#pragma unroll
        for (int b = 0; b < 2; ++b)
#pragma unroll
            for (int m = 0; m < 4; ++m)
#pragma unroll
                for (int n = 0; n < 2; ++n) acc[a][b][m][n] = (f32x4){0.f, 0.f, 0.f, 0.f};
    bf16x8 At[4][2], B0[2][2], B1[2][2];
    const char* cA = PG8_ABASE(cur); const char* cB = PG8_BBASE(cur);
    PG8_STAGE(PG8_SB(0, 0), cB, voffB); PG8_STAGE(PG8_SB(0, 1), cB + hstepB, voffB); PG8_STAGE(PG8_SA(0, 0), cA, voffA); PG8_STAGE(PG8_SA(0, 1), cA + hstepA, voffA);
    if (wr == 1) PG8_BAR;
    PG8_WAIT_V(2); PG8_BAR;
    PG8_STAGE(PG8_SB(1, 0), cB + kstep, voffB); PG8_STAGE(PG8_SA(1, 0), cA + kstep, voffA); PG8_STAGE(PG8_SB(1, 1), cB + hstepB + kstep, voffB);
    PG8_WAIT_V(6); PG8_BAR;
    for (;;) {
        const bool has_next = S.next(ui + 1, nxt);
        const char* nA = has_next ? PG8_ABASE(nxt) : cA; const char* nB = has_next ? PG8_BBASE(nxt) : cB;
        for (int t = 0; t < nt; t += 2) {
            const bool last = (t == nt - 2);
            const char* a1 = cA + (size_t)(t + 1) * kstep;
            const char* a2 = last ? nA : cA + (size_t)(t + 2) * kstep; const char* b2 = last ? nB : cB + (size_t)(t + 2) * kstep;
            const char* a3 = a2 + kstep; const char* b3 = b2 + kstep;
            PG8_LDB(B0, 0, 0); PG8_LDB(B1, 0, 1); PG8_SCHED; PG8_LDA(At, 0, 0); PG8_STAGE(PG8_SA(1, 1), a1 + hstepA, voffA);
            PG8_WAIT_V(8); PG8_WAIT_L(0); PG8_BAR; PG8_MMA(0, 0, At, B0); PG8_MMA(0, 1, At, B1); PG8_BAR; PG8_SCHED;
            PG8_LDA(At, 0, 1); PG8_STAGE(PG8_SB(0, 0), b2, voffB); PG8_STAGE(PG8_SB(0, 1), b2 + hstepB, voffB); PG8_STAGE(PG8_SA(0, 0), a2, voffA);
            PG8_WAIT_V(8); PG8_WAIT_L(0); PG8_BAR; PG8_MMA(1, 0, At, B0); PG8_MMA(1, 1, At, B1); PG8_BAR; PG8_SCHED;
            PG8_LDB(B0, 1, 0); PG8_LDB(B1, 1, 1); PG8_SCHED; PG8_LDA(At, 1, 0); PG8_STAGE(PG8_SA(0, 1), a2 + hstepA, voffA);
            PG8_WAIT_V(8); PG8_WAIT_L(0); PG8_BAR; PG8_MMA(0, 0, At, B0); PG8_MMA(0, 1, At, B1); PG8_BAR; PG8_SCHED;
            PG8_LDA(At, 1, 1); PG8_STAGE(PG8_SB(1, 0), b3, voffB); PG8_STAGE(PG8_SB(1, 1), b3 + hstepB, voffB); PG8_STAGE(PG8_SA(1, 0), a3, voffA);
            PG8_WAIT_V(8); PG8_WAIT_L(0); PG8_BAR; PG8_MMA(1, 0, At, B0); PG8_MMA(1, 1, At, B1); PG8_BAR; PG8_SCHED;
        }
        if (wr == 0) PG8_BAR;
        E(acc, cur, wr, wc, fr, fq);
        if (!has_next) break;
#pragma unroll
        for (int a = 0; a < 2; ++a)
#pragma unroll
            for (int b = 0; b < 2; ++b)
#pragma unroll
                for (int m = 0; m < 4; ++m)
#pragma unroll
                    for (int n = 0; n < 2; ++n) acc[a][b][m][n] = (f32x4){0.f, 0.f, 0.f, 0.f};
        cur = nxt; cA = nA; cB = nB; ++ui;
        if (wr == 1) PG8_BAR;
    }
    PG8_WAIT_V(0);
    PG8_BAR;
#undef PG8_SA
#undef PG8_SB
#undef PG8_STAGE
#undef PG8_LDA
#undef PG8_LDB
#undef PG8_MMA
#undef PG8_WAIT_V
#undef PG8_WAIT_L
#undef PG8_BAR
#undef PG8_SCHED
#undef PG8_ABASE
#undef PG8_BBASE
}
}

struct Args { const float* in[23]; float* out; unsigned char* ws; int ph_lo, ph_hi; };

__device__ __forceinline__ void cvt_item(const float* src, int K, int N, bf16_t* dst, int ldd, int mode, int r0, int c0, LAS float* scr, int li, int lane) {
    const int nblk = (N + 31) >> 5, kb = li / nblk, nb = li % nblk, k0 = 64 * kb, n0 = 32 * nb;
    { const int n = n0 + (lane & 31);
#pragma unroll 8
      for (int i = 0; i < 32; ++i) { const int kk = 2 * i + (lane >> 5); scr[kk * 33 + (lane & 31)] = (n < N) ? src[(size_t)(k0 + kk) * N + n] : 0.f; } }
    LDS_WAIT();
    const int c = lane & 7;
#pragma unroll
    for (int j = 0; j < 4; ++j) { const int nl = (lane >> 3) + 8 * j, n = n0 + nl; const LAS float* s = scr + (8 * c) * 33 + nl;
        u32x4 o; o.x = cvt_pk_bf16(s[0 * 33], s[1 * 33]); o.y = cvt_pk_bf16(s[2 * 33], s[3 * 33]); o.z = cvt_pk_bf16(s[4 * 33], s[5 * 33]); o.w = cvt_pk_bf16(s[6 * 33], s[7 * 33]);
        if (n < N) { const int drow = mode ? ((n >> 7) * 256 + (n & 127) + r0) : (r0 + n); *(u32x4*)(dst + (size_t)drow * ldd + c0 + k0 + 8 * c) = o; } }
    LDS_WAIT();
}

__device__ __forceinline__ void p0_phase(const Args& a, LAS unsigned char* lds, int bid, int G) {
    int tid = threadIdx.x; asm volatile("" : "+v"(tid));
    const int lane = tid & 63, wave = __builtin_amdgcn_readfirstlane(tid >> 6);
    unsigned char* ws = a.ws;
    LAS float* scr = (LAS float*)(lds + wave * 8704);
    const int gw = bid * 8 + wave, NGW = G * 8;
    constexpr int NITEMS = 1888 + 256 + 256 + 1024 + 4096 + 2048 + 11264 + 5632;
    for (int it = gw; it < NITEMS; it += NGW) {
        int r = it;
        if (r < 1888) { const int j = r / 944; cvt_item(a.in[6] + (size_t)j * 1024 * AIN, 1024, AIN, (bf16_t*)(ws + W_AIN) + (size_t)j * 2048 * 1024, 1024, 0, 0, 0, scr, r % 944, lane); continue; } r -= 1888;
        if (r < 256) { const int jj = r >> 4, la = jj >> 3, h = jj & 7; cvt_item(a.in[10] + (size_t)(la * 8 + h) * 128 * 256, 128, 256, (bf16_t*)(ws + W_UK) + (size_t)la * 2048 * 256, 256, 0, h * 256, (h & 1) * 128, scr, r & 15, lane); continue; } r -= 256;
        if (r < 256) { const int jj = r >> 4, la = jj >> 3, h = jj & 7; cvt_item(a.in[11] + (size_t)(la * 8 + h) * 256 * 128, 256, 128, (bf16_t*)(ws + W_UV) + (size_t)la * 1024 * 512, 512, 0, (h >> 1) * 256 + (h & 1) * 128, (h & 1) * 256, scr, r & 15, lane); continue; } r -= 256;
        if (r < 1024) { const int la = r >> 9; cvt_item(a.in[12] + (size_t)la * 1024 * 1024, 1024, 1024, (bf16_t*)(ws + W_O) + (size_t)la * 1024 * 1024, 1024, 0, 0, 0, scr, r & 511, lane); continue; } r -= 1024;
        if (r < 4096) { const int la = r >> 11; cvt_item(a.in[13] + (size_t)la * 1024 * 4096, 1024, 4096, (bf16_t*)(ws + W_BIN) + (size_t)la * 4096 * 1024, 1024, 0, 0, 0, scr, r & 2047, lane); continue; } r -= 4096;
        if (r < 2048) { const int la = r >> 10; cvt_item(a.in[18] + (size_t)la * 2048 * 1024, 2048, 1024, (bf16_t*)(ws + W_BOUT) + (size_t)la * 1024 * 2048, 2048, 0, 0, 0, scr, r & 1023, lane); continue; } r -= 2048;
        if (r < 11264) { const int jj = r / 1408, l = jj & 3, isup = jj >> 2; cvt_item(a.in[isup ? 20 : 19] + (size_t)l * 1024 * DFF, 1024, DFF, (bf16_t*)(ws + W_GU) + (size_t)l * 5632 * 1024, 1024, 1, isup * 128, 0, scr, r % 1408, lane); continue; } r -= 11264;
        { const int l = r / 1408; cvt_item(a.in[21] + (size_t)l * DFF * 1024, DFF, 1024, (bf16_t*)(ws + W_DN) + (size_t)l * 1024 * DFF, DFF, 0, 0, 0, scr, r % 1408, lane); }
    }
    const size_t gt = (size_t)bid * 512 + tid, NT = (size_t)G * 512;
    const u32x4 z = (u32x4){0u, 0u, 0u, 0u};
    for (size_t i = gt; i < 2 * 184 * 128; i += NT) { const int j = (int)(i / (184 * 128)), rem = (int)(i % (184 * 128)), rr = AIN + rem / 128, ch = rem % 128;
        *(u32x4*)((bf16_t*)(ws + W_AIN) + ((size_t)j * 2048 + rr) * 1024 + ch * 8) = z; }
    for (size_t i = gt; i < 2 * 2048 * 16; i += NT) { const int j = (int)(i / (2048 * 16)), rem = (int)(i % (2048 * 16)), rr = rem >> 4, ch = rem & 15, h = rr >> 8;
        *(u32x4*)((bf16_t*)(ws + W_UK) + ((size_t)j * 2048 + rr) * 256 + (1 - (h & 1)) * 128 + ch * 8) = z; }
    for (size_t i = gt; i < 2 * 1024 * 32; i += NT) { const int j = (int)(i / (1024 * 32)), rem = (int)(i % (1024 * 32)), rr = rem >> 5, ch = rem & 31, hh = (rr >> 7) & 1;
        *(u32x4*)((bf16_t*)(ws + W_UV) + ((size_t)j * 1024 + rr) * 512 + (1 - hh) * 256 + ch * 8) = z; }
    __syncthreads();
    LAS float* ca = (LAS float*)lds;
    const float* cvec = a.in[1]; const float* modw = a.in[2]; float* MODP = (float*)(ws + WS_MODP);
    for (int it = bid; it < 768; it += G) {
        const int l = it / 192, rem = it % 192, ng = rem >> 4, kc = rem & 15;
        { const int b = tid >> 6, k = tid & 63; const float cv = cvec[b * 1024 + kc * 64 + k]; ca[b * 64 + k] = cv / (1.0f + __expf(-cv)); }
        __syncthreads();
        const int n = ng * 512 + tid; float acc[8];
#pragma unroll
        for (int b = 0; b < 8; ++b) acc[b] = 0.f;
        const float* wp = modw + ((size_t)l * 1024 + kc * 64) * NMOD + n;
#pragma unroll 8
        for (int k = 0; k < 64; ++k) { const float w = wp[(size_t)k * NMOD];
#pragma unroll
            for (int b = 0; b < 8; ++b) acc[b] += ca[b * 64 + k] * w; }
#pragma unroll
        for (int b = 0; b < 8; ++b) MODP[((size_t)(kc * 4 + l) * 8 + b) * NMOD + n] = acc[b];
        __syncthreads();
    }
}
__device__ __forceinline__ void p0c_phase(const Args& a, int bid, int G) {
    const float* MODP = (const float*)(a.ws + WS_MODP); float* MOD = (float*)(a.ws + WS_MOD); const float* modb = a.in[3];
    int tid0 = threadIdx.x; asm volatile("" : "+v"(tid0));
    for (int i = bid * 512 + tid0; i < 4 * 8 * NMOD; i += G * 512) { const int l = i / (8 * NMOD), n = i % NMOD; float s = modb[l * NMOD + n];
#pragma unroll
        for (int kc = 0; kc < 16; ++kc) s += MODP[(size_t)kc * (4 * 8 * NMOD) + i];
        MOD[i] = s; }
}

__device__ __forceinline__ void norm_mod_phase(const float* x, const float* gain, const float* sh, const float* sc, bf16_t* H, int bid, int G) {
    int tid = threadIdx.x; asm volatile("" : "+v"(tid));
    const int lane = tid & 63, wave = tid >> 6;
    for (int rb = (bid * 8 + wave) * 16; rb < M; rb += G * 8 * 16) {
        const int b = rb / T; f32x4 gs[4], sv[4];
#pragma unroll
        for (int j = 0; j < 4; ++j) { const int c = 4 * lane + 256 * j; const f32x4 g4 = *(const f32x4*)(gain + c), s4 = *(const f32x4*)(sc + (size_t)b * NMOD + c); gs[j] = g4 * (s4 + 1.0f); sv[j] = *(const f32x4*)(sh + (size_t)b * NMOD + c); }
        for (int r = rb; r < rb + 16; ++r) {
            const f32x4* xr = (const f32x4*)(x + (size_t)r * D) + lane; f32x4 v[4]; float ss = 0.f;
#pragma unroll
            for (int j = 0; j < 4; ++j) { v[j] = xr[64 * j]; ss += (v[j][0] * v[j][0] + v[j][1] * v[j][1]) + (v[j][2] * v[j][2] + v[j][3] * v[j][3]); }
            const float rstd = rsqrtf(wave_sum(ss) * (1.0f / D) + EPS);
            u32x2* o = (u32x2*)(H + (size_t)r * D) + lane;
#pragma unroll
            for (int j = 0; j < 4; ++j) { const f32x4 y = v[j] * rstd * gs[j] + sv[j]; u32x2 w; w.x = cvt_pk_bf16(y[0], y[1]); w.y = cvt_pk_bf16(y[2], y[3]); o[64 * j] = w; }
        }
    }
}
__device__ __forceinline__ void final_norm_phase(const float* x, const float* gain, float* out, int bid, int G) {
    int tid = threadIdx.x; asm volatile("" : "+v"(tid));
    const int lane = tid & 63, wave = tid >> 6;
    f32x4 gs[4];
#pragma unroll
    for (int j = 0; j < 4; ++j) gs[j] = *(const f32x4*)(gain + 4 * lane + 256 * j);
    for (int r = bid * 8 + wave; r < M; r += G * 8) {
        const f32x4* xr = (const f32x4*)(x + (size_t)r * D) + lane; f32x4 v[4]; float ss = 0.f;
#pragma unroll
        for (int j = 0; j < 4; ++j) { v[j] = xr[64 * j]; ss += (v[j][0] * v[j][0] + v[j][1] * v[j][1]) + (v[j][2] * v[j][2] + v[j][3] * v[j][3]); }
        const float rstd = rsqrtf(wave_sum(ss) * (1.0f / D) + EPS);
        f32x4* o = (f32x4*)(out + (size_t)r * D) + lane;
#pragma unroll
        for (int j = 0; j < 4; ++j) o[64 * j] = v[j] * rstd * gs[j];
    }
}
__device__ __forceinline__ void dsa_rows_phase(const float* CKVR, const float* KRAW, const float* gkv, const float* gk, const float* bk, bf16_t* CKV, bf16_t* KIDX, float* WIDX, int bid, int G) {
    int tid = threadIdx.x; asm volatile("" : "+v"(tid));
    const int lane = tid & 63, wave = tid >> 6;
    const f32x4 g4 = *(const f32x4*)(gkv + 4 * lane);
    f32x4 gk4 = (f32x4){0.f, 0.f, 0.f, 0.f}, bk4 = gk4;
    if (lane < 16) { gk4 = *(const f32x4*)(gk + 4 * lane); bk4 = *(const f32x4*)(bk + 4 * lane); }
    for (int r = bid * 8 + wave; r < M; r += G * 8) {
        const f32x4 v = *(const f32x4*)(CKVR + (size_t)r * 256 + 4 * lane);
        f32x4 kv = (f32x4){0.f, 0.f, 0.f, 0.f}; if (lane < 32) kv = *(const f32x4*)(KRAW + (size_t)r * 128 + 4 * lane);
        const float ss = wave_sum((v[0] * v[0] + v[1] * v[1]) + (v[2] * v[2] + v[3] * v[3]));
        const float rstd = rsqrtf(ss * (1.0f / 256.0f) + EPS);
        { const f32x4 y = v * rstd * g4; int w = 0; w = __builtin_amdgcn_cvt_pk_fp8_f32(y[0], y[1], w, false); w = __builtin_amdgcn_cvt_pk_fp8_f32(y[2], y[3], w, true); *(int*)((unsigned char*)CKV + (size_t)r * 256 + 4 * lane) = w; }
        const float ks = (lane < 16) ? (kv[0] + kv[1]) + (kv[2] + kv[3]) : 0.f;
        const float mean = wave_sum(ks) * (1.0f / 64.0f);
        const f32x4 dv = kv - mean;
        const float kq = (lane < 16) ? (dv[0] * dv[0] + dv[1] * dv[1]) + (dv[2] * dv[2] + dv[3] * dv[3]) : 0.f;
        const float krstd = rsqrtf(wave_sum(kq) * (1.0f / 64.0f) + EPS);
        if (lane < 16) { const f32x4 y = dv * krstd * gk4 + bk4; u32x2 w; w.x = cvt_pk_bf16(y[0], y[1]); w.y = cvt_pk_bf16(y[2], y[3]); *(u32x2*)(KIDX + ((((size_t)(r >> 5) * 4 + (lane >> 2)) * 64 + (((lane >> 1) & 1) * 32 + (r & 31))) * 8 + (lane & 1) * 4)) = w; }
        else if (lane < 18) { *(f32x4*)(WIDX + (size_t)r * 8 + 4 * (lane - 16)) = kv * 0.04419417382f; }
    }
}

__device__ __forceinline__ float relu_i(float x) { const int b = __float_as_int(x); return __int_as_float(b > 0 ? b : 0); }
__device__ __forceinline__ float relu_mul(float x, float w) { return relu_i(x) * w; }
__device__ __forceinline__ float relu_fma(float x, float w, float acc) { return __builtin_fmaf(relu_i(x), w, acc); }
__device__ __forceinline__ float fmin_raw(float a, float b) { return __builtin_amdgcn_fmed3f(a, b, -__builtin_inff()); }
__device__ __forceinline__ float fmax_raw(float a, float b) { return __builtin_amdgcn_fmed3f(a, b, __builtin_inff()); }
__device__ __forceinline__ unsigned mbcnt64(unsigned long long m) { return __builtin_amdgcn_mbcnt_hi((unsigned)(m >> 32), __builtin_amdgcn_mbcnt_lo((unsigned)m, 0u)); }

template <int SHIFT, int WIDTH>
__device__ __forceinline__ void sel_level(const unsigned (&k)[64], int N, LAS unsigned* hist, int lane, unsigned& prefix, unsigned& need) {
    LAS u32x4* hz = (LAS u32x4*)(hist + 32 * lane);
#pragma unroll
    for (int j = 0; j < 8; ++j) hz[j] = (u32x4){0u, 0u, 0u, 0u};
    LDS_WAIT();
#pragma unroll
    for (int gi = 0; gi < 8; ++gi) if (512 * gi < N) {
#pragma unroll
        for (int ii = 0; ii < 8; ++ii) { const unsigned key = k[8 * gi + ii]; const bool ok = (key >> (SHIFT + WIDTH)) == prefix;
            LAS unsigned* p = ok ? hist + ((key >> SHIFT) & ((1u << WIDTH) - 1u)) : hist + 2048 + lane;
            __hip_atomic_fetch_add(p, 1u, __ATOMIC_RELAXED, __HIP_MEMORY_SCOPE_WORKGROUP); } }
    LDS_WAIT();
    u32x4 hv[8]; unsigned ls = 0u;
#pragma unroll
    for (int j = 0; j < 8; ++j) { hv[j] = hz[j]; ls += (hv[j][0] + hv[j][1]) + (hv[j][2] + hv[j][3]); }
    unsigned incl = ls;
#pragma unroll
    for (int o = 1; o < 64; o <<= 1) { const unsigned v = bperm_u((lane + o) & 63, incl); if (lane + o < 64) incl += v; }
    const unsigned above = incl - ls;
    unsigned cnt = above, d = 0u, nn = 0u;
#pragma unroll
    for (int j = 31; j >= 0; --j) { const unsigned h = hv[j >> 2][j & 3]; const bool hit = (cnt < need) && (need <= cnt + h); d = hit ? (unsigned)(32 * lane + j) : d; nn = hit ? need - cnt : nn; cnt += h; }
    const bool found = (above < need) && (need <= above + ls);
    const unsigned long long fm = __ballot(found);
    const int src = (fm != 0ull) ? (__ffsll((long long)fm) - 1) : 0;
    d = bperm_u(src, d); need = bperm_u(src, nn);
    prefix = (prefix << WIDTH) | d;
}

__device__ __forceinline__ void dsa_select_phase(LAS unsigned char* lds, const bf16_t* QIDX, const bf16_t* KIDX, const float* WIDX, unsigned short* IDX, int bid, int G) {
    int tid0 = threadIdx.x; asm volatile("" : "+v"(tid0));
    const int wave = __builtin_amdgcn_readfirstlane(tid0 >> 6);
    LAS float* SC = (LAS float*)lds;
    LAS unsigned short* IDXL = (LAS unsigned short*)(lds + 135168) + wave * 256;
    LAS float* MM = (LAS float*)(lds + 139264);
    bf16x8 af[2][4]; bf16x8 kb[4][4];
#define DSA_UNIT(itx, b_, t0_, mb_, ntile_, nj_) const int b_ = (itx) & 7, t0_ = ((itx) >> 3) * 8; const size_t mb_ = (size_t)b_ * T; \
    const int ntile_ = (t0_ + 8 + 31) >> 5; const int nj_ = (wave < ntile_) ? ((ntile_ - wave + 7) >> 3) : 0;
#define DSA_KLOAD(buf, j, kbase_, nj_) do { const int jc_ = ((j) < (nj_)) ? (j) : ((nj_) > 0 ? (nj_) - 1 : 0); const bf16_t* kp_ = (kbase_) + (size_t)(wave + 8 * jc_) * 2048; \
    _Pragma("unroll") for (int ks = 0; ks < 4; ++ks) kb[buf][ks] = *(const bf16x8*)(kp_ + 512 * ks); } while (0)
#define DSA_PRELOAD(t0_, mb_, nj_) do { \
    _Pragma("unroll") for (int rg = 0; rg < 2; ++rg) { const bf16_t* qp = QIDX + ((mb_) + (t0_) + 4 * rg + (col >> 3)) * 512 + (col & 7) * 64 + 8 * hf; \
        _Pragma("unroll") for (int ks = 0; ks < 4; ++ks) af[rg][ks] = *(const bf16x8*)(qp + 16 * ks); } \
    (void)(nj_); } while (0)
    { int tid = tid0; asm volatile("" : "+v"(tid)); const int lane = tid & 63, hf = lane >> 5, col = lane & 31;
      if (bid < 4096) { DSA_UNIT(bid, b, t0, mb, ntile, nj) (void)b; (void)ntile; if (t0 + 8 > 256) DSA_PRELOAD(t0, mb, nj); } }
    for (int it = bid; it < 4096; it += G) {
        int tid = tid0; asm volatile("" : "+v"(tid));
        const int lane = tid & 63, hf = lane >> 5, col = lane & 31;
        DSA_UNIT(it, b, t0, mb, ntile, nj) (void)b; (void)ntile;
        const int t = t0 + wave, N = t + 1;
        unsigned short* outp = IDX + (mb + t) * 256;
        const int itn = it + G; const bool hasn = itn < 4096;
        DSA_UNIT(hasn ? itn : it, bn, t0n, mbn, ntilen, njn) (void)bn; (void)ntilen;
        if (t0 + 8 <= 256) {
            *(u32x2*)(outp + 4 * lane) = (u32x2){(unsigned)(4 * lane) | ((unsigned)(4 * lane + 1) << 16), (unsigned)(4 * lane + 2) | ((unsigned)(4 * lane + 3) << 16)};
            if (hasn && t0n + 8 > 256) DSA_PRELOAD(t0n, mbn, njn);
            continue;
        }
        float w[2][4][4]; float mn[2][2], mx[2][2];
#pragma unroll
        for (int rg = 0; rg < 2; ++rg)
#pragma unroll
            for (int e = 0; e < 2; ++e) { mn[rg][e] = 3.0e38f; mx[rg][e] = -3.0e38f; }
        const bf16_t* kbase = KIDX + mb * 64 + (size_t)lane * 8;
        DSA_KLOAD(0, 0, kbase, nj); DSA_KLOAD(1, 1, kbase, nj); DSA_KLOAD(2, 2, kbase, nj); DSA_KLOAD(3, 3, kbase, nj);
#pragma unroll
        for (int rg = 0; rg < 2; ++rg)
#pragma unroll
            for (int qq = 0; qq < 4; ++qq) { const f32x4 wv = *(const f32x4*)(WIDX + (mb + t0 + 4 * rg + qq) * 8 + 4 * hf);
                w[rg][qq][0] = wv[0]; w[rg][qq][1] = wv[1]; w[rg][qq][2] = wv[2]; w[rg][qq][3] = wv[3]; }
#define DSA_KCOMP(buf, j) do { const int s_ = 32 * (wave + 8 * (j)) + col; f32x16 acc0, acc1; \
    _Pragma("unroll") for (int i = 0; i < 16; ++i) { acc0[i] = 0.f; acc1[i] = 0.f; } \
    _Pragma("unroll") for (int ks = 0; ks < 4; ++ks) { acc0 = __builtin_amdgcn_mfma_f32_32x32x16_bf16(af[0][ks], kb[buf][ks], acc0, 0, 0, 0); acc1 = __builtin_amdgcn_mfma_f32_32x32x16_bf16(af[1][ks], kb[buf][ks], acc1, 0, 0, 0); } \
    _Pragma("unroll") for (int rg = 0; rg < 2; ++rg) { float p[4]; \
        _Pragma("unroll") for (int qq = 0; qq < 4; ++qq) { p[qq] = relu_mul(rg ? acc1[4 * qq] : acc0[4 * qq], w[rg][qq][0]); _Pragma("unroll") for (int ii = 1; ii < 4; ++ii) p[qq] = relu_fma(rg ? acc1[4 * qq + ii] : acc0[4 * qq + ii], w[rg][qq][ii], p[qq]); } \
        _Pragma("unroll") for (int e = 0; e < 2; ++e) { const auto r = __builtin_amdgcn_permlane32_swap(__float_as_uint(p[e]), __float_as_uint(p[2 + e]), false, false); \
            const float tot = __uint_as_float(r[0]) + __uint_as_float(r[1]); SC[(4 * rg + 2 * hf + e) * 4096 + s_] = tot; mn[rg][e] = fmin_raw(mn[rg][e], tot); mx[rg][e] = fmax_raw(mx[rg][e], tot); } } } while (0)
        for (int j = 0; j < nj; j += 4) {
            DSA_KCOMP(0, j); if (j + 4 < nj) DSA_KLOAD(0, j + 4, kbase, nj);
            if (j + 1 < nj) DSA_KCOMP(1, j + 1);
            if (j + 5 < nj) DSA_KLOAD(1, j + 5, kbase, nj);
            if (j + 2 < nj) DSA_KCOMP(2, j + 2);
            if (j + 6 < nj) DSA_KLOAD(2, j + 6, kbase, nj);
            if (j + 3 < nj) DSA_KCOMP(3, j + 3);
            if (j + 7 < nj) DSA_KLOAD(3, j + 7, kbase, nj);
        }
#pragma unroll
        for (int rg = 0; rg < 2; ++rg)
#pragma unroll
            for (int e = 0; e < 2; ++e) {
#pragma unroll
                for (int o = 1; o < 32; o <<= 1) { mn[rg][e] = fminf(mn[rg][e], bperm_f(lane ^ o, mn[rg][e])); mx[rg][e] = fmaxf(mx[rg][e], bperm_f(lane ^ o, mx[rg][e])); }
                if (col == 0) { MM[(wave * 8 + 4 * rg + 2 * hf + e) * 2] = mn[rg][e]; MM[(wave * 8 + 4 * rg + 2 * hf + e) * 2 + 1] = mx[rg][e]; } }
        if (hasn && t0n + 8 > 256) DSA_PRELOAD(t0n, mbn, njn);
        __syncthreads();
        {
            const LAS float* scl = SC + wave * 4096 + lane;
            LAS unsigned* hist = (LAS unsigned*)(lds + wave * 16384);
            float lo = 3.0e38f, hi = -3.0e38f;
#pragma unroll
            for (int wv = 0; wv < 8; ++wv) { lo = fminf(lo, MM[(wv * 8 + wave) * 2]); hi = fmaxf(hi, MM[(wv * 8 + wave) * 2 + 1]); }
            const float scale = 4.0e9f / fmaxf(hi - lo, 1e-30f);
            unsigned k[64];
#pragma unroll
            for (int gi = 0; gi < 8; ++gi) { if (512 * gi < N) {
#pragma unroll
                for (int ii = 0; ii < 8; ++ii) k[8 * gi + ii] = __float_as_uint(scl[64 * (8 * gi + ii)]); } else {
#pragma unroll
                for (int ii = 0; ii < 8; ++ii) k[8 * gi + ii] = 0u; } }
            LDS_WAIT();
            { LAS u32x4* hz = (LAS u32x4*)(hist + 16 * lane);
#pragma unroll
              for (int j = 0; j < 4; ++j) hz[j] = (u32x4){0u, 0u, 0u, 0u}; }
            LDS_WAIT();
#pragma unroll
            for (int gi = 0; gi < 8; ++gi) if (512 * gi < N) {
#pragma unroll
                for (int ii = 0; ii < 8; ++ii) { const int i = 8 * gi + ii; const bool valid = lane < N - 64 * i;
                    const unsigned key = valid ? 1u + (unsigned)((__uint_as_float(k[i]) - lo) * scale) : 0u; k[i] = key;
                    LAS unsigned* p = valid ? hist + (key >> 22) : hist + 1024 + lane;
                    __hip_atomic_fetch_add(p, 1u, __ATOMIC_RELAXED, __HIP_MEMORY_SCOPE_WORKGROUP); } }
            LDS_WAIT();
            unsigned d0, need1;
            { const LAS u32x4* hz = (const LAS u32x4*)(hist + 16 * lane); u32x4 hv[4]; unsigned ls = 0u;
#pragma unroll
              for (int j = 0; j < 4; ++j) { hv[j] = hz[j]; ls += (hv[j][0] + hv[j][1]) + (hv[j][2] + hv[j][3]); }
              unsigned incl = ls;
#pragma unroll
              for (int o = 1; o < 64; o <<= 1) { const unsigned v = bperm_u((lane + o) & 63, incl); if (lane + o < 64) incl += v; }
              const unsigned above = incl - ls; unsigned cnt = above, d = 0u, nn = 0u;
#pragma unroll
              for (int j = 15; j >= 0; --j) { const unsigned h = hv[j >> 2][j & 3]; const bool hit = (cnt < 256u) && (256u <= cnt + h); d = hit ? (unsigned)(16 * lane + j) : d; nn = hit ? 256u - cnt : nn; cnt += h; }
              const bool found = (above < 256u) && (256u <= above + ls);
              const unsigned long long fm = __ballot(found);
              const int src = (fm != 0ull) ? (__ffsll((long long)fm) - 1) : 0;
              d0 = bperm_u(src, d); need1 = bperm_u(src, nn); }
            LAS unsigned* CK = hist + 1100; LAS unsigned short* CS = (LAS unsigned short*)(hist + 1170);
            unsigned base = 0u, cbase = 0u;
#pragma unroll
            for (int gi = 0; gi < 8; ++gi) if (512 * gi < N) {
#pragma unroll
                for (int ii = 0; ii < 8; ++ii) { const int i = 8 * gi + ii; const unsigned key = k[i], dg = key >> 22;
                    const bool gt = dg > d0, eq = (dg == d0) && (key != 0u);
                    const unsigned long long mgt = __ballot(gt), meq = __ballot(eq);
                    if (gt) IDXL[base + mbcnt64(mgt)] = (unsigned short)(64 * i + lane);
                    base += (unsigned)__popcll(mgt);
                    if (meq != 0ull) { const unsigned cp = cbase + mbcnt64(meq); if (eq && cp < 64u) { CK[cp] = key; CS[cp] = (unsigned short)(64 * i + lane); } cbase += (unsigned)__popcll(meq); } } }
            LDS_WAIT();
            if (cbase <= 64u) {
                const unsigned mykey = (lane < (int)cbase) ? CK[lane] : 0u; unsigned rank = 0u;
                for (unsigned j = 0; j < cbase; ++j) { const unsigned kj = CK[j]; rank += ((kj > mykey) || (kj == mykey && j < (unsigned)lane)) ? 1u : 0u; }
                const bool sel = (lane < (int)cbase) && (rank < need1);
                const unsigned long long ms = __ballot(sel);
                if (sel) IDXL[base + mbcnt64(ms)] = CS[lane];
            } else {
                unsigned prefix = d0, need = need1;
                LDS_WAIT();
                sel_level<11, 11>(k, N, hist, lane, prefix, need);
                sel_level<0, 11>(k, N, hist, lane, prefix, need);
                unsigned eb = 0u, eqb = 0u;
#pragma unroll
                for (int gi = 0; gi < 8; ++gi) if (512 * gi < N) {
#pragma unroll
                    for (int ii = 0; ii < 8; ++ii) { const int i = 8 * gi + ii; const unsigned key = k[i]; const bool gt = key > prefix, eq = key == prefix;
                        const unsigned long long meq = __ballot(eq); const bool sel = gt || (eq && (eqb + mbcnt64(meq) < need));
                        const unsigned long long msel = __ballot(sel); const unsigned pos = eb + mbcnt64(msel);
                        if (sel && pos < 256u) IDXL[pos] = (unsigned short)(64 * i + lane);
                        eb += (unsigned)__popcll(msel); eqb += (unsigned)__popcll(meq); } }
            }
            LDS_WAIT();
            *(u32x2*)(outp + 4 * lane) = *(const LAS u32x2*)(IDXL + 4 * lane);
        }
        __syncthreads();
    }
#undef DSA_UNIT
#undef DSA_KLOAD
#undef DSA_PRELOAD
#undef DSA_KCOMP
}

__device__ __forceinline__ void dsa_attn_phase(LAS unsigned char* lds, const unsigned char* QLAT8, const unsigned char* CKV8, const unsigned short* IDX, bf16_t* OLAT, int bid, int G) {
    int tid0 = threadIdx.x; asm volatile("" : "+v"(tid0));
    const int wave = __builtin_amdgcn_readfirstlane(tid0 >> 6);
    LAS unsigned char* tile0 = lds + wave * 17408;
    constexpr int TS = 8704, RS = 272;
    constexpr float SCL = 1.4426950408889634f / 16.0f;
    unsigned ixw[8]; u32x4 qf[4]; u32x4 ra[2][2][4];
#define ATT_Q(itx, b_, t_, m_, cnt_) const int b_ = (itx) & 7, t_ = ((itx) >> 3) * 8 + wave; const size_t m_ = (size_t)b_ * T + t_; const int cnt_ = (t_ + 1 < 256) ? t_ + 1 : 256;
#define ATT_LOAD_IX(dst, m_) do { const u32x4 xa_ = *(const u32x4*)(IDX + (m_) * 256 + 16 * c16), xb_ = *(const u32x4*)(IDX + (m_) * 256 + 16 * c16 + 8); \
    dst[0] = xa_[0]; dst[1] = xa_[1]; dst[2] = xa_[2]; dst[3] = xa_[3]; dst[4] = xb_[0]; dst[5] = xb_[1]; dst[6] = xb_[2]; dst[7] = xb_[3]; } while (0)
#define ATT_LOAD_QF(dst, m_) do { const unsigned char* qp_ = QLAT8 + (m_) * 2048 + hd * 256 + 16 * g; _Pragma("unroll") for (int kk = 0; kk < 4; ++kk) dst[kk] = *(const u32x4*)(qp_ + 64 * kk); } while (0)
#define ATT_LOAD_ROWS(buf, ix_, n0_, b_, cnt_) do { const int n1_ = (n0_) + 1; \
    const int k0_ = (16 * c16 + (n0_) < (cnt_)) ? (int)(ix_[(n0_) >> 1] & 0xffffu) : 0, k1_ = (16 * c16 + n1_ < (cnt_)) ? (int)(ix_[n1_ >> 1] >> 16) : 0; \
    const unsigned char* cb_ = CKV8 + (size_t)(b_) * T * 256 + 16 * g; \
    _Pragma("unroll") for (int kk = 0; kk < 4; ++kk) { ra[buf][0][kk] = *(const u32x4*)(cb_ + (size_t)k0_ * 256 + 64 * kk); ra[buf][1][kk] = *(const u32x4*)(cb_ + (size_t)k1_ * 256 + 64 * kk); } } while (0)
#define ATT_QK(bf, d0, d1) do { d0 = (f32x4){0.f, 0.f, 0.f, 0.f}; d1 = d0; \
    _Pragma("unroll") for (int kk = 0; kk < 4; ++kk) _Pragma("unroll") for (int hh = 0; hh < 2; ++hh) { \
        const long qv_ = (long)(((unsigned long long)qf[kk][2 * hh + 1] << 32) | qf[kk][2 * hh]); \
        const long a0_ = (long)(((unsigned long long)ra[bf][0][kk][2 * hh + 1] << 32) | ra[bf][0][kk][2 * hh]); \
        const long a1_ = (long)(((unsigned long long)ra[bf][1][kk][2 * hh + 1] << 32) | ra[bf][1][kk][2 * hh]); \
        d0 = __builtin_amdgcn_mfma_f32_16x16x32_fp8_fp8(a0_, qv_, d0, 0, 0, 0); d1 = __builtin_amdgcn_mfma_f32_16x16x32_fp8_fp8(a1_, qv_, d1, 0, 0, 0); } \
    _Pragma("unroll") for (int kk = 0; kk < 4; ++kk) { *(LAS u32x4*)(tile0 + (bf) * TS + c16 * RS + 64 * kk + 16 * g) = ra[bf][0][kk]; *(LAS u32x4*)(tile0 + (bf) * TS + (16 + c16) * RS + 64 * kk + 16 * g) = ra[bf][1][kk]; } } while (0)
    { int tid = tid0; asm volatile("" : "+v"(tid)); const int lane = tid & 63, g = lane >> 4, c16 = lane & 15, hd = c16 & 7;
      if (bid < 4096) { ATT_Q(bid, b, t, m, cnt) (void)t; ATT_LOAD_IX(ixw, m); ATT_LOAD_QF(qf, m); ATT_LOAD_ROWS(0, ixw, 0, b, cnt); ATT_LOAD_ROWS(1, ixw, 2, b, cnt); } }
    for (int it = bid; it < 4096; it += G) {
        int tid = tid0; asm volatile("" : "+v"(tid));
        const int lane = tid & 63, g = lane >> 4, c16 = lane & 15, hd = c16 & 7, q4 = c16 >> 2, p4 = c16 & 3;
        ATT_Q(it, b, t, m, cnt) (void)t;
        const int itn = it + G; const bool hasn = itn < 4096;
        ATT_Q(hasn ? itn : it, bn, tn, mn, cntn) (void)tn;
        f32x4 oe[8], oo[8];
#pragma unroll
        for (int ub = 0; ub < 8; ++ub) { oe[ub] = (f32x4){0.f, 0.f, 0.f, 0.f}; oo[ub] = oe[ub]; }
        float mrun = -INFINITY, lrun = 0.f;
        f32x4 s0, s1, sn0, sn1;
        ATT_QK(0, s0, s1); ATT_LOAD_ROWS(0, ixw, 4, b, cnt);
#pragma unroll
        for (int ch = 0; ch < 8; ++ch) {
            const int bf = ch & 1, bn1 = (ch + 1) & 1;
            if (ch < 7) { ATT_QK(bn1, sn0, sn1);
                if (ch < 5) ATT_LOAD_ROWS(bn1, ixw, 2 * (ch + 3), b, cnt);
                else if (hasn) ATT_LOAD_ROWS(bn1, ixw, 2 * (ch - 5), bn, cntn); }
            if (ch == 4 && hasn) ATT_LOAD_IX(ixw, mn);
            if (ch == 6 && hasn) ATT_LOAD_QF(qf, mn);
            float cm = -INFINITY;
#pragma unroll
            for (int i = 0; i < 4; ++i) { const int jr = 16 * (4 * g + i) + 2 * ch; if (jr >= cnt) s0[i] = -INFINITY; if (jr + 1 >= cnt) s1[i] = -INFINITY; cm = fmaxf(cm, fmaxf(s0[i], s1[i])); }
            cm = fmaxf(cm, bperm_f(lane ^ 16, cm)); cm = fmaxf(cm, bperm_f(lane ^ 32, cm));
            const float mnew = fmaxf(mrun, cm), alpha = __builtin_amdgcn_exp2f((mrun - mnew) * SCL);
            float p0[4], p1[4], ps = 0.f;
#pragma unroll
            for (int i = 0; i < 4; ++i) { p0[i] = __builtin_amdgcn_exp2f((s0[i] - mnew) * SCL); p1[i] = __builtin_amdgcn_exp2f((s1[i] - mnew) * SCL); ps += p0[i] + p1[i]; }
            lrun = lrun * alpha + ps; mrun = mnew;
            asm volatile("" : "+v"(lrun));
#pragma unroll
            for (int ub = 0; ub < 8; ++ub) { oe[ub] = oe[ub] * alpha; oo[ub] = oo[ub] * alpha; }
            int pl = 0, ph = 0;
            pl = __builtin_amdgcn_cvt_pk_fp8_f32(p0[0], p0[1], pl, false); pl = __builtin_amdgcn_cvt_pk_fp8_f32(p0[2], p0[3], pl, true);
            ph = __builtin_amdgcn_cvt_pk_fp8_f32(p1[0], p1[1], ph, false); ph = __builtin_amdgcn_cvt_pk_fp8_f32(p1[2], p1[3], ph, true);
            const long pb = (long)(((unsigned long long)(unsigned)ph << 32) | (unsigned)pl);
#pragma unroll
            for (int ub = 0; ub < 8; ++ub) {
                const s16x4 t0v = __builtin_amdgcn_ds_read_tr16_b64_v4i16((LAS s16x4*)(tile0 + bf * TS + (4 * g + q4) * RS + 32 * ub + 8 * p4));
                const s16x4 t1v = __builtin_amdgcn_ds_read_tr16_b64_v4i16((LAS s16x4*)(tile0 + bf * TS + (16 + 4 * g + q4) * RS + 32 * ub + 8 * p4));
                const u32x2 w0 = __builtin_bit_cast(u32x2, t0v), w1 = __builtin_bit_cast(u32x2, t1v);
                const unsigned e0 = __builtin_amdgcn_perm(w0.y, w0.x, 0x06040200u), o0 = __builtin_amdgcn_perm(w0.y, w0.x, 0x07050301u);
                const unsigned e1 = __builtin_amdgcn_perm(w1.y, w1.x, 0x06040200u), o1 = __builtin_amdgcn_perm(w1.y, w1.x, 0x07050301u);
                const long ae = (long)(((unsigned long long)e1 << 32) | e0), ao = (long)(((unsigned long long)o1 << 32) | o0);
                oe[ub] = __builtin_amdgcn_mfma_f32_16x16x32_fp8_fp8(ae, pb, oe[ub], 0, 0, 0);
                oo[ub] = __builtin_amdgcn_mfma_f32_16x16x32_fp8_fp8(ao, pb, oo[ub], 0, 0, 0);
            }
            if (ch < 7) { s0 = sn0; s1 = sn1; }
        }
        float lt = lrun + bperm_f(lane ^ 16, lrun); lt += bperm_f(lane ^ 32, lt);
        const float inv = 1.0f / lt;
        if (c16 < 8) { bf16_t* op = OLAT + m * 2048 + c16 * 256 + 8 * g;
#pragma unroll
            for (int ub = 0; ub < 8; ++ub) { const f32x4 ye = oe[ub] * inv, yo = oo[ub] * inv; u32x4 wv;
                wv.x = cvt_pk_bf16(ye[0], yo[0]); wv.y = cvt_pk_bf16(ye[1], yo[1]); wv.z = cvt_pk_bf16(ye[2], yo[2]); wv.w = cvt_pk_bf16(ye[3], yo[3]); *(u32x4*)(op + 32 * ub) = wv; } }
    }
#undef ATT_Q
#undef ATT_LOAD_IX
#undef ATT_LOAD_QF
#undef ATT_LOAD_ROWS
#undef ATT_QK
}

__device__ __forceinline__ void smix_phase(LAS unsigned char* lds, bf16_t* UY, const bf16_t* V, const f32x2* STATS, const float* Wc, const float* bsp, const float* lng, const float* lnb, int bid, int G) {
    int tid = threadIdx.x; asm volatile("" : "+v"(tid));
    const int lane = tid & 63, wave = __builtin_amdgcn_readfirstlane(tid >> 6);
    const int gq = lane >> 4, c16 = lane & 15, q4 = c16 >> 2, p4 = c16 & 3;
    LAS unsigned char* VT = lds;
    LAS unsigned char* AP = lds + 67584;
    LAS float* MU = (LAS float*)(lds + 102400); LAS float* RSTD = MU + 128; LAS float* R1 = MU + 256; LAS float* R2 = MU + 384;
    for (int it = bid; it < 2048; it += G) {
        const int gi = it & 7, rem = it >> 3, b = rem >> 5, ck = rem & 31; const size_t m0 = (size_t)b * T + ck * 128;
        if (tid < 128) { const f32x2* sp = STATS + (m0 + tid) * 32; float s = 0.f, ss = 0.f;
#pragma unroll 8
            for (int p = 0; p < 32; ++p) { const f32x2 v = sp[p]; s += v.x; ss += v.y; }
            const float mu = s * (1.0f / 2048.0f), var = ss * (1.0f / 2048.0f) - mu * mu; MU[tid] = mu; RSTD[tid] = rsqrtf(fmaxf(var, 0.f) + EPS); }
#pragma unroll
        for (int i = 0; i < 8; ++i) { const int cidx = tid + 512 * i, s = cidx >> 5, ch = cidx & 31;
            *(LAS u32x4*)(VT + s * 528 + ch * 16) = *(const u32x4*)(V + (m0 + s) * 2048 + gi * 256 + ch * 8); }
        __syncthreads();
        { const int t = tid >> 2, qd = tid & 3; const float* wp = Wc + ((size_t)gi * 128 + t) * 128 + 32 * qd; float r1 = 0.f, r2 = 0.f;
#pragma unroll
          for (int s8 = 0; s8 < 4; ++s8) { const f32x4 wa = *(const f32x4*)(wp + 8 * s8), wb = *(const f32x4*)(wp + 8 * s8 + 4); float av[8];
#pragma unroll
              for (int e = 0; e < 8; ++e) { const int s = 32 * qd + 8 * s8 + e; const float wv = (s <= t) ? (e < 4 ? wa[e] : wb[e - 4]) : 0.f; const float ab = bf_round(wv * RSTD[s]); av[e] = ab; r1 += ab * MU[s]; r2 += wv; }
              u32x4 o; o.x = cvt_pk_bf16(av[0], av[1]); o.y = cvt_pk_bf16(av[2], av[3]); o.z = cvt_pk_bf16(av[4], av[5]); o.w = cvt_pk_bf16(av[6], av[7]);
              *(LAS u32x4*)(AP + t * 272 + (32 * qd + 8 * s8) * 2) = o; }
          r1 += bperm_f(lane ^ 1, r1); r2 += bperm_f(lane ^ 1, r2); r1 += bperm_f(lane ^ 2, r1); r2 += bperm_f(lane ^ 2, r2);
          if (qd == 0) { R1[t] = r1; R2[t] = r2; } }
        __syncthreads();
        f32x4 acc[8][2];
#pragma unroll
        for (int mt = 0; mt < 8; ++mt) { acc[mt][0] = (f32x4){0.f, 0.f, 0.f, 0.f}; acc[mt][1] = acc[mt][0]; }
#pragma unroll
        for (int ks = 0; ks < 4; ++ks) {
            bf16x8 vf[2];
#pragma unroll
            for (int n2 = 0; n2 < 2; ++n2) { const int nt = 2 * wave + n2;
                const s16x4 t0v = __builtin_amdgcn_ds_read_tr16_b64_v4i16((LAS s16x4*)(VT + (32 * ks + 8 * gq + q4) * 528 + (16 * nt + 4 * p4) * 2));
                const s16x4 t1v = __builtin_amdgcn_ds_read_tr16_b64_v4i16((LAS s16x4*)(VT + (32 * ks + 8 * gq + 4 + q4) * 528 + (16 * nt + 4 * p4) * 2));
                vf[n2] = __builtin_shufflevector(t0v, t1v, 0, 1, 2, 3, 4, 5, 6, 7); }
#pragma unroll
            for (int mt = 0; mt < 8; ++mt) if (mt >= 2 * ks) {
                const bf16x8 afr = *(const LAS bf16x8*)(AP + (16 * mt + c16) * 272 + (32 * ks + 8 * gq) * 2);
                acc[mt][0] = __builtin_amdgcn_mfma_f32_16x16x32_bf16(vf[0], afr, acc[mt][0], 0, 0, 0);
                acc[mt][1] = __builtin_amdgcn_mfma_f32_16x16x32_bf16(vf[1], afr, acc[mt][1], 0, 0, 0); }
        }
        __syncthreads();
#pragma unroll
        for (int i = 0; i < 8; ++i) { const int cidx = tid + 512 * i, s = cidx >> 5, ch = cidx & 31;
            *(LAS u32x4*)(VT + s * 528 + ch * 16) = *(const u32x4*)(UY + (m0 + s) * 2048 + gi * 256 + ch * 8); }
        __syncthreads();
#pragma unroll
        for (int n2 = 0; n2 < 2; ++n2) { const int e0 = 16 * (2 * wave + n2) + 4 * gq; const f32x4 lg4 = *(const f32x4*)(lng + gi * 256 + e0), lb4 = *(const f32x4*)(lnb + gi * 256 + e0);
#pragma unroll
            for (int mt = 0; mt < 8; ++mt) { const int t = 16 * mt + c16; const float r1 = R1[t], r2 = R2[t], bsv = bsp[gi * 128 + t];
                LAS u32x2* up = (LAS u32x2*)(VT + t * 528 + e0 * 2); const u32x2 uw = *up;
                const f32x4 mixed = lg4 * (acc[mt][n2] - r1) + lb4 * r2 + bsv;
                const float y0 = bf2f(uw.x & 0xffffu) * mixed[0], y1 = bf2f(uw.x >> 16) * mixed[1], y2 = bf2f(uw.y & 0xffffu) * mixed[2], y3 = bf2f(uw.y >> 16) * mixed[3];
                u32x2 yw; yw.x = cvt_pk_bf16(y0, y1); yw.y = cvt_pk_bf16(y2, y3); *up = yw; } }
        __syncthreads();
#pragma unroll
        for (int i = 0; i < 8; ++i) { const int cidx = tid + 512 * i, s = cidx >> 5, ch = cidx & 31;
            *(u32x4*)(UY + (m0 + s) * 2048 + gi * 256 + ch * 8) = *(const LAS u32x4*)(VT + s * 528 + ch * 16); }
        __syncthreads();
    }
}

__global__ void __launch_bounds__(512, 2) mk_fwd(Args a) {
    extern __shared__ __attribute__((aligned(16))) unsigned char lds_raw[];
    LAS unsigned char* lds = (LAS unsigned char*)lds_raw;
    cg::grid_group grid = cg::this_grid();
    const int bid = blockIdx.x, G = gridDim.x;
    unsigned char* wsk = a.ws;
    float* X = a.out;
    volatile LAS unsigned* misc = (volatile LAS unsigned*)(lds + LDS_MISC);
    if (threadIdx.x < 2) misc[threadIdx.x] = 0u;
    __syncthreads();
    const XcdBarrier xbar = xcd_barrier_post((unsigned*)(wsk + WS_BAR), misc);
    int ph = 0;
#ifndef PROBE
#define PROBE 0
#endif
#define PHASE_BEGIN if (ph >= a.ph_lo && ph < a.ph_hi) {
#define REP(k) for (int rep_ = 0; rep_ < ((PROBE == (k)) ? 2 : 1); ++rep_)
#define PHASE_END(dosync) if ((dosync) && ph + 1 < a.ph_hi) { if (ph == 0) grid.sync(); else xcd_barrier(xbar); } } ++ph;

    PHASE_BEGIN REP(4) { p0_phase(a, lds, bid, G); __syncthreads(); } PHASE_END(true)
    PHASE_BEGIN p0c_phase(a, bid, G); PHASE_END(true)

#pragma unroll 1
    for (int layer = 0; layer < 4; ++layer) {
        unsigned char* ws = wsk; asm volatile("" : "+s"(ws));
        float* MOD = (float*)(ws + WS_MOD); bf16_t* H = (bf16_t*)(ws + WS_H);
        const int j = layer >> 1; const float* xin = (layer == 0) ? a.in[0] : X;
        const float* modl = MOD + (size_t)layer * 8 * NMOD;
        PHASE_BEGIN REP(3) norm_mod_phase(xin, a.in[4] + layer * D, modl + 0 * D, modl + 1 * D, H, bid, G); PHASE_END(true)
        if ((layer & 1) == 0) {
            bf16_t* Q = (bf16_t*)(ws + WS_Q); float* CKVR = (float*)(ws + WS_CKVR); bf16_t* QIDX = (bf16_t*)(ws + WS_QIDX); float* KRAW = (float*)(ws + WS_KRAW);
            bf16_t* CKV = (bf16_t*)(ws + WS_CKV); bf16_t* KIDX = (bf16_t*)(ws + WS_KIDX); float* WIDX = (float*)(ws + WS_WIDX); unsigned short* IDX = (unsigned short*)(ws + WS_IDX);
            bf16_t* QLAT = (bf16_t*)(ws + WS_QLAT); bf16_t* OLAT = (bf16_t*)(ws + WS_OLAT); bf16_t* O = (bf16_t*)(ws + WS_O);
            PHASE_BEGIN { pg8::Gemm g{H, (const bf16_t*)(ws + W_AIN) + (size_t)j * 2048 * 1024, M, 2048, 1024, 1024, 0, 0}; pg8::StaticOrder S; S.init(M, 2048, G, bid);
                pg8::EpiInproj E{Q, CKVR, QIDX, KRAW}; REP(5) pg8::gemm_phase(lds, g, S, E); } PHASE_END(true)
            PHASE_BEGIN { dsa_rows_phase(CKVR, KRAW, a.in[7] + j * 256, a.in[8] + j * 64, a.in[9] + j * 64, CKV, KIDX, WIDX, bid, G);
                __syncthreads();
                pg8::Gemm g{Q, (const bf16_t*)(ws + W_UK) + (size_t)j * 2048 * 256, M, 2048, 256, 1024, 1, 256}; pg8::StaticOrder S; S.init(M, 2048, G, bid);
                pg8::EpiBf16 E{QLAT, 2048, 1.4142135623730951f, 1}; pg8::gemm_phase(lds, g, S, E); } PHASE_END(true)
            PHASE_BEGIN REP(1) dsa_select_phase(lds, QIDX, KIDX, WIDX, IDX, bid, G); PHASE_END(true)
            PHASE_BEGIN REP(2) dsa_attn_phase(lds, (const unsigned char*)QLAT, (const unsigned char*)CKV, IDX, OLAT, bid, G); PHASE_END(true)
            PHASE_BEGIN { pg8::Gemm g{OLAT, (const bf16_t*)(ws + W_UV) + (size_t)j * 1024 * 512, M, 1024, 512, 2048, 0, 512}; pg8::StaticOrder S; S.init(M, 1024, G, bid);
                pg8::EpiBf16 E{O, 1024, 1.0f, 0}; pg8::gemm_phase(lds, g, S, E); } PHASE_END(true)
            PHASE_BEGIN { pg8::Gemm g{O, (const bf16_t*)(ws + W_O) + (size_t)j * 1024 * 1024, M, 1024, 1024, 1024, 0, 0}; pg8::StaticOrder S; S.init(M, 1024, G, bid);
                pg8::EpiResid E{xin, X, modl + 2 * D}; pg8::gemm_phase(lds, g, S, E); } PHASE_END(true)
        } else {
            bf16_t* U = (bf16_t*)(ws + WS_U); bf16_t* V = (bf16_t*)(ws + WS_V); f32x2* STATS = (f32x2*)(ws + WS_STATS);
            PHASE_BEGIN { pg8::Gemm g{H, (const bf16_t*)(ws + W_BIN) + (size_t)j * 4096 * 1024, M, 4096, 1024, 1024, 0, 0}; pg8::StaticOrder S; S.init(M, 4096, G, bid);
                pg8::EpiGelu E{U, V, STATS}; REP(7) pg8::gemm_phase(lds, g, S, E); } PHASE_END(true)
            PHASE_BEGIN smix_phase(lds, U, V, STATS, a.in[16] + (size_t)j * 8 * 128 * 128, a.in[17] + (size_t)j * 8 * 128, a.in[14] + (size_t)j * 2048, a.in[15] + (size_t)j * 2048, bid, G); PHASE_END(true)
            PHASE_BEGIN { pg8::Gemm g{U, (const bf16_t*)(ws + W_BOUT) + (size_t)j * 1024 * 2048, M, 1024, 2048, 2048, 0, 0}; pg8::StaticOrder S; S.init(M, 1024, G, bid);
                pg8::EpiResid E{xin, X, modl + 2 * D}; pg8::gemm_phase(lds, g, S, E); } PHASE_END(true)
        }
        PHASE_BEGIN REP(3) norm_mod_phase(X, a.in[5] + layer * D, modl + 3 * D, modl + 4 * D, H, bid, G); PHASE_END(true)
        PHASE_BEGIN { pg8::Gemm g{H, (const bf16_t*)(ws + W_GU) + (size_t)layer * 5632 * 1024, M, 5632, 1024, 1024, 0, 0}; pg8::StaticOrder S; S.init(M, 5632, G, bid);
            pg8::EpiSwiglu E{(bf16_t*)(ws + WS_HID)}; REP(6) pg8::gemm_phase(lds, g, S, E); } PHASE_END(true)
        PHASE_BEGIN { pg8::Gemm g{(const bf16_t*)(ws + WS_HID), (const bf16_t*)(ws + W_DN) + (size_t)layer * 1024 * DFF, M, 1024, DFF, DFF, 0, 0}; pg8::StaticOrder S; S.init(M, 1024, G, bid);
            pg8::EpiResid E{X, X, modl + 5 * D}; pg8::gemm_phase(lds, g, S, E); } PHASE_END(true)
    }
    PHASE_BEGIN final_norm_phase(X, a.in[22], a.out, bid, G); PHASE_END(false)
}

extern "C" void kernel_launch(void* const* d_in, const int* in_sizes, int n_in, void* d_out, int out_size, void* d_ws, size_t ws_size, hipStream_t stream) {
    static int grid_blocks = 0;
    if (grid_blocks == 0) {
        int dev = 0, cus = 0, per_cu = 0;
        if (n_in != 23 || out_size != M * D || ws_size < WS_END) { fprintf(stderr, "kernel_launch: unexpected problem (n_in %d out %d ws %zu, need ws >= %zu)\n", n_in, out_size, ws_size, (size_t)WS_END); grid_blocks = -1; return; }
        (void)hipGetDevice(&dev);
        (void)hipDeviceGetAttribute(&cus, hipDeviceAttributeMultiprocessorCount, dev);
        (void)hipFuncSetAttribute((const void*)mk_fwd, hipFuncAttributeMaxDynamicSharedMemorySize, LDS_BYTES);
        (void)hipOccupancyMaxActiveBlocksPerMultiprocessor(&per_cu, (const void*)mk_fwd, 512, LDS_BYTES);
        fprintf(stderr, "kernel_launch: cus %d per_cu %d ws %zu\n", cus, per_cu, ws_size);
        if (per_cu < 1) { fprintf(stderr, "kernel_launch: kernel does not fit a CU\n"); grid_blocks = -1; return; }
        grid_blocks = cus;
    }
    if (grid_blocks < 0) return;
    if (hipMemsetAsync((char*)d_ws + WS_BAR, 0, 16384, stream) != hipSuccess) { fprintf(stderr, "kernel_launch: memset failed\n"); return; }
    Args a{};
    for (int i = 0; i < 23; ++i) a.in[i] = (const float*)d_in[i];
    a.out = (float*)d_out; a.ws = (unsigned char*)d_ws; a.ph_lo = 0; a.ph_hi = 1000;
    void* args[] = {&a};
    hipError_t e = hipLaunchCooperativeKernel((const void*)mk_fwd, dim3(grid_blocks), dim3(512), args, LDS_BYTES, stream);
    if (e != hipSuccess) fprintf(stderr, "cooperative launch failed: %s (grid %d)\n", hipGetErrorString(e), grid_blocks);
}
```

```cpp
#include <hip/hip_runtime.h>
#include <hip/hip_cooperative_groups.h>
#include <cstdio>
#include <cstdint>
namespace cg = cooperative_groups;

#define LAS __attribute__((address_space(3)))
typedef unsigned short bf16_t;
typedef short bf16x8 __attribute__((ext_vector_type(8)));
typedef short s16x4 __attribute__((ext_vector_type(4)));
typedef float f32x4 __attribute__((ext_vector_type(4)));
typedef float f32x16 __attribute__((ext_vector_type(16)));
typedef float f32x2 __attribute__((ext_vector_type(2)));
typedef unsigned u32x4 __attribute__((ext_vector_type(4)));
typedef unsigned u32x2 __attribute__((ext_vector_type(2)));

constexpr int D = 1024, NB = 8, T = 4096, M = NB * T, DFF = 2816, NMOD = 6 * D;
constexpr float EPS = 1e-6f;
constexpr int AIN = 1864;
constexpr size_t MiB = 1u << 20;
constexpr size_t WS_MOD = 0;
constexpr size_t WS_MODP = 1 * MiB;
constexpr size_t WS_W = 13 * MiB;
constexpr size_t W_AIN = WS_W;
constexpr size_t W_UK = W_AIN + 8 * MiB;
constexpr size_t W_UV = W_UK + 2 * MiB;
constexpr size_t W_O = W_UV + 2 * MiB;
constexpr size_t W_BIN = W_O + 4 * MiB;
constexpr size_t W_BOUT = W_BIN + 16 * MiB;
constexpr size_t W_GU = W_BOUT + 8 * MiB;
constexpr size_t W_DN = W_GU + 44 * MiB;
constexpr size_t WS_R1 = W_DN + 22 * MiB;
constexpr size_t WS_H = WS_R1;
constexpr size_t WS_Q = WS_R1 + 64 * MiB;
constexpr size_t WS_OLAT = WS_R1;
constexpr size_t WS_R2 = WS_R1 + 128 * MiB;
constexpr size_t WS_QLAT = WS_R2;
constexpr size_t WS_O = WS_R2;
constexpr size_t WS_R3 = WS_R2 + 128 * MiB;
constexpr size_t WS_CKVR = WS_R3;
constexpr size_t WS_CKV = WS_CKVR + 32 * MiB;
constexpr size_t WS_QIDX = WS_CKV + 16 * MiB;
constexpr size_t WS_KRAW = WS_QIDX + 32 * MiB;
constexpr size_t WS_KIDX = WS_KRAW + 16 * MiB;
constexpr size_t WS_WIDX = WS_KIDX + 4 * MiB;
constexpr size_t WS_IDX = WS_WIDX + 1 * MiB;
constexpr size_t WS_END = WS_IDX + 16 * MiB;
constexpr size_t WS_HID = WS_R1 + 64 * MiB;
constexpr size_t WS_U = WS_R1 + 64 * MiB;
constexpr size_t WS_V = WS_U + 128 * MiB;
constexpr size_t WS_STATS = WS_V + 128 * MiB;
static_assert(WS_STATS + 8 * MiB <= WS_END && WS_HID + 176 * MiB <= WS_R3, "ws map");
constexpr int LDS_BYTES = 147456;
constexpr int LDS_MISC = LDS_BYTES - 256;
constexpr size_t WS_BAR = 1 * MiB - 16384;

__device__ __forceinline__ unsigned cvt_pk_bf16(float lo, float hi) { unsigned r; asm volatile("v_cvt_pk_bf16_f32 %0, %1, %2" : "=v"(r) : "v"(lo), "v"(hi)); return r; }
__device__ __forceinline__ float bf2f(unsigned b) { return __uint_as_float(b << 16); }
__device__ __forceinline__ float bf_round(float f) { unsigned u = __float_as_uint(f); u = (u + 0x7fffu + ((u >> 16) & 1u)) & 0xffff0000u; return __uint_as_float(u); }
__device__ __forceinline__ float wave_sum(float v) {
#pragma unroll
    for (int o = 1; o < 64; o <<= 1) v += __shfl_xor(v, o);
    return v;
}
#define LDS_WAIT() asm volatile("s_waitcnt lgkmcnt(0)" ::: "memory")
__device__ __forceinline__ unsigned bperm_u(int srclane, unsigned v) { return (unsigned)__builtin_amdgcn_ds_bpermute(srclane << 2, (int)v); }
__device__ __forceinline__ float bperm_f(int srclane, float v) { return __int_as_float(__builtin_amdgcn_ds_bpermute(srclane << 2, __float_as_int(v))); }


#define XB_TMO      128
#define XB_XCNT(j)  (256  + 64 * (j))
#define XB_XSUB(j)  (1280 + 64 * (j))
#define XB_XGEN(j)  (2304 + 64 * (j))
#define XB_TOP      3328
#define XB_TOPGEN   3392
#define XCD_BAR_WORDS 3456
#define XB_SPIN_CAP (1u << 22)
__device__ __forceinline__ unsigned xb_ld(unsigned* p)              { return __hip_atomic_load(p, __ATOMIC_RELAXED, __HIP_MEMORY_SCOPE_AGENT); }
__device__ __forceinline__ unsigned xb_add(unsigned* p, unsigned v) { return __hip_atomic_fetch_add(p, v, __ATOMIC_RELAXED, __HIP_MEMORY_SCOPE_AGENT); }
__device__ __forceinline__ unsigned xb_xcc_id() { return (unsigned)__builtin_amdgcn_s_getreg((3 << 11) | 20) & 0xFu; }
#define XB_SPIN(cond, bar) do { unsigned _sp = 0; while (cond) { __builtin_amdgcn_s_sleep(1); \
    if ((++_sp & 255u) == 0u) { if (xb_ld(&(bar)[XB_TMO])) break; if (_sp > XB_SPIN_CAP) { atomicAdd(&(bar)[XB_TMO], 1u); break; } } } } while (0)
struct XcdBarrier { unsigned* bar; unsigned x; volatile LAS unsigned* st; };
__device__ __forceinline__ XcdBarrier xcd_barrier_post(unsigned* bar, volatile LAS unsigned* st) {
    XcdBarrier b; b.bar = bar; b.x = xb_xcc_id(); b.st = st;
    if (threadIdx.x == 0) (void)xb_add(&bar[XB_XCNT(b.x)], 1u);
    return b;
}
__device__ __forceinline__ void xcd_barrier_complete(unsigned* bar, unsigned x, unsigned& nloc, unsigned& nx) {
    const unsigned G = gridDim.x * gridDim.y * gridDim.z;
    unsigned sum, cnt, mine, sp = 0u;
    for (;;) {
        sum = 0u; cnt = 0u; mine = 0u;
#pragma unroll
        for (unsigned j = 0; j < 16; ++j) { const unsigned c = xb_ld(&bar[XB_XCNT(j)]); sum += c; cnt += (c > 0u) ? 1u : 0u; mine = (j == x) ? c : mine; }
        if (sum == G) break;
        __builtin_amdgcn_s_sleep(1);
        if ((++sp & 255u) == 0u) { if (xb_ld(&bar[XB_TMO])) break; if (sp > XB_SPIN_CAP) { atomicAdd(&bar[XB_TMO], 1u); break; } }
    }
    nloc = mine > 0u ? mine : 1u; nx = cnt > 0u ? cnt : 1u;
}
__device__ __forceinline__ void xcd_barrier(const XcdBarrier& b) {
    asm volatile("s_waitcnt vmcnt(0)" ::: "memory");
    __syncthreads();
    if (threadIdx.x == 0) {
        unsigned* bar = b.bar;
        __builtin_amdgcn_s_waitcnt(0);
        unsigned nloc = b.st[0], nx = b.st[1];
        if (nloc == 0u) { xcd_barrier_complete(bar, b.x, nloc, nx); b.st[0] = nloc; b.st[1] = nx; }
        const unsigned old = xb_add(&bar[XB_XSUB(b.x)], 1u);
        const unsigned gen = old / nloc;
        if (old + 1u == (gen + 1u) * nloc) {
            __builtin_amdgcn_fence(__ATOMIC_RELEASE, "agent");
            asm volatile("s_waitcnt vmcnt(0)" ::: "memory");
            const unsigned og = xb_add(&bar[XB_TOP], 1u);
            const unsigned tg = og / nx;
            if (og + 1u == (tg + 1u) * nx) xb_add(&bar[XB_TOPGEN], 1u);
            else XB_SPIN(xb_ld(&bar[XB_TOPGEN]) == tg, bar);
            __builtin_amdgcn_fence(__ATOMIC_ACQUIRE, "agent");
            xb_add(&bar[XB_XGEN(b.x)], 1u);
            asm volatile("s_waitcnt vmcnt(0)" ::: "memory");
        } else {
            XB_SPIN(xb_ld(&bar[XB_XGEN(b.x)]) == gen, bar);
            __builtin_amdgcn_fence(__ATOMIC_ACQUIRE, "agent");
            asm volatile("s_waitcnt vmcnt(0)" ::: "memory");
        }
    }
    __syncthreads();
}

namespace pg8 {
constexpr int BM = 256, BK = 64, HALF = 128, HTB = HALF * BK * 2, STAGE_BYTES = 8 * HTB, NXCD = 8, WGM = 8;
__host__ __device__ __forceinline__ int lds_byte(int r, int c) { const int st = (r >> 4) * 2 + (c >> 5), rr = r & 15, cc = c & 31, ob = rr * 64 + cc * 2; return st * 1024 + (ob ^ (((ob >> 9) & 1) << 5)); }
__host__ __device__ __forceinline__ void stage_rc(int b, int& R, int& C) { const int st = b / 1024, sb = b % 1024, swz = sb ^ (((sb >> 9) & 1) << 5); R = (st >> 1) * 16 + swz / 64; C = (st & 1) * 32 + (swz % 64) / 2; }
__host__ __device__ __forceinline__ int perm32(int rho) { const int n = rho >> 4, i = rho & 15; return 8 * (i >> 2) + 4 * n + (i & 3); }

struct Unit { int pm, pn; };
struct Gemm { const bf16_t* A; const bf16_t* Bt; int M, N, K, lda, agrp_shift, agrp_stride; };

struct StaticOrder {
    int nM, nN, nwg, G, c;
    __device__ void init(int M_, int N_, int G_, int c_) { nM = M_ / BM; nN = N_ / BM; nwg = nM * nN; G = G_; c = c_; }
    __device__ bool next(int i, Unit& u) const {
        const long L = (long)i * G + c; if (L >= nwg) return false;
        int wgid = (int)L; { const int q = nwg / NXCD, r = nwg % NXCD, xcd = wgid % NXCD, off = wgid / NXCD; wgid = (xcd < r ? xcd * (q + 1) : r * (q + 1) + (xcd - r) * q) + off; }
        const int nig = WGM * nN, gid = wgid / nig, fm = gid * WGM, gsz = (nM - fm) < WGM ? (nM - fm) : WGM;
        u.pm = fm + ((wgid % nig) % gsz); u.pn = (wgid % nig) / gsz; return true;
    }
};

typedef f32x4 Acc[2][2][4][2];

__device__ __forceinline__ f32x2 gelu_pk(f32x2 v) {
    const f32x2 av = __builtin_elementwise_abs(v), d = av * 0.2316418882f + 1.0f;
    f32x2 t; t.x = __builtin_amdgcn_rcpf(d.x); t.y = __builtin_amdgcn_rcpf(d.y);
    f32x2 q = t * 0.5307027145f + (-0.7265760135f); q = q * t + 0.7107068705f; q = q * t + (-0.142248368f); q = q * t + 0.127414796f; q = q * t;
    const f32x2 s = (v * v) * (-0.72134752044f);
    f32x2 e; e.x = __builtin_amdgcn_exp2f(s.x); e.y = __builtin_amdgcn_exp2f(s.y);
    const f32x2 m = v * (q * e), r = v - m;
    f32x2 o; o.x = v.x < 0.f ? m.x : r.x; o.y = v.y < 0.f ? m.y : r.y; return o;
}
__device__ __forceinline__ f32x4 gelu4(f32x4 v) { f32x2 a = gelu_pk((f32x2){v[0], v[1]}), b = gelu_pk((f32x2){v[2], v[3]}); return (f32x4){a.x, a.y, b.x, b.y}; }
__device__ __forceinline__ u32x4 pack8(f32x4 v0, f32x4 v1) { u32x4 w; w.x = cvt_pk_bf16(v0[0], v0[1]); w.y = cvt_pk_bf16(v0[2], v0[3]); w.z = cvt_pk_bf16(v1[0], v1[1]); w.w = cvt_pk_bf16(v1[2], v1[3]); return w; }

struct EpiInproj {
    bf16_t* Q; float* CKVR; bf16_t* QIDX; float* KRAW;
    __device__ __forceinline__ void operator()(const Acc& acc, const Unit& u, int wr, int wc, int fr, int fq) const {
        const int row0 = u.pm * BM + wr * 64 + fr, cl = wc * 32 + 8 * fq;
#pragma unroll
        for (int ai = 0; ai < 2; ++ai)
#pragma unroll
            for (int m = 0; m < 4; ++m) { const size_t row = (size_t)(row0 + ai * HALF + m * 16);
#pragma unroll
                for (int bj = 0; bj < 2; ++bj) { const f32x4 v0 = acc[ai][bj][m][0], v1 = acc[ai][bj][m][1]; const int c = bj * HALF + cl;
                    if (u.pn < 4) *(u32x4*)(Q + row * 1024 + u.pn * 256 + c) = pack8(v0, v1);
                    else if (u.pn == 4) { float* p = CKVR + row * 256 + c; *(f32x4*)p = v0; *(f32x4*)(p + 4) = v1; }
                    else if (u.pn < 7) *(u32x4*)(QIDX + row * 512 + (u.pn - 5) * 256 + c) = pack8(v0, v1);
                    else if (bj == 0) { float* p = KRAW + row * 128 + c; *(f32x4*)p = v0; *(f32x4*)(p + 4) = v1; } } }
    }
};
struct EpiBf16 {
    bf16_t* O; int ldc; float scale; int fp8;
    __device__ __forceinline__ void operator()(const Acc& acc, const Unit& u, int wr, int wc, int fr, int fq) const {
        const int row0 = u.pm * BM + wr * 64 + fr, col0 = u.pn * BM + wc * 32 + 8 * fq;
        if (fp8) {
#pragma unroll
            for (int ai = 0; ai < 2; ++ai)
#pragma unroll
                for (int m = 0; m < 4; ++m) { unsigned char* rowp = (unsigned char*)O + (size_t)(row0 + ai * HALF + m * 16) * ldc + col0;
#pragma unroll
                    for (int bj = 0; bj < 2; ++bj) { const f32x4 v0 = acc[ai][bj][m][0] * scale, v1 = acc[ai][bj][m][1] * scale; int w0 = 0, w1 = 0;
                        w0 = __builtin_amdgcn_cvt_pk_fp8_f32(v0[0], v0[1], w0, false); w0 = __builtin_amdgcn_cvt_pk_fp8_f32(v0[2], v0[3], w0, true);
                        w1 = __builtin_amdgcn_cvt_pk_fp8_f32(v1[0], v1[1], w1, false); w1 = __builtin_amdgcn_cvt_pk_fp8_f32(v1[2], v1[3], w1, true);
                        *(u32x2*)(rowp + bj * HALF) = (u32x2){(unsigned)w0, (unsigned)w1}; } }
            return; }
#pragma unroll
        for (int ai = 0; ai < 2; ++ai)
#pragma unroll
            for (int m = 0; m < 4; ++m) { bf16_t* rowp = O + (size_t)(row0 + ai * HALF + m * 16) * ldc + col0;
#pragma unroll
                for (int bj = 0; bj < 2; ++bj) *(u32x4*)(rowp + bj * HALF) = pack8(acc[ai][bj][m][0] * scale, acc[ai][bj][m][1] * scale); }
    }
};
struct EpiResid {
    const float* xin; float* xout; const float* gate;
    __device__ __forceinline__ void operator()(const Acc& acc, const Unit& u, int wr, int wc, int fr, int fq) const {
        const int row0 = u.pm * BM + wr * 64 + fr, col0 = u.pn * BM + wc * 32 + 8 * fq;
        const float* gp = gate + (size_t)(u.pm >> 4) * NMOD + col0;
        f32x4 gv[2][2];
#pragma unroll
        for (int bj = 0; bj < 2; ++bj)
#pragma unroll
            for (int n = 0; n < 2; ++n) gv[bj][n] = *(const f32x4*)(gp + bj * HALF + 4 * n);
#pragma unroll
        for (int ai = 0; ai < 2; ++ai)
#pragma unroll
            for (int m = 0; m < 4; ++m) { const size_t off = (size_t)(row0 + ai * HALF + m * 16) * D + col0;
#pragma unroll
                for (int bj = 0; bj < 2; ++bj)
#pragma unroll
                    for (int n = 0; n < 2; ++n) { const f32x4 xo = *(const f32x4*)(xin + off + bj * HALF + 4 * n);
                        *(f32x4*)(xout + off + bj * HALF + 4 * n) = xo + gv[bj][n] * acc[ai][bj][m][n]; } }
    }
};
struct EpiGelu {
    bf16_t* U; bf16_t* V; f32x2* STATS;
    __device__ __forceinline__ void operator()(const Acc& acc, const Unit& u, int wr, int wc, int fr, int fq) const {
        const int row0 = u.pm * BM + wr * 64 + fr, cl = wc * 32 + 8 * fq;
        const bool isv = u.pn >= 8; bf16_t* base = isv ? V + (u.pn - 8) * 256 : U + u.pn * 256;
#pragma unroll
        for (int ai = 0; ai < 2; ++ai)
#pragma unroll
            for (int m = 0; m < 4; ++m) { const size_t row = (size_t)(row0 + ai * HALF + m * 16); float s = 0.f, ss = 0.f;
#pragma unroll
                for (int bj = 0; bj < 2; ++bj) { const f32x4 v0 = gelu4(acc[ai][bj][m][0]), v1 = gelu4(acc[ai][bj][m][1]);
                    *(u32x4*)(base + row * 2048 + bj * HALF + cl) = pack8(v0, v1);
                    s += (v0[0] + v0[1]) + (v0[2] + v0[3]) + (v1[0] + v1[1]) + (v1[2] + v1[3]);
                    ss += (v0[0] * v0[0] + v0[1] * v0[1]) + (v0[2] * v0[2] + v0[3] * v0[3]) + (v1[0] * v1[0] + v1[1] * v1[1]) + (v1[2] * v1[2] + v1[3] * v1[3]); }
                if (isv) { s += __shfl_xor(s, 16); ss += __shfl_xor(ss, 16); s += __shfl_xor(s, 32); ss += __shfl_xor(ss, 32);
                    if (fq == 0) STATS[row * 32 + (u.pn - 8) * 4 + wc] = (f32x2){s, ss}; } }
    }
};
struct EpiSwiglu {
    bf16_t* HID;
    __device__ __forceinline__ void operator()(const Acc& acc, const Unit& u, int wr, int wc, int fr, int fq) const {
        const int row0 = u.pm * BM + wr * 64 + fr, col0 = u.pn * 128 + wc * 32 + 8 * fq;
#pragma unroll
        for (int ai = 0; ai < 2; ++ai)
#pragma unroll
            for (int m = 0; m < 4; ++m) { f32x4 h[2];
#pragma unroll
                for (int n = 0; n < 2; ++n) { const f32x4 g = acc[ai][0][m][n], up = acc[ai][1][m][n];
#pragma unroll
                    for (int j = 0; j < 4; ++j) h[n][j] = g[j] * __builtin_amdgcn_rcpf(1.0f + __expf(-g[j])) * up[j]; }
                *(u32x4*)(HID + (size_t)(row0 + ai * HALF + m * 16) * DFF + col0) = pack8(h[0], h[1]); }
    }
};

template <class Epi>
__device__ __forceinline__ void gemm_phase(LAS unsigned char* lds, const Gemm g, const StaticOrder& S, const Epi& E) {
    int tid = threadIdx.x; asm volatile("" : "+v"(tid));
    const int wid = __builtin_amdgcn_readfirstlane(tid >> 6), lane = tid & 63, wr = wid >> 2, wc = wid & 3, fr = lane & 15, fq = lane >> 4;
    const int K = g.K, nt = K / BK, lda = g.lda;
    unsigned voffA[2], voffB[2];
#pragma unroll
    for (int i = 0; i < 2; ++i) { int R, C; stage_rc(tid * 16 + i * 8192, R, C); const int Rb = (R & ~31) + perm32(R & 31);
        voffA[i] = (unsigned)(R * lda + C) * 2u; voffB[i] = (unsigned)(Rb * K + C) * 2u; }
    const size_t kstep = (size_t)(BK * 2);
    const size_t hstepA = (size_t)HALF * lda * 2, hstepB = (size_t)HALF * K * 2;
    const unsigned ldsw = (unsigned)wid * 1024u;
    const int aoff = lds_byte(wr * 64 + fr, fq * 8), boff = lds_byte(wc * 32 + fr, fq * 8);
#define PG8_SA(b, h) (((b) * 2 + (h)) * HTB)
#define PG8_SB(b, h) ((4 + (b) * 2 + (h)) * HTB)
#define PG8_STAGE(bufoff, gbase, voff) do { _Pragma("unroll") for (int _i = 0; _i < 2; ++_i) \
        __builtin_amdgcn_global_load_lds((const unsigned*)((const char*)(gbase) + (voff)[_i]), (LAS unsigned*)(lds + (bufoff) + ldsw + _i * 8192), 16, 0, 0); } while (0)
#define PG8_LDA(dst, b, h) do { _Pragma("unroll") for (int m = 0; m < 4; ++m) _Pragma("unroll") for (int k = 0; k < 2; ++k) dst[m][k] = *(const LAS bf16x8*)(lds + PG8_SA(b, h) + aoff + m * 2048 + k * 1024); } while (0)
#define PG8_LDB(dst, b, h) do { _Pragma("unroll") for (int n = 0; n < 2; ++n) _Pragma("unroll") for (int k = 0; k < 2; ++k) dst[n][k] = *(const LAS bf16x8*)(lds + PG8_SB(b, h) + boff + n * 2048 + k * 1024); } while (0)
#define PG8_MMA(ai, bj, At, Bt) do { __builtin_amdgcn_s_setprio(1); _Pragma("unroll") for (int m = 0; m < 4; ++m) _Pragma("unroll") for (int n = 0; n < 2; ++n) _Pragma("unroll") for (int k = 0; k < 2; ++k) \
        acc[ai][bj][m][n] = __builtin_amdgcn_mfma_f32_16x16x32_bf16(Bt[n][k], At[m][k], acc[ai][bj][m][n], 0, 0, 0); __builtin_amdgcn_s_setprio(0); } while (0)
#define PG8_WAIT_V(n) asm volatile("s_waitcnt vmcnt(" #n ")" ::: "memory")
#define PG8_WAIT_L(n) asm volatile("s_waitcnt lgkmcnt(" #n ")" ::: "memory")
#define PG8_BAR __builtin_amdgcn_s_barrier()
#define PG8_SCHED __builtin_amdgcn_sched_barrier(0)
#define PG8_ABASE(u) ((const char*)g.A + ((size_t)(u).pm * BM * lda + (size_t)((u).pn >> g.agrp_shift) * g.agrp_stride) * 2)
#define PG8_BBASE(u) ((const char*)g.Bt + (size_t)(u).pn * 2 * hstepB)
    Unit cur, nxt; int ui = 0;
    if (!S.next(0, cur)) return;
    Acc acc;
#pragma unroll
    for (int a = 0; a < 2; ++a)
#pragma unroll
        for (int b = 0; b < 2; ++b)
#pragma unroll
            for (int m = 0; m < 4; ++m)
#pragma unroll
                for (int n = 0; n < 2; ++n) acc[a][b][m][n] = (f32x4){0.f, 0.f, 0.f, 0.f};
    bf16x8 At[4][2], B0[2][2], B1[2][2];
    const char* cA = PG8_ABASE(cur); const char* cB = PG8_BBASE(cur);
    PG8_STAGE(PG8_SB(0, 0), cB, voffB); PG8_STAGE(PG8_SB(0, 1), cB + hstepB, voffB); PG8_STAGE(PG8_SA(0, 0), cA, voffA); PG8_STAGE(PG8_SA(0, 1), cA + hstepA, voffA);
    if (wr == 1) PG8_BAR;
    PG8_WAIT_V(2); PG8_BAR;
    PG8_STAGE(PG8_SB(1, 0), cB + kstep, voffB); PG8_STAGE(PG8_SA(1, 0), cA + kstep, voffA); PG8_STAGE(PG8_SB(1, 1), cB + hstepB + kstep, voffB);
    PG8_WAIT_V(6); PG8_BAR;
    for (;;) {
        const bool has_next = S.next(ui + 1, nxt);
        const char* nA = has_next ? PG8_ABASE(nxt) : cA; const char* nB = has_next ? PG8_BBASE(nxt) : cB;
        for (int t = 0; t < nt; t += 2) {
            const bool last = (t == nt - 2);
            const char* a1 = cA + (size_t)(t + 1) * kstep;
            const char* a2 = last ? nA : cA + (size_t)(t + 2) * kstep; const char* b2 = last ? nB : cB + (size_t)(t + 2) * kstep;
            const char* a3 = a2 + kstep; const char* b3 = b2 + kstep;
            PG8_LDB(B0, 0, 0); PG8_LDB(B1, 0, 1); PG8_SCHED; PG8_LDA(At, 0, 0); PG8_STAGE(PG8_SA(1, 1), a1 + hstepA, voffA);
            PG8_WAIT_V(8); PG8_WAIT_L(0); PG8_BAR; PG8_MMA(0, 0, At, B0); PG8_MMA(0, 1, At, B1); PG8_BAR; PG8_SCHED;
            PG8_LDA(At, 0, 1); PG8_STAGE(PG8_SB(0, 0), b2, voffB); PG8_STAGE(PG8_SB(0, 1), b2 + hstepB, voffB); PG8_STAGE(PG8_SA(0, 0), a2, voffA);
            PG8_WAIT_V(8); PG8_WAIT_L(0); PG8_BAR; PG8_MMA(1, 0, At, B0); PG8_MMA(1, 1, At, B1); PG8_BAR; PG8_SCHED;
            PG8_LDB(B0, 1, 0); PG8_LDB(B1, 1, 1); PG8_SCHED; PG8_LDA(At, 1, 0); PG8_STAGE(PG8_SA(0, 1), a2 + hstepA, voffA);
            PG8_WAIT_V(8); PG8_WAIT_L(0); PG8_BAR; PG8_MMA(0, 0, At, B0); PG8_MMA(0, 1, At, B1); PG8_BAR; PG8_SCHED;
            PG8_LDA(At, 1, 1); PG8_STAGE(PG8_SB(1, 0), b3, voffB); PG8_STAGE(PG8_SB(1, 1), b3 + hstepB, voffB); PG8_STAGE(PG8_SA(1, 0), a3, voffA);
            PG8_WAIT_V(8); PG8_WAIT_L(0); PG8_BAR; PG8_MMA(1, 0, At, B0); PG8_MMA(1, 1, At, B1); PG8_BAR; PG8_SCHED;
        }
        if (wr == 0) PG8_BAR;
        E(acc, cur, wr, wc, fr, fq);
        if (!has_next) break;
#pragma unroll
        for (int a = 0; a < 2; ++a)
#pragma unroll
            for (int b = 0; b < 2; ++b)
#pragma unroll
                for (int m = 0; m < 4; ++m)
#pragma unroll
                    for (int n = 0; n < 2; ++n) acc[a][b][m][n] = (f32x4){0.f, 0.f, 0.f, 0.f};
        cur = nxt; cA = nA; cB = nB; ++ui;
        if (wr == 1) PG8_BAR;
    }
    PG8_WAIT_V(0);
    PG8_BAR;
#undef PG8_SA
#undef PG8_SB
#undef PG8_STAGE
#undef PG8_LDA
#undef PG8_LDB
#undef PG8_MMA
#undef PG8_WAIT_V
#undef PG8_WAIT_L
#undef PG8_BAR
#undef PG8_SCHED
#undef PG8_ABASE
#undef PG8_BBASE
}
}

struct Args { const float* in[23]; float* out; unsigned char* ws; int ph_lo, ph_hi; };

__device__ __forceinline__ void cvt_item(const float* src, int K, int N, bf16_t* dst, int ldd, int mode, int r0, int c0, LAS float* scr, int li, int lane) {
    const int nblk = (N + 31) >> 5, kb = li / nblk, nb = li % nblk, k0 = 64 * kb, n0 = 32 * nb;
    { const int cc = lane & 7, rr = lane >> 3; const bool ok = n0 + 4 * cc < N;
      f32x4 t[8];
#pragma unroll
      for (int i = 0; i < 8; ++i) t[i] = ok ? *(const f32x4*)(src + (size_t)(k0 + 8 * i + rr) * N + n0 + 4 * cc) : (f32x4){0.f, 0.f, 0.f, 0.f};
#pragma unroll
      for (int i = 0; i < 8; ++i) { LAS float* d = scr + (8 * i + rr) * 33 + 4 * cc; d[0] = t[i][0]; d[1] = t[i][1]; d[2] = t[i][2]; d[3] = t[i][3]; } }
    LDS_WAIT();
    const int c = lane & 7;
#pragma unroll
    for (int j = 0; j < 4; ++j) { const int nl = (lane >> 3) + 8 * j, n = n0 + nl; const LAS float* s = scr + (8 * c) * 33 + nl;
        u32x4 o; o.x = cvt_pk_bf16(s[0 * 33], s[1 * 33]); o.y = cvt_pk_bf16(s[2 * 33], s[3 * 33]); o.z = cvt_pk_bf16(s[4 * 33], s[5 * 33]); o.w = cvt_pk_bf16(s[6 * 33], s[7 * 33]);
        if (n < N) { const int drow = mode ? ((n >> 7) * 256 + (n & 127) + r0) : (r0 + n); *(u32x4*)(dst + (size_t)drow * ldd + c0 + k0 + 8 * c) = o; } }
    LDS_WAIT();
}

__device__ __forceinline__ void p0_phase(const Args& a, LAS unsigned char* lds, int bid, int G) {
    int tid = threadIdx.x; asm volatile("" : "+v"(tid));
    const int lane = tid & 63, wave = __builtin_amdgcn_readfirstlane(tid >> 6);
    unsigned char* ws = a.ws;
    LAS float* scr = (LAS float*)(lds + wave * 8704);
    const int gw = bid * 8 + wave, NGW = G * 8;
    constexpr int NITEMS = 1888 + 256 + 256 + 1024 + 4096 + 2048 + 11264 + 5632;
    for (int it = gw; it < NITEMS; it += NGW) {
        int r = it;
        if (r < 1888) { const int j = r / 944; cvt_item(a.in[6] + (size_t)j * 1024 * AIN, 1024, AIN, (bf16_t*)(ws + W_AIN) + (size_t)j * 2048 * 1024, 1024, 0, 0, 0, scr, r % 944, lane); continue; } r -= 1888;
        if (r < 256) { const int jj = r >> 4, la = jj >> 3, h = jj & 7; cvt_item(a.in[10] + (size_t)(la * 8 + h) * 128 * 256, 128, 256, (bf16_t*)(ws + W_UK) + (size_t)la * 2048 * 256, 256, 0, h * 256, (h & 1) * 128, scr, r & 15, lane); continue; } r -= 256;
        if (r < 256) { const int jj = r >> 4, la = jj >> 3, h = jj & 7; cvt_item(a.in[11] + (size_t)(la * 8 + h) * 256 * 128, 256, 128, (bf16_t*)(ws + W_UV) + (size_t)la * 1024 * 512, 512, 0, (h >> 1) * 256 + (h & 1) * 128, (h & 1) * 256, scr, r & 15, lane); continue; } r -= 256;
        if (r < 1024) { const int la = r >> 9; cvt_item(a.in[12] + (size_t)la * 1024 * 1024, 1024, 1024, (bf16_t*)(ws + W_O) + (size_t)la * 1024 * 1024, 1024, 0, 0, 0, scr, r & 511, lane); continue; } r -= 1024;
        if (r < 4096) { const int la = r >> 11; cvt_item(a.in[13] + (size_t)la * 1024 * 4096, 1024, 4096, (bf16_t*)(ws + W_BIN) + (size_t)la * 4096 * 1024, 1024, 0, 0, 0, scr, r & 2047, lane); continue; } r -= 4096;
        if (r < 2048) { const int la = r >> 10; cvt_item(a.in[18] + (size_t)la * 2048 * 1024, 2048, 1024, (bf16_t*)(ws + W_BOUT) + (size_t)la * 1024 * 2048, 2048, 0, 0, 0, scr, r & 1023, lane); continue; } r -= 2048;
        if (r < 11264) { const int jj = r / 1408, l = jj & 3, isup = jj >> 2; cvt_item(a.in[isup ? 20 : 19] + (size_t)l * 1024 * DFF, 1024, DFF, (bf16_t*)(ws + W_GU) + (size_t)l * 5632 * 1024, 1024, 1, isup * 128, 0, scr, r % 1408, lane); continue; } r -= 11264;
        { const int l = r / 1408; cvt_item(a.in[21] + (size_t)l * DFF * 1024, DFF, 1024, (bf16_t*)(ws + W_DN) + (size_t)l * 1024 * DFF, DFF, 0, 0, 0, scr, r % 1408, lane); }
    }
    const size_t gt = (size_t)bid * 512 + tid, NT = (size_t)G * 512;
    const u32x4 z = (u32x4){0u, 0u, 0u, 0u};
    for (size_t i = gt; i < 2 * 184 * 128; i += NT) { const int j = (int)(i / (184 * 128)), rem = (int)(i % (184 * 128)), rr = AIN + rem / 128, ch = rem % 128;
        *(u32x4*)((bf16_t*)(ws + W_AIN) + ((size_t)j * 2048 + rr) * 1024 + ch * 8) = z; }
    for (size_t i = gt; i < 2 * 2048 * 16; i += NT) { const int j = (int)(i / (2048 * 16)), rem = (int)(i % (2048 * 16)), rr = rem >> 4, ch = rem & 15, h = rr >> 8;
        *(u32x4*)((bf16_t*)(ws + W_UK) + ((size_t)j * 2048 + rr) * 256 + (1 - (h & 1)) * 128 + ch * 8) = z; }
    for (size_t i = gt; i < 2 * 1024 * 32; i += NT) { const int j = (int)(i / (1024 * 32)), rem = (int)(i % (1024 * 32)), rr = rem >> 5, ch = rem & 31, hh = (rr >> 7) & 1;
        *(u32x4*)((bf16_t*)(ws + W_UV) + ((size_t)j * 1024 + rr) * 512 + (1 - hh) * 256 + ch * 8) = z; }
    __syncthreads();
    LAS float* ca = (LAS float*)lds;
    const float* cvec = a.in[1]; const float* modw = a.in[2]; float* MODP = (float*)(ws + WS_MODP);
    for (int it = bid; it < 768; it += G) {
        const int l = it / 192, rem = it % 192, ng = rem >> 4, kc = rem & 15;
        { const int b = tid >> 6, k = tid & 63; const float cv = cvec[b * 1024 + kc * 64 + k]; ca[b * 64 + k] = cv / (1.0f + __expf(-cv)); }
        __syncthreads();
        const int n = ng * 512 + tid; float acc[8];
#pragma unroll
        for (int b = 0; b < 8; ++b) acc[b] = 0.f;
        const float* wp = modw + ((size_t)l * 1024 + kc * 64) * NMOD + n;
#pragma unroll 8
        for (int k = 0; k < 64; ++k) { const float w = wp[(size_t)k * NMOD];
#pragma unroll
            for (int b = 0; b < 8; ++b) acc[b] += ca[b * 64 + k] * w; }
#pragma unroll
        for (int b = 0; b < 8; ++b) MODP[((size_t)(kc * 4 + l) * 8 + b) * NMOD + n] = acc[b];
        __syncthreads();
    }
}
__device__ __forceinline__ void p0c_phase(const Args& a, int bid, int G) {
    const float* MODP = (const float*)(a.ws + WS_MODP); float* MOD = (float*)(a.ws + WS_MOD); const float* modb = a.in[3];
    int tid0 = threadIdx.x; asm volatile("" : "+v"(tid0));
    for (int i = bid * 512 + tid0; i < 4 * 8 * NMOD; i += G * 512) { const int l = i / (8 * NMOD), n = i % NMOD; float s = modb[l * NMOD + n];
#pragma unroll
        for (int kc = 0; kc < 16; ++kc) s += MODP[(size_t)kc * (4 * 8 * NMOD) + i];
        MOD[i] = s; }
}

__device__ __forceinline__ void norm_mod_phase(const float* x, const float* gain, const float* sh, const float* sc, bf16_t* H, int bid, int G) {
    int tid = threadIdx.x; asm volatile("" : "+v"(tid));
    const int lane = tid & 63, wave = tid >> 6;
    for (int rb = (bid * 8 + wave) * 16; rb < M; rb += G * 8 * 16) {
        const int b = rb / T; f32x4 gs[4], sv[4];
#pragma unroll
        for (int j = 0; j < 4; ++j) { const int c = 4 * lane + 256 * j; const f32x4 g4 = *(const f32x4*)(gain + c), s4 = *(const f32x4*)(sc + (size_t)b * NMOD + c); gs[j] = g4 * (s4 + 1.0f); sv[j] = *(const f32x4*)(sh + (size_t)b * NMOD + c); }
        for (int r = rb; r < rb + 16; ++r) {
            const f32x4* xr = (const f32x4*)(x + (size_t)r * D) + lane; f32x4 v[4]; float ss = 0.f;
#pragma unroll
            for (int j = 0; j < 4; ++j) { v[j] = xr[64 * j]; ss += (v[j][0] * v[j][0] + v[j][1] * v[j][1]) + (v[j][2] * v[j][2] + v[j][3] * v[j][3]); }
            const float rstd = rsqrtf(wave_sum(ss) * (1.0f / D) + EPS);
            u32x2* o = (u32x2*)(H + (size_t)r * D) + lane;
#pragma unroll
            for (int j = 0; j < 4; ++j) { const f32x4 y = v[j] * rstd * gs[j] + sv[j]; u32x2 w; w.x = cvt_pk_bf16(y[0], y[1]); w.y = cvt_pk_bf16(y[2], y[3]); o[64 * j] = w; }
        }
    }
}
__device__ __forceinline__ void final_norm_phase(const float* x, const float* gain, float* out, int bid, int G) {
    int tid = threadIdx.x; asm volatile("" : "+v"(tid));
    const int lane = tid & 63, wave = tid >> 6;
    f32x4 gs[4];
#pragma unroll
    for (int j = 0; j < 4; ++j) gs[j] = *(const f32x4*)(gain + 4 * lane + 256 * j);
    for (int r = bid * 8 + wave; r < M; r += G * 8) {
        const f32x4* xr = (const f32x4*)(x + (size_t)r * D) + lane; f32x4 v[4]; float ss = 0.f;
#pragma unroll
        for (int j = 0; j < 4; ++j) { v[j] = xr[64 * j]; ss += (v[j][0] * v[j][0] + v[j][1] * v[j][1]) + (v[j][2] * v[j][2] + v[j][3] * v[j][3]); }
        const float rstd = rsqrtf(wave_sum(ss) * (1.0f / D) + EPS);
        f32x4* o = (f32x4*)(out + (size_t)r * D) + lane;
#pragma unroll
        for (int j = 0; j < 4; ++j) o[64 * j] = v[j] * rstd * gs[j];
    }
}
__device__ __forceinline__ void dsa_rows_phase(const float* CKVR, const float* KRAW, const float* gkv, const float* gk, const float* bk, bf16_t* CKV, bf16_t* KIDX, float* WIDX, int bid, int G) {
    int tid = threadIdx.x; asm volatile("" : "+v"(tid));
    const int lane = tid & 63, wave = tid >> 6;
    const f32x4 g4 = *(const f32x4*)(gkv + 4 * lane);
    f32x4 gk4 = (f32x4){0.f, 0.f, 0.f, 0.f}, bk4 = gk4;
    if (lane < 16) { gk4 = *(const f32x4*)(gk + 4 * lane); bk4 = *(const f32x4*)(bk + 4 * lane); }
    for (int r = bid * 8 + wave; r < M; r += G * 8) {
        const f32x4 v = *(const f32x4*)(CKVR + (size_t)r * 256 + 4 * lane);
        f32x4 kv = (f32x4){0.f, 0.f, 0.f, 0.f}; if (lane < 32) kv = *(const f32x4*)(KRAW + (size_t)r * 128 + 4 * lane);
        const float ss = wave_sum((v[0] * v[0] + v[1] * v[1]) + (v[2] * v[2] + v[3] * v[3]));
        const float rstd = rsqrtf(ss * (1.0f / 256.0f) + EPS);
        { const f32x4 y = v * rstd * g4; int w = 0; w = __builtin_amdgcn_cvt_pk_fp8_f32(y[0], y[1], w, false); w = __builtin_amdgcn_cvt_pk_fp8_f32(y[2], y[3], w, true); *(int*)((unsigned char*)CKV + (size_t)r * 256 + 4 * lane) = w; }
        const float ks = (lane < 16) ? (kv[0] + kv[1]) + (kv[2] + kv[3]) : 0.f;
        const float mean = wave_sum(ks) * (1.0f / 64.0f);
        const f32x4 dv = kv - mean;
        const float kq = (lane < 16) ? (dv[0] * dv[0] + dv[1] * dv[1]) + (dv[2] * dv[2] + dv[3] * dv[3]) : 0.f;
        const float krstd = rsqrtf(wave_sum(kq) * (1.0f / 64.0f) + EPS);
        if (lane < 16) { const f32x4 y = dv * krstd * gk4 + bk4; u32x2 w; w.x = cvt_pk_bf16(y[0], y[1]); w.y = cvt_pk_bf16(y[2], y[3]); *(u32x2*)(KIDX + ((((size_t)(r >> 5) * 4 + (lane >> 2)) * 64 + (((lane >> 1) & 1) * 32 + (r & 31))) * 8 + (lane & 1) * 4)) = w; }
        else if (lane < 18) { *(f32x4*)(WIDX + (size_t)r * 8 + 4 * (lane - 16)) = kv * 0.04419417382f; }
    }
}

__device__ __forceinline__ float relu_i(float x) { const int b = __float_as_int(x); return __int_as_float(b > 0 ? b : 0); }
__device__ __forceinline__ float relu_mul(float x, float w) { return relu_i(x) * w; }
__device__ __forceinline__ float relu_fma(float x, float w, float acc) { return __builtin_fmaf(relu_i(x), w, acc); }
__device__ __forceinline__ float fmin_raw(float a, float b) { return __builtin_amdgcn_fmed3f(a, b, -__builtin_inff()); }
__device__ __forceinline__ float fmax_raw(float a, float b) { return __builtin_amdgcn_fmed3f(a, b, __builtin_inff()); }
__device__ __forceinline__ unsigned mbcnt64(unsigned long long m) { return __builtin_amdgcn_mbcnt_hi((unsigned)(m >> 32), __builtin_amdgcn_mbcnt_lo((unsigned)m, 0u)); }

template <int SHIFT, int WIDTH>
__device__ __forceinline__ void sel_level(const unsigned (&k)[64], int N, LAS unsigned* hist, int lane, unsigned& prefix, unsigned& need) {
    LAS u32x4* hz = (LAS u32x4*)(hist + 32 * lane);
#pragma unroll
    for (int j = 0; j < 8; ++j) hz[j] = (u32x4){0u, 0u, 0u, 0u};
    LDS_WAIT();
#pragma unroll
    for (int gi = 0; gi < 8; ++gi) if (512 * gi < N) {
#pragma unroll
        for (int ii = 0; ii < 8; ++ii) { const unsigned key = k[8 * gi + ii]; const bool ok = (key >> (SHIFT + WIDTH)) == prefix;
            LAS unsigned* p = ok ? hist + ((key >> SHIFT) & ((1u << WIDTH) - 1u)) : hist + 2048 + lane;
            __hip_atomic_fetch_add(p, 1u, __ATOMIC_RELAXED, __HIP_MEMORY_SCOPE_WORKGROUP); } }
    LDS_WAIT();
    u32x4 hv[8]; unsigned ls = 0u;
#pragma unroll
    for (int j = 0; j < 8; ++j) { hv[j] = hz[j]; ls += (hv[j][0] + hv[j][1]) + (hv[j][2] + hv[j][3]); }
    unsigned incl = ls;
#pragma unroll
    for (int o = 1; o < 64; o <<= 1) { const unsigned v = bperm_u((lane + o) & 63, incl); if (lane + o < 64) incl += v; }
    const unsigned above = incl - ls;
    unsigned cnt = above, d = 0u, nn = 0u;
#pragma unroll
    for (int j = 31; j >= 0; --j) { const unsigned h = hv[j >> 2][j & 3]; const bool hit = (cnt < need) && (need <= cnt + h); d = hit ? (unsigned)(32 * lane + j) : d; nn = hit ? need - cnt : nn; cnt += h; }
    const bool found = (above < need) && (need <= above + ls);
    const unsigned long long fm = __ballot(found);
    const int src = (fm != 0ull) ? (__ffsll((long long)fm) - 1) : 0;
    d = bperm_u(src, d); need = bperm_u(src, nn);
    prefix = (prefix << WIDTH) | d;
}

__device__ __forceinline__ void dsa_select_phase(LAS unsigned char* lds, const bf16_t* QIDX, const bf16_t* KIDX, const float* WIDX, unsigned short* IDX, int bid, int G) {
    int tid0 = threadIdx.x; asm volatile("" : "+v"(tid0));
    const int wave = __builtin_amdgcn_readfirstlane(tid0 >> 6);
    LAS float* SC = (LAS float*)lds;
    LAS unsigned short* IDXL = (LAS unsigned short*)(lds + 135168) + wave * 256;
    LAS float* MM = (LAS float*)(lds + 139264);
    bf16x8 af[2][4]; bf16x8 kb[4][4];
#define DSA_UNIT(itx, b_, t0_, mb_, ntile_, nj_) const int b_ = (itx) & 7, t0_ = ((itx) >> 3) * 8; const size_t mb_ = (size_t)b_ * T; \
    const int ntile_ = (t0_ + 8 + 31) >> 5; const int nj_ = (wave < ntile_) ? ((ntile_ - wave + 7) >> 3) : 0;
#define DSA_KLOAD(buf, j, kbase_, nj_) do { const int jc_ = ((j) < (nj_)) ? (j) : ((nj_) > 0 ? (nj_) - 1 : 0); const bf16_t* kp_ = (kbase_) + (size_t)(wave + 8 * jc_) * 2048; \
    _Pragma("unroll") for (int ks = 0; ks < 4; ++ks) kb[buf][ks] = *(const bf16x8*)(kp_ + 512 * ks); } while (0)
#define DSA_PRELOAD(t0_, mb_, nj_) do { \
    _Pragma("unroll") for (int rg = 0; rg < 2; ++rg) { const bf16_t* qp = QIDX + ((mb_) + (t0_) + 4 * rg + (col >> 3)) * 512 + (col & 7) * 64 + 8 * hf; \
        _Pragma("unroll") for (int ks = 0; ks < 4; ++ks) af[rg][ks] = *(const bf16x8*)(qp + 16 * ks); } \
    (void)(nj_); } while (0)
    { int tid = tid0; asm volatile("" : "+v"(tid)); const int lane = tid & 63, hf = lane >> 5, col = lane & 31;
      if (bid < 4096) { DSA_UNIT(bid, b, t0, mb, ntile, nj) (void)b; (void)ntile; if (t0 + 8 > 256) DSA_PRELOAD(t0, mb, nj); } }
    for (int it = bid; it < 4096; it += G) {
        int tid = tid0; asm volatile("" : "+v"(tid));
        const int lane = tid & 63, hf = lane >> 5, col = lane & 31;
        DSA_UNIT(it, b, t0, mb, ntile, nj) (void)b; (void)ntile;
        const int t = t0 + wave, N = t + 1;
        unsigned short* outp = IDX + (mb + t) * 256;
        const int itn = it + G; const bool hasn = itn < 4096;
        DSA_UNIT(hasn ? itn : it, bn, t0n, mbn, ntilen, njn) (void)bn; (void)ntilen;
        if (t0 + 8 <= 256) {
            *(u32x2*)(outp + 4 * lane) = (u32x2){(unsigned)(4 * lane) | ((unsigned)(4 * lane + 1) << 16), (unsigned)(4 * lane + 2) | ((unsigned)(4 * lane + 3) << 16)};
            if (hasn && t0n + 8 > 256) DSA_PRELOAD(t0n, mbn, njn);
            continue;
        }
        float w[2][4][4]; float mn[2][2], mx[2][2];
#pragma unroll
        for (int rg = 0; rg < 2; ++rg)
#pragma unroll
            for (int e = 0; e < 2; ++e) { mn[rg][e] = 3.0e38f; mx[rg][e] = -3.0e38f; }
        const bf16_t* kbase = KIDX + mb * 64 + (size_t)lane * 8;
        DSA_KLOAD(0, 0, kbase, nj); DSA_KLOAD(1, 1, kbase, nj); DSA_KLOAD(2, 2, kbase, nj); DSA_KLOAD(3, 3, kbase, nj);
#pragma unroll
        for (int rg = 0; rg < 2; ++rg)
#pragma unroll
            for (int qq = 0; qq < 4; ++qq) { const f32x4 wv = *(const f32x4*)(WIDX + (mb + t0 + 4 * rg + qq) * 8 + 4 * hf);
                w[rg][qq][0] = wv[0]; w[rg][qq][1] = wv[1]; w[rg][qq][2] = wv[2]; w[rg][qq][3] = wv[3]; }
#define DSA_KCOMP(buf, j) do { const int s_ = 32 * (wave + 8 * (j)) + col; f32x16 acc0, acc1; \
    _Pragma("unroll") for (int i = 0; i < 16; ++i) { acc0[i] = 0.f; acc1[i] = 0.f; } \
    _Pragma("unroll") for (int ks = 0; ks < 4; ++ks) { acc0 = __builtin_amdgcn_mfma_f32_32x32x16_bf16(af[0][ks], kb[buf][ks], acc0, 0, 0, 0); acc1 = __builtin_amdgcn_mfma_f32_32x32x16_bf16(af[1][ks], kb[buf][ks], acc1, 0, 0, 0); } \
    _Pragma("unroll") for (int rg = 0; rg < 2; ++rg) { float p[4]; \
        _Pragma("unroll") for (int qq = 0; qq < 4; ++qq) { p[qq] = relu_mul(rg ? acc1[4 * qq] : acc0[4 * qq], w[rg][qq][0]); _Pragma("unroll") for (int ii = 1; ii < 4; ++ii) p[qq] = relu_fma(rg ? acc1[4 * qq + ii] : acc0[4 * qq + ii], w[rg][qq][ii], p[qq]); } \
        _Pragma("unroll") for (int e = 0; e < 2; ++e) { const auto r = __builtin_amdgcn_permlane32_swap(__float_as_uint(p[e]), __float_as_uint(p[2 + e]), false, false); \
            const float tot = __uint_as_float(r[0]) + __uint_as_float(r[1]); SC[(4 * rg + 2 * hf + e) * 4096 + s_] = tot; mn[rg][e] = fmin_raw(mn[rg][e], tot); mx[rg][e] = fmax_raw(mx[rg][e], tot); } } } while (0)
        for (int j = 0; j < nj; j += 4) {
            DSA_KCOMP(0, j); if (j + 4 < nj) DSA_KLOAD(0, j + 4, kbase, nj);
            if (j + 1 < nj) DSA_KCOMP(1, j + 1);
            if (j + 5 < nj) DSA_KLOAD(1, j + 5, kbase, nj);
            if (j + 2 < nj) DSA_KCOMP(2, j + 2);
            if (j + 6 < nj) DSA_KLOAD(2, j + 6, kbase, nj);
            if (j + 3 < nj) DSA_KCOMP(3, j + 3);
            if (j + 7 < nj) DSA_KLOAD(3, j + 7, kbase, nj);
        }
#pragma unroll
        for (int rg = 0; rg < 2; ++rg)
#pragma unroll
            for (int e = 0; e < 2; ++e) {
#pragma unroll
                for (int o = 1; o < 32; o <<= 1) { mn[rg][e] = fminf(mn[rg][e], bperm_f(lane ^ o, mn[rg][e])); mx[rg][e] = fmaxf(mx[rg][e], bperm_f(lane ^ o, mx[rg][e])); }
                if (col == 0) { MM[(wave * 8 + 4 * rg + 2 * hf + e) * 2] = mn[rg][e]; MM[(wave * 8 + 4 * rg + 2 * hf + e) * 2 + 1] = mx[rg][e]; } }
        if (hasn && t0n + 8 > 256) DSA_PRELOAD(t0n, mbn, njn);
        __syncthreads();
        {
            const LAS float* scl = SC + wave * 4096 + lane;
            LAS unsigned* hist = (LAS unsigned*)(lds + wave * 16384);
            float lo = 3.0e38f, hi = -3.0e38f;
#pragma unroll
            for (int wv = 0; wv < 8; ++wv) { lo = fminf(lo, MM[(wv * 8 + wave) * 2]); hi = fmaxf(hi, MM[(wv * 8 + wave) * 2 + 1]); }
            const float scale = 4.0e9f / fmaxf(hi - lo, 1e-30f);
            unsigned k[64];
#pragma unroll
            for (int gi = 0; gi < 8; ++gi) { if (512 * gi < N) {
#pragma unroll
                for (int ii = 0; ii < 8; ++ii) k[8 * gi + ii] = __float_as_uint(scl[64 * (8 * gi + ii)]); } else {
#pragma unroll
                for (int ii = 0; ii < 8; ++ii) k[8 * gi + ii] = 0u; } }
            LDS_WAIT();
            { LAS u32x4* hz = (LAS u32x4*)(hist + 16 * lane);
#pragma unroll
              for (int j = 0; j < 4; ++j) hz[j] = (u32x4){0u, 0u, 0u, 0u}; }
            LDS_WAIT();
#pragma unroll
            for (int gi = 0; gi < 8; ++gi) if (512 * gi < N) {
#pragma unroll
                for (int ii = 0; ii < 8; ++ii) { const int i = 8 * gi + ii; const bool valid = lane < N - 64 * i;
                    const unsigned key = valid ? 1u + (unsigned)((__uint_as_float(k[i]) - lo) * scale) : 0u; k[i] = key;
                    LAS unsigned* p = valid ? hist + (key >> 22) : hist + 1024 + lane;
                    __hip_atomic_fetch_add(p, 1u, __ATOMIC_RELAXED, __HIP_MEMORY_SCOPE_WORKGROUP); } }
            LDS_WAIT();
            unsigned d0, need1;
            { const LAS u32x4* hz = (const LAS u32x4*)(hist + 16 * lane); u32x4 hv[4]; unsigned ls = 0u;
#pragma unroll
              for (int j = 0; j < 4; ++j) { hv[j] = hz[j]; ls += (hv[j][0] + hv[j][1]) + (hv[j][2] + hv[j][3]); }
              unsigned incl = ls;
#pragma unroll
              for (int o = 1; o < 64; o <<= 1) { const unsigned v = bperm_u((lane + o) & 63, incl); if (lane + o < 64) incl += v; }
              const unsigned above = incl - ls; unsigned cnt = above, d = 0u, nn = 0u;
#pragma unroll
              for (int j = 15; j >= 0; --j) { const unsigned h = hv[j >> 2][j & 3]; const bool hit = (cnt < 256u) && (256u <= cnt + h); d = hit ? (unsigned)(16 * lane + j) : d; nn = hit ? 256u - cnt : nn; cnt += h; }
              const bool found = (above < 256u) && (256u <= above + ls);
              const unsigned long long fm = __ballot(found);
              const int src = (fm != 0ull) ? (__ffsll((long long)fm) - 1) : 0;
              d0 = bperm_u(src, d); need1 = bperm_u(src, nn); }
            LAS unsigned* CK = hist + 1100; LAS unsigned short* CS = (LAS unsigned short*)(hist + 1170);
            unsigned base = 0u, cbase = 0u;
#pragma unroll
            for (int gi = 0; gi < 8; ++gi) if (512 * gi < N) {
#pragma unroll
                for (int ii = 0; ii < 8; ++ii) { const int i = 8 * gi + ii; const unsigned key = k[i], dg = key >> 22;
                    const bool gt = dg > d0, eq = (dg == d0) && (key != 0u);
                    const unsigned long long mgt = __ballot(gt), meq = __ballot(eq);
                    if (gt) IDXL[base + mbcnt64(mgt)] = (unsigned short)(64 * i + lane);
                    base += (unsigned)__popcll(mgt);
                    if (meq != 0ull) { const unsigned cp = cbase + mbcnt64(meq); if (eq && cp < 64u) { CK[cp] = key; CS[cp] = (unsigned short)(64 * i + lane); } cbase += (unsigned)__popcll(meq); } } }
            LDS_WAIT();
            if (cbase <= 64u) {
                const unsigned mykey = (lane < (int)cbase) ? CK[lane] : 0u; unsigned rank = 0u;
                for (unsigned j = 0; j < cbase; ++j) { const unsigned kj = CK[j]; rank += ((kj > mykey) || (kj == mykey && j < (unsigned)lane)) ? 1u : 0u; }
                const bool sel = (lane < (int)cbase) && (rank < need1);
                const unsigned long long ms = __ballot(sel);
                if (sel) IDXL[base + mbcnt64(ms)] = CS[lane];
            } else {
                unsigned prefix = d0, need = need1;
                LDS_WAIT();
                sel_level<11, 11>(k, N, hist, lane, prefix, need);
                sel_level<0, 11>(k, N, hist, lane, prefix, need);
                unsigned eb = 0u, eqb = 0u;
#pragma unroll
                for (int gi = 0; gi < 8; ++gi) if (512 * gi < N) {
#pragma unroll
                    for (int ii = 0; ii < 8; ++ii) { const int i = 8 * gi + ii; const unsigned key = k[i]; const bool gt = key > prefix, eq = key == prefix;
                        const unsigned long long meq = __ballot(eq); const bool sel = gt || (eq && (eqb + mbcnt64(meq) < need));
                        const unsigned long long msel = __ballot(sel); const unsigned pos = eb + mbcnt64(msel);
                        if (sel && pos < 256u) IDXL[pos] = (unsigned short)(64 * i + lane);
                        eb += (unsigned)__popcll(msel); eqb += (unsigned)__popcll(meq); } }
            }
            LDS_WAIT();
            *(u32x2*)(outp + 4 * lane) = *(const LAS u32x2*)(IDXL + 4 * lane);
        }
        __syncthreads();
    }
#undef DSA_UNIT
#undef DSA_KLOAD
#undef DSA_PRELOAD
#undef DSA_KCOMP
}

__device__ __forceinline__ void dsa_attn_phase(LAS unsigned char* lds, const unsigned char* QLAT8, const unsigned char* CKV8, const unsigned short* IDX, bf16_t* OLAT, int bid, int G) {
    int tid0 = threadIdx.x; asm volatile("" : "+v"(tid0));
    const int wave = __builtin_amdgcn_readfirstlane(tid0 >> 6);
    LAS unsigned char* tile0 = lds + wave * 17408;
    constexpr int TS = 8704, RS = 272;
    constexpr float SCL = 1.4426950408889634f / 16.0f;
    unsigned ixw[8]; u32x4 qf[4]; u32x4 ra[2][2][4];
#define ATT_Q(itx, b_, t_, m_, cnt_) const int b_ = (itx) & 7, t_ = ((itx) >> 3) * 8 + wave; const size_t m_ = (size_t)b_ * T + t_; const int cnt_ = (t_ + 1 < 256) ? t_ + 1 : 256;
#define ATT_LOAD_IX(dst, m_) do { const u32x4 xa_ = *(const u32x4*)(IDX + (m_) * 256 + 16 * c16), xb_ = *(const u32x4*)(IDX + (m_) * 256 + 16 * c16 + 8); \
    dst[0] = xa_[0]; dst[1] = xa_[1]; dst[2] = xa_[2]; dst[3] = xa_[3]; dst[4] = xb_[0]; dst[5] = xb_[1]; dst[6] = xb_[2]; dst[7] = xb_[3]; } while (0)
#define ATT_LOAD_QF(dst, m_) do { const unsigned char* qp_ = QLAT8 + (m_) * 2048 + hd * 256 + 16 * g; _Pragma("unroll") for (int kk = 0; kk < 4; ++kk) dst[kk] = *(const u32x4*)(qp_ + 64 * kk); } while (0)
#define ATT_LOAD_ROWS(buf, ix_, n0_, b_, cnt_) do { const int n1_ = (n0_) + 1; \
    const int k0_ = (16 * c16 + (n0_) < (cnt_)) ? (int)(ix_[(n0_) >> 1] & 0xffffu) : 0, k1_ = (16 * c16 + n1_ < (cnt_)) ? (int)(ix_[n1_ >> 1] >> 16) : 0; \
    const unsigned char* cb_ = CKV8 + (size_t)(b_) * T * 256 + 16 * g; \
    _Pragma("unroll") for (int kk = 0; kk < 4; ++kk) { ra[buf][0][kk] = *(const u32x4*)(cb_ + (size_t)k0_ * 256 + 64 * kk); ra[buf][1][kk] = *(const u32x4*)(cb_ + (size_t)k1_ * 256 + 64 * kk); } } while (0)
#define ATT_QK(bf, d0, d1) do { d0 = (f32x4){0.f, 0.f, 0.f, 0.f}; d1 = d0; \
    _Pragma("unroll") for (int kk = 0; kk < 4; ++kk) _Pragma("unroll") for (int hh = 0; hh < 2; ++hh) { \
        const long qv_ = (long)(((unsigned long long)qf[kk][2 * hh + 1] << 32) | qf[kk][2 * hh]); \
        const long a0_ = (long)(((unsigned long long)ra[bf][0][kk][2 * hh + 1] << 32) | ra[bf][0][kk][2 * hh]); \
        const long a1_ = (long)(((unsigned long long)ra[bf][1][kk][2 * hh + 1] << 32) | ra[bf][1][kk][2 * hh]); \
        d0 = __builtin_amdgcn_mfma_f32_16x16x32_fp8_fp8(a0_, qv_, d0, 0, 0, 0); d1 = __builtin_amdgcn_mfma_f32_16x16x32_fp8_fp8(a1_, qv_, d1, 0, 0, 0); } \
    _Pragma("unroll") for (int kk = 0; kk < 4; ++kk) { *(LAS u32x4*)(tile0 + (bf) * TS + c16 * RS + 64 * kk + 16 * g) = ra[bf][0][kk]; *(LAS u32x4*)(tile0 + (bf) * TS + (16 + c16) * RS + 64 * kk + 16 * g) = ra[bf][1][kk]; } } while (0)
    { int tid = tid0; asm volatile("" : "+v"(tid)); const int lane = tid & 63, g = lane >> 4, c16 = lane & 15, hd = c16 & 7;
      if (bid < 4096) { ATT_Q(bid, b, t, m, cnt) (void)t; ATT_LOAD_IX(ixw, m); ATT_LOAD_QF(qf, m); ATT_LOAD_ROWS(0, ixw, 0, b, cnt); ATT_LOAD_ROWS(1, ixw, 2, b, cnt); } }
    for (int it = bid; it < 4096; it += G) {
        int tid = tid0; asm volatile("" : "+v"(tid));
        const int lane = tid & 63, g = lane >> 4, c16 = lane & 15, hd = c16 & 7, q4 = c16 >> 2, p4 = c16 & 3;
        ATT_Q(it, b, t, m, cnt) (void)t;
        const int itn = it + G; const bool hasn = itn < 4096;
        ATT_Q(hasn ? itn : it, bn, tn, mn, cntn) (void)tn;
        f32x4 oe[8], oo[8];
#pragma unroll
        for (int ub = 0; ub < 8; ++ub) { oe[ub] = (f32x4){0.f, 0.f, 0.f, 0.f}; oo[ub] = oe[ub]; }
        float mrun = -INFINITY, lrun = 0.f;
        f32x4 s0, s1, sn0, sn1;
        ATT_QK(0, s0, s1); ATT_LOAD_ROWS(0, ixw, 4, b, cnt);
#pragma unroll
        for (int ch = 0; ch < 8; ++ch) {
            const int bf = ch & 1, bn1 = (ch + 1) & 1;
            if (ch < 7) { ATT_QK(bn1, sn0, sn1);
                if (ch < 5) ATT_LOAD_ROWS(bn1, ixw, 2 * (ch + 3), b, cnt);
                else if (hasn) ATT_LOAD_ROWS(bn1, ixw, 2 * (ch - 5), bn, cntn); }
            if (ch == 4 && hasn) ATT_LOAD_IX(ixw, mn);
            if (ch == 6 && hasn) ATT_LOAD_QF(qf, mn);
            float cm = -INFINITY;
#pragma unroll
            for (int i = 0; i < 4; ++i) { const int jr = 16 * (4 * g + i) + 2 * ch; if (jr >= cnt) s0[i] = -INFINITY; if (jr + 1 >= cnt) s1[i] = -INFINITY; cm = fmaxf(cm, fmaxf(s0[i], s1[i])); }
            cm = fmaxf(cm, bperm_f(lane ^ 16, cm)); cm = fmaxf(cm, bperm_f(lane ^ 32, cm));
            const float mnew = fmaxf(mrun, cm), alpha = __builtin_amdgcn_exp2f((mrun - mnew) * SCL);
            float p0[4], p1[4], ps = 0.f;
#pragma unroll
            for (int i = 0; i < 4; ++i) { p0[i] = __builtin_amdgcn_exp2f((s0[i] - mnew) * SCL); p1[i] = __builtin_amdgcn_exp2f((s1[i] - mnew) * SCL); ps += p0[i] + p1[i]; }
            lrun = lrun * alpha + ps; mrun = mnew;
            asm volatile("" : "+v"(lrun));
#pragma unroll
            for (int ub = 0; ub < 8; ++ub) { oe[ub] = oe[ub] * alpha; oo[ub] = oo[ub] * alpha; }
            int pl = 0, ph = 0;
            pl = __builtin_amdgcn_cvt_pk_fp8_f32(p0[0], p0[1], pl, false); pl = __builtin_amdgcn_cvt_pk_fp8_f32(p0[2], p0[3], pl, true);
            ph = __builtin_amdgcn_cvt_pk_fp8_f32(p1[0], p1[1], ph, false); ph = __builtin_amdgcn_cvt_pk_fp8_f32(p1[2], p1[3], ph, true);
            const long pb = (long)(((unsigned long long)(unsigned)ph << 32) | (unsigned)pl);
#pragma unroll
            for (int ub = 0; ub < 8; ++ub) {
                const s16x4 t0v = __builtin_amdgcn_ds_read_tr16_b64_v4i16((LAS s16x4*)(tile0 + bf * TS + (4 * g + q4) * RS + 32 * ub + 8 * p4));
                const s16x4 t1v = __builtin_amdgcn_ds_read_tr16_b64_v4i16((LAS s16x4*)(tile0 + bf * TS + (16 + 4 * g + q4) * RS + 32 * ub + 8 * p4));
                const u32x2 w0 = __builtin_bit_cast(u32x2, t0v), w1 = __builtin_bit_cast(u32x2, t1v);
                const unsigned e0 = __builtin_amdgcn_perm(w0.y, w0.x, 0x06040200u), o0 = __builtin_amdgcn_perm(w0.y, w0.x, 0x07050301u);
                const unsigned e1 = __builtin_amdgcn_perm(w1.y, w1.x, 0x06040200u), o1 = __builtin_amdgcn_perm(w1.y, w1.x, 0x07050301u);
                const long ae = (long)(((unsigned long long)e1 << 32) | e0), ao = (long)(((unsigned long long)o1 << 32) | o0);
                oe[ub] = __builtin_amdgcn_mfma_f32_16x16x32_fp8_fp8(ae, pb, oe[ub], 0, 0, 0);
                oo[ub] = __builtin_amdgcn_mfma_f32_16x16x32_fp8_fp8(ao, pb, oo[ub], 0, 0, 0);
            }
            if (ch < 7) { s0 = sn0; s1 = sn1; }
        }
        float lt = lrun + bperm_f(lane ^ 16, lrun); lt += bperm_f(lane ^ 32, lt);
        const float inv = 1.0f / lt;
        if (c16 < 8) { bf16_t* op = OLAT + m * 2048 + c16 * 256 + 8 * g;
#pragma unroll
            for (int ub = 0; ub < 8; ++ub) { const f32x4 ye = oe[ub] * inv, yo = oo[ub] * inv; u32x4 wv;
                wv.x = cvt_pk_bf16(ye[0], yo[0]); wv.y = cvt_pk_bf16(ye[1], yo[1]); wv.z = cvt_pk_bf16(ye[2], yo[2]); wv.w = cvt_pk_bf16(ye[3], yo[3]); *(u32x4*)(op + 32 * ub) = wv; } }
    }
#undef ATT_Q
#undef ATT_LOAD_IX
#undef ATT_LOAD_QF
#undef ATT_LOAD_ROWS
#undef ATT_QK
}

__device__ __forceinline__ void smix_phase(LAS unsigned char* lds, bf16_t* UY, const bf16_t* V, const f32x2* STATS, const float* Wc, const float* bsp, const float* lng, const float* lnb, int bid, int G) {
    int tid = threadIdx.x; asm volatile("" : "+v"(tid));
    const int lane = tid & 63, wave = __builtin_amdgcn_readfirstlane(tid >> 6);
    const int gq = lane >> 4, c16 = lane & 15, q4 = c16 >> 2, p4 = c16 & 3;
    LAS unsigned char* VT = lds;
    LAS unsigned char* AP = lds + 67584;
    LAS float* MU = (LAS float*)(lds + 102400); LAS float* RSTD = MU + 128; LAS float* R1 = MU + 256; LAS float* R2 = MU + 384;
    for (int it = bid; it < 2048; it += G) {
        const int gi = it & 7, rem = it >> 3, b = rem >> 5, ck = rem & 31; const size_t m0 = (size_t)b * T + ck * 128;
        if (tid < 128) { const f32x2* sp = STATS + (m0 + tid) * 32; float s = 0.f, ss = 0.f;
#pragma unroll 8
            for (int p = 0; p < 32; ++p) { const f32x2 v = sp[p]; s += v.x; ss += v.y; }
            const float mu = s * (1.0f / 2048.0f), var = ss * (1.0f / 2048.0f) - mu * mu; MU[tid] = mu; RSTD[tid] = rsqrtf(fmaxf(var, 0.f) + EPS); }
#pragma unroll
        for (int i = 0; i < 8; ++i) { const int cidx = tid + 512 * i, s = cidx >> 5, ch = cidx & 31;
            *(LAS u32x4*)(VT + s * 528 + ch * 16) = *(const u32x4*)(V + (m0 + s) * 2048 + gi * 256 + ch * 8); }
        __syncthreads();
        { const int t = tid >> 2, qd = tid & 3; const float* wp = Wc + ((size_t)gi * 128 + t) * 128 + 32 * qd; float r1 = 0.f, r2 = 0.f;
#pragma unroll
          for (int s8 = 0; s8 < 4; ++s8) { const f32x4 wa = *(const f32x4*)(wp + 8 * s8), wb = *(const f32x4*)(wp + 8 * s8 + 4); float av[8];
#pragma unroll
              for (int e = 0; e < 8; ++e) { const int s = 32 * qd + 8 * s8 + e; const float wv = (s <= t) ? (e < 4 ? wa[e] : wb[e - 4]) : 0.f; const float ab = bf_round(wv * RSTD[s]); av[e] = ab; r1 += ab * MU[s]; r2 += wv; }
              u32x4 o; o.x = cvt_pk_bf16(av[0], av[1]); o.y = cvt_pk_bf16(av[2], av[3]); o.z = cvt_pk_bf16(av[4], av[5]); o.w = cvt_pk_bf16(av[6], av[7]);
              *(LAS u32x4*)(AP + t * 272 + (32 * qd + 8 * s8) * 2) = o; }
          r1 += bperm_f(lane ^ 1, r1); r2 += bperm_f(lane ^ 1, r2); r1 += bperm_f(lane ^ 2, r1); r2 += bperm_f(lane ^ 2, r2);
          if (qd == 0) { R1[t] = r1; R2[t] = r2; } }
        __syncthreads();
        f32x4 acc[8][2];
#pragma unroll
        for (int mt = 0; mt < 8; ++mt) { acc[mt][0] = (f32x4){0.f, 0.f, 0.f, 0.f}; acc[mt][1] = acc[mt][0]; }
#pragma unroll
        for (int ks = 0; ks < 4; ++ks) {
            bf16x8 vf[2];
#pragma unroll
            for (int n2 = 0; n2 < 2; ++n2) { const int nt = 2 * wave + n2;
                const s16x4 t0v = __builtin_amdgcn_ds_read_tr16_b64_v4i16((LAS s16x4*)(VT + (32 * ks + 8 * gq + q4) * 528 + (16 * nt + 4 * p4) * 2));
                const s16x4 t1v = __builtin_amdgcn_ds_read_tr16_b64_v4i16((LAS s16x4*)(VT + (32 * ks + 8 * gq + 4 + q4) * 528 + (16 * nt + 4 * p4) * 2));
                vf[n2] = __builtin_shufflevector(t0v, t1v, 0, 1, 2, 3, 4, 5, 6, 7); }
#pragma unroll
            for (int mt = 0; mt < 8; ++mt) if (mt >= 2 * ks) {
                const bf16x8 afr = *(const LAS bf16x8*)(AP + (16 * mt + c16) * 272 + (32 * ks + 8 * gq) * 2);
                acc[mt][0] = __builtin_amdgcn_mfma_f32_16x16x32_bf16(vf[0], afr, acc[mt][0], 0, 0, 0);
                acc[mt][1] = __builtin_amdgcn_mfma_f32_16x16x32_bf16(vf[1], afr, acc[mt][1], 0, 0, 0); }
        }
        __syncthreads();
#pragma unroll
        for (int i = 0; i < 8; ++i) { const int cidx = tid + 512 * i, s = cidx >> 5, ch = cidx & 31;
            *(LAS u32x4*)(VT + s * 528 + ch * 16) = *(const u32x4*)(UY + (m0 + s) * 2048 + gi * 256 + ch * 8); }
        __syncthreads();
#pragma unroll
        for (int n2 = 0; n2 < 2; ++n2) { const int e0 = 16 * (2 * wave + n2) + 4 * gq; const f32x4 lg4 = *(const f32x4*)(lng + gi * 256 + e0), lb4 = *(const f32x4*)(lnb + gi * 256 + e0);
#pragma unroll
            for (int mt = 0; mt < 8; ++mt) { const int t = 16 * mt + c16; const float r1 = R1[t], r2 = R2[t], bsv = bsp[gi * 128 + t];
                LAS u32x2* up = (LAS u32x2*)(VT + t * 528 + e0 * 2); const u32x2 uw = *up;
                const f32x4 mixed = lg4 * (acc[mt][n2] - r1) + lb4 * r2 + bsv;
                const float y0 = bf2f(uw.x & 0xffffu) * mixed[0], y1 = bf2f(uw.x >> 16) * mixed[1], y2 = bf2f(uw.y & 0xffffu) * mixed[2], y3 = bf2f(uw.y >> 16) * mixed[3];
                u32x2 yw; yw.x = cvt_pk_bf16(y0, y1); yw.y = cvt_pk_bf16(y2, y3); *up = yw; } }
        __syncthreads();
#pragma unroll
        for (int i = 0; i < 8; ++i) { const int cidx = tid + 512 * i, s = cidx >> 5, ch = cidx & 31;
            *(u32x4*)(UY + (m0 + s) * 2048 + gi * 256 + ch * 8) = *(const LAS u32x4*)(VT + s * 528 + ch * 16); }
        __syncthreads();
    }
}

__global__ void __launch_bounds__(512, 2) mk_fwd(Args a) {
    extern __shared__ __attribute__((aligned(16))) unsigned char lds_raw[];
    LAS unsigned char* lds = (LAS unsigned char*)lds_raw;
    cg::grid_group grid = cg::this_grid();
    const int bid = blockIdx.x, G = gridDim.x;
    unsigned char* wsk = a.ws;
    float* X = a.out;
    volatile LAS unsigned* misc = (volatile LAS unsigned*)(lds + LDS_MISC);
    if (threadIdx.x < 2) misc[threadIdx.x] = 0u;
    __syncthreads();
    const XcdBarrier xbar = xcd_barrier_post((unsigned*)(wsk + WS_BAR), misc);
    int ph = 0;
#ifndef PROBE
#define PROBE 0
#endif
#define PHASE_BEGIN if (ph >= a.ph_lo && ph < a.ph_hi) {
#define REP(k) for (int rep_ = 0; rep_ < ((PROBE == (k)) ? 2 : 1); ++rep_)
#define PHASE_END(dosync) if ((dosync) && ph + 1 < a.ph_hi) { if (ph == 0) grid.sync(); else xcd_barrier(xbar); } } ++ph;

    PHASE_BEGIN REP(4) { p0_phase(a, lds, bid, G); __syncthreads(); } PHASE_END(true)
    PHASE_BEGIN p0c_phase(a, bid, G); PHASE_END(true)

#pragma unroll 1
    for (int layer = 0; layer < 4; ++layer) {
        unsigned char* ws = wsk; asm volatile("" : "+s"(ws));
        float* MOD = (float*)(ws + WS_MOD); bf16_t* H = (bf16_t*)(ws + WS_H);
        const int j = layer >> 1; const float* xin = (layer == 0) ? a.in[0] : X;
        const float* modl = MOD + (size_t)layer * 8 * NMOD;
        PHASE_BEGIN REP(3) norm_mod_phase(xin, a.in[4] + layer * D, modl + 0 * D, modl + 1 * D, H, bid, G); PHASE_END(true)
        if ((layer & 1) == 0) {
            bf16_t* Q = (bf16_t*)(ws + WS_Q); float* CKVR = (float*)(ws + WS_CKVR); bf16_t* QIDX = (bf16_t*)(ws + WS_QIDX); float* KRAW = (float*)(ws + WS_KRAW);
            bf16_t* CKV = (bf16_t*)(ws + WS_CKV); bf16_t* KIDX = (bf16_t*)(ws + WS_KIDX); float* WIDX = (float*)(ws + WS_WIDX); unsigned short* IDX = (unsigned short*)(ws + WS_IDX);
            bf16_t* QLAT = (bf16_t*)(ws + WS_QLAT); bf16_t* OLAT = (bf16_t*)(ws + WS_OLAT); bf16_t* O = (bf16_t*)(ws + WS_O);
            PHASE_BEGIN { pg8::Gemm g{H, (const bf16_t*)(ws + W_AIN) + (size_t)j * 2048 * 1024, M, 2048, 1024, 1024, 0, 0}; pg8::StaticOrder S; S.init(M, 2048, G, bid);
                pg8::EpiInproj E{Q, CKVR, QIDX, KRAW}; REP(5) pg8::gemm_phase(lds, g, S, E); } PHASE_END(true)
            PHASE_BEGIN { dsa_rows_phase(CKVR, KRAW, a.in[7] + j * 256, a.in[8] + j * 64, a.in[9] + j * 64, CKV, KIDX, WIDX, bid, G);
                __syncthreads();
                pg8::Gemm g{Q, (const bf16_t*)(ws + W_UK) + (size_t)j * 2048 * 256, M, 2048, 256, 1024, 1, 256}; pg8::StaticOrder S; S.init(M, 2048, G, bid);
                pg8::EpiBf16 E{QLAT, 2048, 1.4142135623730951f, 1}; pg8::gemm_phase(lds, g, S, E); } PHASE_END(true)
            PHASE_BEGIN REP(1) dsa_select_phase(lds, QIDX, KIDX, WIDX, IDX, bid, G); PHASE_END(true)
            PHASE_BEGIN REP(2) dsa_attn_phase(lds, (const unsigned char*)QLAT, (const unsigned char*)CKV, IDX, OLAT, bid, G); PHASE_END(true)
            PHASE_BEGIN { pg8::Gemm g{OLAT, (const bf16_t*)(ws + W_UV) + (size_t)j * 1024 * 512, M, 1024, 512, 2048, 0, 512}; pg8::StaticOrder S; S.init(M, 1024, G, bid);
                pg8::EpiBf16 E{O, 1024, 1.0f, 0}; pg8::gemm_phase(lds, g, S, E); } PHASE_END(true)
            PHASE_BEGIN { pg8::Gemm g{O, (const bf16_t*)(ws + W_O) + (size_t)j * 1024 * 1024, M, 1024, 1024, 1024, 0, 0}; pg8::StaticOrder S; S.init(M, 1024, G, bid);
                pg8::EpiResid E{xin, X, modl + 2 * D}; pg8::gemm_phase(lds, g, S, E); } PHASE_END(true)
        } else {
            bf16_t* U = (bf16_t*)(ws + WS_U); bf16_t* V = (bf16_t*)(ws + WS_V); f32x2* STATS = (f32x2*)(ws + WS_STATS);
            PHASE_BEGIN { pg8::Gemm g{H, (const bf16_t*)(ws + W_BIN) + (size_t)j * 4096 * 1024, M, 4096, 1024, 1024, 0, 0}; pg8::StaticOrder S; S.init(M, 4096, G, bid);
                pg8::EpiGelu E{U, V, STATS}; REP(7) pg8::gemm_phase(lds, g, S, E); } PHASE_END(true)
            PHASE_BEGIN smix_phase(lds, U, V, STATS, a.in[16] + (size_t)j * 8 * 128 * 128, a.in[17] + (size_t)j * 8 * 128, a.in[14] + (size_t)j * 2048, a.in[15] + (size_t)j * 2048, bid, G); PHASE_END(true)
            PHASE_BEGIN { pg8::Gemm g{U, (const bf16_t*)(ws + W_BOUT) + (size_t)j * 1024 * 2048, M, 1024, 2048, 2048, 0, 0}; pg8::StaticOrder S; S.init(M, 1024, G, bid);
                pg8::EpiResid E{xin, X, modl + 2 * D}; pg8::gemm_phase(lds, g, S, E); } PHASE_END(true)
        }
        PHASE_BEGIN REP(3) norm_mod_phase(X, a.in[5] + layer * D, modl + 3 * D, modl + 4 * D, H, bid, G); PHASE_END(true)
        PHASE_BEGIN { pg8::Gemm g{H, (const bf16_t*)(ws + W_GU) + (size_t)layer * 5632 * 1024, M, 5632, 1024, 1024, 0, 0}; pg8::StaticOrder S; S.init(M, 5632, G, bid);
            pg8::EpiSwiglu E{(bf16_t*)(ws + WS_HID)}; REP(6) pg8::gemm_phase(lds, g, S, E); } PHASE_END(true)
        PHASE_BEGIN { pg8::Gemm g{(const bf16_t*)(ws + WS_HID), (const bf16_t*)(ws + W_DN) + (size_t)layer * 1024 * DFF, M, 1024, DFF, DFF, 0, 0}; pg8::StaticOrder S; S.init(M, 1024, G, bid);
            pg8::EpiResid E{X, X, modl + 5 * D}; pg8::gemm_phase(lds, g, S, E); } PHASE_END(true)
    }
    PHASE_BEGIN final_norm_phase(X, a.in[22], a.out, bid, G); PHASE_END(false)
}

extern "C" void kernel_launch(void* const* d_in, const int* in_sizes, int n_in, void* d_out, int out_size, void* d_ws, size_t ws_size, hipStream_t stream) {
    static int grid_blocks = 0;
    if (grid_blocks == 0) {
        int dev = 0, cus = 0, per_cu = 0;
        if (n_in != 23 || out_size != M * D || ws_size < WS_END) { fprintf(stderr, "kernel_launch: unexpected problem (n_in %d out %d ws %zu, need ws >= %zu)\n", n_in, out_size, ws_size, (size_t)WS_END); grid_blocks = -1; return; }
        (void)hipGetDevice(&dev);
        (void)hipDeviceGetAttribute(&cus, hipDeviceAttributeMultiprocessorCount, dev);
        (void)hipFuncSetAttribute((const void*)mk_fwd, hipFuncAttributeMaxDynamicSharedMemorySize, LDS_BYTES);
        (void)hipOccupancyMaxActiveBlocksPerMultiprocessor(&per_cu, (const void*)mk_fwd, 512, LDS_BYTES);
        fprintf(stderr, "kernel_launch: cus %d per_cu %d ws %zu\n", cus, per_cu, ws_size);
        if (per_cu < 1) { fprintf(stderr, "kernel_launch: kernel does not fit a CU\n"); grid_blocks = -1; return; }
        grid_blocks = cus;
    }
    if (grid_blocks < 0) return;
    if (hipMemsetAsync((char*)d_ws + WS_BAR, 0, 16384, stream) != hipSuccess) { fprintf(stderr, "kernel_launch: memset failed\n"); return; }
    Args a{};
    for (int i = 0; i < 23; ++i) a.in[i] = (const float*)d_in[i];
    a.out = (float*)d_out; a.ws = (unsigned char*)d_ws; a.ph_lo = 0; a.ph_hi = 1000;
    void* args[] = {&a};
    hipError_t e = hipLaunchCooperativeKernel((const void*)mk_fwd, dim3(grid_blocks), dim3(512), args, LDS_BYTES, stream);
    if (e != hipSuccess) fprintf(stderr, "cooperative launch failed: %s (grid %d)\n", hipGetErrorString(e), grid_blocks);
}
```

```cpp
#include <hip/hip_runtime.h>
#include <hip/hip_cooperative_groups.h>
#include <cstdio>
#include <cstdint>
namespace cg = cooperative_groups;

#define LAS __attribute__((address_space(3)))
typedef unsigned short bf16_t;
typedef short bf16x8 __attribute__((ext_vector_type(8)));
typedef short s16x4 __attribute__((ext_vector_type(4)));
typedef float f32x4 __attribute__((ext_vector_type(4)));
typedef float f32x16 __attribute__((ext_vector_type(16)));
typedef float f32x2 __attribute__((ext_vector_type(2)));
typedef unsigned u32x4 __attribute__((ext_vector_type(4)));
typedef unsigned u32x2 __attribute__((ext_vector_type(2)));
typedef _Float16 f16x8 __attribute__((ext_vector_type(8)));
typedef float f32x8 __attribute__((ext_vector_type(8)));

constexpr int D = 1024, NB = 8, T = 4096, M = NB * T, DFF = 2816, NMOD = 6 * D;
constexpr float EPS = 1e-6f;
constexpr int AIN = 1864;
constexpr size_t MiB = 1u << 20;
constexpr size_t WS_MOD = 0;
constexpr size_t WS_MODP = 1 * MiB;
constexpr size_t WS_W = 13 * MiB;
constexpr size_t W_AIN = WS_W;
constexpr size_t W_UK = W_AIN + 8 * MiB;
constexpr size_t W_UV = W_UK + 2 * MiB;
constexpr size_t W_O = W_UV + 2 * MiB;
constexpr size_t W_BIN = W_O + 4 * MiB;
constexpr size_t W_BOUT = W_BIN + 16 * MiB;
constexpr size_t W_GU = W_BOUT + 8 * MiB;
constexpr size_t W_DN = W_GU + 44 * MiB;
constexpr size_t WS_R1 = W_DN + 22 * MiB;
constexpr size_t WS_X16 = WS_R1;
constexpr size_t WS_Q = WS_R1 + 64 * MiB;
constexpr size_t WS_R2 = WS_R1 + 128 * MiB;
constexpr size_t WS_QLAT = WS_R2;
constexpr size_t WS_O = WS_R2;
constexpr size_t WS_R3 = WS_R2 + 128 * MiB;
constexpr size_t WS_CKVR = WS_R3;
constexpr size_t WS_CKV = WS_CKVR + 32 * MiB;
constexpr size_t WS_QIDX = WS_CKV + 16 * MiB;
constexpr size_t WS_KRAW = WS_QIDX + 32 * MiB;
constexpr size_t WS_KIDX = WS_KRAW + 16 * MiB;
constexpr size_t WS_WIDX = WS_KIDX + 4 * MiB;
constexpr size_t WS_IDX = WS_WIDX + 1 * MiB;
constexpr size_t WS_END = WS_IDX + 16 * MiB;
constexpr size_t WS_HID = WS_R1 + 64 * MiB;
constexpr size_t WS_U = WS_R1 + 64 * MiB;
constexpr size_t WS_V = WS_U + 128 * MiB;
constexpr size_t WS_STATS = WS_V + 128 * MiB;
static_assert(WS_STATS + 8 * MiB <= WS_END && WS_HID + 176 * MiB <= WS_R3, "ws map");
constexpr int LDS_BYTES = 147456;
constexpr int LDS_MISC = LDS_BYTES - 256;
constexpr size_t WS_BAR = 1 * MiB - 16384;

__device__ __forceinline__ unsigned cvt_pk_bf16(float lo, float hi) { unsigned r; asm volatile("v_cvt_pk_bf16_f32 %0, %1, %2" : "=v"(r) : "v"(lo), "v"(hi)); return r; }
__device__ __forceinline__ float bf2f(unsigned b) { return __uint_as_float(b << 16); }
__device__ __forceinline__ float bf_round(float f) { unsigned u = __float_as_uint(f); u = (u + 0x7fffu + ((u >> 16) & 1u)) & 0xffff0000u; return __uint_as_float(u); }
__device__ __forceinline__ float wave_sum(float v) {
#pragma unroll
    for (int o = 1; o < 64; o <<= 1) v += __shfl_xor(v, o);
    return v;
}
#define LDS_WAIT() asm volatile("s_waitcnt lgkmcnt(0)" ::: "memory")
__device__ __forceinline__ unsigned bperm_u(int srclane, unsigned v) { return (unsigned)__builtin_amdgcn_ds_bpermute(srclane << 2, (int)v); }
__device__ __forceinline__ float bperm_f(int srclane, float v) { return __int_as_float(__builtin_amdgcn_ds_bpermute(srclane << 2, __float_as_int(v))); }


#define XB_TMO      128
#define XB_XCNT(j)  (256  + 64 * (j))
#define XB_XSUB(j)  (1280 + 64 * (j))
#define XB_XGEN(j)  (2304 + 64 * (j))
#define XB_TOP      3328
#define XB_TOPGEN   3392
#define XCD_BAR_WORDS 3456
#define XB_SPIN_CAP (1u << 22)
__device__ __forceinline__ unsigned xb_ld(unsigned* p)              { return __hip_atomic_load(p, __ATOMIC_RELAXED, __HIP_MEMORY_SCOPE_AGENT); }
__device__ __forceinline__ unsigned xb_add(unsigned* p, unsigned v) { return __hip_atomic_fetch_add(p, v, __ATOMIC_RELAXED, __HIP_MEMORY_SCOPE_AGENT); }
__device__ __forceinline__ unsigned xb_xcc_id() { return (unsigned)__builtin_amdgcn_s_getreg((3 << 11) | 20) & 0xFu; }
#define XB_SPIN(cond, bar) do { unsigned _sp = 0; while (cond) { __builtin_amdgcn_s_sleep(1); \
    if ((++_sp & 255u) == 0u) { if (xb_ld(&(bar)[XB_TMO])) break; if (_sp > XB_SPIN_CAP) { atomicAdd(&(bar)[XB_TMO], 1u); break; } } } } while (0)
struct XcdBarrier { unsigned* bar; unsigned x; volatile LAS unsigned* st; };
__device__ __forceinline__ XcdBarrier xcd_barrier_post(unsigned* bar, volatile LAS unsigned* st) {
    XcdBarrier b; b.bar = bar; b.x = xb_xcc_id(); b.st = st;
    if (threadIdx.x == 0) (void)xb_add(&bar[XB_XCNT(b.x)], 1u);
    return b;
}
__device__ __forceinline__ void xcd_barrier_complete(unsigned* bar, unsigned x, unsigned& nloc, unsigned& nx) {
    const unsigned G = gridDim.x * gridDim.y * gridDim.z;
    unsigned sum, cnt, mine, sp = 0u;
    for (;;) {
        sum = 0u; cnt = 0u; mine = 0u;
#pragma unroll
        for (unsigned j = 0; j < 16; ++j) { const unsigned c = xb_ld(&bar[XB_XCNT(j)]); sum += c; cnt += (c > 0u) ? 1u : 0u; mine = (j == x) ? c : mine; }
        if (sum == G) break;
        __builtin_amdgcn_s_sleep(1);
        if ((++sp & 255u) == 0u) { if (xb_ld(&bar[XB_TMO])) break; if (sp > XB_SPIN_CAP) { atomicAdd(&bar[XB_TMO], 1u); break; } }
    }
    nloc = mine > 0u ? mine : 1u; nx = cnt > 0u ? cnt : 1u;
}
__device__ __forceinline__ void xcd_barrier(const XcdBarrier& b) {
    asm volatile("s_waitcnt vmcnt(0)" ::: "memory");
    __syncthreads();
    if (threadIdx.x == 0) {
        unsigned* bar = b.bar;
        __builtin_amdgcn_s_waitcnt(0);
        unsigned nloc = b.st[0], nx = b.st[1];
        if (nloc == 0u) { xcd_barrier_complete(bar, b.x, nloc, nx); b.st[0] = nloc; b.st[1] = nx; }
        const unsigned old = xb_add(&bar[XB_XSUB(b.x)], 1u);
        const unsigned gen = old / nloc;
        if (old + 1u == (gen + 1u) * nloc) {
            __builtin_amdgcn_fence(__ATOMIC_RELEASE, "agent");
            asm volatile("s_waitcnt vmcnt(0)" ::: "memory");
            const unsigned og = xb_add(&bar[XB_TOP], 1u);
            const unsigned tg = og / nx;
            if (og + 1u == (tg + 1u) * nx) xb_add(&bar[XB_TOPGEN], 1u);
            else XB_SPIN(xb_ld(&bar[XB_TOPGEN]) == tg, bar);
            __builtin_amdgcn_fence(__ATOMIC_ACQUIRE, "agent");
            xb_add(&bar[XB_XGEN(b.x)], 1u);
            asm volatile("s_waitcnt vmcnt(0)" ::: "memory");
        } else {
            XB_SPIN(xb_ld(&bar[XB_XGEN(b.x)]) == gen, bar);
            __builtin_amdgcn_fence(__ATOMIC_ACQUIRE, "agent");
            asm volatile("s_waitcnt vmcnt(0)" ::: "memory");
        }
    }
    __syncthreads();
}

namespace pg8 {
constexpr int BM = 256, BK = 64, HALF = 128, HTB = HALF * BK * 2, STAGE_BYTES = 8 * HTB, NXCD = 8, WGM = 8;
__host__ __device__ __forceinline__ int lds_byte(int r, int c) { const int st = (r >> 4) * 2 + (c >> 5), rr = r & 15, cc = c & 31, ob = rr * 64 + cc * 2; return st * 1024 + (ob ^ (((ob >> 9) & 1) << 5)); }
__host__ __device__ __forceinline__ void stage_rc(int b, int& R, int& C) { const int st = b / 1024, sb = b % 1024, swz = sb ^ (((sb >> 9) & 1) << 5); R = (st >> 1) * 16 + swz / 64; C = (st & 1) * 32 + (swz % 64) / 2; }
__host__ __device__ __forceinline__ int perm32(int rho) { const int n = rho >> 4, i = rho & 15; return 8 * (i >> 2) + 4 * n + (i & 3); }

struct Unit { int pm, pn; };
struct Gemm { const bf16_t* A; const bf16_t* Bt; int M, N, K, lda, agrp_shift, agrp_stride; };

struct StaticOrder {
    int nM, nN, nwg, G, c;
    __device__ void init(int M_, int N_, int G_, int c_) { nM = M_ / BM; nN = N_ / BM; nwg = nM * nN; G = G_; c = c_; }
    __device__ bool next(int i, Unit& u) const {
        const long L = (long)i * G + c; if (L >= nwg) return false;
        int wgid = (int)L; { const int q = nwg / NXCD, r = nwg % NXCD, xcd = wgid % NXCD, off = wgid / NXCD; wgid = (xcd < r ? xcd * (q + 1) : r * (q + 1) + (xcd - r) * q) + off; }
        const int nig = WGM * nN, gid = wgid / nig, fm = gid * WGM, gsz = (nM - fm) < WGM ? (nM - fm) : WGM;
        u.pm = fm + ((wgid % nig) % gsz); u.pn = (wgid % nig) / gsz; return true;
    }
};

typedef f32x4 Acc[2][2][4][2];

__device__ __forceinline__ f32x2 gelu_pk(f32x2 v) {
    const f32x2 av = __builtin_elementwise_abs(v), d = av * 0.2316418882f + 1.0f;
    f32x2 t; t.x = __builtin_amdgcn_rcpf(d.x); t.y = __builtin_amdgcn_rcpf(d.y);
    f32x2 q = t * 0.5307027145f + (-0.7265760135f); q = q * t + 0.7107068705f; q = q * t + (-0.142248368f); q = q * t + 0.127414796f; q = q * t;
    const f32x2 s = (v * v) * (-0.72134752044f);
    f32x2 e; e.x = __builtin_amdgcn_exp2f(s.x); e.y = __builtin_amdgcn_exp2f(s.y);
    const f32x2 m = v * (q * e), r = v - m;
    f32x2 o; o.x = v.x < 0.f ? m.x : r.x; o.y = v.y < 0.f ? m.y : r.y; return o;
}
__device__ __forceinline__ f32x4 gelu4(f32x4 v) { f32x2 a = gelu_pk((f32x2){v[0], v[1]}), b = gelu_pk((f32x2){v[2], v[3]}); return (f32x4){a.x, a.y, b.x, b.y}; }
__device__ __forceinline__ u32x4 pack8(f32x4 v0, f32x4 v1) { u32x4 w; w.x = cvt_pk_bf16(v0[0], v0[1]); w.y = cvt_pk_bf16(v0[2], v0[3]); w.z = cvt_pk_bf16(v1[0], v1[1]); w.w = cvt_pk_bf16(v1[2], v1[3]); return w; }

struct EpiInproj {
    bf16_t* Q; float* CKVR; bf16_t* QIDX; float* KRAW;
    __device__ __forceinline__ void operator()(const Acc& acc, const Unit& u, int wr, int wc, int fr, int fq) const {
        const int row0 = u.pm * BM + wr * 64 + fr, cl = wc * 32 + 8 * fq;
#pragma unroll
        for (int ai = 0; ai < 2; ++ai)
#pragma unroll
            for (int m = 0; m < 4; ++m) { const size_t row = (size_t)(row0 + ai * HALF + m * 16);
#pragma unroll
                for (int bj = 0; bj < 2; ++bj) { const f32x4 v0 = acc[ai][bj][m][0], v1 = acc[ai][bj][m][1]; const int c = bj * HALF + cl;
                    if (u.pn < 4) *(u32x4*)(Q + row * 1024 + u.pn * 256 + c) = pack8(v0, v1);
                    else if (u.pn == 4) { float* p = CKVR + row * 256 + c; *(f32x4*)p = v0; *(f32x4*)(p + 4) = v1; }
                    else if (u.pn < 7) *(u32x4*)(QIDX + row * 512 + (u.pn - 5) * 256 + c) = pack8(v0, v1);
                    else if (bj == 0) { float* p = KRAW + row * 128 + c; *(f32x4*)p = v0; *(f32x4*)(p + 4) = v1; } } }
    }
};
struct EpiBf16 {
    bf16_t* O; int ldc; float scale; int fp8;
    __device__ __forceinline__ void operator()(const Acc& acc, const Unit& u, int wr, int wc, int fr, int fq) const {
        const int row0 = u.pm * BM + wr * 64 + fr, col0 = u.pn * BM + wc * 32 + 8 * fq;
        if (fp8) {
#pragma unroll
            for (int ai = 0; ai < 2; ++ai)
#pragma unroll
                for (int m = 0; m < 4; ++m) { unsigned char* rowp = (unsigned char*)O + (size_t)(row0 + ai * HALF + m * 16) * ldc + col0;
#pragma unroll
                    for (int bj = 0; bj < 2; ++bj) { const f32x4 v0 = acc[ai][bj][m][0] * scale, v1 = acc[ai][bj][m][1] * scale; int w0 = 0, w1 = 0;
                        w0 = __builtin_amdgcn_cvt_pk_fp8_f32(v0[0], v0[1], w0, false); w0 = __builtin_amdgcn_cvt_pk_fp8_f32(v0[2], v0[3], w0, true);
                        w1 = __builtin_amdgcn_cvt_pk_fp8_f32(v1[0], v1[1], w1, false); w1 = __builtin_amdgcn_cvt_pk_fp8_f32(v1[2], v1[3], w1, true);
                        *(u32x2*)(rowp + bj * HALF) = (u32x2){(unsigned)w0, (unsigned)w1}; } }
            return; }
#pragma unroll
        for (int ai = 0; ai < 2; ++ai)
#pragma unroll
            for (int m = 0; m < 4; ++m) { bf16_t* rowp = O + (size_t)(row0 + ai * HALF + m * 16) * ldc + col0;
#pragma unroll
                for (int bj = 0; bj < 2; ++bj) *(u32x4*)(rowp + bj * HALF) = pack8(acc[ai][bj][m][0] * scale, acc[ai][bj][m][1] * scale); }
    }
};
struct EpiResid {
    _Float16* x; const float* gate;
    __device__ __forceinline__ void operator()(const Acc& acc, const Unit& u, int wr, int wc, int fr, int fq) const {
        const int row0 = u.pm * BM + wr * 64 + fr, col0 = u.pn * BM + wc * 32 + 8 * fq;
        const float* gp = gate + (size_t)(u.pm >> 4) * NMOD + col0;
        f32x4 gv[2][2];
#pragma unroll
        for (int bj = 0; bj < 2; ++bj)
#pragma unroll
            for (int n = 0; n < 2; ++n) gv[bj][n] = *(const f32x4*)(gp + bj * HALF + 4 * n);
#pragma unroll
        for (int ai = 0; ai < 2; ++ai)
#pragma unroll
            for (int m = 0; m < 4; ++m) { _Float16* xp = x + (size_t)(row0 + ai * HALF + m * 16) * D + col0;
#pragma unroll
                for (int bj = 0; bj < 2; ++bj) { const f32x8 xo = __builtin_convertvector(*(const f16x8*)(xp + bj * HALF), f32x8);
                    const f32x4 r0 = (f32x4){xo[0], xo[1], xo[2], xo[3]} + gv[bj][0] * acc[ai][bj][m][0], r1 = (f32x4){xo[4], xo[5], xo[6], xo[7]} + gv[bj][1] * acc[ai][bj][m][1];
                    *(f16x8*)(xp + bj * HALF) = __builtin_convertvector((f32x8){r0[0], r0[1], r0[2], r0[3], r1[0], r1[1], r1[2], r1[3]}, f16x8); } }
    }
};
struct EpiGelu {
    bf16_t* U; bf16_t* V; f32x2* STATS;
    __device__ __forceinline__ void operator()(const Acc& acc, const Unit& u, int wr, int wc, int fr, int fq) const {
        const int row0 = u.pm * BM + wr * 64 + fr, cl = wc * 32 + 8 * fq;
        const bool isv = u.pn >= 8; bf16_t* base = isv ? V + (u.pn - 8) * 256 : U + u.pn * 256;
#pragma unroll
        for (int ai = 0; ai < 2; ++ai)
#pragma unroll
            for (int m = 0; m < 4; ++m) { const size_t row = (size_t)(row0 + ai * HALF + m * 16); float s = 0.f, ss = 0.f;
#pragma unroll
                for (int bj = 0; bj < 2; ++bj) { const f32x4 v0 = gelu4(acc[ai][bj][m][0]), v1 = gelu4(acc[ai][bj][m][1]);
                    *(u32x4*)(base + row * 2048 + bj * HALF + cl) = pack8(v0, v1);
                    s += (v0[0] + v0[1]) + (v0[2] + v0[3]) + (v1[0] + v1[1]) + (v1[2] + v1[3]);
                    ss += (v0[0] * v0[0] + v0[1] * v0[1]) + (v0[2] * v0[2] + v0[3] * v0[3]) + (v1[0] * v1[0] + v1[1] * v1[1]) + (v1[2] * v1[2] + v1[3] * v1[3]); }
                if (isv) { s += __shfl_xor(s, 16); ss += __shfl_xor(ss, 16); s += __shfl_xor(s, 32); ss += __shfl_xor(ss, 32);
                    if (fq == 0) STATS[row * 32 + (u.pn - 8) * 4 + wc] = (f32x2){s, ss}; } }
    }
};
struct EpiSwiglu {
    bf16_t* HID;
    __device__ __forceinline__ void operator()(const Acc& acc, const Unit& u, int wr, int wc, int fr, int fq) const {
        const int row0 = u.pm * BM + wr * 64 + fr, col0 = u.pn * 128 + wc * 32 + 8 * fq;
#pragma unroll
        for (int ai = 0; ai < 2; ++ai)
#pragma unroll
            for (int m = 0; m < 4; ++m) { f32x4 h[2];
#pragma unroll
                for (int n = 0; n < 2; ++n) { const f32x4 g = acc[ai][0][m][n], up = acc[ai][1][m][n];
#pragma unroll
                    for (int j = 0; j < 4; ++j) h[n][j] = g[j] * __builtin_amdgcn_rcpf(1.0f + __expf(-g[j])) * up[j]; }
                *(u32x4*)(HID + (size_t)(row0 + ai * HALF + m * 16) * DFF + col0) = pack8(h[0], h[1]); }
    }
};

template <class Epi>
__device__ __forceinline__ void gemm_phase(LAS unsigned char* lds, const Gemm g, const StaticOrder& S, const Epi& E) {
    int tid = threadIdx.x; asm volatile("" : "+v"(tid));
    const int wid = __builtin_amdgcn_readfirstlane(tid >> 6), lane = tid & 63, wr = wid >> 2, wc = wid & 3, fr = lane & 15, fq = lane >> 4;
    const int K = g.K, nt = K / BK, lda = g.lda;
    unsigned voffA[2], voffB[2];
#pragma unroll
    for (int i = 0; i < 2; ++i) { int R, C; stage_rc(tid * 16 + i * 8192, R, C); const int Rb = (R & ~31) + perm32(R & 31);
        voffA[i] = (unsigned)(R * lda + C) * 2u; voffB[i] = (unsigned)(Rb * K + C) * 2u; }
    const size_t kstep = (size_t)(BK * 2);
    const size_t hstepA = (size_t)HALF * lda * 2, hstepB = (size_t)HALF * K * 2;
    const unsigned ldsw = (unsigned)wid * 1024u;
    const int aoff = lds_byte(wr * 64 + fr, fq * 8), boff = lds_byte(wc * 32 + fr, fq * 8);
#define PG8_SA(b, h) (((b) * 2 + (h)) * HTB)
#define PG8_SB(b, h) ((4 + (b) * 2 + (h)) * HTB)
#define PG8_STAGE(bufoff, gbase, voff) do { _Pragma("unroll") for (int _i = 0; _i < 2; ++_i) \
        __builtin_amdgcn_global_load_lds((const unsigned*)((const char*)(gbase) + (voff)[_i]), (LAS unsigned*)(lds + (bufoff) + ldsw + _i * 8192), 16, 0, 0); } while (0)
#define PG8_LDA(dst, b, h) do { _Pragma("unroll") for (int m = 0; m < 4; ++m) _Pragma("unroll") for (int k = 0; k < 2; ++k) dst[m][k] = *(const LAS bf16x8*)(lds + PG8_SA(b, h) + aoff + m * 2048 + k * 1024); } while (0)
#define PG8_LDB(dst, b, h) do { _Pragma("unroll") for (int n = 0; n < 2; ++n) _Pragma("unroll") for (int k = 0; k < 2; ++k) dst[n][k] = *(const LAS bf16x8*)(lds + PG8_SB(b, h) + boff + n * 2048 + k * 1024); } while (0)
#define PG8_MMA(ai, bj, At, Bt) do { __builtin_amdgcn_s_setprio(1); _Pragma("unroll") for (int m = 0; m < 4; ++m) _Pragma("unroll") for (int n = 0; n < 2; ++n) _Pragma("unroll") for (int k = 0; k < 2; ++k) \
        acc[ai][bj][m][n] = __builtin_amdgcn_mfma_f32_16x16x32_bf16(Bt[n][k], At[m][k], acc[ai][bj][m][n], 0, 0, 0); __builtin_amdgcn_s_setprio(0); } while (0)
#define PG8_WAIT_V(n) asm volatile("s_waitcnt vmcnt(" #n ")" ::: "memory")
#define PG8_WAIT_L(n) asm volatile("s_waitcnt lgkmcnt(" #n ")" ::: "memory")
#define PG8_BAR __builtin_amdgcn_s_barrier()
#define PG8_SCHED __builtin_amdgcn_sched_barrier(0)
#define PG8_ABASE(u) ((const char*)g.A + ((size_t)(u).pm * BM * lda + (size_t)((u).pn >> g.agrp_shift) * g.agrp_stride) * 2)
#define PG8_BBASE(u) ((const char*)g.Bt + (size_t)(u).pn * 2 * hstepB)
    Unit cur, nxt; int ui = 0;
    if (!S.next(0, cur)) return;
    Acc acc;
#pragma unroll
    for (int a = 0; a < 2; ++a)
#pragma unroll
        for (int b = 0; b < 2; ++b)
#pragma unroll
            for (int m = 0; m < 4; ++m)
#pragma unroll
                for (int n = 0; n < 2; ++n) acc[a][b][m][n] = (f32x4){0.f, 0.f, 0.f, 0.f};
    bf16x8 At[4][2], B0[2][2], B1[2][2];
    const char* cA = PG8_ABASE(cur); const char* cB = PG8_BBASE(cur);
    PG8_STAGE(PG8_SB(0, 0), cB, voffB); PG8_STAGE(PG8_SB(0, 1), cB + hstepB, voffB); PG8_STAGE(PG8_SA(0, 0), cA, voffA); PG8_STAGE(PG8_SA(0, 1), cA + hstepA, voffA);
    if (wr == 1) PG8_BAR;
    PG8_WAIT_V(2); PG8_BAR;
    PG8_STAGE(PG8_SB(1, 0), cB + kstep, voffB); PG8_STAGE(PG8_SA(1, 0), cA + kstep, voffA); PG8_STAGE(PG8_SB(1, 1), cB + hstepB + kstep, voffB);
    PG8_WAIT_V(6); PG8_BAR;
    for (;;) {
        const bool has_next = S.next(ui + 1, nxt);
        const char* nA = has_next ? PG8_ABASE(nxt) : cA; const char* nB = has_next ? PG8_BBASE(nxt) : cB;
        for (int t = 0; t < nt; t += 2) {
            const bool last = (t == nt - 2);
            const char* a1 = cA + (size_t)(t + 1) * kstep;
            const char* a2 = last ? nA : cA + (size_t)(t + 2) * kstep; const char* b2 = last ? nB : cB + (size_t)(t + 2) * kstep;
            const char* a3 = a2 + kstep; const char* b3 = b2 + kstep;
            PG8_LDB(B0, 0, 0); PG8_LDB(B1, 0, 1); PG8_SCHED; PG8_LDA(At, 0, 0); PG8_STAGE(PG8_SA(1, 1), a1 + hstepA, voffA);
            PG8_WAIT_V(8); PG8_WAIT_L(0); PG8_BAR; PG8_MMA(0, 0, At, B0); PG8_MMA(0, 1, At, B1); PG8_BAR; PG8_SCHED;
            PG8_LDA(At, 0, 1); PG8_STAGE(PG8_SB(0, 0), b2, voffB); PG8_STAGE(PG8_SB(0, 1), b2 + hstepB, voffB); PG8_STAGE(PG8_SA(0, 0), a2, voffA);
            PG8_WAIT_V(8); PG8_WAIT_L(0); PG8_BAR; PG8_MMA(1, 0, At, B0); PG8_MMA(1, 1, At, B1); PG8_BAR; PG8_SCHED;
            PG8_LDB(B0, 1, 0); PG8_LDB(B1, 1, 1); PG8_SCHED; PG8_LDA(At, 1, 0); PG8_STAGE(PG8_SA(0, 1), a2 + hstepA, voffA);
            PG8_WAIT_V(8); PG8_WAIT_L(0); PG8_BAR; PG8_MMA(0, 0, At, B0); PG8_MMA(0, 1, At, B1); PG8_BAR; PG8_SCHED;
            PG8_LDA(At, 1, 1); PG8_STAGE(PG8_SB(1, 0), b3, voffB); PG8_STAGE(PG8_SB(1, 1), b3 + hstepB, voffB); PG8_STAGE(PG8_SA(1, 0), a3, voffA);
            PG8_WAIT_V(8); PG8_WAIT_L(0); PG8_BAR; PG8_MMA(1, 0, At, B0); PG8_MMA(1, 1, At, B1); PG8_BAR; PG8_SCHED;
        }
        if (wr == 0) PG8_BAR;
        E(acc, cur, wr, wc, fr, fq);
        if (!has_next) break;
#pragma unroll
        for (int a = 0; a < 2; ++a)
#pragma unroll
            for (int b = 0; b < 2; ++b)
#pragma unroll
                for (int m = 0; m < 4; ++m)
#pragma unroll
                    for (int n = 0; n < 2; ++n) acc[a][b][m][n] = (f32x4){0.f, 0.f, 0.f, 0.f};
        cur = nxt; cA = nA; cB = nB; ++ui;
        if (wr == 1) PG8_BAR;
    }
    PG8_WAIT_V(0);
    PG8_BAR;
#undef PG8_SA
#undef PG8_SB
#undef PG8_STAGE
#undef PG8_LDA
#undef PG8_LDB
#undef PG8_MMA
#undef PG8_WAIT_V
#undef PG8_WAIT_L
#undef PG8_BAR
#undef PG8_SCHED
#undef PG8_ABASE
#undef PG8_BBASE
}
}

struct Args { const float* in[23]; float* out; unsigned char* ws; int ph_lo, ph_hi; };

__device__ __forceinline__ void cvt_item(const float* src, int K, int N, bf16_t* dst, int ldd, int mode, int r0, int c0, LAS float* scr, int li, int lane) {
    const int nblk = (N + 31) >> 5, kb = li / nblk, nb = li % nblk, k0 = 64 * kb, n0 = 32 * nb;
    { const int cc = lane & 7, rr = lane >> 3; const bool ok = n0 + 4 * cc < N;
      f32x4 t[8];
#pragma unroll
      for (int i = 0; i < 8; ++i) t[i] = ok ? *(const f32x4*)(src + (size_t)(k0 + 8 * i + rr) * N + n0 + 4 * cc) : (f32x4){0.f, 0.f, 0.f, 0.f};
#pragma unroll
      for (int i = 0; i < 8; ++i) { LAS float* d = scr + (8 * i + rr) * 33 + 4 * cc; d[0] = t[i][0]; d[1] = t[i][1]; d[2] = t[i][2]; d[3] = t[i][3]; } }
    LDS_WAIT();
    const int c = lane & 7;
#pragma unroll
    for (int j = 0; j < 4; ++j) { const int nl = (lane >> 3) + 8 * j, n = n0 + nl; const LAS float* s = scr + (8 * c) * 33 + nl;
        u32x4 o; o.x = cvt_pk_bf16(s[0 * 33], s[1 * 33]); o.y = cvt_pk_bf16(s[2 * 33], s[3 * 33]); o.z = cvt_pk_bf16(s[4 * 33], s[5 * 33]); o.w = cvt_pk_bf16(s[6 * 33], s[7 * 33]);
        if (n < N) { const int drow = mode ? ((n >> 7) * 256 + (n & 127) + r0) : (r0 + n); *(u32x4*)(dst + (size_t)drow * ldd + c0 + k0 + 8 * c) = o; } }
    LDS_WAIT();
}

__device__ __forceinline__ void p0_phase(const Args& a, LAS unsigned char* lds, int bid, int G) {
    int tid = threadIdx.x; asm volatile("" : "+v"(tid));
    const int lane = tid & 63, wave = __builtin_amdgcn_readfirstlane(tid >> 6);
    unsigned char* ws = a.ws;
    LAS float* scr = (LAS float*)(lds + wave * 8704);
    const int gw = bid * 8 + wave, NGW = G * 8;
    constexpr int NITEMS = 1888 + 256 + 256 + 1024 + 4096 + 2048 + 11264 + 5632;
    for (int it = gw; it < NITEMS; it += NGW) {
        int r = it;
        if (r < 1888) { const int j = r / 944; cvt_item(a.in[6] + (size_t)j * 1024 * AIN, 1024, AIN, (bf16_t*)(ws + W_AIN) + (size_t)j * 2048 * 1024, 1024, 0, 0, 0, scr, r % 944, lane); continue; } r -= 1888;
        if (r < 256) { const int jj = r >> 4, la = jj >> 3, h = jj & 7; cvt_item(a.in[10] + (size_t)(la * 8 + h) * 128 * 256, 128, 256, (bf16_t*)(ws + W_UK) + (size_t)la * 2048 * 256, 256, 0, h * 256, (h & 1) * 128, scr, r & 15, lane); continue; } r -= 256;
        if (r < 256) { const int jj = r >> 4, la = jj >> 3, h = jj & 7; cvt_item(a.in[11] + (size_t)(la * 8 + h) * 256 * 128, 256, 128, (bf16_t*)(ws + W_UV) + (size_t)la * 1024 * 512, 512, 0, (h >> 1) * 256 + (h & 1) * 128, (h & 1) * 256, scr, r & 15, lane); continue; } r -= 256;
        if (r < 1024) { const int la = r >> 9; cvt_item(a.in[12] + (size_t)la * 1024 * 1024, 1024, 1024, (bf16_t*)(ws + W_O) + (size_t)la * 1024 * 1024, 1024, 0, 0, 0, scr, r & 511, lane); continue; } r -= 1024;
        if (r < 4096) { const int la = r >> 11; cvt_item(a.in[13] + (size_t)la * 1024 * 4096, 1024, 4096, (bf16_t*)(ws + W_BIN) + (size_t)la * 4096 * 1024, 1024, 0, 0, 0, scr, r & 2047, lane); continue; } r -= 4096;
        if (r < 2048) { const int la = r >> 10; cvt_item(a.in[18] + (size_t)la * 2048 * 1024, 2048, 1024, (bf16_t*)(ws + W_BOUT) + (size_t)la * 1024 * 2048, 2048, 0, 0, 0, scr, r & 1023, lane); continue; } r -= 2048;
        if (r < 11264) { const int jj = r / 1408, l = jj & 3, isup = jj >> 2; cvt_item(a.in[isup ? 20 : 19] + (size_t)l * 1024 * DFF, 1024, DFF, (bf16_t*)(ws + W_GU) + (size_t)l * 5632 * 1024, 1024, 1, isup * 128, 0, scr, r % 1408, lane); continue; } r -= 11264;
        { const int l = r / 1408; cvt_item(a.in[21] + (size_t)l * DFF * 1024, DFF, 1024, (bf16_t*)(ws + W_DN) + (size_t)l * 1024 * DFF, DFF, 0, 0, 0, scr, r % 1408, lane); }
    }
    const size_t gt = (size_t)bid * 512 + tid, NT = (size_t)G * 512;
    const u32x4 z = (u32x4){0u, 0u, 0u, 0u};
    for (size_t i = gt; i < 2 * 184 * 128; i += NT) { const int j = (int)(i / (184 * 128)), rem = (int)(i % (184 * 128)), rr = AIN + rem / 128, ch = rem % 128;
        *(u32x4*)((bf16_t*)(ws + W_AIN) + ((size_t)j * 2048 + rr) * 1024 + ch * 8) = z; }
    for (size_t i = gt; i < 2 * 2048 * 16; i += NT) { const int j = (int)(i / (2048 * 16)), rem = (int)(i % (2048 * 16)), rr = rem >> 4, ch = rem & 15, h = rr >> 8;
        *(u32x4*)((bf16_t*)(ws + W_UK) + ((size_t)j * 2048 + rr) * 256 + (1 - (h & 1)) * 128 + ch * 8) = z; }
    for (size_t i = gt; i < 2 * 1024 * 32; i += NT) { const int j = (int)(i / (1024 * 32)), rem = (int)(i % (1024 * 32)), rr = rem >> 5, ch = rem & 31, hh = (rr >> 7) & 1;
        *(u32x4*)((bf16_t*)(ws + W_UV) + ((size_t)j * 1024 + rr) * 512 + (1 - hh) * 256 + ch * 8) = z; }
    __syncthreads();
    LAS float* ca = (LAS float*)lds;
    const float* cvec = a.in[1]; const float* modw = a.in[2]; float* MODP = (float*)(ws + WS_MODP);
    for (int it = bid; it < 768; it += G) {
        const int l = it / 192, rem = it % 192, ng = rem >> 4, kc = rem & 15;
        { const int b = tid >> 6, k = tid & 63; const float cv = cvec[b * 1024 + kc * 64 + k]; ca[b * 64 + k] = cv / (1.0f + __expf(-cv)); }
        __syncthreads();
        const int n = ng * 512 + tid; float acc[8];
#pragma unroll
        for (int b = 0; b < 8; ++b) acc[b] = 0.f;
        const float* wp = modw + ((size_t)l * 1024 + kc * 64) * NMOD + n;
#pragma unroll 8
        for (int k = 0; k < 64; ++k) { const float w = wp[(size_t)k * NMOD];
#pragma unroll
            for (int b = 0; b < 8; ++b) acc[b] += ca[b * 64 + k] * w; }
#pragma unroll
        for (int b = 0; b < 8; ++b) MODP[((size_t)(kc * 4 + l) * 8 + b) * NMOD + n] = acc[b];
        __syncthreads();
    }
}
__device__ __forceinline__ void p0c_phase(const Args& a, int bid, int G) {
    const float* MODP = (const float*)(a.ws + WS_MODP); float* MOD = (float*)(a.ws + WS_MOD); const float* modb = a.in[3];
    int tid0 = threadIdx.x; asm volatile("" : "+v"(tid0));
    for (int i = bid * 512 + tid0; i < 4 * 8 * NMOD; i += G * 512) { const int l = i / (8 * NMOD), n = i % NMOD; float s = modb[l * NMOD + n];
#pragma unroll
        for (int kc = 0; kc < 16; ++kc) s += MODP[(size_t)kc * (4 * 8 * NMOD) + i];
        MOD[i] = s; }
}

template <bool FIRST>
__device__ __forceinline__ void norm_mod_phase(const float* x32, _Float16* x16, const float* gain, const float* sh, const float* sc, bf16_t* H, int bid, int G) {
    int tid = threadIdx.x; asm volatile("" : "+v"(tid));
    const int lane = tid & 63, wave = tid >> 6;
    for (int rb = (bid * 8 + wave) * 16; rb < M; rb += G * 8 * 16) {
        const int b = rb / T; f32x4 gs[4], sv[4];
#pragma unroll
        for (int j = 0; j < 4; ++j) { const int c = 8 * lane + 512 * (j >> 1) + 4 * (j & 1); const f32x4 g4 = *(const f32x4*)(gain + c), s4 = *(const f32x4*)(sc + (size_t)b * NMOD + c); gs[j] = g4 * (s4 + 1.0f); sv[j] = *(const f32x4*)(sh + (size_t)b * NMOD + c); }
        f32x4 nx[4]; f16x8 nh[2];
        if (FIRST) {
#pragma unroll
            for (int j = 0; j < 4; ++j) nx[j] = *(const f32x4*)(x32 + (size_t)rb * D + 8 * lane + 512 * (j >> 1) + 4 * (j & 1)); }
        else {
#pragma unroll
            for (int j = 0; j < 2; ++j) nh[j] = *(const f16x8*)(x16 + (size_t)rb * D + 8 * lane + 512 * j); }
        for (int r = rb; r < rb + 16; ++r) {
            f32x4 v[4];
            if (FIRST) {
#pragma unroll
                for (int j = 0; j < 4; ++j) v[j] = nx[j];
#pragma unroll
                for (int j = 0; j < 2; ++j) *(f16x8*)(x16 + (size_t)r * D + 8 * lane + 512 * j) = __builtin_convertvector((f32x8){v[2 * j][0], v[2 * j][1], v[2 * j][2], v[2 * j][3], v[2 * j + 1][0], v[2 * j + 1][1], v[2 * j + 1][2], v[2 * j + 1][3]}, f16x8);
            } else {
#pragma unroll
                for (int j = 0; j < 2; ++j) { const f32x8 t = __builtin_convertvector(nh[j], f32x8); v[2 * j] = (f32x4){t[0], t[1], t[2], t[3]}; v[2 * j + 1] = (f32x4){t[4], t[5], t[6], t[7]}; }
            }
            const int rn = (r + 1 < rb + 16) ? r + 1 : r;
            if (FIRST) {
#pragma unroll
                for (int j = 0; j < 4; ++j) nx[j] = *(const f32x4*)(x32 + (size_t)rn * D + 8 * lane + 512 * (j >> 1) + 4 * (j & 1)); }
            else {
#pragma unroll
                for (int j = 0; j < 2; ++j) nh[j] = *(const f16x8*)(x16 + (size_t)rn * D + 8 * lane + 512 * j); }
            float ss = 0.f;
#pragma unroll
            for (int j = 0; j < 4; ++j) ss += (v[j][0] * v[j][0] + v[j][1] * v[j][1]) + (v[j][2] * v[j][2] + v[j][3] * v[j][3]);
            const float rstd = rsqrtf(wave_sum(ss) * (1.0f / D) + EPS);
#pragma unroll
            for (int j = 0; j < 2; ++j) { const f32x4 y0 = v[2 * j] * rstd * gs[2 * j] + sv[2 * j], y1 = v[2 * j + 1] * rstd * gs[2 * j + 1] + sv[2 * j + 1];
                u32x4 w; w.x = cvt_pk_bf16(y0[0], y0[1]); w.y = cvt_pk_bf16(y0[2], y0[3]); w.z = cvt_pk_bf16(y1[0], y1[1]); w.w = cvt_pk_bf16(y1[2], y1[3]);
                *(u32x4*)(H + (size_t)r * D + 8 * lane + 512 * j) = w; }
        }
    }
}
__device__ __forceinline__ void final_norm_phase(const _Float16* x16, const float* gain, float* out, int bid, int G) {
    int tid = threadIdx.x; asm volatile("" : "+v"(tid));
    const int lane = tid & 63, wave = tid >> 6;
    f32x4 gs[4];
#pragma unroll
    for (int j = 0; j < 4; ++j) gs[j] = *(const f32x4*)(gain + 8 * lane + 512 * (j >> 1) + 4 * (j & 1));
    f16x8 nh[2];
    { const int r0 = bid * 8 + wave;
#pragma unroll
      for (int j = 0; j < 2; ++j) nh[j] = *(const f16x8*)(x16 + (size_t)r0 * D + 8 * lane + 512 * j); }
    for (int r = bid * 8 + wave; r < M; r += G * 8) {
        f32x4 v[4]; float ss = 0.f;
#pragma unroll
        for (int j = 0; j < 2; ++j) { const f32x8 t = __builtin_convertvector(nh[j], f32x8); v[2 * j] = (f32x4){t[0], t[1], t[2], t[3]}; v[2 * j + 1] = (f32x4){t[4], t[5], t[6], t[7]}; }
        const int rn = (r + G * 8 < M) ? r + G * 8 : r;
#pragma unroll
        for (int j = 0; j < 2; ++j) nh[j] = *(const f16x8*)(x16 + (size_t)rn * D + 8 * lane + 512 * j);
#pragma unroll
        for (int j = 0; j < 4; ++j) ss += (v[j][0] * v[j][0] + v[j][1] * v[j][1]) + (v[j][2] * v[j][2] + v[j][3] * v[j][3]);
        const float rstd = rsqrtf(wave_sum(ss) * (1.0f / D) + EPS);
#pragma unroll
        for (int j = 0; j < 4; ++j) *(f32x4*)(out + (size_t)r * D + 8 * lane + 512 * (j >> 1) + 4 * (j & 1)) = v[j] * rstd * gs[j];
    }
}
__device__ __forceinline__ void dsa_rows_phase(const float* CKVR, const float* KRAW, const float* gkv, const float* gk, const float* bk, bf16_t* CKV, bf16_t* KIDX, float* WIDX, int bid, int G) {
    int tid = threadIdx.x; asm volatile("" : "+v"(tid));
    const int lane = tid & 63, wave = tid >> 6;
    const f32x4 g4 = *(const f32x4*)(gkv + 4 * lane);
    f32x4 gk4 = (f32x4){0.f, 0.f, 0.f, 0.f}, bk4 = gk4;
    if (lane < 16) { gk4 = *(const f32x4*)(gk + 4 * lane); bk4 = *(const f32x4*)(bk + 4 * lane); }
    for (int r = bid * 8 + wave; r < M; r += G * 8) {
        const f32x4 v = *(const f32x4*)(CKVR + (size_t)r * 256 + 4 * lane);
        f32x4 kv = (f32x4){0.f, 0.f, 0.f, 0.f}; if (lane < 32) kv = *(const f32x4*)(KRAW + (size_t)r * 128 + 4 * lane);
        const float ss = wave_sum((v[0] * v[0] + v[1] * v[1]) + (v[2] * v[2] + v[3] * v[3]));
        const float rstd = rsqrtf(ss * (1.0f / 256.0f) + EPS);
        { const f32x4 y = v * rstd * g4; int w = 0; w = __builtin_amdgcn_cvt_pk_fp8_f32(y[0], y[1], w, false); w = __builtin_amdgcn_cvt_pk_fp8_f32(y[2], y[3], w, true); *(int*)((unsigned char*)CKV + (size_t)r * 256 + 4 * lane) = w; }
        const float ks = (lane < 16) ? (kv[0] + kv[1]) + (kv[2] + kv[3]) : 0.f;
        const float mean = wave_sum(ks) * (1.0f / 64.0f);
        const f32x4 dv = kv - mean;
        const float kq = (lane < 16) ? (dv[0] * dv[0] + dv[1] * dv[1]) + (dv[2] * dv[2] + dv[3] * dv[3]) : 0.f;
        const float krstd = rsqrtf(wave_sum(kq) * (1.0f / 64.0f) + EPS);
        if (lane < 16) { const f32x4 y = dv * krstd * gk4 + bk4; u32x2 w; w.x = cvt_pk_bf16(y[0], y[1]); w.y = cvt_pk_bf16(y[2], y[3]); *(u32x2*)(KIDX + ((((size_t)(r >> 5) * 4 + (lane >> 2)) * 64 + (((lane >> 1) & 1) * 32 + (r & 31))) * 8 + (lane & 1) * 4)) = w; }
        else if (lane < 18) { *(f32x4*)(WIDX + (size_t)r * 8 + 4 * (lane - 16)) = kv * 0.04419417382f; }
    }
}

__device__ __forceinline__ float relu_i(float x) { const int b = __float_as_int(x); return __int_as_float(b > 0 ? b : 0); }
__device__ __forceinline__ float relu_mul(float x, float w) { return relu_i(x) * w; }
__device__ __forceinline__ float relu_fma(float x, float w, float acc) { return __builtin_fmaf(relu_i(x), w, acc); }
__device__ __forceinline__ float fmin_raw(float a, float b) { return __builtin_amdgcn_fmed3f(a, b, -__builtin_inff()); }
__device__ __forceinline__ float fmax_raw(float a, float b) { return __builtin_amdgcn_fmed3f(a, b, __builtin_inff()); }
__device__ __forceinline__ unsigned mbcnt64(unsigned long long m) { return __builtin_amdgcn_mbcnt_hi((unsigned)(m >> 32), __builtin_amdgcn_mbcnt_lo((unsigned)m, 0u)); }

template <int SHIFT, int WIDTH>
__device__ __forceinline__ void sel_level(const unsigned (&k)[64], int N, LAS unsigned* hist, int lane, unsigned& prefix, unsigned& need) {
    LAS u32x4* hz = (LAS u32x4*)(hist + 32 * lane);
#pragma unroll
    for (int j = 0; j < 8; ++j) hz[j] = (u32x4){0u, 0u, 0u, 0u};
    LDS_WAIT();
#pragma unroll
    for (int gi = 0; gi < 8; ++gi) if (512 * gi < N) {
#pragma unroll
        for (int ii = 0; ii < 8; ++ii) { const unsigned key = k[8 * gi + ii]; const bool ok = (key >> (SHIFT + WIDTH)) == prefix;
            LAS unsigned* p = ok ? hist + ((key >> SHIFT) & ((1u << WIDTH) - 1u)) : hist + 2048 + lane;
            __hip_atomic_fetch_add(p, 1u, __ATOMIC_RELAXED, __HIP_MEMORY_SCOPE_WORKGROUP); } }
    LDS_WAIT();
    u32x4 hv[8]; unsigned ls = 0u;
#pragma unroll
    for (int j = 0; j < 8; ++j) { hv[j] = hz[j]; ls += (hv[j][0] + hv[j][1]) + (hv[j][2] + hv[j][3]); }
    unsigned incl = ls;
#pragma unroll
    for (int o = 1; o < 64; o <<= 1) { const unsigned v = bperm_u((lane + o) & 63, incl); if (lane + o < 64) incl += v; }
    const unsigned above = incl - ls;
    unsigned cnt = above, d = 0u, nn = 0u;
#pragma unroll
    for (int j = 31; j >= 0; --j) { const unsigned h = hv[j >> 2][j & 3]; const bool hit = (cnt < need) && (need <= cnt + h); d = hit ? (unsigned)(32 * lane + j) : d; nn = hit ? need - cnt : nn; cnt += h; }
    const bool found = (above < need) && (need <= above + ls);
    const unsigned long long fm = __ballot(found);
    const int src = (fm != 0ull) ? (__ffsll((long long)fm) - 1) : 0;
    d = bperm_u(src, d); need = bperm_u(src, nn);
    prefix = (prefix << WIDTH) | d;
}

__device__ __forceinline__ void dsa_select_phase(LAS unsigned char* lds, const bf16_t* QIDX, const bf16_t* KIDX, const float* WIDX, unsigned short* IDX, int bid, int G) {
    int tid0 = threadIdx.x; asm volatile("" : "+v"(tid0));
    const int wave = __builtin_amdgcn_readfirstlane(tid0 >> 6);
    LAS float* SC = (LAS float*)lds;
    LAS unsigned short* IDXL = (LAS unsigned short*)(lds + 135168) + wave * 256;
    LAS float* MM = (LAS float*)(lds + 139264);
    bf16x8 af[2][4]; bf16x8 kb[4][4];
#define DSA_UNIT(itx, b_, t0_, mb_, ntile_, nj_) const int b_ = (itx) & 7, t0_ = ((itx) >> 3) * 8; const size_t mb_ = (size_t)b_ * T; \
    const int ntile_ = (t0_ + 8 + 31) >> 5; const int nj_ = (wave < ntile_) ? ((ntile_ - wave + 7) >> 3) : 0;
#define DSA_KLOAD(buf, j, kbase_, nj_) do { const int jc_ = ((j) < (nj_)) ? (j) : ((nj_) > 0 ? (nj_) - 1 : 0); const bf16_t* kp_ = (kbase_) + (size_t)(wave + 8 * jc_) * 2048; \
    _Pragma("unroll") for (int ks = 0; ks < 4; ++ks) kb[buf][ks] = *(const bf16x8*)(kp_ + 512 * ks); } while (0)
#define DSA_PRELOAD(t0_, mb_, nj_) do { \
    _Pragma("unroll") for (int rg = 0; rg < 2; ++rg) { const bf16_t* qp = QIDX + ((mb_) + (t0_) + 4 * rg + (col >> 3)) * 512 + (col & 7) * 64 + 8 * hf; \
        _Pragma("unroll") for (int ks = 0; ks < 4; ++ks) af[rg][ks] = *(const bf16x8*)(qp + 16 * ks); } \
    (void)(nj_); } while (0)
    { int tid = tid0; asm volatile("" : "+v"(tid)); const int lane = tid & 63, hf = lane >> 5, col = lane & 31;
      if (bid < 4096) { DSA_UNIT(bid, b, t0, mb, ntile, nj) (void)b; (void)ntile; if (t0 + 8 > 256) DSA_PRELOAD(t0, mb, nj); } }
    for (int it = bid; it < 4096; it += G) {
        int tid = tid0; asm volatile("" : "+v"(tid));
        const int lane = tid & 63, hf = lane >> 5, col = lane & 31;
        DSA_UNIT(it, b, t0, mb, ntile, nj) (void)b; (void)ntile;
        const int t = t0 + wave, N = t + 1;
        unsigned short* outp = IDX + (mb + t) * 256;
        const int itn = it + G; const bool hasn = itn < 4096;
        DSA_UNIT(hasn ? itn : it, bn, t0n, mbn, ntilen, njn) (void)bn; (void)ntilen;
        if (t0 + 8 <= 256) {
            *(u32x2*)(outp + 4 * lane) = (u32x2){(unsigned)(4 * lane) | ((unsigned)(4 * lane + 1) << 16), (unsigned)(4 * lane + 2) | ((unsigned)(4 * lane + 3) << 16)};
            if (hasn && t0n + 8 > 256) DSA_PRELOAD(t0n, mbn, njn);
            continue;
        }
        float w[2][4][4]; float mn[2][2], mx[2][2];
#pragma unroll
        for (int rg = 0; rg < 2; ++rg)
#pragma unroll
            for (int e = 0; e < 2; ++e) { mn[rg][e] = 3.0e38f; mx[rg][e] = -3.0e38f; }
        const bf16_t* kbase = KIDX + mb * 64 + (size_t)lane * 8;
        DSA_KLOAD(0, 0, kbase, nj); DSA_KLOAD(1, 1, kbase, nj); DSA_KLOAD(2, 2, kbase, nj); DSA_KLOAD(3, 3, kbase, nj);
#pragma unroll
        for (int rg = 0; rg < 2; ++rg)
#pragma unroll
            for (int qq = 0; qq < 4; ++qq) { const f32x4 wv = *(const f32x4*)(WIDX + (mb + t0 + 4 * rg + qq) * 8 + 4 * hf);
                w[rg][qq][0] = wv[0]; w[rg][qq][1] = wv[1]; w[rg][qq][2] = wv[2]; w[rg][qq][3] = wv[3]; }
#define DSA_KCOMP(buf, j) do { const int s_ = 32 * (wave + 8 * (j)) + col; f32x16 acc0, acc1; \
    _Pragma("unroll") for (int i = 0; i < 16; ++i) { acc0[i] = 0.f; acc1[i] = 0.f; } \
    _Pragma("unroll") for (int ks = 0; ks < 4; ++ks) { acc0 = __builtin_amdgcn_mfma_f32_32x32x16_bf16(af[0][ks], kb[buf][ks], acc0, 0, 0, 0); acc1 = __builtin_amdgcn_mfma_f32_32x32x16_bf16(af[1][ks], kb[buf][ks], acc1, 0, 0, 0); } \
    _Pragma("unroll") for (int rg = 0; rg < 2; ++rg) { float p[4]; \
        _Pragma("unroll") for (int qq = 0; qq < 4; ++qq) { p[qq] = relu_mul(rg ? acc1[4 * qq] : acc0[4 * qq], w[rg][qq][0]); _Pragma("unroll") for (int ii = 1; ii < 4; ++ii) p[qq] = relu_fma(rg ? acc1[4 * qq + ii] : acc0[4 * qq + ii], w[rg][qq][ii], p[qq]); } \
        _Pragma("unroll") for (int e = 0; e < 2; ++e) { const auto r = __builtin_amdgcn_permlane32_swap(__float_as_uint(p[e]), __float_as_uint(p[2 + e]), false, false); \
            const float tot = __uint_as_float(r[0]) + __uint_as_float(r[1]); SC[(4 * rg + 2 * hf + e) * 4096 + s_] = tot; mn[rg][e] = fmin_raw(mn[rg][e], tot); mx[rg][e] = fmax_raw(mx[rg][e], tot); } } } while (0)
        for (int j = 0; j < nj; j += 4) {
            DSA_KCOMP(0, j); if (j + 4 < nj) DSA_KLOAD(0, j + 4, kbase, nj);
            if (j + 1 < nj) DSA_KCOMP(1, j + 1);
            if (j + 5 < nj) DSA_KLOAD(1, j + 5, kbase, nj);
            if (j + 2 < nj) DSA_KCOMP(2, j + 2);
            if (j + 6 < nj) DSA_KLOAD(2, j + 6, kbase, nj);
            if (j + 3 < nj) DSA_KCOMP(3, j + 3);
            if (j + 7 < nj) DSA_KLOAD(3, j + 7, kbase, nj);
        }
#pragma unroll
        for (int rg = 0; rg < 2; ++rg)
#pragma unroll
            for (int e = 0; e < 2; ++e) {
#pragma unroll
                for (int o = 1; o < 32; o <<= 1) { mn[rg][e] = fminf(mn[rg][e], bperm_f(lane ^ o, mn[rg][e])); mx[rg][e] = fmaxf(mx[rg][e], bperm_f(lane ^ o, mx[rg][e])); }
                if (col == 0) { MM[(wave * 8 + 4 * rg + 2 * hf + e) * 2] = mn[rg][e]; MM[(wave * 8 + 4 * rg + 2 * hf + e) * 2 + 1] = mx[rg][e]; } }
        if (hasn && t0n + 8 > 256) DSA_PRELOAD(t0n, mbn, njn);
        __syncthreads();
        {
            const LAS float* scl = SC + wave * 4096 + lane;
            LAS unsigned* hist = (LAS unsigned*)(lds + wave * 16384);
            float lo = 3.0e38f, hi = -3.0e38f;
#pragma unroll
            for (int wv = 0; wv < 8; ++wv) { lo = fminf(lo, MM[(wv * 8 + wave) * 2]); hi = fmaxf(hi, MM[(wv * 8 + wave) * 2 + 1]); }
            const float scale = 4.0e9f / fmaxf(hi - lo, 1e-30f);
            unsigned k[64];
#pragma unroll
            for (int gi = 0; gi < 8; ++gi) { if (512 * gi < N) {
#pragma unroll
                for (int ii = 0; ii < 8; ++ii) k[8 * gi + ii] = __float_as_uint(scl[64 * (8 * gi + ii)]); } else {
#pragma unroll
                for (int ii = 0; ii < 8; ++ii) k[8 * gi + ii] = 0u; } }
            LDS_WAIT();
            { LAS u32x4* hz = (LAS u32x4*)(hist + 16 * lane);
#pragma unroll
              for (int j = 0; j < 4; ++j) hz[j] = (u32x4){0u, 0u, 0u, 0u}; }
            LDS_WAIT();
#pragma unroll
            for (int gi = 0; gi < 8; ++gi) if (512 * gi < N) {
#pragma unroll
                for (int ii = 0; ii < 8; ++ii) { const int i = 8 * gi + ii; const bool valid = lane < N - 64 * i;
                    const unsigned key = valid ? 1u + (unsigned)((__uint_as_float(k[i]) - lo) * scale) : 0u; k[i] = key;
                    LAS unsigned* p = valid ? hist + (key >> 22) : hist + 1024 + lane;
                    __hip_atomic_fetch_add(p, 1u, __ATOMIC_RELAXED, __HIP_MEMORY_SCOPE_WORKGROUP); } }
            LDS_WAIT();
            unsigned d0, need1;
            { const LAS u32x4* hz = (const LAS u32x4*)(hist + 16 * lane); u32x4 hv[4]; unsigned ls = 0u;
#pragma unroll
              for (int j = 0; j < 4; ++j) { hv[j] = hz[j]; ls += (hv[j][0] + hv[j][1]) + (hv[j][2] + hv[j][3]); }
              unsigned incl = ls;
#pragma unroll
              for (int o = 1; o < 64; o <<= 1) { const unsigned v = bperm_u((lane + o) & 63, incl); if (lane + o < 64) incl += v; }
              const unsigned above = incl - ls; unsigned cnt = above, d = 0u, nn = 0u;
#pragma unroll
              for (int j = 15; j >= 0; --j) { const unsigned h = hv[j >> 2][j & 3]; const bool hit = (cnt < 256u) && (256u <= cnt + h); d = hit ? (unsigned)(16 * lane + j) : d; nn = hit ? 256u - cnt : nn; cnt += h; }
              const bool found = (above < 256u) && (256u <= above + ls);
              const unsigned long long fm = __ballot(found);
              const int src = (fm != 0ull) ? (__ffsll((long long)fm) - 1) : 0;
              d0 = bperm_u(src, d); need1 = bperm_u(src, nn); }
            LAS unsigned* CK = hist + 1100; LAS unsigned short* CS = (LAS unsigned short*)(hist + 1170);
            unsigned base = 0u, cbase = 0u;
#pragma unroll
            for (int gi = 0; gi < 8; ++gi) if (512 * gi < N) {
#pragma unroll
                for (int ii = 0; ii < 8; ++ii) { const int i = 8 * gi + ii; const unsigned key = k[i], dg = key >> 22;
                    const bool gt = dg > d0, eq = (dg == d0) && (key != 0u);
                    const unsigned long long mgt = __ballot(gt), meq = __ballot(eq);
                    if (gt) IDXL[base + mbcnt64(mgt)] = (unsigned short)(64 * i + lane);
                    base += (unsigned)__popcll(mgt);
                    if (meq != 0ull) { const unsigned cp = cbase + mbcnt64(meq); if (eq && cp < 64u) { CK[cp] = key; CS[cp] = (unsigned short)(64 * i + lane); } cbase += (unsigned)__popcll(meq); } } }
            LDS_WAIT();
            if (cbase <= 64u) {
                const unsigned mykey = (lane < (int)cbase) ? CK[lane] : 0u; unsigned rank = 0u;
                for (unsigned j = 0; j < cbase; ++j) { const unsigned kj = CK[j]; rank += ((kj > mykey) || (kj == mykey && j < (unsigned)lane)) ? 1u : 0u; }
                const bool sel = (lane < (int)cbase) && (rank < need1);
                const unsigned long long ms = __ballot(sel);
                if (sel) IDXL[base + mbcnt64(ms)] = CS[lane];
            } else {
                unsigned prefix = d0, need = need1;
                LDS_WAIT();
                sel_level<11, 11>(k, N, hist, lane, prefix, need);
                sel_level<0, 11>(k, N, hist, lane, prefix, need);
                unsigned eb = 0u, eqb = 0u;
#pragma unroll
                for (int gi = 0; gi < 8; ++gi) if (512 * gi < N) {
#pragma unroll
                    for (int ii = 0; ii < 8; ++ii) { const int i = 8 * gi + ii; const unsigned key = k[i]; const bool gt = key > prefix, eq = key == prefix;
                        const unsigned long long meq = __ballot(eq); const bool sel = gt || (eq && (eqb + mbcnt64(meq) < need));
                        const unsigned long long msel = __ballot(sel); const unsigned pos = eb + mbcnt64(msel);
                        if (sel && pos < 256u) IDXL[pos] = (unsigned short)(64 * i + lane);
                        eb += (unsigned)__popcll(msel); eqb += (unsigned)__popcll(meq); } }
            }
            LDS_WAIT();
            *(u32x2*)(outp + 4 * lane) = *(const LAS u32x2*)(IDXL + 4 * lane);
        }
        __syncthreads();
    }
#undef DSA_UNIT
#undef DSA_KLOAD
#undef DSA_PRELOAD
#undef DSA_KCOMP
}

__device__ __forceinline__ void dsa_attn_phase(LAS unsigned char* lds, const unsigned char* QLAT8, const unsigned char* CKV8, const unsigned short* IDX, bf16_t* OLAT, int bid, int G) {
    int tid0 = threadIdx.x; asm volatile("" : "+v"(tid0));
    const int wave = __builtin_amdgcn_readfirstlane(tid0 >> 6);
    LAS unsigned char* tile0 = lds + wave * 17408;
    constexpr int TS = 8704, RS = 272;
    constexpr float SCL = 1.4426950408889634f / 16.0f;
    unsigned ixw[8]; u32x4 qf[4]; u32x4 ra[2][2][4];
#define ATT_Q(itx, b_, t_, m_, cnt_) const int b_ = (itx) & 7, t_ = ((itx) >> 3) * 8 + wave; const size_t m_ = (size_t)b_ * T + t_; const int cnt_ = (t_ + 1 < 256) ? t_ + 1 : 256;
#define ATT_LOAD_IX(dst, m_) do { const u32x4 xa_ = *(const u32x4*)(IDX + (m_) * 256 + 16 * c16), xb_ = *(const u32x4*)(IDX + (m_) * 256 + 16 * c16 + 8); \
    dst[0] = xa_[0]; dst[1] = xa_[1]; dst[2] = xa_[2]; dst[3] = xa_[3]; dst[4] = xb_[0]; dst[5] = xb_[1]; dst[6] = xb_[2]; dst[7] = xb_[3]; } while (0)
#define ATT_LOAD_QF(dst, m_) do { const unsigned char* qp_ = QLAT8 + (m_) * 2048 + hd * 256 + 16 * g; _Pragma("unroll") for (int kk = 0; kk < 4; ++kk) dst[kk] = *(const u32x4*)(qp_ + 64 * kk); } while (0)
#define ATT_LOAD_ROWS(buf, ix_, n0_, b_, cnt_) do { const int n1_ = (n0_) + 1; \
    const int k0_ = (16 * c16 + (n0_) < (cnt_)) ? (int)(ix_[(n0_) >> 1] & 0xffffu) : 0, k1_ = (16 * c16 + n1_ < (cnt_)) ? (int)(ix_[n1_ >> 1] >> 16) : 0; \
    const unsigned char* cb_ = CKV8 + (size_t)(b_) * T * 256 + 16 * g; \
    _Pragma("unroll") for (int kk = 0; kk < 4; ++kk) { ra[buf][0][kk] = *(const u32x4*)(cb_ + (size_t)k0_ * 256 + 64 * kk); ra[buf][1][kk] = *(const u32x4*)(cb_ + (size_t)k1_ * 256 + 64 * kk); } } while (0)
#define ATT_QK(bf, d0, d1) do { d0 = (f32x4){0.f, 0.f, 0.f, 0.f}; d1 = d0; \
    _Pragma("unroll") for (int kk = 0; kk < 4; ++kk) _Pragma("unroll") for (int hh = 0; hh < 2; ++hh) { \
        const long qv_ = (long)(((unsigned long long)qf[kk][2 * hh + 1] << 32) | qf[kk][2 * hh]); \
        const long a0_ = (long)(((unsigned long long)ra[bf][0][kk][2 * hh + 1] << 32) | ra[bf][0][kk][2 * hh]); \
        const long a1_ = (long)(((unsigned long long)ra[bf][1][kk][2 * hh + 1] << 32) | ra[bf][1][kk][2 * hh]); \
        d0 = __builtin_amdgcn_mfma_f32_16x16x32_fp8_fp8(a0_, qv_, d0, 0, 0, 0); d1 = __builtin_amdgcn_mfma_f32_16x16x32_fp8_fp8(a1_, qv_, d1, 0, 0, 0); } \
    _Pragma("unroll") for (int kk = 0; kk < 4; ++kk) { *(LAS u32x4*)(tile0 + (bf) * TS + c16 * RS + 64 * kk + 16 * g) = ra[bf][0][kk]; *(LAS u32x4*)(tile0 + (bf) * TS + (16 + c16) * RS + 64 * kk + 16 * g) = ra[bf][1][kk]; } } while (0)
    { int tid = tid0; asm volatile("" : "+v"(tid)); const int lane = tid & 63, g = lane >> 4, c16 = lane & 15, hd = c16 & 7;
      if (bid < 4096) { ATT_Q(bid, b, t, m, cnt) (void)t; ATT_LOAD_IX(ixw, m); ATT_LOAD_QF(qf, m); ATT_LOAD_ROWS(0, ixw, 0, b, cnt); ATT_LOAD_ROWS(1, ixw, 2, b, cnt); } }
    for (int it = bid; it < 4096; it += G) {
        int tid = tid0; asm volatile("" : "+v"(tid));
        const int lane = tid & 63, g = lane >> 4, c16 = lane & 15, hd = c16 & 7, q4 = c16 >> 2, p4 = c16 & 3;
        ATT_Q(it, b, t, m, cnt) (void)t;
        const int itn = it + G; const bool hasn = itn < 4096;
        ATT_Q(hasn ? itn : it, bn, tn, mn, cntn) (void)tn;
        f32x4 oe[8], oo[8];
#pragma unroll
        for (int ub = 0; ub < 8; ++ub) { oe[ub] = (f32x4){0.f, 0.f, 0.f, 0.f}; oo[ub] = oe[ub]; }
        float mrun = -INFINITY, lrun = 0.f;
        f32x4 s0, s1, sn0, sn1;
        ATT_QK(0, s0, s1); ATT_LOAD_ROWS(0, ixw, 4, b, cnt);
#pragma unroll
        for (int ch = 0; ch < 8; ++ch) {
            const int bf = ch & 1, bn1 = (ch + 1) & 1;
            if (ch < 7) { ATT_QK(bn1, sn0, sn1);
                if (ch < 5) ATT_LOAD_ROWS(bn1, ixw, 2 * (ch + 3), b, cnt);
                else if (hasn) ATT_LOAD_ROWS(bn1, ixw, 2 * (ch - 5), bn, cntn); }
            if (ch == 4 && hasn) ATT_LOAD_IX(ixw, mn);
            if (ch == 6 && hasn) ATT_LOAD_QF(qf, mn);
            float cm = -INFINITY;
#pragma unroll
            for (int i = 0; i < 4; ++i) { const int jr = 16 * (4 * g + i) + 2 * ch; if (jr >= cnt) s0[i] = -INFINITY; if (jr + 1 >= cnt) s1[i] = -INFINITY; cm = fmaxf(cm, fmaxf(s0[i], s1[i])); }
            cm = fmaxf(cm, bperm_f(lane ^ 16, cm)); cm = fmaxf(cm, bperm_f(lane ^ 32, cm));
            const float mnew = fmaxf(mrun, cm), alpha = __builtin_amdgcn_exp2f((mrun - mnew) * SCL);
            float p0[4], p1[4], ps = 0.f;
#pragma unroll
            for (int i = 0; i < 4; ++i) { p0[i] = __builtin_amdgcn_exp2f((s0[i] - mnew) * SCL); p1[i] = __builtin_amdgcn_exp2f((s1[i] - mnew) * SCL); ps += p0[i] + p1[i]; }
            lrun = lrun * alpha + ps; mrun = mnew;
            asm volatile("" : "+v"(lrun));
#pragma unroll
            for (int ub = 0; ub < 8; ++ub) { oe[ub] = oe[ub] * alpha; oo[ub] = oo[ub] * alpha; }
            int pl = 0, ph = 0;
            pl = __builtin_amdgcn_cvt_pk_fp8_f32(p0[0], p0[1], pl, false); pl = __builtin_amdgcn_cvt_pk_fp8_f32(p0[2], p0[3], pl, true);
            ph = __builtin_amdgcn_cvt_pk_fp8_f32(p1[0], p1[1], ph, false); ph = __builtin_amdgcn_cvt_pk_fp8_f32(p1[2], p1[3], ph, true);
            const long pb = (long)(((unsigned long long)(unsigned)ph << 32) | (unsigned)pl);
#pragma unroll
            for (int ub = 0; ub < 8; ++ub) {
                const s16x4 t0v = __builtin_amdgcn_ds_read_tr16_b64_v4i16((LAS s16x4*)(tile0 + bf * TS + (4 * g + q4) * RS + 32 * ub + 8 * p4));
                const s16x4 t1v = __builtin_amdgcn_ds_read_tr16_b64_v4i16((LAS s16x4*)(tile0 + bf * TS + (16 + 4 * g + q4) * RS + 32 * ub + 8 * p4));
                const u32x2 w0 = __builtin_bit_cast(u32x2, t0v), w1 = __builtin_bit_cast(u32x2, t1v);
                const unsigned e0 = __builtin_amdgcn_perm(w0.y, w0.x, 0x06040200u), o0 = __builtin_amdgcn_perm(w0.y, w0.x, 0x07050301u);
                const unsigned e1 = __builtin_amdgcn_perm(w1.y, w1.x, 0x06040200u), o1 = __builtin_amdgcn_perm(w1.y, w1.x, 0x07050301u);
                const long ae = (long)(((unsigned long long)e1 << 32) | e0), ao = (long)(((unsigned long long)o1 << 32) | o0);
                oe[ub] = __builtin_amdgcn_mfma_f32_16x16x32_fp8_fp8(ae, pb, oe[ub], 0, 0, 0);
                oo[ub] = __builtin_amdgcn_mfma_f32_16x16x32_fp8_fp8(ao, pb, oo[ub], 0, 0, 0);
            }
            if (ch < 7) { s0 = sn0; s1 = sn1; }
        }
        float lt = lrun + bperm_f(lane ^ 16, lrun); lt += bperm_f(lane ^ 32, lt);
        const float inv = 1.0f / lt;
        if (c16 < 8) { bf16_t* op = OLAT + m * 2048 + c16 * 256 + 8 * g;
#pragma unroll
            for (int ub = 0; ub < 8; ++ub) { const f32x4 ye = oe[ub] * inv, yo = oo[ub] * inv; u32x4 wv;
                wv.x = cvt_pk_bf16(ye[0], yo[0]); wv.y = cvt_pk_bf16(ye[1], yo[1]); wv.z = cvt_pk_bf16(ye[2], yo[2]); wv.w = cvt_pk_bf16(ye[3], yo[3]); *(u32x4*)(op + 32 * ub) = wv; } }
    }
#undef ATT_Q
#undef ATT_LOAD_IX
#undef ATT_LOAD_QF
#undef ATT_LOAD_ROWS
#undef ATT_QK
}

__device__ __forceinline__ void smix_phase(LAS unsigned char* lds, bf16_t* UY, const bf16_t* V, const f32x2* STATS, const float* Wc, const float* bsp, const float* lng, const float* lnb, int bid, int G) {
    int tid = threadIdx.x; asm volatile("" : "+v"(tid));
    const int lane = tid & 63, wave = __builtin_amdgcn_readfirstlane(tid >> 6);
    const int gq = lane >> 4, c16 = lane & 15, q4 = c16 >> 2, p4 = c16 & 3;
    LAS unsigned char* VT = lds;
    LAS unsigned char* AP = lds + 67584;
    LAS float* MU = (LAS float*)(lds + 102400); LAS float* RSTD = MU + 128; LAS float* R1 = MU + 256; LAS float* R2 = MU + 384;
    for (int it = bid; it < 2048; it += G) {
        const int gi = it & 7, rem = it >> 3, b = rem >> 5, ck = rem & 31; const size_t m0 = (size_t)b * T + ck * 128;
        if (tid < 128) { const f32x2* sp = STATS + (m0 + tid) * 32; float s = 0.f, ss = 0.f;
#pragma unroll 8
            for (int p = 0; p < 32; ++p) { const f32x2 v = sp[p]; s += v.x; ss += v.y; }
            const float mu = s * (1.0f / 2048.0f), var = ss * (1.0f / 2048.0f) - mu * mu; MU[tid] = mu; RSTD[tid] = rsqrtf(fmaxf(var, 0.f) + EPS); }
#pragma unroll
        for (int i = 0; i < 8; ++i) { const int cidx = tid + 512 * i, s = cidx >> 5, ch = cidx & 31;
            *(LAS u32x4*)(VT + s * 528 + ch * 16) = *(const u32x4*)(V + (m0 + s) * 2048 + gi * 256 + ch * 8); }
        __syncthreads();
        { const int t = tid >> 2, qd = tid & 3; const float* wp = Wc + ((size_t)gi * 128 + t) * 128 + 32 * qd; float r1 = 0.f, r2 = 0.f;
#pragma unroll
          for (int s8 = 0; s8 < 4; ++s8) { const f32x4 wa = *(const f32x4*)(wp + 8 * s8), wb = *(const f32x4*)(wp + 8 * s8 + 4); float av[8];
#pragma unroll
              for (int e = 0; e < 8; ++e) { const int s = 32 * qd + 8 * s8 + e; const float wv = (s <= t) ? (e < 4 ? wa[e] : wb[e - 4]) : 0.f; const float ab = bf_round(wv * RSTD[s]); av[e] = ab; r1 += ab * MU[s]; r2 += wv; }
              u32x4 o; o.x = cvt_pk_bf16(av[0], av[1]); o.y = cvt_pk_bf16(av[2], av[3]); o.z = cvt_pk_bf16(av[4], av[5]); o.w = cvt_pk_bf16(av[6], av[7]);
              *(LAS u32x4*)(AP + t * 272 + (32 * qd + 8 * s8) * 2) = o; }
          r1 += bperm_f(lane ^ 1, r1); r2 += bperm_f(lane ^ 1, r2); r1 += bperm_f(lane ^ 2, r1); r2 += bperm_f(lane ^ 2, r2);
          if (qd == 0) { R1[t] = r1; R2[t] = r2; } }
        __syncthreads();
        f32x4 acc[8][2];
#pragma unroll
        for (int mt = 0; mt < 8; ++mt) { acc[mt][0] = (f32x4){0.f, 0.f, 0.f, 0.f}; acc[mt][1] = acc[mt][0]; }
#pragma unroll
        for (int ks = 0; ks < 4; ++ks) {
            bf16x8 vf[2];
#pragma unroll
            for (int n2 = 0; n2 < 2; ++n2) { const int nt = 2 * wave + n2;
                const s16x4 t0v = __builtin_amdgcn_ds_read_tr16_b64_v4i16((LAS s16x4*)(VT + (32 * ks + 8 * gq + q4) * 528 + (16 * nt + 4 * p4) * 2));
                const s16x4 t1v = __builtin_amdgcn_ds_read_tr16_b64_v4i16((LAS s16x4*)(VT + (32 * ks + 8 * gq + 4 + q4) * 528 + (16 * nt + 4 * p4) * 2));
                vf[n2] = __builtin_shufflevector(t0v, t1v, 0, 1, 2, 3, 4, 5, 6, 7); }
#pragma unroll
            for (int mt = 0; mt < 8; ++mt) if (mt >= 2 * ks) {
                const bf16x8 afr = *(const LAS bf16x8*)(AP + (16 * mt + c16) * 272 + (32 * ks + 8 * gq) * 2);
                acc[mt][0] = __builtin_amdgcn_mfma_f32_16x16x32_bf16(vf[0], afr, acc[mt][0], 0, 0, 0);
                acc[mt][1] = __builtin_amdgcn_mfma_f32_16x16x32_bf16(vf[1], afr, acc[mt][1], 0, 0, 0); }
        }
        __syncthreads();
#pragma unroll
        for (int i = 0; i < 8; ++i) { const int cidx = tid + 512 * i, s = cidx >> 5, ch = cidx & 31;
            *(LAS u32x4*)(VT + s * 528 + ch * 16) = *(const u32x4*)(UY + (m0 + s) * 2048 + gi * 256 + ch * 8); }
        __syncthreads();
#pragma unroll
        for (int n2 = 0; n2 < 2; ++n2) { const int e0 = 16 * (2 * wave + n2) + 4 * gq; const f32x4 lg4 = *(const f32x4*)(lng + gi * 256 + e0), lb4 = *(const f32x4*)(lnb + gi * 256 + e0);
#pragma unroll
            for (int mt = 0; mt < 8; ++mt) { const int t = 16 * mt + c16; const float r1 = R1[t], r2 = R2[t], bsv = bsp[gi * 128 + t];
                LAS u32x2* up = (LAS u32x2*)(VT + t * 528 + e0 * 2); const u32x2 uw = *up;
                const f32x4 mixed = lg4 * (acc[mt][n2] - r1) + lb4 * r2 + bsv;
                const float y0 = bf2f(uw.x & 0xffffu) * mixed[0], y1 = bf2f(uw.x >> 16) * mixed[1], y2 = bf2f(uw.y & 0xffffu) * mixed[2], y3 = bf2f(uw.y >> 16) * mixed[3];
                u32x2 yw; yw.x = cvt_pk_bf16(y0, y1); yw.y = cvt_pk_bf16(y2, y3); *up = yw; } }
        __syncthreads();
#pragma unroll
        for (int i = 0; i < 8; ++i) { const int cidx = tid + 512 * i, s = cidx >> 5, ch = cidx & 31;
            *(u32x4*)(UY + (m0 + s) * 2048 + gi * 256 + ch * 8) = *(const LAS u32x4*)(VT + s * 528 + ch * 16); }
        __syncthreads();
    }
}

__global__ void __launch_bounds__(512, 2) mk_fwd(Args a) {
    extern __shared__ __attribute__((aligned(16))) unsigned char lds_raw[];
    LAS unsigned char* lds = (LAS unsigned char*)lds_raw;
    cg::grid_group grid = cg::this_grid();
    const int bid = blockIdx.x, G = gridDim.x;
    unsigned char* wsk = a.ws;
    volatile LAS unsigned* misc = (volatile LAS unsigned*)(lds + LDS_MISC);
    if (threadIdx.x < 2) misc[threadIdx.x] = 0u;
    __syncthreads();
    const XcdBarrier xbar = xcd_barrier_post((unsigned*)(wsk + WS_BAR), misc);
    int ph = 0;
#ifndef PROBE
#define PROBE 0
#endif
#define PHASE_BEGIN if (ph >= a.ph_lo && ph < a.ph_hi) {
#define REP(k) for (int rep_ = 0; rep_ < ((PROBE == (k)) ? 2 : 1); ++rep_)
#define PHASE_END(dosync) if ((dosync) && ph + 1 < a.ph_hi) { if (ph == 0) grid.sync(); else xcd_barrier(xbar); } } ++ph;

    PHASE_BEGIN REP(4) { p0_phase(a, lds, bid, G); __syncthreads(); } PHASE_END(true)
    PHASE_BEGIN p0c_phase(a, bid, G); PHASE_END(true)

#pragma unroll 1
    for (int layer = 0; layer < 4; ++layer) {
        unsigned char* ws = wsk; asm volatile("" : "+s"(ws));
        float* MOD = (float*)(ws + WS_MOD); bf16_t* H = (bf16_t*)a.out; _Float16* X = (_Float16*)(ws + WS_X16);
        const int j = layer >> 1;
        const float* modl = MOD + (size_t)layer * 8 * NMOD;
        PHASE_BEGIN REP(3) { if (layer == 0) norm_mod_phase<true>(a.in[0], X, a.in[4] + layer * D, modl + 0 * D, modl + 1 * D, H, bid, G);
            else norm_mod_phase<false>(nullptr, X, a.in[4] + layer * D, modl + 0 * D, modl + 1 * D, H, bid, G); } PHASE_END(true)
        if ((layer & 1) == 0) {
            bf16_t* Q = (bf16_t*)(ws + WS_Q); float* CKVR = (float*)(ws + WS_CKVR); bf16_t* QIDX = (bf16_t*)(ws + WS_QIDX); float* KRAW = (float*)(ws + WS_KRAW);
            bf16_t* CKV = (bf16_t*)(ws + WS_CKV); bf16_t* KIDX = (bf16_t*)(ws + WS_KIDX); float* WIDX = (float*)(ws + WS_WIDX); unsigned short* IDX = (unsigned short*)(ws + WS_IDX);
            bf16_t* QLAT = (bf16_t*)(ws + WS_QLAT); bf16_t* OLAT = (bf16_t*)a.out; bf16_t* O = (bf16_t*)(ws + WS_O);
            PHASE_BEGIN { pg8::Gemm g{H, (const bf16_t*)(ws + W_AIN) + (size_t)j * 2048 * 1024, M, 2048, 1024, 1024, 0, 0}; pg8::StaticOrder S; S.init(M, 2048, G, bid);
                pg8::EpiInproj E{Q, CKVR, QIDX, KRAW}; REP(5) pg8::gemm_phase(lds, g, S, E); } PHASE_END(true)
            PHASE_BEGIN { dsa_rows_phase(CKVR, KRAW, a.in[7] + j * 256, a.in[8] + j * 64, a.in[9] + j * 64, CKV, KIDX, WIDX, bid, G);
                __syncthreads();
                pg8::Gemm g{Q, (const bf16_t*)(ws + W_UK) + (size_t)j * 2048 * 256, M, 2048, 256, 1024, 1, 256}; pg8::StaticOrder S; S.init(M, 2048, G, bid);
                pg8::EpiBf16 E{QLAT, 2048, 1.4142135623730951f, 1}; pg8::gemm_phase(lds, g, S, E); } PHASE_END(true)
            PHASE_BEGIN REP(1) dsa_select_phase(lds, QIDX, KIDX, WIDX, IDX, bid, G); PHASE_END(true)
            PHASE_BEGIN REP(2) dsa_attn_phase(lds, (const unsigned char*)QLAT, (const unsigned char*)CKV, IDX, OLAT, bid, G); PHASE_END(true)
            PHASE_BEGIN { pg8::Gemm g{OLAT, (const bf16_t*)(ws + W_UV) + (size_t)j * 1024 * 512, M, 1024, 512, 2048, 0, 512}; pg8::StaticOrder S; S.init(M, 1024, G, bid);
                pg8::EpiBf16 E{O, 1024, 1.0f, 0}; pg8::gemm_phase(lds, g, S, E); } PHASE_END(true)
            PHASE_BEGIN { pg8::Gemm g{O, (const bf16_t*)(ws + W_O) + (size_t)j * 1024 * 1024, M, 1024, 1024, 1024, 0, 0}; pg8::StaticOrder S; S.init(M, 1024, G, bid);
                pg8::EpiResid E{X, modl + 2 * D}; pg8::gemm_phase(lds, g, S, E); } PHASE_END(true)
        } else {
            bf16_t* U = (bf16_t*)(ws + WS_U); bf16_t* V = (bf16_t*)(ws + WS_V); f32x2* STATS = (f32x2*)(ws + WS_STATS);
            PHASE_BEGIN { pg8::Gemm g{H, (const bf16_t*)(ws + W_BIN) + (size_t)j * 4096 * 1024, M, 4096, 1024, 1024, 0, 0}; pg8::StaticOrder S; S.init(M, 4096, G, bid);
                pg8::EpiGelu E{U, V, STATS}; REP(7) pg8::gemm_phase(lds, g, S, E); } PHASE_END(true)
            PHASE_BEGIN smix_phase(lds, U, V, STATS, a.in[16] + (size_t)j * 8 * 128 * 128, a.in[17] + (size_t)j * 8 * 128, a.in[14] + (size_t)j * 2048, a.in[15] + (size_t)j * 2048, bid, G); PHASE_END(true)
            PHASE_BEGIN { pg8::Gemm g{U, (const bf16_t*)(ws + W_BOUT) + (size_t)j * 1024 * 2048, M, 1024, 2048, 2048, 0, 0}; pg8::StaticOrder S; S.init(M, 1024, G, bid);
                pg8::EpiResid E{X, modl + 2 * D}; pg8::gemm_phase(lds, g, S, E); } PHASE_END(true)
        }
        PHASE_BEGIN REP(3) norm_mod_phase<false>(nullptr, X, a.in[5] + layer * D, modl + 3 * D, modl + 4 * D, H, bid, G); PHASE_END(true)
        PHASE_BEGIN { pg8::Gemm g{H, (const bf16_t*)(ws + W_GU) + (size_t)layer * 5632 * 1024, M, 5632, 1024, 1024, 0, 0}; pg8::StaticOrder S; S.init(M, 5632, G, bid);
            pg8::EpiSwiglu E{(bf16_t*)(ws + WS_HID)}; REP(6) pg8::gemm_phase(lds, g, S, E); } PHASE_END(true)
        PHASE_BEGIN { pg8::Gemm g{(const bf16_t*)(ws + WS_HID), (const bf16_t*)(ws + W_DN) + (size_t)layer * 1024 * DFF, M, 1024, DFF, DFF, 0, 0}; pg8::StaticOrder S; S.init(M, 1024, G, bid);
            pg8::EpiResid E{X, modl + 5 * D}; pg8::gemm_phase(lds, g, S, E); } PHASE_END(true)
    }
    PHASE_BEGIN final_norm_phase((const _Float16*)(wsk + WS_X16), a.in[22], a.out, bid, G); PHASE_END(false)
}

extern "C" void kernel_launch(void* const* d_in, const int* in_sizes, int n_in, void* d_out, int out_size, void* d_ws, size_t ws_size, hipStream_t stream) {
    static int grid_blocks = 0;
    if (grid_blocks == 0) {
        int dev = 0, cus = 0, per_cu = 0;
        if (n_in != 23 || out_size != M * D || ws_size < WS_END) { fprintf(stderr, "kernel_launch: unexpected problem (n_in %d out %d ws %zu, need ws >= %zu)\n", n_in, out_size, ws_size, (size_t)WS_END); grid_blocks = -1; return; }
        (void)hipGetDevice(&dev);
        (void)hipDeviceGetAttribute(&cus, hipDeviceAttributeMultiprocessorCount, dev);
        (void)hipFuncSetAttribute((const void*)mk_fwd, hipFuncAttributeMaxDynamicSharedMemorySize, LDS_BYTES);
        (void)hipOccupancyMaxActiveBlocksPerMultiprocessor(&per_cu, (const void*)mk_fwd, 512, LDS_BYTES);
        fprintf(stderr, "kernel_launch: cus %d per_cu %d ws %zu\n", cus, per_cu, ws_size);
        if (per_cu < 1) { fprintf(stderr, "kernel_launch: kernel does not fit a CU\n"); grid_blocks = -1; return; }
        grid_blocks = cus;
    }
    if (grid_blocks < 0) return;
    if (hipMemsetAsync((char*)d_ws + WS_BAR, 0, 16384, stream) != hipSuccess) { fprintf(stderr, "kernel_launch: memset failed\n"); return; }
    Args a{};
    for (int i = 0; i < 23; ++i) a.in[i] = (const float*)d_in[i];
    a.out = (float*)d_out; a.ws = (unsigned char*)d_ws; a.ph_lo = 0; a.ph_hi = 1000;
    void* args[] = {&a};
    hipError_t e = hipLaunchCooperativeKernel((const void*)mk_fwd, dim3(grid_blocks), dim3(512), args, LDS_BYTES, stream);
    if (e != hipSuccess) fprintf(stderr, "cooperative launch failed: %s (grid %d)\n", hipGetErrorString(e), grid_blocks);
}
```

```cpp
#include <hip/hip_runtime.h>
#include <hip/hip_cooperative_groups.h>
#include <cstdio>
#include <cstdint>
namespace cg = cooperative_groups;

#define LAS __attribute__((address_space(3)))
typedef unsigned short bf16_t;
typedef short bf16x8 __attribute__((ext_vector_type(8)));
typedef short s16x4 __attribute__((ext_vector_type(4)));
typedef float f32x4 __attribute__((ext_vector_type(4)));
typedef float f32x16 __attribute__((ext_vector_type(16)));
typedef float f32x2 __attribute__((ext_vector_type(2)));
typedef unsigned u32x4 __attribute__((ext_vector_type(4)));
typedef unsigned u32x2 __attribute__((ext_vector_type(2)));
typedef int i32x2 __attribute__((ext_vector_type(2)));
typedef _Float16 f16x8 __attribute__((ext_vector_type(8)));
typedef float f32x8 __attribute__((ext_vector_type(8)));

constexpr int D = 1024, NB = 8, T = 4096, M = NB * T, DFF = 2816, NMOD = 6 * D;
constexpr float EPS = 1e-6f;
constexpr int AIN = 1864;
constexpr size_t MiB = 1u << 20;
constexpr size_t WS_MOD = 0;
constexpr size_t WS_MODP = 1 * MiB;
constexpr size_t WS_W = 13 * MiB;
constexpr size_t W_AIN = WS_W;
constexpr size_t W_UK = W_AIN + 8 * MiB;
constexpr size_t W_UV = W_UK + 2 * MiB;
constexpr size_t W_O = W_UV + 2 * MiB;
constexpr size_t W_BIN = W_O + 4 * MiB;
constexpr size_t W_BOUT = W_BIN + 16 * MiB;
constexpr size_t W_GU = W_BOUT + 8 * MiB;
constexpr size_t W_DN = W_GU + 44 * MiB;
constexpr size_t WS_ACT = W_DN + 22 * MiB;
constexpr size_t KiB = 1024, SLAB = 47 * MiB;
constexpr size_t S_X16 = 0;
constexpr size_t S_Q = 8 * MiB;
constexpr size_t S_HID = 8 * MiB;
constexpr size_t S_U = 8 * MiB;
constexpr size_t S_V = 24 * MiB;
constexpr size_t S_STATS = 40 * MiB;
constexpr size_t S_QLAT = 16 * MiB;
constexpr size_t S_O = 16 * MiB;
constexpr size_t S_CKVR = 32 * MiB;
constexpr size_t S_CKV = 36 * MiB;
constexpr size_t S_QIDX = 38 * MiB;
constexpr size_t S_KRAW = 42 * MiB;
constexpr size_t S_KIDX = 44 * MiB;
constexpr size_t S_WIDX = 44 * MiB + 512 * KiB;
constexpr size_t S_IDX = 44 * MiB + 640 * KiB;
static_assert(S_IDX + 2 * MiB <= SLAB && S_HID + 22 * MiB <= S_CKVR && S_STATS + MiB <= SLAB, "slab map");
constexpr size_t WS_END = WS_ACT + 8 * SLAB;
constexpr int LDS_BYTES = 147456;
constexpr int LDS_MISC = LDS_BYTES - 256;
constexpr size_t WS_BAR = 1 * MiB - 16384;

__device__ __forceinline__ unsigned cvt_pk_bf16(float lo, float hi) { unsigned r; asm volatile("v_cvt_pk_bf16_f32 %0, %1, %2" : "=v"(r) : "v"(lo), "v"(hi)); return r; }
__device__ __forceinline__ float bf2f(unsigned b) { return __uint_as_float(b << 16); }
__device__ __forceinline__ float bf_round(float f) { unsigned u = __float_as_uint(f); u = (u + 0x7fffu + ((u >> 16) & 1u)) & 0xffff0000u; return __uint_as_float(u); }
__device__ __forceinline__ float wave_sum(float v) {
#pragma unroll
    for (int o = 1; o < 64; o <<= 1) v += __shfl_xor(v, o);
    return v;
}
#define LDS_WAIT() asm volatile("s_waitcnt lgkmcnt(0)" ::: "memory")
__device__ __forceinline__ unsigned bperm_u(int srclane, unsigned v) { return (unsigned)__builtin_amdgcn_ds_bpermute(srclane << 2, (int)v); }
__device__ __forceinline__ int hw_lane() { int l; asm volatile("v_mbcnt_lo_u32_b32 %0, -1, 0\n\tv_mbcnt_hi_u32_b32 %0, -1, %0" : "=v"(l)); return l; }
__device__ __forceinline__ float bperm_f(int srclane, float v) { return __int_as_float(__builtin_amdgcn_ds_bpermute(srclane << 2, __float_as_int(v))); }


#define XB_TMO      128
#define XB_XCNT(j)  (256  + 64 * (j))
#define XB_XSUB(j)  (1280 + 64 * (j))
#define XB_XGEN(j)  (2304 + 64 * (j))
#define XB_TOP      3328
#define XB_TOPGEN   3392
#define XCD_BAR_WORDS 3456
#define XB_SPIN_CAP (1u << 22)
__device__ __forceinline__ unsigned xb_ld(unsigned* p)              { return __hip_atomic_load(p, __ATOMIC_RELAXED, __HIP_MEMORY_SCOPE_AGENT); }
__device__ __forceinline__ unsigned xb_add(unsigned* p, unsigned v) { return __hip_atomic_fetch_add(p, v, __ATOMIC_RELAXED, __HIP_MEMORY_SCOPE_AGENT); }
__device__ __forceinline__ unsigned xb_xcc_id() { return (unsigned)__builtin_amdgcn_s_getreg((3 << 11) | 20) & 0xFu; }
#define XB_SPIN(cond, bar) do { unsigned _sp = 0; while (cond) { __builtin_amdgcn_s_sleep(1); \
    if ((++_sp & 255u) == 0u) { if (xb_ld(&(bar)[XB_TMO])) break; if (_sp > XB_SPIN_CAP) { atomicAdd(&(bar)[XB_TMO], 1u); break; } } } } while (0)
struct XcdBarrier { unsigned* bar; unsigned x; volatile LAS unsigned* st; int wvs; };
__device__ __forceinline__ XcdBarrier xcd_barrier_post(unsigned* bar, volatile LAS unsigned* st, int wvs) {
    XcdBarrier b; b.bar = bar; b.x = xb_xcc_id(); b.st = st; b.wvs = wvs;
    if (wvs == 0 && hw_lane() == 0) st[2] = xb_add(&bar[XB_XCNT(b.x)], 1u);
    return b;
}
__device__ __forceinline__ void xcd_barrier_complete(unsigned* bar, unsigned x, unsigned& nloc, unsigned& nx) {
    const unsigned G = gridDim.x * gridDim.y * gridDim.z;
    unsigned sum, cnt, mine, sp = 0u;
    for (;;) {
        sum = 0u; cnt = 0u; mine = 0u;
#pragma unroll
        for (unsigned j = 0; j < 16; ++j) { const unsigned c = xb_ld(&bar[XB_XCNT(j)]); sum += c; cnt += (c > 0u) ? 1u : 0u; mine = (j == x) ? c : mine; }
        if (sum == G) break;
        __builtin_amdgcn_s_sleep(1);
        if ((++sp & 255u) == 0u) { if (xb_ld(&bar[XB_TMO])) break; if (sp > XB_SPIN_CAP) { atomicAdd(&bar[XB_TMO], 1u); break; } }
    }
    nloc = mine > 0u ? mine : 1u; nx = cnt > 0u ? cnt : 1u;
}
__device__ __forceinline__ void xcd_barrier(const XcdBarrier& b) {
    asm volatile("s_waitcnt vmcnt(0)" ::: "memory");
    __syncthreads();
    if (b.wvs == 0 && hw_lane() == 0) {
        unsigned* bar = b.bar;
        __builtin_amdgcn_s_waitcnt(0);
        unsigned nloc = b.st[0], nx = b.st[1];
        if (nloc == 0u) { xcd_barrier_complete(bar, b.x, nloc, nx); b.st[0] = nloc; b.st[1] = nx; }
        const unsigned old = xb_add(&bar[XB_XSUB(b.x)], 1u);
        const unsigned gen = old / nloc;
        if (old + 1u == (gen + 1u) * nloc) {
            __builtin_amdgcn_fence(__ATOMIC_RELEASE, "agent");
            asm volatile("s_waitcnt vmcnt(0)" ::: "memory");
            const unsigned og = xb_add(&bar[XB_TOP], 1u);
            const unsigned tg = og / nx;
            if (og + 1u == (tg + 1u) * nx) xb_add(&bar[XB_TOPGEN], 1u);
            else XB_SPIN(xb_ld(&bar[XB_TOPGEN]) == tg, bar);
            __builtin_amdgcn_fence(__ATOMIC_ACQUIRE, "agent");
            xb_add(&bar[XB_XGEN(b.x)], 1u);
            asm volatile("s_waitcnt vmcnt(0)" ::: "memory");
        } else {
            XB_SPIN(xb_ld(&bar[XB_XGEN(b.x)]) == gen, bar);
            __builtin_amdgcn_fence(__ATOMIC_ACQUIRE, "agent");
            asm volatile("s_waitcnt vmcnt(0)" ::: "memory");
        }
    }
    __syncthreads();
}

__device__ __forceinline__ void xcd_barrier_local(const XcdBarrier& b) {
    asm volatile("s_waitcnt vmcnt(0)" ::: "memory");
    __syncthreads();
    if (b.wvs == 0 && hw_lane() == 0) {
        unsigned* bar = b.bar;
        __builtin_amdgcn_s_waitcnt(0);
        const unsigned nloc = b.st[0];
        asm volatile("buffer_inv sc1" ::: "memory");
        const unsigned old = xb_add(&bar[XB_XSUB(b.x)], 1u);
        const unsigned gen = old / nloc;
        if (old + 1u == (gen + 1u) * nloc) xb_add(&bar[XB_XGEN(b.x)], 1u);
        else XB_SPIN(xb_ld(&bar[XB_XGEN(b.x)]) == gen, bar);
        asm volatile("s_waitcnt vmcnt(0)" ::: "memory");
    }
    __syncthreads();
}

namespace pg8 {
constexpr int BM = 256, BK = 64, HALF = 128, HTB = HALF * BK * 2, STAGE_BYTES = 8 * HTB, NXCD = 8, WGM = 8;
__host__ __device__ __forceinline__ int lds_byte(int r, int c) { return (r >> 3) * 1024 + (r & 7) * 128 + (((c >> 3) ^ ((r >> 1) & 7)) << 4) + (c & 7) * 2; }
__host__ __device__ __forceinline__ void stage_rc(int b, int& R, int& C) { const int blk = b / 1024, sb = b % 1024; R = blk * 8 + sb / 128; C = ((((sb % 128) >> 4) ^ ((R >> 1) & 7))) * 8; }
__host__ __device__ __forceinline__ int perm32(int rho) { const int n = rho >> 4, i = rho & 15; return 8 * (i >> 2) + 4 * n + (i & 3); }

struct Unit { int pm, pn; };
struct Gemm { const bf16_t* A; const bf16_t* Bt; int M, N, K, lda, agrp_shift, agrp_stride; };

struct StaticOrder {
    int nM, nN, nwg, G, c;
    __device__ void init(int M_, int N_, int G_, int c_) { nM = M_ / BM; nN = N_ / BM; nwg = nM * nN; G = G_; c = c_; }
    __device__ bool next(int i, Unit& u) const {
        const long L = (long)i * G + c; if (L >= nwg) return false;
        int wgid = (int)L; { const int q = nwg / NXCD, r = nwg % NXCD, xcd = wgid % NXCD, off = wgid / NXCD; wgid = (xcd < r ? xcd * (q + 1) : r * (q + 1) + (xcd - r) * q) + off; }
        const int nig = WGM * nN, gid = wgid / nig, fm = gid * WGM, gsz = (nM - fm) < WGM ? (nM - fm) : WGM;
        u.pm = fm + ((wgid % nig) % gsz); u.pn = (wgid % nig) / gsz; return true;
    }
};

typedef f32x4 Acc[2][2][4][2];

__device__ __forceinline__ f32x2 gelu_pk(f32x2 v) {
    const f32x2 av = __builtin_elementwise_abs(v), d = av * 0.2316418882f + 1.0f;
    f32x2 t; t.x = __builtin_amdgcn_rcpf(d.x); t.y = __builtin_amdgcn_rcpf(d.y);
    f32x2 q = t * 0.5307027145f + (-0.7265760135f); q = q * t + 0.7107068705f; q = q * t + (-0.142248368f); q = q * t + 0.127414796f; q = q * t;
    const f32x2 s = (v * v) * (-0.72134752044f);
    f32x2 e; e.x = __builtin_amdgcn_exp2f(s.x); e.y = __builtin_amdgcn_exp2f(s.y);
    const f32x2 m = v * (q * e), r = v - m;
    f32x2 o; o.x = v.x < 0.f ? m.x : r.x; o.y = v.y < 0.f ? m.y : r.y; return o;
}
__device__ __forceinline__ f32x4 gelu4(f32x4 v) { f32x2 a = gelu_pk((f32x2){v[0], v[1]}), b = gelu_pk((f32x2){v[2], v[3]}); return (f32x4){a.x, a.y, b.x, b.y}; }
__device__ __forceinline__ u32x4 pack8(f32x4 v0, f32x4 v1) { u32x4 w; w.x = cvt_pk_bf16(v0[0], v0[1]); w.y = cvt_pk_bf16(v0[2], v0[3]); w.z = cvt_pk_bf16(v1[0], v1[1]); w.w = cvt_pk_bf16(v1[2], v1[3]); return w; }

struct EpiInproj {
    static constexpr int NS = 0, PREF = 0;
    bf16_t* Q; bf16_t* QIDX; unsigned char* CKV; bf16_t* KIDX; float* WIDX; const float* gkv; const float* gk; const float* bk; LAS float* rs;
    __device__ __forceinline__ void operator()(const Acc& acc, const Unit& u, int wr, int wc, int fr, int fq) const {
        const int row0 = u.pm * BM + wr * 64 + fr, cl = wc * 32 + 8 * fq;
        if (u.pn == 4) {
#pragma unroll
            for (int ai = 0; ai < 2; ++ai)
#pragma unroll
                for (int m = 0; m < 4; ++m) { float ss = 0.f;
#pragma unroll
                    for (int bj = 0; bj < 2; ++bj)
#pragma unroll
                        for (int n = 0; n < 2; ++n) { const f32x4 v = acc[ai][bj][m][n]; ss += (v[0] * v[0] + v[1] * v[1]) + (v[2] * v[2] + v[3] * v[3]); }
                    ss += bperm_f((16 * fq + fr) ^ 16, ss); ss += bperm_f((16 * fq + fr) ^ 32, ss);
                    if (fq == 0) rs[(ai * HALF + wr * 64 + m * 16 + fr) * 4 + wc] = ss; }
            asm volatile("s_waitcnt lgkmcnt(0)" ::: "memory"); __builtin_amdgcn_s_barrier();
            f32x4 g4[2][2];
#pragma unroll
            for (int bj = 0; bj < 2; ++bj)
#pragma unroll
                for (int n = 0; n < 2; ++n) g4[bj][n] = *(const f32x4*)(gkv + bj * HALF + cl + 4 * n);
#pragma unroll
            for (int ai = 0; ai < 2; ++ai)
#pragma unroll
                for (int m = 0; m < 4; ++m) { const f32x4 p = *(const LAS f32x4*)(rs + (ai * HALF + wr * 64 + m * 16 + fr) * 4);
                    const float rstd = rsqrtf(((p[0] + p[1]) + (p[2] + p[3])) * (1.0f / 256.0f) + EPS);
                    unsigned char* rowp = CKV + (size_t)(row0 + ai * HALF + m * 16) * 256 + cl;
#pragma unroll
                    for (int bj = 0; bj < 2; ++bj) { const f32x4 y0 = acc[ai][bj][m][0] * rstd * g4[bj][0], y1 = acc[ai][bj][m][1] * rstd * g4[bj][1]; int w0 = 0, w1 = 0;
                        w0 = __builtin_amdgcn_cvt_pk_fp8_f32(y0[0], y0[1], w0, false); w0 = __builtin_amdgcn_cvt_pk_fp8_f32(y0[2], y0[3], w0, true);
                        w1 = __builtin_amdgcn_cvt_pk_fp8_f32(y1[0], y1[1], w1, false); w1 = __builtin_amdgcn_cvt_pk_fp8_f32(y1[2], y1[3], w1, true);
                        *(u32x2*)(rowp + bj * HALF) = (u32x2){(unsigned)w0, (unsigned)w1}; } }
            return; }
        if (u.pn == 7) {
            LAS f32x2* rs2 = (LAS f32x2*)rs;
#pragma unroll
            for (int ai = 0; ai < 2; ++ai)
#pragma unroll
                for (int m = 0; m < 4; ++m) { const f32x4 v0 = acc[ai][0][m][0], v1 = acc[ai][0][m][1];
                    float sm = (v0[0] + v0[1]) + (v0[2] + v0[3]) + (v1[0] + v1[1]) + (v1[2] + v1[3]);
                    float sq = (v0[0] * v0[0] + v0[1] * v0[1]) + (v0[2] * v0[2] + v0[3] * v0[3]) + (v1[0] * v1[0] + v1[1] * v1[1]) + (v1[2] * v1[2] + v1[3] * v1[3]);
                    sm += bperm_f((16 * fq + fr) ^ 16, sm); sq += bperm_f((16 * fq + fr) ^ 16, sq); sm += bperm_f((16 * fq + fr) ^ 32, sm); sq += bperm_f((16 * fq + fr) ^ 32, sq);
                    if (fq == 0 && wc < 2) rs2[(ai * HALF + wr * 64 + m * 16 + fr) * 2 + wc] = (f32x2){sm, sq}; }
            asm volatile("s_waitcnt lgkmcnt(0)" ::: "memory"); __builtin_amdgcn_s_barrier();
            if (wc < 2) { const f32x4 ga = *(const f32x4*)(gk + cl), gb = *(const f32x4*)(gk + cl + 4), ba = *(const f32x4*)(bk + cl), bb4 = *(const f32x4*)(bk + cl + 4);
#pragma unroll
                for (int ai = 0; ai < 2; ++ai)
#pragma unroll
                    for (int m = 0; m < 4; ++m) { const f32x4 p = *(const LAS f32x4*)(rs + (ai * HALF + wr * 64 + m * 16 + fr) * 4);
                        const float mean = (p[0] + p[2]) * (1.0f / 64.0f), var = fmaxf((p[1] + p[3]) * (1.0f / 64.0f) - mean * mean, 0.f), krstd = rsqrtf(var + EPS);
                        const f32x4 y0 = (acc[ai][0][m][0] - mean) * krstd * ga + ba, y1 = (acc[ai][0][m][1] - mean) * krstd * gb + bb4;
                        const size_t r = (size_t)(row0 + ai * HALF + m * 16);
                        *(u32x4*)(KIDX + (((r >> 5) * 4 + (size_t)(cl >> 4)) * 64 + (size_t)(((cl >> 3) & 1) * 32) + (r & 31)) * 8) = pack8(y0, y1); } }
            else if (wc == 2 && fq == 0) {
#pragma unroll
                for (int ai = 0; ai < 2; ++ai)
#pragma unroll
                    for (int m = 0; m < 4; ++m) { float* p = WIDX + (size_t)(row0 + ai * HALF + m * 16) * 8; *(f32x4*)p = acc[ai][0][m][0] * 0.04419417382f; *(f32x4*)(p + 4) = acc[ai][0][m][1] * 0.04419417382f; } }
            return; }
#pragma unroll
        for (int ai = 0; ai < 2; ++ai)
#pragma unroll
            for (int m = 0; m < 4; ++m) { const size_t row = (size_t)(row0 + ai * HALF + m * 16);
#pragma unroll
                for (int bj = 0; bj < 2; ++bj) { const f32x4 v0 = acc[ai][bj][m][0], v1 = acc[ai][bj][m][1]; const int c = bj * HALF + cl;
                    if (u.pn < 4) *(u32x4*)(Q + row * 1024 + u.pn * 256 + c) = pack8(v0, v1);
                    else *(u32x4*)(QIDX + row * 512 + (u.pn - 5) * 256 + c) = pack8(v0, v1); } }
    }
};
struct EpiBf16 {
    static constexpr int NS = 16, PREF = 0;
    bf16_t* O; int ldc; float scale; int fp8;
    __device__ __forceinline__ void operator()(const Acc& acc, const Unit& u, int wr, int wc, int fr, int fq) const {
        const int row0 = u.pm * BM + wr * 64 + fr, col0 = u.pn * BM + wc * 32 + 8 * fq;
        if (fp8) {
#pragma unroll
            for (int ai = 0; ai < 2; ++ai)
#pragma unroll
                for (int m = 0; m < 4; ++m) { unsigned char* rowp = (unsigned char*)O + (size_t)(row0 + ai * HALF + m * 16) * ldc + col0;
#pragma unroll
                    for (int bj = 0; bj < 2; ++bj) { const f32x4 v0 = acc[ai][bj][m][0] * scale, v1 = acc[ai][bj][m][1] * scale; int w0 = 0, w1 = 0;
                        w0 = __builtin_amdgcn_cvt_pk_fp8_f32(v0[0], v0[1], w0, false); w0 = __builtin_amdgcn_cvt_pk_fp8_f32(v0[2], v0[3], w0, true);
                        w1 = __builtin_amdgcn_cvt_pk_fp8_f32(v1[0], v1[1], w1, false); w1 = __builtin_amdgcn_cvt_pk_fp8_f32(v1[2], v1[3], w1, true);
                        *(u32x2*)(rowp + bj * HALF) = (u32x2){(unsigned)w0, (unsigned)w1}; } }
            return; }
#pragma unroll
        for (int ai = 0; ai < 2; ++ai)
#pragma unroll
            for (int m = 0; m < 4; ++m) { bf16_t* rowp = O + (size_t)(row0 + ai * HALF + m * 16) * ldc + col0;
#pragma unroll
                for (int bj = 0; bj < 2; ++bj) *(u32x4*)(rowp + bj * HALF) = pack8(acc[ai][bj][m][0] * scale, acc[ai][bj][m][1] * scale); }
    }
};
struct EpiResid {
    static constexpr int NS = 36, PREF = 0;
    _Float16* x; const float* gate;
    __device__ __forceinline__ unsigned pref_off(const Unit& u, int wr, int wc, int lane) const { return (unsigned)((u.pm * BM + wr * 64 + lane) * D + u.pn * BM + wc * 32) * 2u; }
    __device__ __forceinline__ void operator()(const Acc& acc, const Unit& u, int wr, int wc, int fr, int fq) const {
        const int row0 = u.pm * BM + wr * 64 + fr, col0 = u.pn * BM + wc * 32 + 8 * fq;
        const float* gp = gate + (size_t)(u.pm >> 4) * NMOD + col0;
        f32x4 gv[2][2];
#pragma unroll
        for (int bj = 0; bj < 2; ++bj)
#pragma unroll
            for (int n = 0; n < 2; ++n) gv[bj][n] = *(const f32x4*)(gp + bj * HALF + 4 * n);
        f16x8 xa[4][2], ya[4][2], xb[4][2];
#pragma unroll
        for (int m = 0; m < 4; ++m)
#pragma unroll
            for (int bj = 0; bj < 2; ++bj) xa[m][bj] = *(const f16x8*)(x + (size_t)(row0 + m * 16) * D + col0 + bj * HALF);
        asm volatile("" ::: "memory");
#pragma unroll
        for (int m = 0; m < 4; ++m)
#pragma unroll
            for (int bj = 0; bj < 2; ++bj) { const f32x8 xf = __builtin_convertvector(xa[m][bj], f32x8);
                const f32x4 r0 = (f32x4){xf[0], xf[1], xf[2], xf[3]} + gv[bj][0] * acc[0][bj][m][0], r1 = (f32x4){xf[4], xf[5], xf[6], xf[7]} + gv[bj][1] * acc[0][bj][m][1];
                ya[m][bj] = __builtin_convertvector((f32x8){r0[0], r0[1], r0[2], r0[3], r1[0], r1[1], r1[2], r1[3]}, f16x8); }
        asm volatile("" ::: "memory");
#pragma unroll
        for (int m = 0; m < 4; ++m)
#pragma unroll
            for (int bj = 0; bj < 2; ++bj) xb[m][bj] = *(const f16x8*)(x + (size_t)(row0 + HALF + m * 16) * D + col0 + bj * HALF);
        asm volatile("" ::: "memory");
#pragma unroll
        for (int m = 0; m < 4; ++m)
#pragma unroll
            for (int bj = 0; bj < 2; ++bj) *(f16x8*)(x + (size_t)(row0 + m * 16) * D + col0 + bj * HALF) = ya[m][bj];
        asm volatile("" ::: "memory");
#pragma unroll
        for (int m = 0; m < 4; ++m)
#pragma unroll
            for (int bj = 0; bj < 2; ++bj) { const f32x8 xf = __builtin_convertvector(xb[m][bj], f32x8);
                const f32x4 r0 = (f32x4){xf[0], xf[1], xf[2], xf[3]} + gv[bj][0] * acc[1][bj][m][0], r1 = (f32x4){xf[4], xf[5], xf[6], xf[7]} + gv[bj][1] * acc[1][bj][m][1];
                *(f16x8*)(x + (size_t)(row0 + HALF + m * 16) * D + col0 + bj * HALF) = __builtin_convertvector((f32x8){r0[0], r0[1], r0[2], r0[3], r1[0], r1[1], r1[2], r1[3]}, f16x8); }
    }
};
struct EpiGelu {
    static constexpr int NS = 16, PREF = 0;
    bf16_t* U; bf16_t* V; f32x2* STATS;
    __device__ __forceinline__ void operator()(const Acc& acc, const Unit& u, int wr, int wc, int fr, int fq) const {
        const int row0 = u.pm * BM + wr * 64 + fr, cl = wc * 32 + 8 * fq;
        const bool isv = u.pn >= 8; bf16_t* base = isv ? V + (u.pn - 8) * 256 : U + u.pn * 256;
#pragma unroll
        for (int ai = 0; ai < 2; ++ai)
#pragma unroll
            for (int m = 0; m < 4; ++m) { const size_t row = (size_t)(row0 + ai * HALF + m * 16); float s = 0.f, ss = 0.f;
#pragma unroll
                for (int bj = 0; bj < 2; ++bj) { const f32x4 v0 = gelu4(acc[ai][bj][m][0]), v1 = gelu4(acc[ai][bj][m][1]);
                    *(u32x4*)(base + row * 2048 + bj * HALF + cl) = pack8(v0, v1);
                    s += (v0[0] + v0[1]) + (v0[2] + v0[3]) + (v1[0] + v1[1]) + (v1[2] + v1[3]);
                    ss += (v0[0] * v0[0] + v0[1] * v0[1]) + (v0[2] * v0[2] + v0[3] * v0[3]) + (v1[0] * v1[0] + v1[1] * v1[1]) + (v1[2] * v1[2] + v1[3] * v1[3]); }
                if (isv) { s += __shfl_xor(s, 16); ss += __shfl_xor(ss, 16); s += __shfl_xor(s, 32); ss += __shfl_xor(ss, 32);
                    if (fq == 0) STATS[row * 32 + (u.pn - 8) * 4 + wc] = (f32x2){s, ss}; } }
    }
};
struct EpiSwiglu {
    static constexpr int NS = 8, PREF = 0;
    bf16_t* HID;
    __device__ __forceinline__ void operator()(const Acc& acc, const Unit& u, int wr, int wc, int fr, int fq) const {
        const int row0 = u.pm * BM + wr * 64 + fr, col0 = u.pn * 128 + wc * 32 + 8 * fq;
#pragma unroll
        for (int ai = 0; ai < 2; ++ai)
#pragma unroll
            for (int m = 0; m < 4; ++m) { f32x4 h[2];
#pragma unroll
                for (int n = 0; n < 2; ++n) { const f32x4 g = acc[ai][0][m][n], up = acc[ai][1][m][n];
#pragma unroll
                    for (int j = 0; j < 4; ++j) h[n][j] = g[j] * __builtin_amdgcn_rcpf(1.0f + __expf(-g[j])) * up[j]; }
                *(u32x4*)(HID + (size_t)(row0 + ai * HALF + m * 16) * DFF + col0) = pack8(h[0], h[1]); }
    }
};

template <class Epi>
__device__ __forceinline__ void gemm_phase(LAS unsigned char* lds, const Gemm g, const StaticOrder& S, const Epi& E, const int wvs) {
    int tid = wvs * 64 + hw_lane(); asm volatile("" : "+v"(tid));
    const int wid = wvs, lane = tid & 63, wr = wid >> 2, wc = wid & 3, fr = lane & 15, fq = lane >> 4;
    const int K = g.K, nt = K / BK, lda = g.lda;
    unsigned voffA[2], voffB[2];
#pragma unroll
    for (int i = 0; i < 2; ++i) { int R, C; stage_rc(tid * 16 + i * 8192, R, C); const int Rb = (R & ~31) + perm32(R & 31);
        voffA[i] = (unsigned)(R * lda + C) * 2u; voffB[i] = (unsigned)(Rb * K + C) * 2u; }
    const size_t kstep = (size_t)(BK * 2);
    const size_t hstepA = (size_t)HALF * lda * 2, hstepB = (size_t)HALF * K * 2;
    const unsigned ldsw = (unsigned)wid * 1024u; const unsigned ldsb = (unsigned)(size_t)lds + ldsw;
    const int aoff = lds_byte(wr * 64 + fr, fq * 8), boff = lds_byte(wc * 32 + fr, fq * 8);
#define PG8_SA(b, h) (((b) * 2 + (h)) * HTB)
#define PG8_SB(b, h) ((4 + (b) * 2 + (h)) * HTB)
#define PG8_STAGE(bufoff, gbase, voff) asm volatile("s_mov_b32 m0, %2\n\ts_nop 0\n\tglobal_load_lds_dwordx4 %0, %3\n\ts_mov_b32 m0, %4\n\ts_nop 0\n\tglobal_load_lds_dwordx4 %1, %3" \
        :: "v"((voff)[0]), "v"((voff)[1]), "s"(ldsb + (unsigned)(bufoff)), "s"((const char*)(gbase)), "s"(ldsb + (unsigned)(bufoff) + 8192u) : "memory", "m0")
#define PG8_LDA(dst, b, h) do { _Pragma("unroll") for (int m = 0; m < 4; ++m) _Pragma("unroll") for (int k = 0; k < 2; ++k) dst[m][k] = *(const LAS bf16x8*)(lds + PG8_SA(b, h) + (aoff ^ (k * 64)) + m * 2048); } while (0)
#define PG8_LDB(dst, b, h) do { _Pragma("unroll") for (int n = 0; n < 2; ++n) _Pragma("unroll") for (int k = 0; k < 2; ++k) dst[n][k] = *(const LAS bf16x8*)(lds + PG8_SB(b, h) + (boff ^ (k * 64)) + n * 2048); } while (0)
#define PG8_MMA(ai, bj, At, Bt) do { __builtin_amdgcn_s_setprio(1); _Pragma("unroll") for (int m = 0; m < 4; ++m) _Pragma("unroll") for (int n = 0; n < 2; ++n) _Pragma("unroll") for (int k = 0; k < 2; ++k) \
        acc[ai][bj][m][n] = __builtin_amdgcn_mfma_f32_16x16x32_bf16(Bt[n][k], At[m][k], acc[ai][bj][m][n], 0, 0, 0); __builtin_amdgcn_s_setprio(0); } while (0)
#define PG8_WAIT_V(n) asm volatile("s_waitcnt vmcnt(" #n ")" ::: "memory")
#define PG8_WAIT_V1(f) asm volatile("s_cmp_lg_u32 %0, 0\n\ts_cbranch_scc1 .Lpg8a_%=\n\ts_waitcnt vmcnt(8)\n.Lpg8a_%=:\n\ts_cmp_gt_u32 %0, 1\n\ts_cbranch_scc1 .Lpg8b_%=\n\ts_waitcnt vmcnt(%1)\n.Lpg8b_%=:\n\ts_waitcnt vmcnt(%2)" :: "s"(f), "n"(8 + Epi::PREF), "n"(8 + Epi::NS) : "memory", "scc")
#define PG8_WAIT_L(n) asm volatile("s_waitcnt lgkmcnt(" #n ")" ::: "memory")
#define PG8_BAR __builtin_amdgcn_s_barrier()
#define PG8_SCHED __builtin_amdgcn_sched_barrier(0)
#define PG8_ABASE(u) ((const char*)g.A + ((size_t)(u).pm * BM * lda + (size_t)((u).pn >> g.agrp_shift) * g.agrp_stride) * 2)
#define PG8_BBASE(u) ((const char*)g.Bt + (size_t)(u).pn * 2 * hstepB)
    Unit cur, nxt; int ui = 0;
    if (!S.next(0, cur)) return;
    Acc acc;
#pragma unroll
    for (int a = 0; a < 2; ++a)
#pragma unroll
        for (int b = 0; b < 2; ++b)
#pragma unroll
            for (int m = 0; m < 4; ++m)
#pragma unroll
                for (int n = 0; n < 2; ++n) acc[a][b][m][n] = (f32x4){0.f, 0.f, 0.f, 0.f};
    bf16x8 At[4][2], B0[2][2], B1[2][2];
    const char* cA = PG8_ABASE(cur); const char* cB = PG8_BBASE(cur);
    PG8_STAGE(PG8_SB(0, 0), cB, voffB); PG8_STAGE(PG8_SB(0, 1), cB + hstepB, voffB); PG8_STAGE(PG8_SA(0, 0), cA, voffA); PG8_STAGE(PG8_SA(0, 1), cA + hstepA, voffA);
    if (wr == 1) PG8_BAR;
    PG8_WAIT_V(2); PG8_BAR;
    PG8_STAGE(PG8_SB(1, 0), cB + kstep, voffB); PG8_STAGE(PG8_SA(1, 0), cA + kstep, voffA); PG8_STAGE(PG8_SB(1, 1), cB + hstepB + kstep, voffB);
    PG8_WAIT_V(6); PG8_BAR;
    for (;;) {
        const bool has_next = S.next(ui + 1, nxt);
        const char* nA = has_next ? PG8_ABASE(nxt) : cA; const char* nB = has_next ? PG8_BBASE(nxt) : cB;
        for (int t = 0; t < nt; t += 2) {
            const bool last = (t == nt - 2);
            const char* a1 = cA + (size_t)(t + 1) * kstep;
            const char* a2 = last ? nA : cA + (size_t)(t + 2) * kstep; const char* b2 = last ? nB : cB + (size_t)(t + 2) * kstep;
            const char* a3 = a2 + kstep; const char* b3 = b2 + kstep;
            static_assert(Epi::PREF <= Epi::NS, "wait classes must nest");
            const int lenv = (t == 0) ? (ui > 0 ? 2 : 0) : ((Epi::PREF != 0 && t == nt - 2) ? 1 : 0);
            int len; asm volatile("v_readfirstlane_b32 %0, %1" : "=s"(len) : "v"(lenv));
            if constexpr (Epi::PREF != 0) {
                unsigned ptmp; const unsigned poff = E.pref_off(cur, wr, wc, hw_lane()), pdst = (unsigned)(size_t)(lds + 8 * HTB) + (unsigned)wid * 256u;
                asm volatile("s_cmp_lg_u32 %2, 1\n\ts_cbranch_scc1 .Lpg8p_%=\n\ts_mov_b32 m0, %3\n\ts_nop 0\n\tglobal_load_lds_dword %1, %4\n\tglobal_load_lds_dword %1, %4 offset:256\n\t"
                             "v_add_u32_e32 %0, 0x40000, %1\n\tglobal_load_lds_dword %0, %4\n\tglobal_load_lds_dword %0, %4 offset:256\n.Lpg8p_%=:"
                             : "=&v"(ptmp) : "v"(poff), "s"(len), "s"(pdst), "s"(E.x) : "memory", "scc", "m0"); }
            PG8_LDB(B0, 0, 0); PG8_LDB(B1, 0, 1); PG8_SCHED; PG8_LDA(At, 0, 0); PG8_STAGE(PG8_SA(1, 1), a1 + hstepA, voffA);
            PG8_WAIT_V1(len); PG8_WAIT_L(0); PG8_BAR; PG8_MMA(0, 0, At, B0); PG8_MMA(0, 1, At, B1); PG8_BAR; PG8_SCHED;
            PG8_LDA(At, 0, 1); PG8_STAGE(PG8_SB(0, 0), b2, voffB); PG8_STAGE(PG8_SB(0, 1), b2 + hstepB, voffB); PG8_STAGE(PG8_SA(0, 0), a2, voffA);
            PG8_WAIT_V1(len); PG8_WAIT_L(0); PG8_BAR; PG8_MMA(1, 0, At, B0); PG8_MMA(1, 1, At, B1); PG8_BAR; PG8_SCHED;
            PG8_LDB(B0, 1, 0); PG8_LDB(B1, 1, 1); PG8_SCHED; PG8_LDA(At, 1, 0); PG8_STAGE(PG8_SA(0, 1), a2 + hstepA, voffA);
            PG8_WAIT_V(8); PG8_WAIT_L(0); PG8_BAR; PG8_MMA(0, 0, At, B0); PG8_MMA(0, 1, At, B1); PG8_BAR; PG8_SCHED;
            PG8_LDA(At, 1, 1); PG8_STAGE(PG8_SB(1, 0), b3, voffB); PG8_STAGE(PG8_SB(1, 1), b3 + hstepB, voffB); PG8_STAGE(PG8_SA(1, 0), a3, voffA);
            PG8_WAIT_V(8); PG8_WAIT_L(0); PG8_BAR; PG8_MMA(1, 0, At, B0); PG8_MMA(1, 1, At, B1); PG8_BAR; PG8_SCHED;
        }
        if (wr == 0) PG8_BAR;
        { const int l2 = hw_lane();
          E(acc, cur, wr, wc, l2 & 15, l2 >> 4); }
        if (!has_next) break;
#pragma unroll
        for (int a = 0; a < 2; ++a)
#pragma unroll
            for (int b = 0; b < 2; ++b)
#pragma unroll
                for (int m = 0; m < 4; ++m)
#pragma unroll
                    for (int n = 0; n < 2; ++n) acc[a][b][m][n] = (f32x4){0.f, 0.f, 0.f, 0.f};
        cur = nxt; cA = nA; cB = nB; ++ui;
        if (wr == 1) PG8_BAR;
    }
    PG8_WAIT_V(0);
    PG8_BAR;
#undef PG8_SA
#undef PG8_SB
#undef PG8_STAGE
#undef PG8_LDA
#undef PG8_LDB
#undef PG8_MMA
#undef PG8_WAIT_V
#undef PG8_WAIT_L
#undef PG8_WAIT_V1
#undef PG8_BAR
#undef PG8_SCHED
#undef PG8_ABASE
#undef PG8_BBASE
}
}

struct Args { const float* in[23]; float* out; unsigned char* ws; int ph_lo, ph_hi; };

struct CvtDesc { const float* src; bf16_t* dst; int N, ldd, mode, r0, c0, li; };
__device__ __forceinline__ void cvt_load(const CvtDesc& d, int lane, f32x4 (&t)[8]) {
    const int nblk = (d.N + 31) >> 5, k0 = 64 * (d.li / nblk), n0 = 32 * (d.li % nblk);
    const int cc = lane & 7, rr = lane >> 3; const bool ok = n0 + 4 * cc < d.N;
#pragma unroll
    for (int i = 0; i < 8; ++i) t[i] = ok ? *(const f32x4*)(d.src + (size_t)(k0 + 8 * i + rr) * d.N + n0 + 4 * cc) : (f32x4){0.f, 0.f, 0.f, 0.f};
}
__device__ __forceinline__ void cvt_store(const CvtDesc& d, LAS float* scr, int lane, const f32x4 (&t)[8]) {
    const int nblk = (d.N + 31) >> 5, k0 = 64 * (d.li / nblk), n0 = 32 * (d.li % nblk);
    { const int cc = lane & 7, rr = lane >> 3;
#pragma unroll
      for (int i = 0; i < 8; ++i) { LAS float* q = scr + (8 * i + rr) * 33 + 4 * cc; q[0] = t[i][0]; q[1] = t[i][1]; q[2] = t[i][2]; q[3] = t[i][3]; } }
    LDS_WAIT();
    const int c = lane & 7;
#pragma unroll
    for (int j = 0; j < 4; ++j) { const int nl = (lane >> 3) + 8 * j, n = n0 + nl; const LAS float* sp = scr + (8 * c) * 33 + nl;
        u32x4 o; o.x = cvt_pk_bf16(sp[0 * 33], sp[1 * 33]); o.y = cvt_pk_bf16(sp[2 * 33], sp[3 * 33]); o.z = cvt_pk_bf16(sp[4 * 33], sp[5 * 33]); o.w = cvt_pk_bf16(sp[6 * 33], sp[7 * 33]);
        if (n < d.N) { const int drow = d.mode ? ((n >> 7) * 256 + (n & 127) + d.r0) : (d.r0 + n); *(u32x4*)(d.dst + (size_t)drow * d.ldd + d.c0 + k0 + 8 * c) = o; } }
    LDS_WAIT();
}
__device__ __forceinline__ CvtDesc cvt_decode(const Args& a, unsigned char* ws, int r) {
    if (r < 1888) { const int j = r / 944; return CvtDesc{a.in[6] + (size_t)j * 1024 * AIN, (bf16_t*)(ws + W_AIN) + (size_t)j * 2048 * 1024, AIN, 1024, 0, 0, 0, r % 944}; } r -= 1888;
    if (r < 256) { const int jj = r >> 4, la = jj >> 3, h = jj & 7; return CvtDesc{a.in[10] + (size_t)(la * 8 + h) * 128 * 256, (bf16_t*)(ws + W_UK) + (size_t)la * 2048 * 256, 256, 256, 0, h * 256, (h & 1) * 128, r & 15}; } r -= 256;
    if (r < 256) { const int jj = r >> 4, la = jj >> 3, h = jj & 7; return CvtDesc{a.in[11] + (size_t)(la * 8 + h) * 256 * 128, (bf16_t*)(ws + W_UV) + (size_t)la * 1024 * 512, 128, 512, 0, (h >> 1) * 256 + (h & 1) * 128, (h & 1) * 256, r & 15}; } r -= 256;
    if (r < 1024) { const int la = r >> 9; return CvtDesc{a.in[12] + (size_t)la * 1024 * 1024, (bf16_t*)(ws + W_O) + (size_t)la * 1024 * 1024, 1024, 1024, 0, 0, 0, r & 511}; } r -= 1024;
    if (r < 4096) { const int la = r >> 11; return CvtDesc{a.in[13] + (size_t)la * 1024 * 4096, (bf16_t*)(ws + W_BIN) + (size_t)la * 4096 * 1024, 4096, 1024, 0, 0, 0, r & 2047}; } r -= 4096;
    if (r < 2048) { const int la = r >> 10; return CvtDesc{a.in[18] + (size_t)la * 2048 * 1024, (bf16_t*)(ws + W_BOUT) + (size_t)la * 1024 * 2048, 1024, 2048, 0, 0, 0, r & 1023}; } r -= 2048;
    if (r < 11264) { const int jj = r / 1408, l = jj & 3, isup = jj >> 2; return CvtDesc{a.in[isup ? 20 : 19] + (size_t)l * 1024 * DFF, (bf16_t*)(ws + W_GU) + (size_t)l * 5632 * 1024, DFF, 1024, 1, isup * 128, 0, r % 1408}; } r -= 11264;
    { const int l = r / 1408; return CvtDesc{a.in[21] + (size_t)l * DFF * 1024, (bf16_t*)(ws + W_DN) + (size_t)l * 1024 * DFF, 1024, DFF, 0, 0, 0, r % 1408}; }
}

__device__ __forceinline__ void p0_phase(const Args& a, LAS unsigned char* lds, int bid, int G, const int wvs) {
    int tid = wvs * 64 + hw_lane(); asm volatile("" : "+v"(tid));
    const int lane = tid & 63, wave = __builtin_amdgcn_readfirstlane(tid >> 6);
    unsigned char* ws = a.ws;
    LAS float* scr = (LAS float*)(lds + wave * 8704);
    const int gw = bid * 8 + wave, NGW = G * 8;
    constexpr int NITEMS = 1888 + 256 + 256 + 1024 + 4096 + 2048 + 11264 + 5632;
    {
        f32x4 tc[8], tn[8]; CvtDesc dc{}, dn{};
        if (gw < NITEMS) { dc = cvt_decode(a, ws, gw); cvt_load(dc, lane, tc); }
        for (int it = gw; it < NITEMS; it += NGW) {
            const bool hn = it + NGW < NITEMS;
            if (hn) { dn = cvt_decode(a, ws, it + NGW); cvt_load(dn, lane, tn); }
            cvt_store(dc, scr, lane, tc);
            if (hn) { dc = dn;
#pragma unroll
                for (int i = 0; i < 8; ++i) tc[i] = tn[i]; }
        }
    }
    const size_t gt = (size_t)bid * 512 + tid, NT = (size_t)G * 512;
    const u32x4 z = (u32x4){0u, 0u, 0u, 0u};
    for (size_t i = gt; i < 2 * 184 * 128; i += NT) { const int j = (int)(i / (184 * 128)), rem = (int)(i % (184 * 128)), rr = AIN + rem / 128, ch = rem % 128;
        *(u32x4*)((bf16_t*)(ws + W_AIN) + ((size_t)j * 2048 + rr) * 1024 + ch * 8) = z; }
    for (size_t i = gt; i < 2 * 2048 * 16; i += NT) { const int j = (int)(i / (2048 * 16)), rem = (int)(i % (2048 * 16)), rr = rem >> 4, ch = rem & 15, h = rr >> 8;
        *(u32x4*)((bf16_t*)(ws + W_UK) + ((size_t)j * 2048 + rr) * 256 + (1 - (h & 1)) * 128 + ch * 8) = z; }
    for (size_t i = gt; i < 2 * 1024 * 32; i += NT) { const int j = (int)(i / (1024 * 32)), rem = (int)(i % (1024 * 32)), rr = rem >> 5, ch = rem & 31, hh = (rr >> 7) & 1;
        *(u32x4*)((bf16_t*)(ws + W_UV) + ((size_t)j * 1024 + rr) * 512 + (1 - hh) * 256 + ch * 8) = z; }
    __syncthreads();
    LAS float* ca = (LAS float*)lds;
    const float* cvec = a.in[1]; const float* modw = a.in[2]; float* MODP = (float*)(ws + WS_MODP);
    for (int it = bid; it < 768; it += G) {
        const int l = it / 192, rem = it % 192, ng = rem >> 4, kc = rem & 15;
        { const int b = tid >> 6, k = tid & 63; const float cv = cvec[b * 1024 + kc * 64 + k]; ca[b * 64 + k] = cv / (1.0f + __expf(-cv)); }
        __syncthreads();
        const int n = ng * 512 + tid; float acc[8];
#pragma unroll
        for (int b = 0; b < 8; ++b) acc[b] = 0.f;
        const float* wp = modw + ((size_t)l * 1024 + kc * 64) * NMOD + n;
#pragma unroll 8
        for (int k = 0; k < 64; ++k) { const float w = wp[(size_t)k * NMOD];
#pragma unroll
            for (int b = 0; b < 8; ++b) acc[b] += ca[b * 64 + k] * w; }
#pragma unroll
        for (int b = 0; b < 8; ++b) MODP[((size_t)(kc * 4 + l) * 8 + b) * NMOD + n] = acc[b];
        __syncthreads();
    }
}
__device__ __forceinline__ void p0c_phase(const Args& a, int bid, int G, const int wvs) {
    const float* MODP = (const float*)(a.ws + WS_MODP); float* MOD = (float*)(a.ws + WS_MOD); const float* modb = a.in[3];
    int tid0 = wvs * 64 + hw_lane(); asm volatile("" : "+v"(tid0));
    for (int i = bid * 512 + tid0; i < 4 * 8 * NMOD; i += G * 512) { const int l = i / (8 * NMOD), n = i % NMOD; float s = modb[l * NMOD + n];
#pragma unroll
        for (int kc = 0; kc < 16; ++kc) s += MODP[(size_t)kc * (4 * 8 * NMOD) + i];
        MOD[i] = s; }
}

template <bool FIRST>
__device__ __forceinline__ void norm_mod_phase(const float* x32, _Float16* x16, const float* gain, const float* sh, const float* sc, bf16_t* H, int bid, int G, const int wvs) {
    int tid = wvs * 64 + hw_lane(); asm volatile("" : "+v"(tid));
    const int lane = tid & 63, wave = tid >> 6;
    for (int q = (bid >> 3) * 8 + wave; q < T / 16; q += (G >> 3) * 8) {
        const int b = bid & 7, rb = b * T + q * 16; f32x4 gs[4], sv[4];
#pragma unroll
        for (int j = 0; j < 4; ++j) { const int c = 8 * lane + 512 * (j >> 1) + 4 * (j & 1); const f32x4 g4 = *(const f32x4*)(gain + c), s4 = *(const f32x4*)(sc + (size_t)b * NMOD + c); gs[j] = g4 * (s4 + 1.0f); sv[j] = *(const f32x4*)(sh + (size_t)b * NMOD + c); }
        f32x4 nx[4]; f16x8 nh[2];
        if (FIRST) {
#pragma unroll
            for (int j = 0; j < 4; ++j) nx[j] = *(const f32x4*)(x32 + (size_t)rb * D + 8 * lane + 512 * (j >> 1) + 4 * (j & 1)); }
        else {
#pragma unroll
            for (int j = 0; j < 2; ++j) nh[j] = *(const f16x8*)(x16 + (size_t)rb * D + 8 * lane + 512 * j); }
        for (int r = rb; r < rb + 16; ++r) {
            f32x4 v[4];
            if (FIRST) {
#pragma unroll
                for (int j = 0; j < 4; ++j) v[j] = nx[j];
#pragma unroll
                for (int j = 0; j < 2; ++j) *(f16x8*)(x16 + (size_t)r * D + 8 * lane + 512 * j) = __builtin_convertvector((f32x8){v[2 * j][0], v[2 * j][1], v[2 * j][2], v[2 * j][3], v[2 * j + 1][0], v[2 * j + 1][1], v[2 * j + 1][2], v[2 * j + 1][3]}, f16x8);
            } else {
#pragma unroll
                for (int j = 0; j < 2; ++j) { const f32x8 t = __builtin_convertvector(nh[j], f32x8); v[2 * j] = (f32x4){t[0], t[1], t[2], t[3]}; v[2 * j + 1] = (f32x4){t[4], t[5], t[6], t[7]}; }
            }
            const int rn = (r + 1 < rb + 16) ? r + 1 : r;
            if (FIRST) {
#pragma unroll
                for (int j = 0; j < 4; ++j) nx[j] = *(const f32x4*)(x32 + (size_t)rn * D + 8 * lane + 512 * (j >> 1) + 4 * (j & 1)); }
            else {
#pragma unroll
                for (int j = 0; j < 2; ++j) nh[j] = *(const f16x8*)(x16 + (size_t)rn * D + 8 * lane + 512 * j); }
            float ss = 0.f;
#pragma unroll
            for (int j = 0; j < 4; ++j) ss += (v[j][0] * v[j][0] + v[j][1] * v[j][1]) + (v[j][2] * v[j][2] + v[j][3] * v[j][3]);
            const float rstd = rsqrtf(wave_sum(ss) * (1.0f / D) + EPS);
#pragma unroll
            for (int j = 0; j < 2; ++j) { const f32x4 y0 = v[2 * j] * rstd * gs[2 * j] + sv[2 * j], y1 = v[2 * j + 1] * rstd * gs[2 * j + 1] + sv[2 * j + 1];
                u32x4 w; w.x = cvt_pk_bf16(y0[0], y0[1]); w.y = cvt_pk_bf16(y0[2], y0[3]); w.z = cvt_pk_bf16(y1[0], y1[1]); w.w = cvt_pk_bf16(y1[2], y1[3]);
                *(u32x4*)(H + (size_t)r * D + 8 * lane + 512 * j) = w; }
        }
    }
}
__device__ __forceinline__ void final_norm_phase(const _Float16* x16, const float* gain, float* out, int bid, int G, const int wvs) {
    int tid = wvs * 64 + hw_lane(); asm volatile("" : "+v"(tid));
    const int lane = tid & 63, wave = tid >> 6;
    f32x4 gs[4];
#pragma unroll
    for (int j = 0; j < 4; ++j) gs[j] = *(const f32x4*)(gain + 8 * lane + 512 * (j >> 1) + 4 * (j & 1));
    f16x8 nh[2];
    { const int r0 = (bid & 7) * T + (bid >> 3) * 8 + wave;
#pragma unroll
      for (int j = 0; j < 2; ++j) nh[j] = *(const f16x8*)(x16 + (size_t)r0 * D + 8 * lane + 512 * j); }
    for (int q = (bid >> 3) * 8 + wave; q < T; q += (G >> 3) * 8) { const int r = (bid & 7) * T + q;
        f32x4 v[4]; float ss = 0.f;
#pragma unroll
        for (int j = 0; j < 2; ++j) { const f32x8 t = __builtin_convertvector(nh[j], f32x8); v[2 * j] = (f32x4){t[0], t[1], t[2], t[3]}; v[2 * j + 1] = (f32x4){t[4], t[5], t[6], t[7]}; }
        const int rn = (q + (G >> 3) * 8 < T) ? r + (G >> 3) * 8 : r;
#pragma unroll
        for (int j = 0; j < 2; ++j) nh[j] = *(const f16x8*)(x16 + (size_t)rn * D + 8 * lane + 512 * j);
#pragma unroll
        for (int j = 0; j < 4; ++j) ss += (v[j][0] * v[j][0] + v[j][1] * v[j][1]) + (v[j][2] * v[j][2] + v[j][3] * v[j][3]);
        const float rstd = rsqrtf(wave_sum(ss) * (1.0f / D) + EPS);
#pragma unroll
        for (int j = 0; j < 4; ++j) *(f32x4*)(out + (size_t)r * D + 8 * lane + 512 * (j >> 1) + 4 * (j & 1)) = v[j] * rstd * gs[j];
    }
}
__device__ __forceinline__ void dsa_rows_phase(const float* CKVR, const float* KRAW, const float* gkv, const float* gk, const float* bk, bf16_t* CKV, bf16_t* KIDX, float* WIDX, int bid, int G, const int wvs) {
    int tid = wvs * 64 + hw_lane(); asm volatile("" : "+v"(tid));
    const int lane = tid & 63, wave = tid >> 6;
    const f32x4 g4 = *(const f32x4*)(gkv + 4 * lane);
    f32x4 gk4 = (f32x4){0.f, 0.f, 0.f, 0.f}, bk4 = gk4;
    if (lane < 16) { gk4 = *(const f32x4*)(gk + 4 * lane); bk4 = *(const f32x4*)(bk + 4 * lane); }
    for (int q = (bid >> 3) * 8 + wave; q < T; q += (G >> 3) * 8) { const int r = (bid & 7) * T + q;
        const f32x4 v = *(const f32x4*)(CKVR + (size_t)r * 256 + 4 * lane);
        f32x4 kv = (f32x4){0.f, 0.f, 0.f, 0.f}; if (lane < 32) kv = *(const f32x4*)(KRAW + (size_t)r * 128 + 4 * lane);
        const float ss = wave_sum((v[0] * v[0] + v[1] * v[1]) + (v[2] * v[2] + v[3] * v[3]));
        const float rstd = rsqrtf(ss * (1.0f / 256.0f) + EPS);
        { const f32x4 y = v * rstd * g4; int w = 0; w = __builtin_amdgcn_cvt_pk_fp8_f32(y[0], y[1], w, false); w = __builtin_amdgcn_cvt_pk_fp8_f32(y[2], y[3], w, true); *(int*)((unsigned char*)CKV + (size_t)r * 256 + 4 * lane) = w; }
        const float ks = (lane < 16) ? (kv[0] + kv[1]) + (kv[2] + kv[3]) : 0.f;
        const float mean = wave_sum(ks) * (1.0f / 64.0f);
        const f32x4 dv = kv - mean;
        const float kq = (lane < 16) ? (dv[0] * dv[0] + dv[1] * dv[1]) + (dv[2] * dv[2] + dv[3] * dv[3]) : 0.f;
        const float krstd = rsqrtf(wave_sum(kq) * (1.0f / 64.0f) + EPS);
        if (lane < 16) { const f32x4 y = dv * krstd * gk4 + bk4; u32x2 w; w.x = cvt_pk_bf16(y[0], y[1]); w.y = cvt_pk_bf16(y[2], y[3]); *(u32x2*)(KIDX + ((((size_t)(r >> 5) * 4 + (lane >> 2)) * 64 + (((lane >> 1) & 1) * 32 + (r & 31))) * 8 + (lane & 1) * 4)) = w; }
        else if (lane < 18) { *(f32x4*)(WIDX + (size_t)r * 8 + 4 * (lane - 16)) = kv * 0.04419417382f; }
    }
}

__device__ __forceinline__ float relu_i(float x) { const int b = __float_as_int(x); return __int_as_float(b > 0 ? b : 0); }
__device__ __forceinline__ float relu_mul(float x, float w) { return relu_i(x) * w; }
__device__ __forceinline__ float relu_fma(float x, float w, float acc) { return __builtin_fmaf(relu_i(x), w, acc); }
__device__ __forceinline__ float fmin_raw(float a, float b) { return __builtin_amdgcn_fmed3f(a, b, -__builtin_inff()); }
__device__ __forceinline__ float fmax_raw(float a, float b) { return __builtin_amdgcn_fmed3f(a, b, __builtin_inff()); }
__device__ __forceinline__ unsigned mbcnt64(unsigned long long m) { return __builtin_amdgcn_mbcnt_hi((unsigned)(m >> 32), __builtin_amdgcn_mbcnt_lo((unsigned)m, 0u)); }

template <int SHIFT, int WIDTH>
__device__ __forceinline__ void sel_level(const unsigned (&k)[64], int N, LAS unsigned* hist, int lane, unsigned& prefix, unsigned& need) {
    LAS u32x4* hz = (LAS u32x4*)(hist + 32 * lane);
#pragma unroll
    for (int j = 0; j < 8; ++j) hz[j] = (u32x4){0u, 0u, 0u, 0u};
    LDS_WAIT();
#pragma unroll
    for (int gi = 0; gi < 8; ++gi) if (512 * gi < N) {
#pragma unroll
        for (int ii = 0; ii < 8; ++ii) { const unsigned key = k[8 * gi + ii]; const bool ok = (key >> (SHIFT + WIDTH)) == prefix;
            LAS unsigned* p = ok ? hist + ((key >> SHIFT) & ((1u << WIDTH) - 1u)) : hist + 2048 + lane;
            __hip_atomic_fetch_add(p, 1u, __ATOMIC_RELAXED, __HIP_MEMORY_SCOPE_WORKGROUP); } }
    LDS_WAIT();
    u32x4 hv[8]; unsigned ls = 0u;
#pragma unroll
    for (int j = 0; j < 8; ++j) { hv[j] = hz[j]; ls += (hv[j][0] + hv[j][1]) + (hv[j][2] + hv[j][3]); }
    unsigned incl = ls;
#pragma unroll
    for (int o = 1; o < 64; o <<= 1) { const unsigned v = bperm_u((lane + o) & 63, incl); if (lane + o < 64) incl += v; }
    const unsigned above = incl - ls;
    unsigned cnt = above, d = 0u, nn = 0u;
#pragma unroll
    for (int j = 31; j >= 0; --j) { const unsigned h = hv[j >> 2][j & 3]; const bool hit = (cnt < need) && (need <= cnt + h); d = hit ? (unsigned)(32 * lane + j) : d; nn = hit ? need - cnt : nn; cnt += h; }
    const bool found = (above < need) && (need <= above + ls);
    const unsigned long long fm = __ballot(found);
    const int src = (fm != 0ull) ? (__ffsll((long long)fm) - 1) : 0;
    d = bperm_u(src, d); need = bperm_u(src, nn);
    prefix = (prefix << WIDTH) | d;
}

__device__ __forceinline__ void dsa_select_phase(LAS unsigned char* lds, const bf16_t* QIDX, const bf16_t* KIDX, const float* WIDX, unsigned short* IDX, int bid, int G, const int wvs) {
    int tid0 = wvs * 64 + hw_lane(); asm volatile("" : "+v"(tid0));
    const int wave = __builtin_amdgcn_readfirstlane(tid0 >> 6);
    LAS float* SC = (LAS float*)lds;
    LAS unsigned short* IDXL = (LAS unsigned short*)(lds + 135168) + wave * 256;
    LAS float* MM = (LAS float*)(lds + 139264);
    bf16x8 af[2][4]; bf16x8 kb[4][4];
#define DSA_UNIT(itx, b_, t0_, mb_, ntile_, nj_) const int b_ = (itx) & 7, t0_ = ((itx) >> 3) * 8; const size_t mb_ = (size_t)b_ * T; \
    const int ntile_ = (t0_ + 8 + 31) >> 5; const int nj_ = (wave < ntile_) ? ((ntile_ - wave + 7) >> 3) : 0;
#define DSA_KLOAD(buf, j, kbase_, nj_) do { const int jc_ = ((j) < (nj_)) ? (j) : ((nj_) > 0 ? (nj_) - 1 : 0); const bf16_t* kp_ = (kbase_) + (size_t)(wave + 8 * jc_) * 2048; \
    _Pragma("unroll") for (int ks = 0; ks < 4; ++ks) kb[buf][ks] = *(const bf16x8*)(kp_ + 512 * ks); } while (0)
#define DSA_PRELOAD(t0_, mb_, nj_) do { \
    _Pragma("unroll") for (int rg = 0; rg < 2; ++rg) { const bf16_t* qp = QIDX + ((mb_) + (t0_) + 4 * rg + (col >> 3)) * 512 + (col & 7) * 64 + 8 * hf; \
        _Pragma("unroll") for (int ks = 0; ks < 4; ++ks) af[rg][ks] = *(const bf16x8*)(qp + 16 * ks); } \
    (void)(nj_); } while (0)
    { int tid = tid0; asm volatile("" : "+v"(tid)); const int lane = tid & 63, hf = lane >> 5, col = lane & 31;
      if (bid < 4096) { DSA_UNIT(bid, b, t0, mb, ntile, nj) (void)b; (void)ntile; if (t0 + 8 > 256) DSA_PRELOAD(t0, mb, nj); } }
    for (int it = bid; it < 4096; it += G) {
        int tid = tid0; asm volatile("" : "+v"(tid));
        const int lane = tid & 63, hf = lane >> 5, col = lane & 31;
        DSA_UNIT(it, b, t0, mb, ntile, nj) (void)b; (void)ntile;
        const int t = t0 + wave, N = t + 1;
        unsigned short* outp = IDX + (mb + t) * 256;
        const int itn = it + G; const bool hasn = itn < 4096;
        DSA_UNIT(hasn ? itn : it, bn, t0n, mbn, ntilen, njn) (void)bn; (void)ntilen;
        if (t0 + 8 <= 256) {
            *(u32x2*)(outp + 4 * lane) = (u32x2){(unsigned)(4 * lane) | ((unsigned)(4 * lane + 1) << 16), (unsigned)(4 * lane + 2) | ((unsigned)(4 * lane + 3) << 16)};
            if (hasn && t0n + 8 > 256) DSA_PRELOAD(t0n, mbn, njn);
            continue;
        }
        float w[2][4][4]; float mn[2][2], mx[2][2];
#pragma unroll
        for (int rg = 0; rg < 2; ++rg)
#pragma unroll
            for (int e = 0; e < 2; ++e) { mn[rg][e] = 3.0e38f; mx[rg][e] = -3.0e38f; }
        const bf16_t* kbase = KIDX + mb * 64 + (size_t)lane * 8;
        DSA_KLOAD(0, 0, kbase, nj); DSA_KLOAD(1, 1, kbase, nj); DSA_KLOAD(2, 2, kbase, nj); DSA_KLOAD(3, 3, kbase, nj);
#pragma unroll
        for (int rg = 0; rg < 2; ++rg)
#pragma unroll
            for (int qq = 0; qq < 4; ++qq) { const f32x4 wv = *(const f32x4*)(WIDX + (mb + t0 + 4 * rg + qq) * 8 + 4 * hf);
                w[rg][qq][0] = wv[0]; w[rg][qq][1] = wv[1]; w[rg][qq][2] = wv[2]; w[rg][qq][3] = wv[3]; }
#define DSA_KCOMP(buf, j) do { const int s_ = 32 * (wave + 8 * (j)) + col; f32x16 acc0, acc1; \
    _Pragma("unroll") for (int i = 0; i < 16; ++i) { acc0[i] = 0.f; acc1[i] = 0.f; } \
    _Pragma("unroll") for (int ks = 0; ks < 4; ++ks) { acc0 = __builtin_amdgcn_mfma_f32_32x32x16_bf16(af[0][ks], kb[buf][ks], acc0, 0, 0, 0); acc1 = __builtin_amdgcn_mfma_f32_32x32x16_bf16(af[1][ks], kb[buf][ks], acc1, 0, 0, 0); } \
    _Pragma("unroll") for (int rg = 0; rg < 2; ++rg) { float p[4]; \
        _Pragma("unroll") for (int qq = 0; qq < 4; ++qq) { p[qq] = relu_mul(rg ? acc1[4 * qq] : acc0[4 * qq], w[rg][qq][0]); _Pragma("unroll") for (int ii = 1; ii < 4; ++ii) p[qq] = relu_fma(rg ? acc1[4 * qq + ii] : acc0[4 * qq + ii], w[rg][qq][ii], p[qq]); } \
        _Pragma("unroll") for (int e = 0; e < 2; ++e) { const auto r = __builtin_amdgcn_permlane32_swap(__float_as_uint(p[e]), __float_as_uint(p[2 + e]), false, false); \
            const float tot = __uint_as_float(r[0]) + __uint_as_float(r[1]); SC[(4 * rg + 2 * hf + e) * 4096 + s_] = tot; mn[rg][e] = fmin_raw(mn[rg][e], tot); mx[rg][e] = fmax_raw(mx[rg][e], tot); } } } while (0)
        for (int j = 0; j < nj; j += 4) {
            DSA_KCOMP(0, j); if (j + 4 < nj) DSA_KLOAD(0, j + 4, kbase, nj);
            if (j + 1 < nj) DSA_KCOMP(1, j + 1);
            if (j + 5 < nj) DSA_KLOAD(1, j + 5, kbase, nj);
            if (j + 2 < nj) DSA_KCOMP(2, j + 2);
            if (j + 6 < nj) DSA_KLOAD(2, j + 6, kbase, nj);
            if (j + 3 < nj) DSA_KCOMP(3, j + 3);
            if (j + 7 < nj) DSA_KLOAD(3, j + 7, kbase, nj);
        }
#pragma unroll
        for (int rg = 0; rg < 2; ++rg)
#pragma unroll
            for (int e = 0; e < 2; ++e) {
#pragma unroll
                for (int o = 1; o < 32; o <<= 1) { mn[rg][e] = fminf(mn[rg][e], bperm_f(lane ^ o, mn[rg][e])); mx[rg][e] = fmaxf(mx[rg][e], bperm_f(lane ^ o, mx[rg][e])); }
                if (col == 0) { MM[(wave * 8 + 4 * rg + 2 * hf + e) * 2] = mn[rg][e]; MM[(wave * 8 + 4 * rg + 2 * hf + e) * 2 + 1] = mx[rg][e]; } }
        if (hasn && t0n + 8 > 256) DSA_PRELOAD(t0n, mbn, njn);
        __syncthreads();
        {
            const LAS float* scl = SC + wave * 4096 + lane;
            LAS unsigned* hist = (LAS unsigned*)(lds + wave * 16384);
            float lo = 3.0e38f, hi = -3.0e38f;
#pragma unroll
            for (int wv = 0; wv < 8; ++wv) { lo = fminf(lo, MM[(wv * 8 + wave) * 2]); hi = fmaxf(hi, MM[(wv * 8 + wave) * 2 + 1]); }
            const float scale = 4.0e9f / fmaxf(hi - lo, 1e-30f);
            unsigned k[64];
#pragma unroll
            for (int gi = 0; gi < 8; ++gi) { if (512 * gi < N) {
#pragma unroll
                for (int ii = 0; ii < 8; ++ii) k[8 * gi + ii] = __float_as_uint(scl[64 * (8 * gi + ii)]); } else {
#pragma unroll
                for (int ii = 0; ii < 8; ++ii) k[8 * gi + ii] = 0u; } }
            LDS_WAIT();
            { LAS u32x4* hz = (LAS u32x4*)(hist + 16 * lane);
#pragma unroll
              for (int j = 0; j < 4; ++j) hz[j] = (u32x4){0u, 0u, 0u, 0u}; }
            LDS_WAIT();
#pragma unroll
            for (int gi = 0; gi < 8; ++gi) if (512 * gi < N) {
#pragma unroll
                for (int ii = 0; ii < 8; ++ii) { const int i = 8 * gi + ii; const bool valid = lane < N - 64 * i;
                    const unsigned key = valid ? 1u + (unsigned)((__uint_as_float(k[i]) - lo) * scale) : 0u; k[i] = key;
                    LAS unsigned* p = valid ? hist + (key >> 22) : hist + 1024 + lane;
                    __hip_atomic_fetch_add(p, 1u, __ATOMIC_RELAXED, __HIP_MEMORY_SCOPE_WORKGROUP); } }
            LDS_WAIT();
            unsigned d0, need1;
            { const LAS u32x4* hz = (const LAS u32x4*)(hist + 16 * lane); u32x4 hv[4]; unsigned ls = 0u;
#pragma unroll
              for (int j = 0; j < 4; ++j) { hv[j] = hz[j]; ls += (hv[j][0] + hv[j][1]) + (hv[j][2] + hv[j][3]); }
              unsigned incl = ls;
#pragma unroll
              for (int o = 1; o < 64; o <<= 1) { const unsigned v = bperm_u((lane + o) & 63, incl); if (lane + o < 64) incl += v; }
              const unsigned above = incl - ls; unsigned cnt = above, d = 0u, nn = 0u;
#pragma unroll
              for (int j = 15; j >= 0; --j) { const unsigned h = hv[j >> 2][j & 3]; const bool hit = (cnt < 256u) && (256u <= cnt + h); d = hit ? (unsigned)(16 * lane + j) : d; nn = hit ? 256u - cnt : nn; cnt += h; }
              const bool found = (above < 256u) && (256u <= above + ls);
              const unsigned long long fm = __ballot(found);
              const int src = (fm != 0ull) ? (__ffsll((long long)fm) - 1) : 0;
              d0 = bperm_u(src, d); need1 = bperm_u(src, nn); }
            LAS unsigned* CK = hist + 1100; LAS unsigned short* CS = (LAS unsigned short*)(hist + 1170);
            unsigned base = 0u, cbase = 0u;
#pragma unroll
            for (int gi = 0; gi < 8; ++gi) if (512 * gi < N) {
#pragma unroll
                for (int ii = 0; ii < 8; ++ii) { const int i = 8 * gi + ii; const unsigned key = k[i], dg = key >> 22;
                    const bool gt = dg > d0, eq = (dg == d0) && (key != 0u);
                    const unsigned long long mgt = __ballot(gt), meq = __ballot(eq);
                    if (gt) IDXL[base + mbcnt64(mgt)] = (unsigned short)(64 * i + lane);
                    base += (unsigned)__popcll(mgt);
                    if (meq != 0ull) { const unsigned cp = cbase + mbcnt64(meq); if (eq && cp < 64u) { CK[cp] = key; CS[cp] = (unsigned short)(64 * i + lane); } cbase += (unsigned)__popcll(meq); } } }
            LDS_WAIT();
            if (cbase <= 64u) {
                const unsigned mykey = (lane < (int)cbase) ? CK[lane] : 0u; unsigned rank = 0u;
                for (unsigned j = 0; j < cbase; ++j) { const unsigned kj = CK[j]; rank += ((kj > mykey) || (kj == mykey && j < (unsigned)lane)) ? 1u : 0u; }
                const bool sel = (lane < (int)cbase) && (rank < need1);
                const unsigned long long ms = __ballot(sel);
                if (sel) IDXL[base + mbcnt64(ms)] = CS[lane];
            } else {
                unsigned prefix = d0, need = need1;
                LDS_WAIT();
                sel_level<11, 11>(k, N, hist, lane, prefix, need);
                sel_level<0, 11>(k, N, hist, lane, prefix, need);
                unsigned eb = 0u, eqb = 0u;
#pragma unroll
                for (int gi = 0; gi < 8; ++gi) if (512 * gi < N) {
#pragma unroll
                    for (int ii = 0; ii < 8; ++ii) { const int i = 8 * gi + ii; const unsigned key = k[i]; const bool gt = key > prefix, eq = key == prefix;
                        const unsigned long long meq = __ballot(eq); const bool sel = gt || (eq && (eqb + mbcnt64(meq) < need));
                        const unsigned long long msel = __ballot(sel); const unsigned pos = eb + mbcnt64(msel);
                        if (sel && pos < 256u) IDXL[pos] = (unsigned short)(64 * i + lane);
                        eb += (unsigned)__popcll(msel); eqb += (unsigned)__popcll(meq); } }
            }
            LDS_WAIT();
            *(u32x2*)(outp + 4 * lane) = *(const LAS u32x2*)(IDXL + 4 * lane);
        }
        __syncthreads();
    }
#undef DSA_UNIT
#undef DSA_KLOAD
#undef DSA_PRELOAD
#undef DSA_KCOMP
}

__device__ __forceinline__ void dsa_attn_phase(LAS unsigned char* lds, const unsigned char* QLAT8, const unsigned char* CKV8, const unsigned short* IDX, bf16_t* OLAT, int bid, int G, const int wvs) {
    int tid0 = wvs * 64 + hw_lane(); asm volatile("" : "+v"(tid0));
    const int wave = __builtin_amdgcn_readfirstlane(tid0 >> 6);
    constexpr int RS = 272, T1OFF = 16 * RS + 128, TS = 32 * RS + 128;
    LAS unsigned char* tile0 = lds + wave * (2 * TS);
    constexpr float SCL = 1.4426950408889634f / 16.0f;
    unsigned ixw[8]; u32x4 qf[4]; u32x4 ra[2][2][4];
#define ATT_Q(itx, b_, t_, m_, cnt_) const int b_ = (itx) & 7, t_ = ((itx) >> 3) * 8 + wave; const size_t m_ = (size_t)b_ * T + t_; const int cnt_ = (t_ + 1 < 256) ? t_ + 1 : 256;
#define ATT_LOAD_IX(dst, m_) do { const u32x4 xa_ = *(const u32x4*)(IDX + (m_) * 256 + 16 * c16), xb_ = *(const u32x4*)(IDX + (m_) * 256 + 16 * c16 + 8); \
    dst[0] = xa_[0]; dst[1] = xa_[1]; dst[2] = xa_[2]; dst[3] = xa_[3]; dst[4] = xb_[0]; dst[5] = xb_[1]; dst[6] = xb_[2]; dst[7] = xb_[3]; } while (0)
#define ATT_LOAD_QF(dst, m_) do { const unsigned char* qp_ = QLAT8 + (m_) * 2048 + hd * 256 + 16 * g; _Pragma("unroll") for (int kk = 0; kk < 4; ++kk) dst[kk] = *(const u32x4*)(qp_ + 64 * kk); } while (0)
#define ATT_LOAD_ROWS(buf, ix_, n0_, b_, cnt_) do { const int n1_ = (n0_) + 1; \
    const int k0_ = (16 * c16 + (n0_) < (cnt_)) ? (int)(ix_[(n0_) >> 1] & 0xffffu) : 0, k1_ = (16 * c16 + n1_ < (cnt_)) ? (int)(ix_[n1_ >> 1] >> 16) : 0; \
    const unsigned char* cb_ = CKV8 + (size_t)(b_) * T * 256 + 16 * g; \
    _Pragma("unroll") for (int kk = 0; kk < 4; ++kk) { ra[buf][0][kk] = *(const u32x4*)(cb_ + (size_t)k0_ * 256 + 64 * kk); ra[buf][1][kk] = *(const u32x4*)(cb_ + (size_t)k1_ * 256 + 64 * kk); } } while (0)
#define ATT_QK(bf, d0, d1) do { d0 = (f32x4){0.f, 0.f, 0.f, 0.f}; d1 = d0; \
    _Pragma("unroll") for (int kk = 0; kk < 4; ++kk) _Pragma("unroll") for (int hh = 0; hh < 2; ++hh) { \
        const long qv_ = (long)(((unsigned long long)qf[kk][2 * hh + 1] << 32) | qf[kk][2 * hh]); \
        const long a0_ = (long)(((unsigned long long)ra[bf][0][kk][2 * hh + 1] << 32) | ra[bf][0][kk][2 * hh]); \
        const long a1_ = (long)(((unsigned long long)ra[bf][1][kk][2 * hh + 1] << 32) | ra[bf][1][kk][2 * hh]); \
        d0 = __builtin_amdgcn_mfma_f32_16x16x32_fp8_fp8(a0_, qv_, d0, 0, 0, 0); d1 = __builtin_amdgcn_mfma_f32_16x16x32_fp8_fp8(a1_, qv_, d1, 0, 0, 0); } \
    _Pragma("unroll") for (int kk = 0; kk < 4; ++kk) { *(LAS u32x4*)(tile0 + (bf) * TS + c16 * RS + 64 * kk + 16 * g) = ra[bf][0][kk]; *(LAS u32x4*)(tile0 + (bf) * TS + T1OFF + c16 * RS + 64 * kk + 16 * g) = ra[bf][1][kk]; } } while (0)
    { int tid = tid0; asm volatile("" : "+v"(tid)); const int lane = tid & 63, g = lane >> 4, c16 = lane & 15, hd = c16 & 7;
      if (bid < 4096) { ATT_Q(bid, b, t, m, cnt) (void)t; ATT_LOAD_IX(ixw, m); ATT_LOAD_QF(qf, m); ATT_LOAD_ROWS(0, ixw, 0, b, cnt); ATT_LOAD_ROWS(1, ixw, 2, b, cnt); } }
    for (int it = bid; it < 4096; it += G) {
        int tid = tid0; asm volatile("" : "+v"(tid));
        const int lane = tid & 63, g = lane >> 4, c16 = lane & 15, hd = c16 & 7, q4 = c16 >> 2, p4 = c16 & 3;
        ATT_Q(it, b, t, m, cnt) (void)t;
        const int itn = it + G; const bool hasn = itn < 4096;
        ATT_Q(hasn ? itn : it, bn, tn, mn, cntn) (void)tn;
        f32x4 o[16];
#pragma unroll
        for (int db = 0; db < 16; ++db) o[db] = (f32x4){0.f, 0.f, 0.f, 0.f};
        const int trow = ((c16 >> 1) < 4 ? (4 * g + (c16 >> 1)) * RS : T1OFF + (4 * g + (c16 >> 1) - 4) * RS) + 8 * (c16 & 1);
        float mrun = -INFINITY, lrun = 0.f;
        f32x4 s0, s1, sn0, sn1;
        ATT_QK(0, s0, s1); ATT_LOAD_ROWS(0, ixw, 4, b, cnt);
#pragma unroll
        for (int ch = 0; ch < 8; ++ch) {
            const int bf = ch & 1, bn1 = (ch + 1) & 1;
            if (ch < 7) { ATT_QK(bn1, sn0, sn1);
                if (ch < 5) ATT_LOAD_ROWS(bn1, ixw, 2 * (ch + 3), b, cnt);
                else if (hasn) ATT_LOAD_ROWS(bn1, ixw, 2 * (ch - 5), bn, cntn); }
            if (ch == 4 && hasn) ATT_LOAD_IX(ixw, mn);
            if (ch == 6 && hasn) ATT_LOAD_QF(qf, mn);
            float cm = -INFINITY;
#pragma unroll
            for (int i = 0; i < 4; ++i) { const int jr = 16 * (4 * g + i) + 2 * ch; if (jr >= cnt) s0[i] = -INFINITY; if (jr + 1 >= cnt) s1[i] = -INFINITY; cm = fmaxf(cm, fmaxf(s0[i], s1[i])); }
            cm = fmaxf(cm, bperm_f(lane ^ 16, cm)); cm = fmaxf(cm, bperm_f(lane ^ 32, cm));
            const float mnew = fmaxf(mrun, cm), alpha = __builtin_amdgcn_exp2f((mrun - mnew) * SCL);
            float p0[4], p1[4], ps = 0.f;
#pragma unroll
            for (int i = 0; i < 4; ++i) { p0[i] = __builtin_amdgcn_exp2f((s0[i] - mnew) * SCL); p1[i] = __builtin_amdgcn_exp2f((s1[i] - mnew) * SCL); ps += p0[i] + p1[i]; }
            lrun = lrun * alpha + ps; mrun = mnew;
            asm volatile("" : "+v"(lrun));
#pragma unroll
            for (int db = 0; db < 16; ++db) o[db] = o[db] * alpha;
            int pl = 0, ph = 0;
            pl = __builtin_amdgcn_cvt_pk_fp8_f32(p0[0], p0[1], pl, false); pl = __builtin_amdgcn_cvt_pk_fp8_f32(p0[2], p0[3], pl, true);
            ph = __builtin_amdgcn_cvt_pk_fp8_f32(p1[0], p1[1], ph, false); ph = __builtin_amdgcn_cvt_pk_fp8_f32(p1[2], p1[3], ph, true);
            const long pb = (long)(((unsigned long long)(unsigned)ph << 32) | (unsigned)pl);
#pragma unroll
            for (int db = 0; db < 16; ++db) {
                const i32x2 tv = __builtin_amdgcn_ds_read_tr8_b64_v2i32((LAS i32x2*)(tile0 + bf * TS + trow + 16 * db));
                const long av = (long)(((unsigned long long)(unsigned)tv.y << 32) | (unsigned)tv.x);
                o[db] = __builtin_amdgcn_mfma_f32_16x16x32_fp8_fp8(av, pb, o[db], 0, 0, 0);
            }
            if (ch < 7) { s0 = sn0; s1 = sn1; }
        }
        float lt = lrun + bperm_f(lane ^ 16, lrun); lt += bperm_f(lane ^ 32, lt);
        const float inv = 1.0f / lt;
        if (c16 < 8) { bf16_t* op = OLAT + m * 2048 + c16 * 256 + 4 * g;
#pragma unroll
            for (int db = 0; db < 16; ++db) { const f32x4 y = o[db] * inv; *(u32x2*)(op + 16 * db) = (u32x2){cvt_pk_bf16(y[0], y[1]), cvt_pk_bf16(y[2], y[3])}; } }
    }
#undef ATT_Q
#undef ATT_LOAD_IX
#undef ATT_LOAD_QF
#undef ATT_LOAD_ROWS
#undef ATT_QK
}

__device__ __forceinline__ void smix_phase(LAS unsigned char* lds, bf16_t* UY, const bf16_t* V, const f32x2* STATS, const float* Wc, const float* bsp, const float* lng, const float* lnb, int bid, int G, const int wvs) {
    int tid0 = wvs * 64 + hw_lane(); asm volatile("" : "+v"(tid0));
    const int wave = wvs;
    LAS unsigned char* VT = lds;
    LAS unsigned char* AP = lds + 67584;
    LAS float* MU = (LAS float*)(lds + 102400); LAS float* RSTD = MU + 128; LAS float* R1 = MU + 256; LAS float* R2 = MU + 384;
    u32x4 vr[8]; f32x4 sr[4];
#define SMIX_UNIT(itx, b_, gi_, m0_) const int b_ = (itx) & 7, gi_ = ((itx) >> 3) & 7; const size_t m0_ = (size_t)b_ * T + ((itx) >> 6) * 128;
#define SMIX_PRELOAD(m0_, gi_) do { \
    _Pragma("unroll") for (int i = 0; i < 8; ++i) { const int cidx = tid + 512 * i, s_ = cidx >> 5, ch = cidx & 31; vr[i] = *(const u32x4*)(V + ((m0_) + s_) * 2048 + (gi_) * 256 + ch * 8); } \
    { const f32x4* sp = (const f32x4*)(STATS + ((m0_) + (tid >> 2)) * 32 + (tid & 3) * 8); _Pragma("unroll") for (int j = 0; j < 4; ++j) sr[j] = sp[j]; } } while (0)
    if (bid < 2048) { const int tid = tid0; SMIX_UNIT(bid, b0, gi0, m00) (void)b0; SMIX_PRELOAD(m00, gi0); }
    for (int it = bid; it < 2048; it += G) {
        int tid = tid0; asm volatile("" : "+v"(tid));
        const int lane = tid & 63, gq = lane >> 4, c16 = lane & 15, q4 = c16 >> 2, p4 = c16 & 3;
        SMIX_UNIT(it, b, gi, m0) (void)b;
        u32x4 ur[8];
#pragma unroll
        for (int i = 0; i < 8; ++i) { const int cidx = tid + 512 * i, s = cidx >> 5, ch = cidx & 31; ur[i] = *(const u32x4*)(UY + (m0 + s) * 2048 + gi * 256 + ch * 8); }
        { float s = ((sr[0][0] + sr[0][2]) + (sr[1][0] + sr[1][2])) + ((sr[2][0] + sr[2][2]) + (sr[3][0] + sr[3][2])), ss = ((sr[0][1] + sr[0][3]) + (sr[1][1] + sr[1][3])) + ((sr[2][1] + sr[2][3]) + (sr[3][1] + sr[3][3]));
          s += bperm_f(lane ^ 1, s); ss += bperm_f(lane ^ 1, ss); s += bperm_f(lane ^ 2, s); ss += bperm_f(lane ^ 2, ss);
          if ((tid & 3) == 0) { const float mu = s * (1.0f / 2048.0f), var = ss * (1.0f / 2048.0f) - mu * mu; MU[tid >> 2] = mu; RSTD[tid >> 2] = rsqrtf(fmaxf(var, 0.f) + EPS); } }
#pragma unroll
        for (int i = 0; i < 8; ++i) { const int cidx = tid + 512 * i, s = cidx >> 5, ch = cidx & 31; *(LAS u32x4*)(VT + s * 528 + ch * 16) = vr[i]; }
        f32x4 wq[8];
        { const float* wp = Wc + ((size_t)gi * 128 + (tid >> 2)) * 128 + 32 * (tid & 3);
#pragma unroll
          for (int j = 0; j < 8; ++j) wq[j] = *(const f32x4*)(wp + 4 * j); }
        __syncthreads();
        { const int t = tid >> 2, qd = tid & 3; float r1 = 0.f, r2 = 0.f;
#pragma unroll
          for (int s8 = 0; s8 < 4; ++s8) { const f32x4 wa = wq[2 * s8], wb = wq[2 * s8 + 1]; float av[8];
#pragma unroll
              for (int e = 0; e < 8; ++e) { const int s = 32 * qd + 8 * s8 + e; const float wv = (s <= t) ? (e < 4 ? wa[e] : wb[e - 4]) : 0.f; const float ab = bf_round(wv * RSTD[s]); av[e] = ab; r1 += ab * MU[s]; r2 += wv; }
              u32x4 o; o.x = cvt_pk_bf16(av[0], av[1]); o.y = cvt_pk_bf16(av[2], av[3]); o.z = cvt_pk_bf16(av[4], av[5]); o.w = cvt_pk_bf16(av[6], av[7]);
              *(LAS u32x4*)(AP + t * 272 + (32 * qd + 8 * s8) * 2) = o; }
          r1 += bperm_f(lane ^ 1, r1); r2 += bperm_f(lane ^ 1, r2); r1 += bperm_f(lane ^ 2, r1); r2 += bperm_f(lane ^ 2, r2);
          if (qd == 0) { R1[t] = r1; R2[t] = r2; } }
        __syncthreads();
        f32x4 acc[8][2];
#pragma unroll
        for (int mt = 0; mt < 8; ++mt) { acc[mt][0] = (f32x4){0.f, 0.f, 0.f, 0.f}; acc[mt][1] = acc[mt][0]; }
#pragma unroll
        for (int ks = 0; ks < 4; ++ks) {
            bf16x8 vf[2];
#pragma unroll
            for (int n2 = 0; n2 < 2; ++n2) { const int nt = 2 * wave + n2;
                const s16x4 t0v = __builtin_amdgcn_ds_read_tr16_b64_v4i16((LAS s16x4*)(VT + (32 * ks + 8 * gq + q4) * 528 + (16 * nt + 4 * p4) * 2));
                const s16x4 t1v = __builtin_amdgcn_ds_read_tr16_b64_v4i16((LAS s16x4*)(VT + (32 * ks + 8 * gq + 4 + q4) * 528 + (16 * nt + 4 * p4) * 2));
                vf[n2] = __builtin_shufflevector(t0v, t1v, 0, 1, 2, 3, 4, 5, 6, 7); }
#pragma unroll
            for (int mt = 0; mt < 8; ++mt) if (mt >= 2 * ks) {
                const bf16x8 afr = *(const LAS bf16x8*)(AP + (16 * mt + c16) * 272 + (32 * ks + 8 * gq) * 2);
                acc[mt][0] = __builtin_amdgcn_mfma_f32_16x16x32_bf16(vf[0], afr, acc[mt][0], 0, 0, 0);
                acc[mt][1] = __builtin_amdgcn_mfma_f32_16x16x32_bf16(vf[1], afr, acc[mt][1], 0, 0, 0); }
        }
        { const int itn = it + G; if (itn < 2048) { SMIX_UNIT(itn, bn, gin, m0n) (void)bn; SMIX_PRELOAD(m0n, gin); } }
        __syncthreads();
#pragma unroll
        for (int i = 0; i < 8; ++i) { const int cidx = tid + 512 * i, s = cidx >> 5, ch = cidx & 31; *(LAS u32x4*)(VT + s * 528 + ch * 16) = ur[i]; }
        __syncthreads();
#pragma unroll
        for (int n2 = 0; n2 < 2; ++n2) { const int e0 = 16 * (2 * wave + n2) + 4 * gq; const f32x4 lg4 = *(const f32x4*)(lng + gi * 256 + e0), lb4 = *(const f32x4*)(lnb + gi * 256 + e0);
#pragma unroll
            for (int mt = 0; mt < 8; ++mt) { const int t = 16 * mt + c16; const float r1 = R1[t], r2 = R2[t], bsv = bsp[gi * 128 + t];
                LAS u32x2* up = (LAS u32x2*)(VT + t * 528 + e0 * 2); const u32x2 uw = *up;
                const f32x4 mixed = lg4 * (acc[mt][n2] - r1) + lb4 * r2 + bsv;
                const float y0 = bf2f(uw.x & 0xffffu) * mixed[0], y1 = bf2f(uw.x >> 16) * mixed[1], y2 = bf2f(uw.y & 0xffffu) * mixed[2], y3 = bf2f(uw.y >> 16) * mixed[3];
                u32x2 yw; yw.x = cvt_pk_bf16(y0, y1); yw.y = cvt_pk_bf16(y2, y3); *up = yw; } }
        __syncthreads();
#pragma unroll
        for (int i = 0; i < 8; ++i) { const int cidx = tid + 512 * i, s = cidx >> 5, ch = cidx & 31;
            *(u32x4*)(UY + (m0 + s) * 2048 + gi * 256 + ch * 8) = *(const LAS u32x4*)(VT + s * 528 + ch * 16); }
        __syncthreads();
    }
#undef SMIX_UNIT
#undef SMIX_PRELOAD
}

__global__ void __launch_bounds__(512, 2) mk_fwd(Args a) {
    extern __shared__ __attribute__((aligned(16))) unsigned char lds_raw[];
    LAS unsigned char* lds = (LAS unsigned char*)lds_raw;
    cg::grid_group grid = cg::this_grid();
    int bid = blockIdx.x; const int G = gridDim.x;
    unsigned char* wsk = a.ws;
    volatile LAS unsigned* misc = (volatile LAS unsigned*)(lds + LDS_MISC);
    const int wvs = __builtin_amdgcn_readfirstlane((int)threadIdx.x >> 6);
    if (wvs == 0 && hw_lane() < 2) misc[hw_lane()] = 0u;
    __syncthreads();
    const XcdBarrier xbar = xcd_barrier_post((unsigned*)(wsk + WS_BAR), misc, wvs);
    int ph = 0;
#ifndef PROBE
#define PROBE 0
#endif
#define PHASE_BEGIN if (ph >= a.ph_lo && ph < a.ph_hi) { size_t bb = (size_t)(bid & 7); asm volatile("" : "+s"(bb)); unsigned char* const act = wsk + WS_ACT + bb * SLAB; (void)act;
#define REP(k) for (int rep_ = 0; rep_ < ((PROBE == (k)) ? 2 : 1); ++rep_)
#define PHASE_END(dosync) if ((dosync) && ph + 1 < a.ph_hi) { if (ph == 0) grid.sync(); else if (ph == 1 || !local) xcd_barrier(xbar); else xcd_barrier_local(xbar); } } ++ph;

    bool local = false;
    PHASE_BEGIN REP(4) { p0_phase(a, lds, bid, G, wvs); __syncthreads(); } PHASE_END(true)
    {   if (wvs == 0 && hw_lane() == 0) { unsigned ok = (G == 256) ? 1u : 0u;
            for (unsigned j = 0; j < 16; ++j) { const unsigned c = xb_ld(&xbar.bar[XB_XCNT(j)]); ok &= (c == (j < 8u ? 32u : 0u)) ? 1u : 0u; }
            misc[3] = ok; }
        __syncthreads();
        if (misc[3] != 0u) { local = true; bid = __builtin_amdgcn_readfirstlane((int)(misc[2] * 8u + xbar.x)); }
    }
    PHASE_BEGIN p0c_phase(a, bid, G, wvs); PHASE_END(true)

#define ACT(off, rowbytes) (act + (off) - bb * T * (size_t)(rowbytes))
#define H ((bf16_t*)((unsigned char*)a.out + bb * (16 * MiB) - bb * T * 2048))
#define X ((_Float16*)ACT(S_X16, 2048))
#define Q ((bf16_t*)ACT(S_Q, 2048))
#define CKVR ((float*)ACT(S_CKVR, 1024))
#define QIDX ((bf16_t*)ACT(S_QIDX, 1024))
#define KRAW ((float*)ACT(S_KRAW, 512))
#define CKV ((bf16_t*)ACT(S_CKV, 256))
#define KIDX ((bf16_t*)ACT(S_KIDX, 128))
#define WIDX ((float*)ACT(S_WIDX, 32))
#define IDX ((unsigned short*)ACT(S_IDX, 512))
#define QLAT ((bf16_t*)ACT(S_QLAT, 2048))
#define OLAT ((bf16_t*)a.out)
#define O ((bf16_t*)ACT(S_O, 2048))
#define U ((bf16_t*)ACT(S_U, 4096))
#define V ((bf16_t*)ACT(S_V, 4096))
#define STATS ((f32x2*)ACT(S_STATS, 256))
    auto layer_body = [&](const int layer) __attribute__((always_inline)) {
        unsigned char* ws = wsk; asm volatile("" : "+s"(ws));
        float* MOD = (float*)(ws + WS_MOD);
        const int j = layer >> 1;
        const float* modl = MOD + (size_t)layer * 8 * NMOD;
        PHASE_BEGIN REP(3) { if (layer == 0) norm_mod_phase<true>(a.in[0], X, a.in[4] + layer * D, modl + 0 * D, modl + 1 * D, H, bid, G, wvs);
            else norm_mod_phase<false>(nullptr, X, a.in[4] + layer * D, modl + 0 * D, modl + 1 * D, H, bid, G, wvs); } PHASE_END(true)
        if ((layer & 1) == 0) {
            PHASE_BEGIN { pg8::Gemm g{H, (const bf16_t*)(ws + W_AIN) + (size_t)j * 2048 * 1024, M, 2048, 1024, 1024, 0, 0}; pg8::StaticOrder S; S.init(M, 2048, G, bid);
                pg8::EpiInproj E{Q, QIDX, (unsigned char*)CKV, KIDX, WIDX, a.in[7] + j * 256, a.in[8] + j * 64, a.in[9] + j * 64, (LAS float*)(lds + 8 * pg8::HTB)}; REP(5) pg8::gemm_phase(lds, g, S, E, wvs); } PHASE_END(true)
            PHASE_BEGIN {
                pg8::Gemm g{Q, (const bf16_t*)(ws + W_UK) + (size_t)j * 2048 * 256, M, 2048, 256, 1024, 1, 256}; pg8::StaticOrder S; S.init(M, 2048, G, bid);
                pg8::EpiBf16 E{QLAT, 2048, 1.4142135623730951f, 1}; pg8::gemm_phase(lds, g, S, E, wvs); } PHASE_END(true)
            PHASE_BEGIN REP(1) dsa_select_phase(lds, QIDX, KIDX, WIDX, IDX, bid, G, wvs); PHASE_END(true)
            PHASE_BEGIN REP(2) dsa_attn_phase(lds, (const unsigned char*)QLAT, (const unsigned char*)CKV, IDX, OLAT, bid, G, wvs); PHASE_END(true)
            PHASE_BEGIN { pg8::Gemm g{OLAT, (const bf16_t*)(ws + W_UV) + (size_t)j * 1024 * 512, M, 1024, 512, 2048, 0, 512}; pg8::StaticOrder S; S.init(M, 1024, G, bid);
                pg8::EpiBf16 E{O, 1024, 1.0f, 0}; pg8::gemm_phase(lds, g, S, E, wvs); } PHASE_END(true)
            PHASE_BEGIN { pg8::Gemm g{O, (const bf16_t*)(ws + W_O) + (size_t)j * 1024 * 1024, M, 1024, 1024, 1024, 0, 0}; pg8::StaticOrder S; S.init(M, 1024, G, bid);
                pg8::EpiResid E{X, modl + 2 * D}; pg8::gemm_phase(lds, g, S, E, wvs); } PHASE_END(true)
        } else {
            PHASE_BEGIN { pg8::Gemm g{H, (const bf16_t*)(ws + W_BIN) + (size_t)j * 4096 * 1024, M, 4096, 1024, 1024, 0, 0}; pg8::StaticOrder S; S.init(M, 4096, G, bid);
                pg8::EpiGelu E{U, V, STATS}; REP(7) pg8::gemm_phase(lds, g, S, E, wvs); } PHASE_END(true)
            PHASE_BEGIN smix_phase(lds, U, V, STATS, a.in[16] + (size_t)j * 8 * 128 * 128, a.in[17] + (size_t)j * 8 * 128, a.in[14] + (size_t)j * 2048, a.in[15] + (size_t)j * 2048, bid, G, wvs); PHASE_END(true)
            PHASE_BEGIN { pg8::Gemm g{U, (const bf16_t*)(ws + W_BOUT) + (size_t)j * 1024 * 2048, M, 1024, 2048, 2048, 0, 0}; pg8::StaticOrder S; S.init(M, 1024, G, bid);
                pg8::EpiResid E{X, modl + 2 * D}; pg8::gemm_phase(lds, g, S, E, wvs); } PHASE_END(true)
        }
        PHASE_BEGIN REP(3) norm_mod_phase<false>(nullptr, X, a.in[5] + layer * D, modl + 3 * D, modl + 4 * D, H, bid, G, wvs); PHASE_END(true)
        PHASE_BEGIN { pg8::Gemm g{H, (const bf16_t*)(ws + W_GU) + (size_t)layer * 5632 * 1024, M, 5632, 1024, 1024, 0, 0}; pg8::StaticOrder S; S.init(M, 5632, G, bid);
            pg8::EpiSwiglu E{(bf16_t*)ACT(S_HID, 5632)}; REP(6) pg8::gemm_phase(lds, g, S, E, wvs); } PHASE_END(true)
        PHASE_BEGIN { pg8::Gemm g{(const bf16_t*)ACT(S_HID, 5632), (const bf16_t*)(ws + W_DN) + (size_t)layer * 1024 * DFF, M, 1024, DFF, DFF, 0, 0}; pg8::StaticOrder S; S.init(M, 1024, G, bid);
            pg8::EpiResid E{X, modl + 5 * D}; pg8::gemm_phase(lds, g, S, E, wvs); } PHASE_END(true)
    };
    layer_body(0); layer_body(1); layer_body(2); layer_body(3);
    PHASE_BEGIN final_norm_phase(X, a.in[22], a.out, bid, G, wvs); PHASE_END(false)
#undef H
#undef X
#undef Q
#undef CKVR
#undef QIDX
#undef KRAW
#undef CKV
#undef KIDX
#undef WIDX
#undef IDX
#undef QLAT
#undef OLAT
#undef O
#undef U
#undef V
#undef STATS
#undef ACT
}

extern "C" void kernel_launch(void* const* d_in, const int* in_sizes, int n_in, void* d_out, int out_size, void* d_ws, size_t ws_size, hipStream_t stream) {
    static int grid_blocks = 0;
    if (grid_blocks == 0) {
        int dev = 0, cus = 0, per_cu = 0;
        if (n_in != 23 || out_size != M * D || ws_size < WS_END) { fprintf(stderr, "kernel_launch: unexpected problem (n_in %d out %d ws %zu, need ws >= %zu)\n", n_in, out_size, ws_size, (size_t)WS_END); grid_blocks = -1; return; }
        (void)hipGetDevice(&dev);
        (void)hipDeviceGetAttribute(&cus, hipDeviceAttributeMultiprocessorCount, dev);
        (void)hipFuncSetAttribute((const void*)mk_fwd, hipFuncAttributeMaxDynamicSharedMemorySize, LDS_BYTES);
        (void)hipOccupancyMaxActiveBlocksPerMultiprocessor(&per_cu, (const void*)mk_fwd, 512, LDS_BYTES);
        fprintf(stderr, "kernel_launch: cus %d per_cu %d ws %zu\n", cus, per_cu, ws_size);
        if (per_cu < 1) { fprintf(stderr, "kernel_launch: kernel does not fit a CU\n"); grid_blocks = -1; return; }
        grid_blocks = cus;
    }
    if (grid_blocks < 0) return;
    if (hipMemsetAsync((char*)d_ws + WS_BAR, 0, 16384, stream) != hipSuccess) { fprintf(stderr, "kernel_launch: memset failed\n"); return; }
    Args a{};
    for (int i = 0; i < 23; ++i) a.in[i] = (const float*)d_in[i];
    a.out = (float*)d_out; a.ws = (unsigned char*)d_ws; a.ph_lo = 0; a.ph_hi = 1000;
    void* args[] = {&a};
    hipError_t e = hipLaunchCooperativeKernel((const void*)mk_fwd, dim3(grid_blocks), dim3(512), args, LDS_BYTES, stream);
    if (e != hipSuccess) fprintf(stderr, "cooperative launch failed: %s (grid %d)\n", hipGetErrorString(e), grid_blocks);
}
```

```cpp
#include <hip/hip_runtime.h>
#include <hip/hip_cooperative_groups.h>
#include <cstdio>
#include <cstdint>
namespace cg = cooperative_groups;

#define LAS __attribute__((address_space(3)))
typedef unsigned short bf16_t;
typedef short bf16x8 __attribute__((ext_vector_type(8)));
typedef short s16x4 __attribute__((ext_vector_type(4)));
typedef float f32x4 __attribute__((ext_vector_type(4)));
typedef float f32x16 __attribute__((ext_vector_type(16)));
typedef float f32x2 __attribute__((ext_vector_type(2)));
typedef unsigned u32x4 __attribute__((ext_vector_type(4)));
typedef unsigned u32x2 __attribute__((ext_vector_type(2)));
typedef int i32x2 __attribute__((ext_vector_type(2)));
typedef _Float16 f16x8 __attribute__((ext_vector_type(8)));
typedef float f32x8 __attribute__((ext_vector_type(8)));

constexpr int D = 1024, NB = 8, T = 4096, M = NB * T, DFF = 2816, NMOD = 6 * D;
constexpr float EPS = 1e-6f;
constexpr int AIN = 1864;
constexpr size_t MiB = 1u << 20;
constexpr size_t WS_MOD = 0;
constexpr size_t WS_MODP = 1 * MiB;
constexpr size_t WS_W = 13 * MiB;
constexpr size_t W_AIN = WS_W;
constexpr size_t W_UK = W_AIN + 8 * MiB;
constexpr size_t W_UV = W_UK + 2 * MiB;
constexpr size_t W_O = W_UV + 2 * MiB;
constexpr size_t W_BIN = W_O + 4 * MiB;
constexpr size_t W_BOUT = W_BIN + 16 * MiB;
constexpr size_t W_GU = W_BOUT + 8 * MiB;
constexpr size_t W_DN = W_GU + 44 * MiB;
constexpr size_t WS_ACT = W_DN + 22 * MiB;
constexpr size_t KiB = 1024, SLAB = 47 * MiB;
constexpr size_t S_X16 = 0;
constexpr size_t S_Q = 8 * MiB;
constexpr size_t S_HID = 8 * MiB;
constexpr size_t S_U = 8 * MiB;
constexpr size_t S_V = 24 * MiB;
constexpr size_t S_STATS = 40 * MiB;
constexpr size_t S_QLAT = 16 * MiB;
constexpr size_t S_O = 16 * MiB;
constexpr size_t S_CKVR = 32 * MiB;
constexpr size_t S_CKV = 36 * MiB;
constexpr size_t S_QIDX = 38 * MiB;
constexpr size_t S_KRAW = 42 * MiB;
constexpr size_t S_KIDX = 44 * MiB;
constexpr size_t S_WIDX = 44 * MiB + 512 * KiB;
constexpr size_t S_IDX = 44 * MiB + 640 * KiB;
static_assert(S_IDX + 2 * MiB <= SLAB && S_HID + 22 * MiB <= S_CKVR && S_STATS + MiB <= SLAB, "slab map");
constexpr size_t WS_END = WS_ACT + 8 * SLAB;
constexpr int LDS_BYTES = 147456;
constexpr int LDS_MISC = LDS_BYTES - 256;
constexpr size_t WS_BAR = 1 * MiB - 16384;

__device__ __forceinline__ unsigned cvt_pk_bf16(float lo, float hi) { unsigned r; asm volatile("v_cvt_pk_bf16_f32 %0, %1, %2" : "=v"(r) : "v"(lo), "v"(hi)); return r; }
__device__ __forceinline__ float bf2f(unsigned b) { return __uint_as_float(b << 16); }
__device__ __forceinline__ float bf_round(float f) { unsigned u = __float_as_uint(f); u = (u + 0x7fffu + ((u >> 16) & 1u)) & 0xffff0000u; return __uint_as_float(u); }
__device__ __forceinline__ float wave_sum(float v) {
#pragma unroll
    for (int o = 1; o < 64; o <<= 1) v += __shfl_xor(v, o);
    return v;
}
#define LDS_WAIT() asm volatile("s_waitcnt lgkmcnt(0)" ::: "memory")
__device__ __forceinline__ unsigned bperm_u(int srclane, unsigned v) { return (unsigned)__builtin_amdgcn_ds_bpermute(srclane << 2, (int)v); }
__device__ __forceinline__ int hw_lane() { int l; asm volatile("v_mbcnt_lo_u32_b32 %0, -1, 0\n\tv_mbcnt_hi_u32_b32 %0, -1, %0" : "=v"(l)); return l; }
__device__ __forceinline__ float bperm_f(int srclane, float v) { return __int_as_float(__builtin_amdgcn_ds_bpermute(srclane << 2, __float_as_int(v))); }


#define XB_TMO      128
#define XB_XCNT(j)  (256  + 64 * (j))
#define XB_XSUB(j)  (1280 + 64 * (j))
#define XB_XGEN(j)  (2304 + 64 * (j))
#define XB_TOP      3328
#define XB_TOPGEN   3392
#define XCD_BAR_WORDS 3456
#define XB_SPIN_CAP (1u << 22)
__device__ __forceinline__ unsigned xb_ld(unsigned* p)              { return __hip_atomic_load(p, __ATOMIC_RELAXED, __HIP_MEMORY_SCOPE_AGENT); }
__device__ __forceinline__ unsigned xb_add(unsigned* p, unsigned v) { return __hip_atomic_fetch_add(p, v, __ATOMIC_RELAXED, __HIP_MEMORY_SCOPE_AGENT); }
__device__ __forceinline__ unsigned xb_xcc_id() { return (unsigned)__builtin_amdgcn_s_getreg((3 << 11) | 20) & 0xFu; }
#define XB_SPIN(cond, bar) do { unsigned _sp = 0; while (cond) { __builtin_amdgcn_s_sleep(1); \
    if ((++_sp & 255u) == 0u) { if (xb_ld(&(bar)[XB_TMO])) break; if (_sp > XB_SPIN_CAP) { atomicAdd(&(bar)[XB_TMO], 1u); break; } } } } while (0)
struct XcdBarrier { unsigned* bar; unsigned x; volatile LAS unsigned* st; int wvs; };
__device__ __forceinline__ XcdBarrier xcd_barrier_post(unsigned* bar, volatile LAS unsigned* st, int wvs) {
    XcdBarrier b; b.bar = bar; b.x = xb_xcc_id(); b.st = st; b.wvs = wvs;
    if (wvs == 0 && hw_lane() == 0) st[2] = xb_add(&bar[XB_XCNT(b.x)], 1u);
    return b;
}
__device__ __forceinline__ void xcd_barrier_complete(unsigned* bar, unsigned x, unsigned& nloc, unsigned& nx) {
    const unsigned G = gridDim.x * gridDim.y * gridDim.z;
    unsigned sum, cnt, mine, sp = 0u;
    for (;;) {
        sum = 0u; cnt = 0u; mine = 0u;
#pragma unroll
        for (unsigned j = 0; j < 16; ++j) { const unsigned c = xb_ld(&bar[XB_XCNT(j)]); sum += c; cnt += (c > 0u) ? 1u : 0u; mine = (j == x) ? c : mine; }
        if (sum == G) break;
        __builtin_amdgcn_s_sleep(1);
        if ((++sp & 255u) == 0u) { if (xb_ld(&bar[XB_TMO])) break; if (sp > XB_SPIN_CAP) { atomicAdd(&bar[XB_TMO], 1u); break; } }
    }
    nloc = mine > 0u ? mine : 1u; nx = cnt > 0u ? cnt : 1u;
}
__device__ __forceinline__ void xcd_barrier(const XcdBarrier& b) {
    asm volatile("s_waitcnt vmcnt(0)" ::: "memory");
    __syncthreads();
    if (b.wvs == 0 && hw_lane() == 0) {
        unsigned* bar = b.bar;
        __builtin_amdgcn_s_waitcnt(0);
        unsigned nloc = b.st[0], nx = b.st[1];
        if (nloc == 0u) { xcd_barrier_complete(bar, b.x, nloc, nx); b.st[0] = nloc; b.st[1] = nx; }
        const unsigned old = xb_add(&bar[XB_XSUB(b.x)], 1u);
        const unsigned gen = old / nloc;
        if (old + 1u == (gen + 1u) * nloc) {
            __builtin_amdgcn_fence(__ATOMIC_RELEASE, "agent");
            asm volatile("s_waitcnt vmcnt(0)" ::: "memory");
            const unsigned og = xb_add(&bar[XB_TOP], 1u);
            const unsigned tg = og / nx;
            if (og + 1u == (tg + 1u) * nx) xb_add(&bar[XB_TOPGEN], 1u);
            else XB_SPIN(xb_ld(&bar[XB_TOPGEN]) == tg, bar);
            __builtin_amdgcn_fence(__ATOMIC_ACQUIRE, "agent");
            xb_add(&bar[XB_XGEN(b.x)], 1u);
            asm volatile("s_waitcnt vmcnt(0)" ::: "memory");
        } else {
            XB_SPIN(xb_ld(&bar[XB_XGEN(b.x)]) == gen, bar);
            __builtin_amdgcn_fence(__ATOMIC_ACQUIRE, "agent");
            asm volatile("s_waitcnt vmcnt(0)" ::: "memory");
        }
    }
    __syncthreads();
}

__device__ __forceinline__ void xcd_barrier_local(const XcdBarrier& b) {
    asm volatile("s_waitcnt vmcnt(0)" ::: "memory");
    __syncthreads();
    if (b.wvs == 0 && hw_lane() == 0) {
        unsigned* bar = b.bar;
        __builtin_amdgcn_s_waitcnt(0);
        const unsigned nloc = b.st[0];
        asm volatile("buffer_inv sc1" ::: "memory");
        const unsigned old = xb_add(&bar[XB_XSUB(b.x)], 1u);
        const unsigned gen = old / nloc;
        if (old + 1u == (gen + 1u) * nloc) xb_add(&bar[XB_XGEN(b.x)], 1u);
        else XB_SPIN(xb_ld(&bar[XB_XGEN(b.x)]) == gen, bar);
        asm volatile("s_waitcnt vmcnt(0)" ::: "memory");
    }
    __syncthreads();
}

namespace pg8 {
constexpr int BM = 256, BK = 64, HALF = 128, HTB = HALF * BK * 2, STAGE_BYTES = 8 * HTB, NXCD = 8, WGM = 8;
__host__ __device__ __forceinline__ int lds_byte(int r, int c) { return (r >> 3) * 1024 + (r & 7) * 128 + (((c >> 3) ^ ((r >> 1) & 7)) << 4) + (c & 7) * 2; }
__host__ __device__ __forceinline__ void stage_rc(int b, int& R, int& C) { const int blk = b / 1024, sb = b % 1024; R = blk * 8 + sb / 128; C = ((((sb % 128) >> 4) ^ ((R >> 1) & 7))) * 8; }
__host__ __device__ __forceinline__ int perm32(int rho) { const int n = rho >> 4, i = rho & 15; return 8 * (i >> 2) + 4 * n + (i & 3); }

struct Unit { int pm, pn; };
struct Gemm { const bf16_t* A; const bf16_t* Bt; int M, N, K, lda, agrp_shift, agrp_stride; };

struct StaticOrder {
    int nM, nN, nwg, G, c;
    __device__ void init(int M_, int N_, int G_, int c_) { nM = M_ / BM; nN = N_ / BM; nwg = nM * nN; G = G_; c = c_; }
    __device__ bool next(int i, Unit& u) const {
        const long L = (long)i * G + c; if (L >= nwg) return false;
        int wgid = (int)L; { const int q = nwg / NXCD, r = nwg % NXCD, xcd = wgid % NXCD, off = wgid / NXCD; wgid = (xcd < r ? xcd * (q + 1) : r * (q + 1) + (xcd - r) * q) + off; }
        const int nig = WGM * nN, gid = wgid / nig, fm = gid * WGM, gsz = (nM - fm) < WGM ? (nM - fm) : WGM;
        u.pm = fm + ((wgid % nig) % gsz); u.pn = (wgid % nig) / gsz; return true;
    }
};

typedef f32x4 Acc[2][2][4][2];

__device__ __forceinline__ f32x2 gelu_pk(f32x2 v) {
    const f32x2 av = __builtin_elementwise_abs(v), d = av * 0.2316418882f + 1.0f;
    f32x2 t; t.x = __builtin_amdgcn_rcpf(d.x); t.y = __builtin_amdgcn_rcpf(d.y);
    f32x2 q = t * 0.5307027145f + (-0.7265760135f); q = q * t + 0.7107068705f; q = q * t + (-0.142248368f); q = q * t + 0.127414796f; q = q * t;
    const f32x2 s = (v * v) * (-0.72134752044f);
    f32x2 e; e.x = __builtin_amdgcn_exp2f(s.x); e.y = __builtin_amdgcn_exp2f(s.y);
    const f32x2 m = v * (q * e), r = v - m;
    f32x2 o; o.x = v.x < 0.f ? m.x : r.x; o.y = v.y < 0.f ? m.y : r.y; return o;
}
__device__ __forceinline__ f32x4 gelu4(f32x4 v) { f32x2 a = gelu_pk((f32x2){v[0], v[1]}), b = gelu_pk((f32x2){v[2], v[3]}); return (f32x4){a.x, a.y, b.x, b.y}; }
__device__ __forceinline__ u32x4 pack8(f32x4 v0, f32x4 v1) { u32x4 w; w.x = cvt_pk_bf16(v0[0], v0[1]); w.y = cvt_pk_bf16(v0[2], v0[3]); w.z = cvt_pk_bf16(v1[0], v1[1]); w.w = cvt_pk_bf16(v1[2], v1[3]); return w; }

struct EpiInproj {
    static constexpr int NS = 0, PREF = 0;
    bf16_t* Q; bf16_t* QIDX; unsigned char* CKV; bf16_t* KIDX; float* WIDX; const float* gkv; const float* gk; const float* bk; LAS float* rs;
    __device__ __forceinline__ void operator()(const Acc& acc, const Unit& u, int wr, int wc, int fr, int fq) const {
        const int row0 = u.pm * BM + wr * 64 + fr, cl = wc * 32 + 8 * fq;
        if (u.pn == 4) {
#pragma unroll
            for (int ai = 0; ai < 2; ++ai)
#pragma unroll
                for (int m = 0; m < 4; ++m) { float ss = 0.f;
#pragma unroll
                    for (int bj = 0; bj < 2; ++bj)
#pragma unroll
                        for (int n = 0; n < 2; ++n) { const f32x4 v = acc[ai][bj][m][n]; ss += (v[0] * v[0] + v[1] * v[1]) + (v[2] * v[2] + v[3] * v[3]); }
                    ss += bperm_f((16 * fq + fr) ^ 16, ss); ss += bperm_f((16 * fq + fr) ^ 32, ss);
                    if (fq == 0) rs[(ai * HALF + wr * 64 + m * 16 + fr) * 4 + wc] = ss; }
            asm volatile("s_waitcnt lgkmcnt(0)" ::: "memory"); __builtin_amdgcn_s_barrier();
            f32x4 g4[2][2];
#pragma unroll
            for (int bj = 0; bj < 2; ++bj)
#pragma unroll
                for (int n = 0; n < 2; ++n) g4[bj][n] = *(const f32x4*)(gkv + bj * HALF + cl + 4 * n);
#pragma unroll
            for (int ai = 0; ai < 2; ++ai)
#pragma unroll
                for (int m = 0; m < 4; ++m) { const f32x4 p = *(const LAS f32x4*)(rs + (ai * HALF + wr * 64 + m * 16 + fr) * 4);
                    const float rstd = rsqrtf(((p[0] + p[1]) + (p[2] + p[3])) * (1.0f / 256.0f) + EPS);
                    unsigned char* rowp = CKV + (size_t)(row0 + ai * HALF + m * 16) * 256 + cl;
#pragma unroll
                    for (int bj = 0; bj < 2; ++bj) { const f32x4 y0 = acc[ai][bj][m][0] * rstd * g4[bj][0], y1 = acc[ai][bj][m][1] * rstd * g4[bj][1]; int w0 = 0, w1 = 0;
                        w0 = __builtin_amdgcn_cvt_pk_fp8_f32(y0[0], y0[1], w0, false); w0 = __builtin_amdgcn_cvt_pk_fp8_f32(y0[2], y0[3], w0, true);
                        w1 = __builtin_amdgcn_cvt_pk_fp8_f32(y1[0], y1[1], w1, false); w1 = __builtin_amdgcn_cvt_pk_fp8_f32(y1[2], y1[3], w1, true);
                        *(u32x2*)(rowp + bj * HALF) = (u32x2){(unsigned)w0, (unsigned)w1}; } }
            return; }
        if (u.pn == 7) {
            LAS f32x2* rs2 = (LAS f32x2*)rs;
#pragma unroll
            for (int ai = 0; ai < 2; ++ai)
#pragma unroll
                for (int m = 0; m < 4; ++m) { const f32x4 v0 = acc[ai][0][m][0], v1 = acc[ai][0][m][1];
                    float sm = (v0[0] + v0[1]) + (v0[2] + v0[3]) + (v1[0] + v1[1]) + (v1[2] + v1[3]);
                    float sq = (v0[0] * v0[0] + v0[1] * v0[1]) + (v0[2] * v0[2] + v0[3] * v0[3]) + (v1[0] * v1[0] + v1[1] * v1[1]) + (v1[2] * v1[2] + v1[3] * v1[3]);
                    sm += bperm_f((16 * fq + fr) ^ 16, sm); sq += bperm_f((16 * fq + fr) ^ 16, sq); sm += bperm_f((16 * fq + fr) ^ 32, sm); sq += bperm_f((16 * fq + fr) ^ 32, sq);
                    if (fq == 0 && wc < 2) rs2[(ai * HALF + wr * 64 + m * 16 + fr) * 2 + wc] = (f32x2){sm, sq}; }
            asm volatile("s_waitcnt lgkmcnt(0)" ::: "memory"); __builtin_amdgcn_s_barrier();
            if (wc < 2) { const f32x4 ga = *(const f32x4*)(gk + cl), gb = *(const f32x4*)(gk + cl + 4), ba = *(const f32x4*)(bk + cl), bb4 = *(const f32x4*)(bk + cl + 4);
#pragma unroll
                for (int ai = 0; ai < 2; ++ai)
#pragma unroll
                    for (int m = 0; m < 4; ++m) { const f32x4 p = *(const LAS f32x4*)(rs + (ai * HALF + wr * 64 + m * 16 + fr) * 4);
                        const float mean = (p[0] + p[2]) * (1.0f / 64.0f), var = fmaxf((p[1] + p[3]) * (1.0f / 64.0f) - mean * mean, 0.f), krstd = rsqrtf(var + EPS);
                        const f32x4 y0 = (acc[ai][0][m][0] - mean) * krstd * ga + ba, y1 = (acc[ai][0][m][1] - mean) * krstd * gb + bb4;
                        const size_t r = (size_t)(row0 + ai * HALF + m * 16);
                        *(u32x4*)(KIDX + (((r >> 5) * 4 + (size_t)(cl >> 4)) * 64 + (size_t)(((cl >> 3) & 1) * 32) + (r & 31)) * 8) = pack8(y0, y1); } }
            else if (wc == 2 && fq == 0) {
#pragma unroll
                for (int ai = 0; ai < 2; ++ai)
#pragma unroll
                    for (int m = 0; m < 4; ++m) { float* p = WIDX + (size_t)(row0 + ai * HALF + m * 16) * 8; *(f32x4*)p = acc[ai][0][m][0] * 0.04419417382f; *(f32x4*)(p + 4) = acc[ai][0][m][1] * 0.04419417382f; } }
            return; }
#pragma unroll
        for (int ai = 0; ai < 2; ++ai)
#pragma unroll
            for (int m = 0; m < 4; ++m) { const size_t row = (size_t)(row0 + ai * HALF + m * 16);
#pragma unroll
                for (int bj = 0; bj < 2; ++bj) { const f32x4 v0 = acc[ai][bj][m][0], v1 = acc[ai][bj][m][1]; const int c = bj * HALF + cl;
                    if (u.pn < 4) *(u32x4*)(Q + row * 1024 + u.pn * 256 + c) = pack8(v0, v1);
                    else *(u32x4*)(QIDX + row * 512 + (u.pn - 5) * 256 + c) = pack8(v0, v1); } }
    }
};
struct EpiBf16 {
    static constexpr int NS = 16, PREF = 0;
    bf16_t* O; int ldc; float scale; int fp8;
    __device__ __forceinline__ void operator()(const Acc& acc, const Unit& u, int wr, int wc, int fr, int fq) const {
        const int row0 = u.pm * BM + wr * 64 + fr, col0 = u.pn * BM + wc * 32 + 8 * fq;
        if (fp8) {
#pragma unroll
            for (int ai = 0; ai < 2; ++ai)
#pragma unroll
                for (int m = 0; m < 4; ++m) { unsigned char* rowp = (unsigned char*)O + (size_t)(row0 + ai * HALF + m * 16) * ldc + col0;
#pragma unroll
                    for (int bj = 0; bj < 2; ++bj) { const f32x4 v0 = acc[ai][bj][m][0] * scale, v1 = acc[ai][bj][m][1] * scale; int w0 = 0, w1 = 0;
                        w0 = __builtin_amdgcn_cvt_pk_fp8_f32(v0[0], v0[1], w0, false); w0 = __builtin_amdgcn_cvt_pk_fp8_f32(v0[2], v0[3], w0, true);
                        w1 = __builtin_amdgcn_cvt_pk_fp8_f32(v1[0], v1[1], w1, false); w1 = __builtin_amdgcn_cvt_pk_fp8_f32(v1[2], v1[3], w1, true);
                        *(u32x2*)(rowp + bj * HALF) = (u32x2){(unsigned)w0, (unsigned)w1}; } }
            return; }
#pragma unroll
        for (int ai = 0; ai < 2; ++ai)
#pragma unroll
            for (int m = 0; m < 4; ++m) { bf16_t* rowp = O + (size_t)(row0 + ai * HALF + m * 16) * ldc + col0;
#pragma unroll
                for (int bj = 0; bj < 2; ++bj) *(u32x4*)(rowp + bj * HALF) = pack8(acc[ai][bj][m][0] * scale, acc[ai][bj][m][1] * scale); }
    }
};
struct EpiResid {
    static constexpr int NS = 36, PREF = 0;
    _Float16* x; const float* gate;
    __device__ __forceinline__ unsigned pref_off(const Unit& u, int wr, int wc, int lane) const { return (unsigned)((u.pm * BM + wr * 64 + lane) * D + u.pn * BM + wc * 32) * 2u; }
    __device__ __forceinline__ void operator()(const Acc& acc, const Unit& u, int wr, int wc, int fr, int fq) const {
        const int row0 = u.pm * BM + wr * 64 + fr, col0 = u.pn * BM + wc * 32 + 8 * fq;
        const float* gp = gate + (size_t)(u.pm >> 4) * NMOD + col0;
        f32x4 gv[2][2];
#pragma unroll
        for (int bj = 0; bj < 2; ++bj)
#pragma unroll
            for (int n = 0; n < 2; ++n) gv[bj][n] = *(const f32x4*)(gp + bj * HALF + 4 * n);
#pragma unroll
        for (int ai = 0; ai < 2; ++ai)
#pragma unroll
            for (int m = 0; m < 4; ++m) { _Float16* xp = x + (size_t)(row0 + ai * HALF + m * 16) * D + col0;
#pragma unroll
                for (int bj = 0; bj < 2; ++bj) { const f32x8 xo = __builtin_convertvector(*(const f16x8*)(xp + bj * HALF), f32x8);
                    const f32x4 r0 = (f32x4){xo[0], xo[1], xo[2], xo[3]} + gv[bj][0] * acc[ai][bj][m][0], r1 = (f32x4){xo[4], xo[5], xo[6], xo[7]} + gv[bj][1] * acc[ai][bj][m][1];
                    *(f16x8*)(xp + bj * HALF) = __builtin_convertvector((f32x8){r0[0], r0[1], r0[2], r0[3], r1[0], r1[1], r1[2], r1[3]}, f16x8); } }
    }
};
struct EpiGelu {
    static constexpr int NS = 16, PREF = 0;
    bf16_t* U; bf16_t* V; f32x2* STATS;
    __device__ __forceinline__ void operator()(const Acc& acc, const Unit& u, int wr, int wc, int fr, int fq) const {
        const int row0 = u.pm * BM + wr * 64 + fr, cl = wc * 32 + 8 * fq;
        const bool isv = u.pn >= 8; bf16_t* base = isv ? V + (u.pn - 8) * 256 : U + u.pn * 256;
#pragma unroll
        for (int ai = 0; ai < 2; ++ai)
#pragma unroll
            for (int m = 0; m < 4; ++m) { const size_t row = (size_t)(row0 + ai * HALF + m * 16); float s = 0.f, ss = 0.f;
#pragma unroll
                for (int bj = 0; bj < 2; ++bj) { const f32x4 v0 = gelu4(acc[ai][bj][m][0]), v1 = gelu4(acc[ai][bj][m][1]);
                    *(u32x4*)(base + row * 2048 + bj * HALF + cl) = pack8(v0, v1);
                    s += (v0[0] + v0[1]) + (v0[2] + v0[3]) + (v1[0] + v1[1]) + (v1[2] + v1[3]);
                    ss += (v0[0] * v0[0] + v0[1] * v0[1]) + (v0[2] * v0[2] + v0[3] * v0[3]) + (v1[0] * v1[0] + v1[1] * v1[1]) + (v1[2] * v1[2] + v1[3] * v1[3]); }
                if (isv) { s += __shfl_xor(s, 16); ss += __shfl_xor(ss, 16); s += __shfl_xor(s, 32); ss += __shfl_xor(ss, 32);
                    if (fq == 0) STATS[row * 32 + (u.pn - 8) * 4 + wc] = (f32x2){s, ss}; } }
    }
};
struct EpiSwiglu {
    static constexpr int NS = 8, PREF = 0;
    bf16_t* HID;
    __device__ __forceinline__ void operator()(const Acc& acc, const Unit& u, int wr, int wc, int fr, int fq) const {
        const int row0 = u.pm * BM + wr * 64 + fr, col0 = u.pn * 128 + wc * 32 + 8 * fq;
#pragma unroll
        for (int ai = 0; ai < 2; ++ai)
#pragma unroll
            for (int m = 0; m < 4; ++m) { f32x4 h[2];
#pragma unroll
                for (int n = 0; n < 2; ++n) { const f32x4 g = acc[ai][0][m][n], up = acc[ai][1][m][n];
#pragma unroll
                    for (int j = 0; j < 4; ++j) h[n][j] = g[j] * __builtin_amdgcn_rcpf(1.0f + __expf(-g[j])) * up[j]; }
                *(u32x4*)(HID + (size_t)(row0 + ai * HALF + m * 16) * DFF + col0) = pack8(h[0], h[1]); }
    }
};

template <class Epi>
__device__ __forceinline__ void gemm_phase(LAS unsigned char* lds, const Gemm g, const StaticOrder& S, const Epi& E, const int wvs) {
    int tid = wvs * 64 + hw_lane(); asm volatile("" : "+v"(tid));
    const int wid = wvs, lane = tid & 63, wr = wid >> 2, wc = wid & 3, fr = lane & 15, fq = lane >> 4;
    const int K = g.K, nt = K / BK, lda = g.lda;
    unsigned voffA[2], voffB[2];
#pragma unroll
    for (int i = 0; i < 2; ++i) { int R, C; stage_rc(tid * 16 + i * 8192, R, C); const int Rb = (R & ~31) + perm32(R & 31);
        voffA[i] = (unsigned)(R * lda + C) * 2u; voffB[i] = (unsigned)(Rb * K + C) * 2u; }
    const size_t kstep = (size_t)(BK * 2);
    const size_t hstepA = (size_t)HALF * lda * 2, hstepB = (size_t)HALF * K * 2;
    const unsigned ldsw = (unsigned)wid * 1024u; const unsigned ldsb = (unsigned)(size_t)lds + ldsw;
    const int aoff = lds_byte(wr * 64 + fr, fq * 8), boff = lds_byte(wc * 32 + fr, fq * 8);
#define PG8_SA(b, h) (((b) * 2 + (h)) * HTB)
#define PG8_SB(b, h) ((4 + (b) * 2 + (h)) * HTB)
#define PG8_STAGE(bufoff, gbase, voff) asm volatile("s_mov_b32 m0, %2\n\ts_nop 0\n\tglobal_load_lds_dwordx4 %0, %3\n\ts_mov_b32 m0, %4\n\ts_nop 0\n\tglobal_load_lds_dwordx4 %1, %3" \
        :: "v"((voff)[0]), "v"((voff)[1]), "s"(ldsb + (unsigned)(bufoff)), "s"((const char*)(gbase)), "s"(ldsb + (unsigned)(bufoff) + 8192u) : "memory", "m0")
#define PG8_LDA(dst, b, h) do { _Pragma("unroll") for (int m = 0; m < 4; ++m) _Pragma("unroll") for (int k = 0; k < 2; ++k) dst[m][k] = *(const LAS bf16x8*)(lds + PG8_SA(b, h) + (aoff ^ (k * 64)) + m * 2048); } while (0)
#define PG8_LDB(dst, b, h) do { _Pragma("unroll") for (int n = 0; n < 2; ++n) _Pragma("unroll") for (int k = 0; k < 2; ++k) dst[n][k] = *(const LAS bf16x8*)(lds + PG8_SB(b, h) + (boff ^ (k * 64)) + n * 2048); } while (0)
#define PG8_MMA(ai, bj, At, Bt) do { __builtin_amdgcn_s_setprio(1); _Pragma("unroll") for (int m = 0; m < 4; ++m) _Pragma("unroll") for (int n = 0; n < 2; ++n) _Pragma("unroll") for (int k = 0; k < 2; ++k) \
        acc[ai][bj][m][n] = __builtin_amdgcn_mfma_f32_16x16x32_bf16(Bt[n][k], At[m][k], acc[ai][bj][m][n], 0, 0, 0); __builtin_amdgcn_s_setprio(0); } while (0)
#define PG8_WAIT_V(n) asm volatile("s_waitcnt vmcnt(" #n ")" ::: "memory")
#define PG8_WAIT_V1(f) asm volatile("s_cmp_lg_u32 %0, 0\n\ts_cbranch_scc1 .Lpg8a_%=\n\ts_waitcnt vmcnt(8)\n.Lpg8a_%=:\n\ts_cmp_gt_u32 %0, 1\n\ts_cbranch_scc1 .Lpg8b_%=\n\ts_waitcnt vmcnt(%1)\n.Lpg8b_%=:\n\ts_waitcnt vmcnt(%2)" :: "s"(f), "n"(8 + Epi::PREF), "n"(8 + Epi::NS) : "memory", "scc")
#define PG8_WAIT_L(n) asm volatile("s_waitcnt lgkmcnt(" #n ")" ::: "memory")
#define PG8_BAR __builtin_amdgcn_s_barrier()
#define PG8_SCHED __builtin_amdgcn_sched_barrier(0)
#define PG8_ABASE(u) ((const char*)g.A + ((size_t)(u).pm * BM * lda + (size_t)((u).pn >> g.agrp_shift) * g.agrp_stride) * 2)
#define PG8_BBASE(u) ((const char*)g.Bt + (size_t)(u).pn * 2 * hstepB)
    Unit cur, nxt; int ui = 0;
    if (!S.next(0, cur)) return;
    Acc acc;
#pragma unroll
    for (int a = 0; a < 2; ++a)
#pragma unroll
        for (int b = 0; b < 2; ++b)
#pragma unroll
            for (int m = 0; m < 4; ++m)
#pragma unroll
                for (int n = 0; n < 2; ++n) acc[a][b][m][n] = (f32x4){0.f, 0.f, 0.f, 0.f};
    bf16x8 At[4][2], B0[2][2], B1[2][2];
    const char* cA = PG8_ABASE(cur); const char* cB = PG8_BBASE(cur);
    PG8_STAGE(PG8_SB(0, 0), cB, voffB); PG8_STAGE(PG8_SB(0, 1), cB + hstepB, voffB); PG8_STAGE(PG8_SA(0, 0), cA, voffA); PG8_STAGE(PG8_SA(0, 1), cA + hstepA, voffA);
    if (wr == 1) PG8_BAR;
    PG8_WAIT_V(2); PG8_BAR;
    PG8_STAGE(PG8_SB(1, 0), cB + kstep, voffB); PG8_STAGE(PG8_SA(1, 0), cA + kstep, voffA); PG8_STAGE(PG8_SB(1, 1), cB + hstepB + kstep, voffB);
    PG8_WAIT_V(6); PG8_BAR;
    for (;;) {
        const bool has_next = S.next(ui + 1, nxt);
        const char* nA = has_next ? PG8_ABASE(nxt) : cA; const char* nB = has_next ? PG8_BBASE(nxt) : cB;
        for (int t = 0; t < nt; t += 2) {
            const bool last = (t == nt - 2);
            const char* a1 = cA + (size_t)(t + 1) * kstep;
            const char* a2 = last ? nA : cA + (size_t)(t + 2) * kstep; const char* b2 = last ? nB : cB + (size_t)(t + 2) * kstep;
            const char* a3 = a2 + kstep; const char* b3 = b2 + kstep;
            static_assert(Epi::PREF <= Epi::NS, "wait classes must nest");
            const int lenv = (t == 0) ? (ui > 0 ? 2 : 0) : ((Epi::PREF != 0 && t == nt - 2) ? 1 : 0);
            int len; asm volatile("v_readfirstlane_b32 %0, %1" : "=s"(len) : "v"(lenv));
            if constexpr (Epi::PREF != 0) {
                unsigned ptmp; const unsigned poff = E.pref_off(cur, wr, wc, hw_lane()), pdst = (unsigned)(size_t)(lds + 8 * HTB) + (unsigned)wid * 256u;
                asm volatile("s_cmp_lg_u32 %2, 1\n\ts_cbranch_scc1 .Lpg8p_%=\n\ts_mov_b32 m0, %3\n\ts_nop 0\n\tglobal_load_lds_dword %1, %4\n\tglobal_load_lds_dword %1, %4 offset:256\n\t"
                             "v_add_u32_e32 %0, 0x40000, %1\n\tglobal_load_lds_dword %0, %4\n\tglobal_load_lds_dword %0, %4 offset:256\n.Lpg8p_%=:"
                             : "=&v"(ptmp) : "v"(poff), "s"(len), "s"(pdst), "s"(E.x) : "memory", "scc", "m0"); }
            PG8_LDB(B0, 0, 0); PG8_LDB(B1, 0, 1); PG8_SCHED; PG8_LDA(At, 0, 0); PG8_STAGE(PG8_SA(1, 1), a1 + hstepA, voffA);
            PG8_WAIT_V1(len); PG8_WAIT_L(0); PG8_BAR; PG8_MMA(0, 0, At, B0); PG8_MMA(0, 1, At, B1); PG8_BAR; PG8_SCHED;
            PG8_LDA(At, 0, 1); PG8_STAGE(PG8_SB(0, 0), b2, voffB); PG8_STAGE(PG8_SB(0, 1), b2 + hstepB, voffB); PG8_STAGE(PG8_SA(0, 0), a2, voffA);
            PG8_WAIT_V1(len); PG8_WAIT_L(0); PG8_BAR; PG8_MMA(1, 0, At, B0); PG8_MMA(1, 1, At, B1); PG8_BAR; PG8_SCHED;
            PG8_LDB(B0, 1, 0); PG8_LDB(B1, 1, 1); PG8_SCHED; PG8_LDA(At, 1, 0); PG8_STAGE(PG8_SA(0, 1), a2 + hstepA, voffA);
            PG8_WAIT_V(8); PG8_WAIT_L(0); PG8_BAR; PG8_MMA(0, 0, At, B0); PG8_MMA(0, 1, At, B1); PG8_BAR; PG8_SCHED;
            PG8_LDA(At, 1, 1); PG8_STAGE(PG8_SB(1, 0), b3, voffB); PG8_STAGE(PG8_SB(1, 1), b3 + hstepB, voffB); PG8_STAGE(PG8_SA(1, 0), a3, voffA);
            PG8_WAIT_V(8); PG8_WAIT_L(0); PG8_BAR; PG8_MMA(1, 0, At, B0); PG8_MMA(1, 1, At, B1); PG8_BAR; PG8_SCHED;
        }
        if (wr == 0) PG8_BAR;
        { const int l2 = hw_lane();
          E(acc, cur, wr, wc, l2 & 15, l2 >> 4); }
        if (!has_next) break;
#pragma unroll
        for (int a = 0; a < 2; ++a)
#pragma unroll
            for (int b = 0; b < 2; ++b)
#pragma unroll
                for (int m = 0; m < 4; ++m)
#pragma unroll
                    for (int n = 0; n < 2; ++n) acc[a][b][m][n] = (f32x4){0.f, 0.f, 0.f, 0.f};
        cur = nxt; cA = nA; cB = nB; ++ui;
        if (wr == 1) PG8_BAR;
    }
    PG8_WAIT_V(0);
    PG8_BAR;
#undef PG8_SA
#undef PG8_SB
#undef PG8_STAGE
#undef PG8_LDA
#undef PG8_LDB
#undef PG8_MMA
#undef PG8_WAIT_V
#undef PG8_WAIT_L
#undef PG8_WAIT_V1
#undef PG8_BAR
#undef PG8_SCHED
#undef PG8_ABASE
#undef PG8_BBASE
}
}

struct Args { const float* in[23]; float* out; unsigned char* ws; int ph_lo, ph_hi; };

struct CvtDesc { const float* src; bf16_t* dst; int N, ldd, mode, r0, c0, li; };
__device__ __forceinline__ void cvt_load(const CvtDesc& d, int lane, f32x4 (&t)[8]) {
    const int nblk = (d.N + 31) >> 5, k0 = 64 * (d.li / nblk), n0 = 32 * (d.li % nblk);
    const int cc = lane & 7, rr = lane >> 3; const bool ok = n0 + 4 * cc < d.N;
#pragma unroll
    for (int i = 0; i < 8; ++i) t[i] = ok ? *(const f32x4*)(d.src + (size_t)(k0 + 8 * i + rr) * d.N + n0 + 4 * cc) : (f32x4){0.f, 0.f, 0.f, 0.f};
}
__device__ __forceinline__ void cvt_store(const CvtDesc& d, LAS float* scr, int lane, const f32x4 (&t)[8]) {
    const int nblk = (d.N + 31) >> 5, k0 = 64 * (d.li / nblk), n0 = 32 * (d.li % nblk);
    { const int cc = lane & 7, rr = lane >> 3;
#pragma unroll
      for (int i = 0; i < 8; ++i) { LAS float* q = scr + (8 * i + rr) * 33 + 4 * cc; q[0] = t[i][0]; q[1] = t[i][1]; q[2] = t[i][2]; q[3] = t[i][3]; } }
    LDS_WAIT();
    const int c = lane & 7;
#pragma unroll
    for (int j = 0; j < 4; ++j) { const int nl = (lane >> 3) + 8 * j, n = n0 + nl; const LAS float* sp = scr + (8 * c) * 33 + nl;
        u32x4 o; o.x = cvt_pk_bf16(sp[0 * 33], sp[1 * 33]); o.y = cvt_pk_bf16(sp[2 * 33], sp[3 * 33]); o.z = cvt_pk_bf16(sp[4 * 33], sp[5 * 33]); o.w = cvt_pk_bf16(sp[6 * 33], sp[7 * 33]);
        if (n < d.N) { const int drow = d.mode ? ((n >> 7) * 256 + (n & 127) + d.r0) : (d.r0 + n); *(u32x4*)(d.dst + (size_t)drow * d.ldd + d.c0 + k0 + 8 * c) = o; } }
    LDS_WAIT();
}
__device__ __forceinline__ CvtDesc cvt_decode(const Args& a, unsigned char* ws, int r) {
    if (r < 1888) { const int j = r / 944; return CvtDesc{a.in[6] + (size_t)j * 1024 * AIN, (bf16_t*)(ws + W_AIN) + (size_t)j * 2048 * 1024, AIN, 1024, 0, 0, 0, r % 944}; } r -= 1888;
    if (r < 256) { const int jj = r >> 4, la = jj >> 3, h = jj & 7; return CvtDesc{a.in[10] + (size_t)(la * 8 + h) * 128 * 256, (bf16_t*)(ws + W_UK) + (size_t)la * 2048 * 256, 256, 256, 0, h * 256, (h & 1) * 128, r & 15}; } r -= 256;
    if (r < 256) { const int jj = r >> 4, la = jj >> 3, h = jj & 7; return CvtDesc{a.in[11] + (size_t)(la * 8 + h) * 256 * 128, (bf16_t*)(ws + W_UV) + (size_t)la * 1024 * 512, 128, 512, 0, (h >> 1) * 256 + (h & 1) * 128, (h & 1) * 256, r & 15}; } r -= 256;
    if (r < 1024) { const int la = r >> 9; return CvtDesc{a.in[12] + (size_t)la * 1024 * 1024, (bf16_t*)(ws + W_O) + (size_t)la * 1024 * 1024, 1024, 1024, 0, 0, 0, r & 511}; } r -= 1024;
    if (r < 4096) { const int la = r >> 11; return CvtDesc{a.in[13] + (size_t)la * 1024 * 4096, (bf16_t*)(ws + W_BIN) + (size_t)la * 4096 * 1024, 4096, 1024, 0, 0, 0, r & 2047}; } r -= 4096;
    if (r < 2048) { const int la = r >> 10; return CvtDesc{a.in[18] + (size_t)la * 2048 * 1024, (bf16_t*)(ws + W_BOUT) + (size_t)la * 1024 * 2048, 1024, 2048, 0, 0, 0, r & 1023}; } r -= 2048;
    if (r < 11264) { const int jj = r / 1408, l = jj & 3, isup = jj >> 2; return CvtDesc{a.in[isup ? 20 : 19] + (size_t)l * 1024 * DFF, (bf16_t*)(ws + W_GU) + (size_t)l * 5632 * 1024, DFF, 1024, 1, isup * 128, 0, r % 1408}; } r -= 11264;
    { const int l = r / 1408; return CvtDesc{a.in[21] + (size_t)l * DFF * 1024, (bf16_t*)(ws + W_DN) + (size_t)l * 1024 * DFF, 1024, DFF, 0, 0, 0, r % 1408}; }
}

__device__ __forceinline__ void p0_phase(const Args& a, LAS unsigned char* lds, int bid, int G, const int wvs) {
    int tid = wvs * 64 + hw_lane(); asm volatile("" : "+v"(tid));
    const int lane = tid & 63, wave = __builtin_amdgcn_readfirstlane(tid >> 6);
    unsigned char* ws = a.ws;
    LAS float* scr = (LAS float*)(lds + wave * 8704);
    const int gw = bid * 8 + wave, NGW = G * 8;
    constexpr int NITEMS = 1888 + 256 + 256 + 1024 + 4096 + 2048 + 11264 + 5632;
    {
        f32x4 tc[8], tn[8]; CvtDesc dc{}, dn{};
        if (gw < NITEMS) { dc = cvt_decode(a, ws, gw); cvt_load(dc, lane, tc); }
        for (int it = gw; it < NITEMS; it += NGW) {
            const bool hn = it + NGW < NITEMS;
            if (hn) { dn = cvt_decode(a, ws, it + NGW); cvt_load(dn, lane, tn); }
            cvt_store(dc, scr, lane, tc);
            if (hn) { dc = dn;
#pragma unroll
                for (int i = 0; i < 8; ++i) tc[i] = tn[i]; }
        }
    }
    const size_t gt = (size_t)bid * 512 + tid, NT = (size_t)G * 512;
    const u32x4 z = (u32x4){0u, 0u, 0u, 0u};
    for (size_t i = gt; i < 2 * 184 * 128; i += NT) { const int j = (int)(i / (184 * 128)), rem = (int)(i % (184 * 128)), rr = AIN + rem / 128, ch = rem % 128;
        *(u32x4*)((bf16_t*)(ws + W_AIN) + ((size_t)j * 2048 + rr) * 1024 + ch * 8) = z; }
    for (size_t i = gt; i < 2 * 2048 * 16; i += NT) { const int j = (int)(i / (2048 * 16)), rem = (int)(i % (2048 * 16)), rr = rem >> 4, ch = rem & 15, h = rr >> 8;
        *(u32x4*)((bf16_t*)(ws + W_UK) + ((size_t)j * 2048 + rr) * 256 + (1 - (h & 1)) * 128 + ch * 8) = z; }
    for (size_t i = gt; i < 2 * 1024 * 32; i += NT) { const int j = (int)(i / (1024 * 32)), rem = (int)(i % (1024 * 32)), rr = rem >> 5, ch = rem & 31, hh = (rr >> 7) & 1;
        *(u32x4*)((bf16_t*)(ws + W_UV) + ((size_t)j * 1024 + rr) * 512 + (1 - hh) * 256 + ch * 8) = z; }
    __syncthreads();
    LAS float* ca = (LAS float*)lds;
    const float* cvec = a.in[1]; const float* modw = a.in[2]; float* MODP = (float*)(ws + WS_MODP);
    for (int it = bid; it < 768; it += G) {
        const int l = it / 192, rem = it % 192, ng = rem >> 4, kc = rem & 15;
        { const int b = tid >> 6, k = tid & 63; const float cv = cvec[b * 1024 + kc * 64 + k]; ca[b * 64 + k] = cv / (1.0f + __expf(-cv)); }
        __syncthreads();
        const int n = ng * 512 + tid; float acc[8];
#pragma unroll
        for (int b = 0; b < 8; ++b) acc[b] = 0.f;
        const float* wp = modw + ((size_t)l * 1024 + kc * 64) * NMOD + n;
#pragma unroll 8
        for (int k = 0; k < 64; ++k) { const float w = wp[(size_t)k * NMOD];
#pragma unroll
            for (int b = 0; b < 8; ++b) acc[b] += ca[b * 64 + k] * w; }
#pragma unroll
        for (int b = 0; b < 8; ++b) MODP[((size_t)(kc * 4 + l) * 8 + b) * NMOD + n] = acc[b];
        __syncthreads();
    }
}
__device__ __forceinline__ void p0c_phase(const Args& a, int bid, int G, const int wvs) {
    const float* MODP = (const float*)(a.ws + WS_MODP); float* MOD = (float*)(a.ws + WS_MOD); const float* modb = a.in[3];
    int tid0 = wvs * 64 + hw_lane(); asm volatile("" : "+v"(tid0));
    for (int i = bid * 512 + tid0; i < 4 * 8 * NMOD; i += G * 512) { const int l = i / (8 * NMOD), n = i % NMOD; float s = modb[l * NMOD + n];
#pragma unroll
        for (int kc = 0; kc < 16; ++kc) s += MODP[(size_t)kc * (4 * 8 * NMOD) + i];
        MOD[i] = s; }
}

template <bool FIRST>
__device__ __forceinline__ void norm_mod_phase(const float* x32, _Float16* x16, const float* gain, const float* sh, const float* sc, bf16_t* H, int bid, int G, const int wvs) {
    int tid = wvs * 64 + hw_lane(); asm volatile("" : "+v"(tid));
    const int lane = tid & 63, wave = tid >> 6;
    for (int q = (bid >> 3) * 8 + wave; q < T / 16; q += (G >> 3) * 8) {
        const int b = bid & 7, rb = b * T + q * 16; f32x4 gs[4], sv[4];
#pragma unroll
        for (int j = 0; j < 4; ++j) { const int c = 8 * lane + 512 * (j >> 1) + 4 * (j & 1); const f32x4 g4 = *(const f32x4*)(gain + c), s4 = *(const f32x4*)(sc + (size_t)b * NMOD + c); gs[j] = g4 * (s4 + 1.0f); sv[j] = *(const f32x4*)(sh + (size_t)b * NMOD + c); }
        f32x4 nx[4]; f16x8 nh[2];
        if (FIRST) {
#pragma unroll
            for (int j = 0; j < 4; ++j) nx[j] = *(const f32x4*)(x32 + (size_t)rb * D + 8 * lane + 512 * (j >> 1) + 4 * (j & 1)); }
        else {
#pragma unroll
            for (int j = 0; j < 2; ++j) nh[j] = *(const f16x8*)(x16 + (size_t)rb * D + 8 * lane + 512 * j); }
        for (int r = rb; r < rb + 16; ++r) {
            f32x4 v[4];
            if (FIRST) {
#pragma unroll
                for (int j = 0; j < 4; ++j) v[j] = nx[j];
#pragma unroll
                for (int j = 0; j < 2; ++j) *(f16x8*)(x16 + (size_t)r * D + 8 * lane + 512 * j) = __builtin_convertvector((f32x8){v[2 * j][0], v[2 * j][1], v[2 * j][2], v[2 * j][3], v[2 * j + 1][0], v[2 * j + 1][1], v[2 * j + 1][2], v[2 * j + 1][3]}, f16x8);
            } else {
#pragma unroll
                for (int j = 0; j < 2; ++j) { const f32x8 t = __builtin_convertvector(nh[j], f32x8); v[2 * j] = (f32x4){t[0], t[1], t[2], t[3]}; v[2 * j + 1] = (f32x4){t[4], t[5], t[6], t[7]}; }
            }
            const int rn = (r + 1 < rb + 16) ? r + 1 : r;
            if (FIRST) {
#pragma unroll
                for (int j = 0; j < 4; ++j) nx[j] = *(const f32x4*)(x32 + (size_t)rn * D + 8 * lane + 512 * (j >> 1) + 4 * (j & 1)); }
            else {
#pragma unroll
                for (int j = 0; j < 2; ++j) nh[j] = *(const f16x8*)(x16 + (size_t)rn * D + 8 * lane + 512 * j); }
            float ss = 0.f;
#pragma unroll
            for (int j = 0; j < 4; ++j) ss += (v[j][0] * v[j][0] + v[j][1] * v[j][1]) + (v[j][2] * v[j][2] + v[j][3] * v[j][3]);
            const float rstd = rsqrtf(wave_sum(ss) * (1.0f / D) + EPS);
#pragma unroll
            for (int j = 0; j < 2; ++j) { const f32x4 y0 = v[2 * j] * rstd * gs[2 * j] + sv[2 * j], y1 = v[2 * j + 1] * rstd * gs[2 * j + 1] + sv[2 * j + 1];
                u32x4 w; w.x = cvt_pk_bf16(y0[0], y0[1]); w.y = cvt_pk_bf16(y0[2], y0[3]); w.z = cvt_pk_bf16(y1[0], y1[1]); w.w = cvt_pk_bf16(y1[2], y1[3]);
                *(u32x4*)(H + (size_t)r * D + 8 * lane + 512 * j) = w; }
        }
    }
}
__device__ __forceinline__ void final_norm_phase(const _Float16* x16, const float* gain, float* out, int bid, int G, const int wvs) {
    int tid = wvs * 64 + hw_lane(); asm volatile("" : "+v"(tid));
    const int lane = tid & 63, wave = tid >> 6;
    f32x4 gs[4];
#pragma unroll
    for (int j = 0; j < 4; ++j) gs[j] = *(const f32x4*)(gain + 8 * lane + 512 * (j >> 1) + 4 * (j & 1));
    f16x8 nh[2];
    { const int r0 = (bid & 7) * T + (bid >> 3) * 8 + wave;
#pragma unroll
      for (int j = 0; j < 2; ++j) nh[j] = *(const f16x8*)(x16 + (size_t)r0 * D + 8 * lane + 512 * j); }
    for (int q = (bid >> 3) * 8 + wave; q < T; q += (G >> 3) * 8) { const int r = (bid & 7) * T + q;
        f32x4 v[4]; float ss = 0.f;
#pragma unroll
        for (int j = 0; j < 2; ++j) { const f32x8 t = __builtin_convertvector(nh[j], f32x8); v[2 * j] = (f32x4){t[0], t[1], t[2], t[3]}; v[2 * j + 1] = (f32x4){t[4], t[5], t[6], t[7]}; }
        const int rn = (q + (G >> 3) * 8 < T) ? r + (G >> 3) * 8 : r;
#pragma unroll
        for (int j = 0; j < 2; ++j) nh[j] = *(const f16x8*)(x16 + (size_t)rn * D + 8 * lane + 512 * j);
#pragma unroll
        for (int j = 0; j < 4; ++j) ss += (v[j][0] * v[j][0] + v[j][1] * v[j][1]) + (v[j][2] * v[j][2] + v[j][3] * v[j][3]);
        const float rstd = rsqrtf(wave_sum(ss) * (1.0f / D) + EPS);
#pragma unroll
        for (int j = 0; j < 4; ++j) *(f32x4*)(out + (size_t)r * D + 8 * lane + 512 * (j >> 1) + 4 * (j & 1)) = v[j] * rstd * gs[j];
    }
}
__device__ __forceinline__ void dsa_rows_phase(const float* CKVR, const float* KRAW, const float* gkv, const float* gk, const float* bk, bf16_t* CKV, bf16_t* KIDX, float* WIDX, int bid, int G, const int wvs) {
    int tid = wvs * 64 + hw_lane(); asm volatile("" : "+v"(tid));
    const int lane = tid & 63, wave = tid >> 6;
    const f32x4 g4 = *(const f32x4*)(gkv + 4 * lane);
    f32x4 gk4 = (f32x4){0.f, 0.f, 0.f, 0.f}, bk4 = gk4;
    if (lane < 16) { gk4 = *(const f32x4*)(gk + 4 * lane); bk4 = *(const f32x4*)(bk + 4 * lane); }
    for (int q = (bid >> 3) * 8 + wave; q < T; q += (G >> 3) * 8) { const int r = (bid & 7) * T + q;
        const f32x4 v = *(const f32x4*)(CKVR + (size_t)r * 256 + 4 * lane);
        f32x4 kv = (f32x4){0.f, 0.f, 0.f, 0.f}; if (lane < 32) kv = *(const f32x4*)(KRAW + (size_t)r * 128 + 4 * lane);
        const float ss = wave_sum((v[0] * v[0] + v[1] * v[1]) + (v[2] * v[2] + v[3] * v[3]));
        const float rstd = rsqrtf(ss * (1.0f / 256.0f) + EPS);
        { const f32x4 y = v * rstd * g4; int w = 0; w = __builtin_amdgcn_cvt_pk_fp8_f32(y[0], y[1], w, false); w = __builtin_amdgcn_cvt_pk_fp8_f32(y[2], y[3], w, true); *(int*)((unsigned char*)CKV + (size_t)r * 256 + 4 * lane) = w; }
        const float ks = (lane < 16) ? (kv[0] + kv[1]) + (kv[2] + kv[3]) : 0.f;
        const float mean = wave_sum(ks) * (1.0f / 64.0f);
        const f32x4 dv = kv - mean;
        const float kq = (lane < 16) ? (dv[0] * dv[0] + dv[1] * dv[1]) + (dv[2] * dv[2] + dv[3] * dv[3]) : 0.f;
        const float krstd = rsqrtf(wave_sum(kq) * (1.0f / 64.0f) + EPS);
        if (lane < 16) { const f32x4 y = dv * krstd * gk4 + bk4; u32x2 w; w.x = cvt_pk_bf16(y[0], y[1]); w.y = cvt_pk_bf16(y[2], y[3]); *(u32x2*)(KIDX + ((((size_t)(r >> 5) * 4 + (lane >> 2)) * 64 + (((lane >> 1) & 1) * 32 + (r & 31))) * 8 + (lane & 1) * 4)) = w; }
        else if (lane < 18) { *(f32x4*)(WIDX + (size_t)r * 8 + 4 * (lane - 16)) = kv * 0.04419417382f; }
    }
}

__device__ __forceinline__ float relu_i(float x) { const int b = __float_as_int(x); return __int_as_float(b > 0 ? b : 0); }
__device__ __forceinline__ float relu_mul(float x, float w) { return relu_i(x) * w; }
__device__ __forceinline__ float relu_fma(float x, float w, float acc) { return __builtin_fmaf(relu_i(x), w, acc); }
__device__ __forceinline__ float fmin_raw(float a, float b) { return __builtin_amdgcn_fmed3f(a, b, -__builtin_inff()); }
__device__ __forceinline__ float fmax_raw(float a, float b) { return __builtin_amdgcn_fmed3f(a, b, __builtin_inff()); }
__device__ __forceinline__ unsigned mbcnt64(unsigned long long m) { return __builtin_amdgcn_mbcnt_hi((unsigned)(m >> 32), __builtin_amdgcn_mbcnt_lo((unsigned)m, 0u)); }

template <int SHIFT, int WIDTH>
__device__ __forceinline__ void sel_level(const unsigned (&k)[64], int N, LAS unsigned* hist, int lane, unsigned& prefix, unsigned& need) {
    LAS u32x4* hz = (LAS u32x4*)(hist + 32 * lane);
#pragma unroll
    for (int j = 0; j < 8; ++j) hz[j] = (u32x4){0u, 0u, 0u, 0u};
    LDS_WAIT();
#pragma unroll
    for (int gi = 0; gi < 8; ++gi) if (512 * gi < N) {
#pragma unroll
        for (int ii = 0; ii < 8; ++ii) { const unsigned key = k[8 * gi + ii]; const bool ok = (key >> (SHIFT + WIDTH)) == prefix;
            LAS unsigned* p = ok ? hist + ((key >> SHIFT) & ((1u << WIDTH) - 1u)) : hist + 2048 + lane;
            __hip_atomic_fetch_add(p, 1u, __ATOMIC_RELAXED, __HIP_MEMORY_SCOPE_WORKGROUP); } }
    LDS_WAIT();
    u32x4 hv[8]; unsigned ls = 0u;
#pragma unroll
    for (int j = 0; j < 8; ++j) { hv[j] = hz[j]; ls += (hv[j][0] + hv[j][1]) + (hv[j][2] + hv[j][3]); }
    unsigned incl = ls;
#pragma unroll
    for (int o = 1; o < 64; o <<= 1) { const unsigned v = bperm_u((lane + o) & 63, incl); if (lane + o < 64) incl += v; }
    const unsigned above = incl - ls;
    unsigned cnt = above, d = 0u, nn = 0u;
#pragma unroll
    for (int j = 31; j >= 0; --j) { const unsigned h = hv[j >> 2][j & 3]; const bool hit = (cnt < need) && (need <= cnt + h); d = hit ? (unsigned)(32 * lane + j) : d; nn = hit ? need - cnt : nn; cnt += h; }
    const bool found = (above < need) && (need <= above + ls);
    const unsigned long long fm = __ballot(found);
    const int src = (fm != 0ull) ? (__ffsll((long long)fm) - 1) : 0;
    d = bperm_u(src, d); need = bperm_u(src, nn);
    prefix = (prefix << WIDTH) | d;
}

__device__ __forceinline__ void dsa_select_phase(LAS unsigned char* lds, const bf16_t* QIDX, const bf16_t* KIDX, const float* WIDX, unsigned short* IDX, int bid, int G, const int wvs) {
    int tid0 = wvs * 64 + hw_lane(); asm volatile("" : "+v"(tid0));
    const int wave = __builtin_amdgcn_readfirstlane(tid0 >> 6);
    LAS float* SC = (LAS float*)lds;
    LAS unsigned short* IDXL = (LAS unsigned short*)(lds + 135168) + wave * 256;
    LAS float* MM = (LAS float*)(lds + 139264);
    bf16x8 af[2][4]; bf16x8 kb[4][4];
#define DSA_UNIT(itx, b_, t0_, mb_, ntile_, nj_) const int b_ = (itx) & 7, t0_ = ((itx) >> 3) * 8; const size_t mb_ = (size_t)b_ * T; \
    const int ntile_ = (t0_ + 8 + 31) >> 5; const int nj_ = (wave < ntile_) ? ((ntile_ - wave + 7) >> 3) : 0;
#define DSA_KLOAD(buf, j, kbase_, nj_) do { const int jc_ = ((j) < (nj_)) ? (j) : ((nj_) > 0 ? (nj_) - 1 : 0); const bf16_t* kp_ = (kbase_) + (size_t)(wave + 8 * jc_) * 2048; \
    _Pragma("unroll") for (int ks = 0; ks < 4; ++ks) kb[buf][ks] = *(const bf16x8*)(kp_ + 512 * ks); } while (0)
#define DSA_PRELOAD(t0_, mb_, nj_) do { \
    _Pragma("unroll") for (int rg = 0; rg < 2; ++rg) { const bf16_t* qp = QIDX + ((mb_) + (t0_) + 4 * rg + (col >> 3)) * 512 + (col & 7) * 64 + 8 * hf; \
        _Pragma("unroll") for (int ks = 0; ks < 4; ++ks) af[rg][ks] = *(const bf16x8*)(qp + 16 * ks); } \
    (void)(nj_); } while (0)
    { int tid = tid0; asm volatile("" : "+v"(tid)); const int lane = tid & 63, hf = lane >> 5, col = lane & 31;
      if (bid < 4096) { DSA_UNIT(bid, b, t0, mb, ntile, nj) (void)b; (void)ntile; if (t0 + 8 > 256) DSA_PRELOAD(t0, mb, nj); } }
    for (int it = bid; it < 4096; it += G) {
        int tid = tid0; asm volatile("" : "+v"(tid));
        const int lane = tid & 63, hf = lane >> 5, col = lane & 31;
        DSA_UNIT(it, b, t0, mb, ntile, nj) (void)b; (void)ntile;
        const int t = t0 + wave, N = t + 1;
        unsigned short* outp = IDX + (mb + t) * 256;
        const int itn = it + G; const bool hasn = itn < 4096;
        DSA_UNIT(hasn ? itn : it, bn, t0n, mbn, ntilen, njn) (void)bn; (void)ntilen;
        if (t0 + 8 <= 256) {
            *(u32x2*)(outp + 4 * lane) = (u32x2){(unsigned)(4 * lane) | ((unsigned)(4 * lane + 1) << 16), (unsigned)(4 * lane + 2) | ((unsigned)(4 * lane + 3) << 16)};
            if (hasn && t0n + 8 > 256) DSA_PRELOAD(t0n, mbn, njn);
            continue;
        }
        float w[2][4][4]; float mn[2][2], mx[2][2];
#pragma unroll
        for (int rg = 0; rg < 2; ++rg)
#pragma unroll
            for (int e = 0; e < 2; ++e) { mn[rg][e] = 3.0e38f; mx[rg][e] = -3.0e38f; }
        const bf16_t* kbase = KIDX + mb * 64 + (size_t)lane * 8;
        DSA_KLOAD(0, 0, kbase, nj); DSA_KLOAD(1, 1, kbase, nj); DSA_KLOAD(2, 2, kbase, nj); DSA_KLOAD(3, 3, kbase, nj);
#pragma unroll
        for (int rg = 0; rg < 2; ++rg)
#pragma unroll
            for (int qq = 0; qq < 4; ++qq) { const f32x4 wv = *(const f32x4*)(WIDX + (mb + t0 + 4 * rg + qq) * 8 + 4 * hf);
                w[rg][qq][0] = wv[0]; w[rg][qq][1] = wv[1]; w[rg][qq][2] = wv[2]; w[rg][qq][3] = wv[3]; }
#define DSA_KCOMP(buf, j) do { const int s_ = 32 * (wave + 8 * (j)) + col; f32x16 acc0, acc1; \
    _Pragma("unroll") for (int i = 0; i < 16; ++i) { acc0[i] = 0.f; acc1[i] = 0.f; } \
    _Pragma("unroll") for (int ks = 0; ks < 4; ++ks) { acc0 = __builtin_amdgcn_mfma_f32_32x32x16_bf16(af[0][ks], kb[buf][ks], acc0, 0, 0, 0); acc1 = __builtin_amdgcn_mfma_f32_32x32x16_bf16(af[1][ks], kb[buf][ks], acc1, 0, 0, 0); } \
    _Pragma("unroll") for (int rg = 0; rg < 2; ++rg) { float p[4]; \
        _Pragma("unroll") for (int qq = 0; qq < 4; ++qq) { p[qq] = relu_mul(rg ? acc1[4 * qq] : acc0[4 * qq], w[rg][qq][0]); _Pragma("unroll") for (int ii = 1; ii < 4; ++ii) p[qq] = relu_fma(rg ? acc1[4 * qq + ii] : acc0[4 * qq + ii], w[rg][qq][ii], p[qq]); } \
        _Pragma("unroll") for (int e = 0; e < 2; ++e) { const auto r = __builtin_amdgcn_permlane32_swap(__float_as_uint(p[e]), __float_as_uint(p[2 + e]), false, false); \
            const float tot = __uint_as_float(r[0]) + __uint_as_float(r[1]); SC[(4 * rg + 2 * hf + e) * 4096 + s_] = tot; mn[rg][e] = fmin_raw(mn[rg][e], tot); mx[rg][e] = fmax_raw(mx[rg][e], tot); } } } while (0)
        for (int j = 0; j < nj; j += 4) {
            DSA_KCOMP(0, j); if (j + 4 < nj) DSA_KLOAD(0, j + 4, kbase, nj);
            if (j + 1 < nj) DSA_KCOMP(1, j + 1);
            if (j + 5 < nj) DSA_KLOAD(1, j + 5, kbase, nj);
            if (j + 2 < nj) DSA_KCOMP(2, j + 2);
            if (j + 6 < nj) DSA_KLOAD(2, j + 6, kbase, nj);
            if (j + 3 < nj) DSA_KCOMP(3, j + 3);
            if (j + 7 < nj) DSA_KLOAD(3, j + 7, kbase, nj);
        }
#pragma unroll
        for (int rg = 0; rg < 2; ++rg)
#pragma unroll
            for (int e = 0; e < 2; ++e) {
#pragma unroll
                for (int o = 1; o < 32; o <<= 1) { mn[rg][e] = fminf(mn[rg][e], bperm_f(lane ^ o, mn[rg][e])); mx[rg][e] = fmaxf(mx[rg][e], bperm_f(lane ^ o, mx[rg][e])); }
                if (col == 0) { MM[(wave * 8 + 4 * rg + 2 * hf + e) * 2] = mn[rg][e]; MM[(wave * 8 + 4 * rg + 2 * hf + e) * 2 + 1] = mx[rg][e]; } }
        if (hasn && t0n + 8 > 256) DSA_PRELOAD(t0n, mbn, njn);
        __syncthreads();
        {
            const LAS float* scl = SC + wave * 4096 + lane;
            LAS unsigned* hist = (LAS unsigned*)(lds + wave * 16384);
            float lo = 3.0e38f, hi = -3.0e38f;
#pragma unroll
            for (int wv = 0; wv < 8; ++wv) { lo = fminf(lo, MM[(wv * 8 + wave) * 2]); hi = fmaxf(hi, MM[(wv * 8 + wave) * 2 + 1]); }
            const float scale = 4.0e9f / fmaxf(hi - lo, 1e-30f);
            unsigned k[64];
#pragma unroll
            for (int gi = 0; gi < 8; ++gi) { if (512 * gi < N) {
#pragma unroll
                for (int ii = 0; ii < 8; ++ii) k[8 * gi + ii] = __float_as_uint(scl[64 * (8 * gi + ii)]); } else {
#pragma unroll
                for (int ii = 0; ii < 8; ++ii) k[8 * gi + ii] = 0u; } }
            LDS_WAIT();
            { LAS u32x4* hz = (LAS u32x4*)(hist + 16 * lane);
#pragma unroll
              for (int j = 0; j < 4; ++j) hz[j] = (u32x4){0u, 0u, 0u, 0u}; }
            LDS_WAIT();
#pragma unroll
            for (int gi = 0; gi < 8; ++gi) if (512 * gi < N) {
#pragma unroll
                for (int ii = 0; ii < 8; ++ii) { const int i = 8 * gi + ii; const bool valid = lane < N - 64 * i;
                    const unsigned key = valid ? 1u + (unsigned)((__uint_as_float(k[i]) - lo) * scale) : 0u; k[i] = key;
                    LAS unsigned* p = valid ? hist + (key >> 22) : hist + 1024 + lane;
                    __hip_atomic_fetch_add(p, 1u, __ATOMIC_RELAXED, __HIP_MEMORY_SCOPE_WORKGROUP); } }
            LDS_WAIT();
            unsigned d0, need1;
            { const LAS u32x4* hz = (const LAS u32x4*)(hist + 16 * lane); u32x4 hv[4]; unsigned ls = 0u;
#pragma unroll
              for (int j = 0; j < 4; ++j) { hv[j] = hz[j]; ls += (hv[j][0] + hv[j][1]) + (hv[j][2] + hv[j][3]); }
              unsigned incl = ls;
#pragma unroll
              for (int o = 1; o < 64; o <<= 1) { const unsigned v = bperm_u((lane + o) & 63, incl); if (lane + o < 64) incl += v; }
              const unsigned above = incl - ls; unsigned cnt = above, d = 0u, nn = 0u;
#pragma unroll
              for (int j = 15; j >= 0; --j) { const unsigned h = hv[j >> 2][j & 3]; const bool hit = (cnt < 256u) && (256u <= cnt + h); d = hit ? (unsigned)(16 * lane + j) : d; nn = hit ? 256u - cnt : nn; cnt += h; }
              const bool found = (above < 256u) && (256u <= above + ls);
              const unsigned long long fm = __ballot(found);
              const int src = (fm != 0ull) ? (__ffsll((long long)fm) - 1) : 0;
              d0 = bperm_u(src, d); need1 = bperm_u(src, nn); }
            LAS unsigned* CK = hist + 1100; LAS unsigned short* CS = (LAS unsigned short*)(hist + 1170);
            unsigned base = 0u, cbase = 0u;
#pragma unroll
            for (int gi = 0; gi < 8; ++gi) if (512 * gi < N) {
#pragma unroll
                for (int ii = 0; ii < 8; ++ii) { const int i = 8 * gi + ii; const unsigned key = k[i], dg = key >> 22;
                    const bool gt = dg > d0, eq = (dg == d0) && (key != 0u);
                    const unsigned long long mgt = __ballot(gt), meq = __ballot(eq);
                    if (gt) IDXL[base + mbcnt64(mgt)] = (unsigned short)(64 * i + lane);
                    base += (unsigned)__popcll(mgt);
                    if (meq != 0ull) { const unsigned cp = cbase + mbcnt64(meq); if (eq && cp < 64u) { CK[cp] = key; CS[cp] = (unsigned short)(64 * i + lane); } cbase += (unsigned)__popcll(meq); } } }
            LDS_WAIT();
            if (cbase <= 64u) {
                const unsigned mykey = (lane < (int)cbase) ? CK[lane] : 0u; unsigned rank = 0u;
                for (unsigned j = 0; j < cbase; ++j) { const unsigned kj = CK[j]; rank += ((kj > mykey) || (kj == mykey && j < (unsigned)lane)) ? 1u : 0u; }
                const bool sel = (lane < (int)cbase) && (rank < need1);
                const unsigned long long ms = __ballot(sel);
                if (sel) IDXL[base + mbcnt64(ms)] = CS[lane];
            } else {
                unsigned prefix = d0, need = need1;
                LDS_WAIT();
                sel_level<11, 11>(k, N, hist, lane, prefix, need);
                sel_level<0, 11>(k, N, hist, lane, prefix, need);
                unsigned eb = 0u, eqb = 0u;
#pragma unroll
                for (int gi = 0; gi < 8; ++gi) if (512 * gi < N) {
#pragma unroll
                    for (int ii = 0; ii < 8; ++ii) { const int i = 8 * gi + ii; const unsigned key = k[i]; const bool gt = key > prefix, eq = key == prefix;
                        const unsigned long long meq = __ballot(eq); const bool sel = gt || (eq && (eqb + mbcnt64(meq) < need));
                        const unsigned long long msel = __ballot(sel); const unsigned pos = eb + mbcnt64(msel);
                        if (sel && pos < 256u) IDXL[pos] = (unsigned short)(64 * i + lane);
                        eb += (unsigned)__popcll(msel); eqb += (unsigned)__popcll(meq); } }
            }
            LDS_WAIT();
            *(u32x2*)(outp + 4 * lane) = *(const LAS u32x2*)(IDXL + 4 * lane);
        }
        __syncthreads();
    }
#undef DSA_UNIT
#undef DSA_KLOAD
#undef DSA_PRELOAD
#undef DSA_KCOMP
}

__device__ __forceinline__ void dsa_attn_phase(LAS unsigned char* lds, const unsigned char* QLAT8, const unsigned char* CKV8, const unsigned short* IDX, bf16_t* OLAT, int bid, int G, const int wvs) {
    int tid0 = wvs * 64 + hw_lane(); asm volatile("" : "+v"(tid0));
    const int wave = __builtin_amdgcn_readfirstlane(tid0 >> 6);
    constexpr int RS = 272, T1OFF = 16 * RS + 128, TS = 32 * RS + 128;
    LAS unsigned char* tile0 = lds + wave * (2 * TS);
    constexpr float SCL = 1.4426950408889634f / 16.0f;
    unsigned ixw[8]; u32x4 qf[4]; u32x4 ra[2][2][4];
#define ATT_Q(itx, b_, t_, m_, cnt_) const int b_ = (itx) & 7, t_ = ((itx) >> 3) * 8 + wave; const size_t m_ = (size_t)b_ * T + t_; const int cnt_ = (t_ + 1 < 256) ? t_ + 1 : 256;
#define ATT_LOAD_IX(dst, m_) do { const u32x4 xa_ = *(const u32x4*)(IDX + (m_) * 256 + 16 * c16), xb_ = *(const u32x4*)(IDX + (m_) * 256 + 16 * c16 + 8); \
    dst[0] = xa_[0]; dst[1] = xa_[1]; dst[2] = xa_[2]; dst[3] = xa_[3]; dst[4] = xb_[0]; dst[5] = xb_[1]; dst[6] = xb_[2]; dst[7] = xb_[3]; } while (0)
#define ATT_LOAD_QF(dst, m_) do { const unsigned char* qp_ = QLAT8 + (m_) * 2048 + hd * 256 + 16 * g; _Pragma("unroll") for (int kk = 0; kk < 4; ++kk) dst[kk] = *(const u32x4*)(qp_ + 64 * kk); } while (0)
#define ATT_LOAD_ROWS(buf, ix_, n0_, b_, cnt_) do { const int n1_ = (n0_) + 1; \
    const int k0_ = (16 * c16 + (n0_) < (cnt_)) ? (int)(ix_[(n0_) >> 1] & 0xffffu) : 0, k1_ = (16 * c16 + n1_ < (cnt_)) ? (int)(ix_[n1_ >> 1] >> 16) : 0; \
    const int r0_ = __builtin_amdgcn_update_dpp(0, k0_, 0x128, 0xf, 0xf, false), r1_ = __builtin_amdgcn_update_dpp(0, k1_, 0x128, 0xf, 0xf, false); \
    const unsigned char* cb_ = CKV8 + (size_t)(b_) * T * 256 + 16 * (g + 4 * (c16 >> 3)); \
    _Pragma("unroll") for (int kg = 0; kg < 2; ++kg) { const int ka_ = ((c16 >> 3) == kg) ? k0_ : r0_, kb_ = ((c16 >> 3) == kg) ? k1_ : r1_; \
        _Pragma("unroll") for (int h = 0; h < 2; ++h) { ra[buf][0][2 * kg + h] = *(const u32x4*)(cb_ + (size_t)ka_ * 256 + 128 * h); ra[buf][1][2 * kg + h] = *(const u32x4*)(cb_ + (size_t)kb_ * 256 + 128 * h); } } } while (0)
#define ATT_IMG(bf) do { _Pragma("unroll") for (int kg = 0; kg < 2; ++kg) _Pragma("unroll") for (int h = 0; h < 2; ++h) { const int rw_ = (8 * kg + (c16 & 7)) * RS + 128 * h + 16 * (g + 4 * (c16 >> 3)); \
    *(LAS u32x4*)(tile0 + (bf) * TS + rw_) = ra[bf][0][2 * kg + h]; *(LAS u32x4*)(tile0 + (bf) * TS + T1OFF + rw_) = ra[bf][1][2 * kg + h]; } } while (0)
#define ATT_QK(bf, d0, d1) do { d0 = (f32x4){0.f, 0.f, 0.f, 0.f}; d1 = d0; \
    _Pragma("unroll") for (int kk = 0; kk < 4; ++kk) { const u32x4 fa_ = *(const LAS u32x4*)(tile0 + (bf) * TS + c16 * RS + 64 * kk + 16 * g), fb_ = *(const LAS u32x4*)(tile0 + (bf) * TS + T1OFF + c16 * RS + 64 * kk + 16 * g); \
        _Pragma("unroll") for (int hh = 0; hh < 2; ++hh) { \
            const long qv_ = (long)(((unsigned long long)qf[kk][2 * hh + 1] << 32) | qf[kk][2 * hh]); \
            const long a0_ = (long)(((unsigned long long)fa_[2 * hh + 1] << 32) | fa_[2 * hh]); \
            const long a1_ = (long)(((unsigned long long)fb_[2 * hh + 1] << 32) | fb_[2 * hh]); \
            d0 = __builtin_amdgcn_mfma_f32_16x16x32_fp8_fp8(a0_, qv_, d0, 0, 0, 0); d1 = __builtin_amdgcn_mfma_f32_16x16x32_fp8_fp8(a1_, qv_, d1, 0, 0, 0); } } } while (0)
    { int tid = tid0; asm volatile("" : "+v"(tid)); const int lane = tid & 63, g = lane >> 4, c16 = lane & 15, hd = c16 & 7;
      if (bid < 4096) { ATT_Q(bid, b, t, m, cnt) (void)t; ATT_LOAD_IX(ixw, m); ATT_LOAD_QF(qf, m); ATT_LOAD_ROWS(0, ixw, 0, b, cnt); ATT_LOAD_ROWS(1, ixw, 2, b, cnt); } }
    for (int it = bid; it < 4096; it += G) {
        int tid = tid0; asm volatile("" : "+v"(tid));
        const int lane = tid & 63, g = lane >> 4, c16 = lane & 15, hd = c16 & 7, q4 = c16 >> 2, p4 = c16 & 3;
        ATT_Q(it, b, t, m, cnt) (void)t;
        const int itn = it + G; const bool hasn = itn < 4096;
        ATT_Q(hasn ? itn : it, bn, tn, mn, cntn) (void)tn;
        f32x4 o[16];
#pragma unroll
        for (int db = 0; db < 16; ++db) o[db] = (f32x4){0.f, 0.f, 0.f, 0.f};
        const int trow = ((c16 >> 1) < 4 ? (4 * g + (c16 >> 1)) * RS : T1OFF + (4 * g + (c16 >> 1) - 4) * RS) + 8 * (c16 & 1);
        float mrun = -INFINITY, lrun = 0.f;
        f32x4 s0, s1, sn0, sn1;
        ATT_IMG(0); ATT_LOAD_ROWS(0, ixw, 4, b, cnt); ATT_QK(0, s0, s1);
#pragma unroll
        for (int ch = 0; ch < 8; ++ch) {
            const int bf = ch & 1, bn1 = (ch + 1) & 1;
            if (ch < 7) { ATT_IMG(bn1);
                if (ch < 5) ATT_LOAD_ROWS(bn1, ixw, 2 * (ch + 3), b, cnt);
                else if (hasn) ATT_LOAD_ROWS(bn1, ixw, 2 * (ch - 5), bn, cntn);
                ATT_QK(bn1, sn0, sn1); }
            if (ch == 4 && hasn) ATT_LOAD_IX(ixw, mn);
            if (ch == 6 && hasn) ATT_LOAD_QF(qf, mn);
            float cm = -INFINITY;
#pragma unroll
            for (int i = 0; i < 4; ++i) { const int jr = 16 * (4 * g + i) + 2 * ch; if (jr >= cnt) s0[i] = -INFINITY; if (jr + 1 >= cnt) s1[i] = -INFINITY; cm = fmaxf(cm, fmaxf(s0[i], s1[i])); }
            cm = fmaxf(cm, bperm_f(lane ^ 16, cm)); cm = fmaxf(cm, bperm_f(lane ^ 32, cm));
            const float mnew = fmaxf(mrun, cm), alpha = __builtin_amdgcn_exp2f((mrun - mnew) * SCL);
            float p0[4], p1[4], ps = 0.f;
#pragma unroll
            for (int i = 0; i < 4; ++i) { p0[i] = __builtin_amdgcn_exp2f((s0[i] - mnew) * SCL); p1[i] = __builtin_amdgcn_exp2f((s1[i] - mnew) * SCL); ps += p0[i] + p1[i]; }
            lrun = lrun * alpha + ps; mrun = mnew;
            asm volatile("" : "+v"(lrun));
#pragma unroll
            for (int db = 0; db < 16; ++db) o[db] = o[db] * alpha;
            int pl = 0, ph = 0;
            pl = __builtin_amdgcn_cvt_pk_fp8_f32(p0[0], p0[1], pl, false); pl = __builtin_amdgcn_cvt_pk_fp8_f32(p0[2], p0[3], pl, true);
            ph = __builtin_amdgcn_cvt_pk_fp8_f32(p1[0], p1[1], ph, false); ph = __builtin_amdgcn_cvt_pk_fp8_f32(p1[2], p1[3], ph, true);
            const long pb = (long)(((unsigned long long)(unsigned)ph << 32) | (unsigned)pl);
#pragma unroll
            for (int db = 0; db < 16; ++db) {
                const i32x2 tv = __builtin_amdgcn_ds_read_tr8_b64_v2i32((LAS i32x2*)(tile0 + bf * TS + trow + 16 * db));
                const long av = (long)(((unsigned long long)(unsigned)tv.y << 32) | (unsigned)tv.x);
                o[db] = __builtin_amdgcn_mfma_f32_16x16x32_fp8_fp8(av, pb, o[db], 0, 0, 0);
            }
            if (ch < 7) { s0 = sn0; s1 = sn1; }
        }
        float lt = lrun + bperm_f(lane ^ 16, lrun); lt += bperm_f(lane ^ 32, lt);
        const float inv = 1.0f / lt;
        if (c16 < 8) { bf16_t* op = OLAT + m * 2048 + c16 * 256 + 4 * g;
#pragma unroll
            for (int db = 0; db < 16; ++db) { const f32x4 y = o[db] * inv; *(u32x2*)(op + 16 * db) = (u32x2){cvt_pk_bf16(y[0], y[1]), cvt_pk_bf16(y[2], y[3])}; } }
    }
#undef ATT_Q
#undef ATT_LOAD_IX
#undef ATT_LOAD_QF
#undef ATT_LOAD_ROWS
#undef ATT_QK
#undef ATT_IMG
}

__device__ __forceinline__ void smix_phase(LAS unsigned char* lds, bf16_t* UY, const bf16_t* V, const f32x2* STATS, const float* Wc, const float* bsp, const float* lng, const float* lnb, int bid, int G, const int wvs) {
    int tid0 = wvs * 64 + hw_lane(); asm volatile("" : "+v"(tid0));
    const int wave = wvs;
    LAS unsigned char* VT = lds;
    LAS unsigned char* AP = lds + 67584;
    LAS float* MU = (LAS float*)(lds + 102400); LAS float* RSTD = MU + 128; LAS float* R1 = MU + 256; LAS float* R2 = MU + 384;
    u32x4 vr[8]; f32x4 sr[4];
#define SMIX_UNIT(itx, b_, gi_, m0_) const int b_ = (itx) & 7, gi_ = ((itx) >> 3) & 7; const size_t m0_ = (size_t)b_ * T + ((itx) >> 6) * 128;
#define SMIX_PRELOAD(m0_, gi_) do { \
    _Pragma("unroll") for (int i = 0; i < 8; ++i) { const int cidx = tid + 512 * i, s_ = cidx >> 5, ch = cidx & 31; vr[i] = *(const u32x4*)(V + ((m0_) + s_) * 2048 + (gi_) * 256 + ch * 8); } \
    { const f32x4* sp = (const f32x4*)(STATS + ((m0_) + (tid >> 2)) * 32 + (tid & 3) * 8); _Pragma("unroll") for (int j = 0; j < 4; ++j) sr[j] = sp[j]; } } while (0)
    if (bid < 2048) { const int tid = tid0; SMIX_UNIT(bid, b0, gi0, m00) (void)b0; SMIX_PRELOAD(m00, gi0); }
    for (int it = bid; it < 2048; it += G) {
        int tid = tid0; asm volatile("" : "+v"(tid));
        const int lane = tid & 63, gq = lane >> 4, c16 = lane & 15, q4 = c16 >> 2, p4 = c16 & 3;
        SMIX_UNIT(it, b, gi, m0) (void)b;
        u32x4 ur[8];
#pragma unroll
        for (int i = 0; i < 8; ++i) { const int cidx = tid + 512 * i, s = cidx >> 5, ch = cidx & 31; ur[i] = *(const u32x4*)(UY + (m0 + s) * 2048 + gi * 256 + ch * 8); }
        { float s = ((sr[0][0] + sr[0][2]) + (sr[1][0] + sr[1][2])) + ((sr[2][0] + sr[2][2]) + (sr[3][0] + sr[3][2])), ss = ((sr[0][1] + sr[0][3]) + (sr[1][1] + sr[1][3])) + ((sr[2][1] + sr[2][3]) + (sr[3][1] + sr[3][3]));
          s += bperm_f(lane ^ 1, s); ss += bperm_f(lane ^ 1, ss); s += bperm_f(lane ^ 2, s); ss += bperm_f(lane ^ 2, ss);
          if ((tid & 3) == 0) { const float mu = s * (1.0f / 2048.0f), var = ss * (1.0f / 2048.0f) - mu * mu; MU[tid >> 2] = mu; RSTD[tid >> 2] = rsqrtf(fmaxf(var, 0.f) + EPS); } }
#pragma unroll
        for (int i = 0; i < 8; ++i) { const int cidx = tid + 512 * i, s = cidx >> 5, ch = cidx & 31; *(LAS u32x4*)(VT + s * 528 + ch * 16) = vr[i]; }
        f32x4 wq[8];
        { const float* wp = Wc + ((size_t)gi * 128 + (tid >> 2)) * 128 + 32 * (tid & 3);
#pragma unroll
          for (int j = 0; j < 8; ++j) wq[j] = *(const f32x4*)(wp + 4 * j); }
        __syncthreads();
        { const int t = tid >> 2, qd = tid & 3; float r1 = 0.f, r2 = 0.f;
#pragma unroll
          for (int s8 = 0; s8 < 4; ++s8) { const f32x4 wa = wq[2 * s8], wb = wq[2 * s8 + 1]; float av[8];
#pragma unroll
              for (int e = 0; e < 8; ++e) { const int s = 32 * qd + 8 * s8 + e; const float wv = (s <= t) ? (e < 4 ? wa[e] : wb[e - 4]) : 0.f; const float ab = bf_round(wv * RSTD[s]); av[e] = ab; r1 += ab * MU[s]; r2 += wv; }
              u32x4 o; o.x = cvt_pk_bf16(av[0], av[1]); o.y = cvt_pk_bf16(av[2], av[3]); o.z = cvt_pk_bf16(av[4], av[5]); o.w = cvt_pk_bf16(av[6], av[7]);
              *(LAS u32x4*)(AP + t * 272 + (32 * qd + 8 * s8) * 2) = o; }
          r1 += bperm_f(lane ^ 1, r1); r2 += bperm_f(lane ^ 1, r2); r1 += bperm_f(lane ^ 2, r1); r2 += bperm_f(lane ^ 2, r2);
          if (qd == 0) { R1[t] = r1; R2[t] = r2; } }
        __syncthreads();
        f32x4 acc[8][2];
#pragma unroll
        for (int mt = 0; mt < 8; ++mt) { acc[mt][0] = (f32x4){0.f, 0.f, 0.f, 0.f}; acc[mt][1] = acc[mt][0]; }
#pragma unroll
        for (int ks = 0; ks < 4; ++ks) {
            bf16x8 vf[2];
#pragma unroll
            for (int n2 = 0; n2 < 2; ++n2) { const int nt = 2 * wave + n2;
                const s16x4 t0v = __builtin_amdgcn_ds_read_tr16_b64_v4i16((LAS s16x4*)(VT + (32 * ks + 8 * gq + q4) * 528 + (16 * nt + 4 * p4) * 2));
                const s16x4 t1v = __builtin_amdgcn_ds_read_tr16_b64_v4i16((LAS s16x4*)(VT + (32 * ks + 8 * gq + 4 + q4) * 528 + (16 * nt + 4 * p4) * 2));
                vf[n2] = __builtin_shufflevector(t0v, t1v, 0, 1, 2, 3, 4, 5, 6, 7); }
#pragma unroll
            for (int mt = 0; mt < 8; ++mt) if (mt >= 2 * ks) {
                const bf16x8 afr = *(const LAS bf16x8*)(AP + (16 * mt + c16) * 272 + (32 * ks + 8 * gq) * 2);
                acc[mt][0] = __builtin_amdgcn_mfma_f32_16x16x32_bf16(vf[0], afr, acc[mt][0], 0, 0, 0);
                acc[mt][1] = __builtin_amdgcn_mfma_f32_16x16x32_bf16(vf[1], afr, acc[mt][1], 0, 0, 0); }
        }
        { const int itn = it + G; if (itn < 2048) { SMIX_UNIT(itn, bn, gin, m0n) (void)bn; SMIX_PRELOAD(m0n, gin); } }
        __syncthreads();
#pragma unroll
        for (int i = 0; i < 8; ++i) { const int cidx = tid + 512 * i, s = cidx >> 5, ch = cidx & 31; *(LAS u32x4*)(VT + s * 528 + ch * 16) = ur[i]; }
        __syncthreads();
#pragma unroll
        for (int n2 = 0; n2 < 2; ++n2) { const int e0 = 16 * (2 * wave + n2) + 4 * gq; const f32x4 lg4 = *(const f32x4*)(lng + gi * 256 + e0), lb4 = *(const f32x4*)(lnb + gi * 256 + e0);
#pragma unroll
            for (int mt = 0; mt < 8; ++mt) { const int t = 16 * mt + c16; const float r1 = R1[t], r2 = R2[t], bsv = bsp[gi * 128 + t];
                LAS u32x2* up = (LAS u32x2*)(VT + t * 528 + e0 * 2); const u32x2 uw = *up;
                const f32x4 mixed = lg4 * (acc[mt][n2] - r1) + lb4 * r2 + bsv;
                const float y0 = bf2f(uw.x & 0xffffu) * mixed[0], y1 = bf2f(uw.x >> 16) * mixed[1], y2 = bf2f(uw.y & 0xffffu) * mixed[2], y3 = bf2f(uw.y >> 16) * mixed[3];
                u32x2 yw; yw.x = cvt_pk_bf16(y0, y1); yw.y = cvt_pk_bf16(y2, y3); *up = yw; } }
        __syncthreads();
#pragma unroll
        for (int i = 0; i < 8; ++i) { const int cidx = tid + 512 * i, s = cidx >> 5, ch = cidx & 31;
            *(u32x4*)(UY + (m0 + s) * 2048 + gi * 256 + ch * 8) = *(const LAS u32x4*)(VT + s * 528 + ch * 16); }
        __syncthreads();
    }
#undef SMIX_UNIT
#undef SMIX_PRELOAD
}

__global__ void __launch_bounds__(512, 2) mk_fwd(Args a) {
    extern __shared__ __attribute__((aligned(16))) unsigned char lds_raw[];
    LAS unsigned char* lds = (LAS unsigned char*)lds_raw;
    cg::grid_group grid = cg::this_grid();
    int bid = blockIdx.x; const int G = gridDim.x;
    unsigned char* wsk = a.ws;
    volatile LAS unsigned* misc = (volatile LAS unsigned*)(lds + LDS_MISC);
    const int wvs = __builtin_amdgcn_readfirstlane((int)threadIdx.x >> 6);
    if (wvs == 0 && hw_lane() < 2) misc[hw_lane()] = 0u;
    __syncthreads();
    const XcdBarrier xbar = xcd_barrier_post((unsigned*)(wsk + WS_BAR), misc, wvs);
    int ph = 0;
#ifndef PROBE
#define PROBE 0
#endif
#define PHASE_BEGIN if (ph >= a.ph_lo && ph < a.ph_hi) { size_t bb = (size_t)(bid & 7); asm volatile("" : "+s"(bb)); unsigned char* const act = wsk + WS_ACT + bb * SLAB; (void)act;
#define REP(k) for (int rep_ = 0; rep_ < ((PROBE == (k)) ? 2 : 1); ++rep_)
#define PHASE_END(dosync) if ((dosync) && ph + 1 < a.ph_hi) { if (ph == 0) grid.sync(); else if (ph == 1 || !local) xcd_barrier(xbar); else xcd_barrier_local(xbar); } } ++ph;

    bool local = false;
    PHASE_BEGIN REP(4) { p0_phase(a, lds, bid, G, wvs); __syncthreads(); } PHASE_END(true)
    {   if (wvs == 0 && hw_lane() == 0) { unsigned ok = (G == 256) ? 1u : 0u;
            for (unsigned j = 0; j < 16; ++j) { const unsigned c = xb_ld(&xbar.bar[XB_XCNT(j)]); ok &= (c == (j < 8u ? 32u : 0u)) ? 1u : 0u; }
            misc[3] = ok; }
        __syncthreads();
        if (misc[3] != 0u) { local = true; bid = __builtin_amdgcn_readfirstlane((int)(misc[2] * 8u + xbar.x)); }
    }
    PHASE_BEGIN p0c_phase(a, bid, G, wvs); PHASE_END(true)

#define ACT(off, rowbytes) (act + (off) - bb * T * (size_t)(rowbytes))
#define H ((bf16_t*)((unsigned char*)a.out + bb * (16 * MiB) - bb * T * 2048))
#define X ((_Float16*)ACT(S_X16, 2048))
#define Q ((bf16_t*)ACT(S_Q, 2048))
#define CKVR ((float*)ACT(S_CKVR, 1024))
#define QIDX ((bf16_t*)ACT(S_QIDX, 1024))
#define KRAW ((float*)ACT(S_KRAW, 512))
#define CKV ((bf16_t*)ACT(S_CKV, 256))
#define KIDX ((bf16_t*)ACT(S_KIDX, 128))
#define WIDX ((float*)ACT(S_WIDX, 32))
#define IDX ((unsigned short*)ACT(S_IDX, 512))
#define QLAT ((bf16_t*)ACT(S_QLAT, 2048))
#define OLAT ((bf16_t*)a.out)
#define O ((bf16_t*)ACT(S_O, 2048))
#define U ((bf16_t*)ACT(S_U, 4096))
#define V ((bf16_t*)ACT(S_V, 4096))
#define STATS ((f32x2*)ACT(S_STATS, 256))
    auto layer_body = [&](const int layer) __attribute__((always_inline)) {
        unsigned char* ws = wsk; asm volatile("" : "+s"(ws));
        float* MOD = (float*)(ws + WS_MOD);
        const int j = layer >> 1;
        const float* modl = MOD + (size_t)layer * 8 * NMOD;
        PHASE_BEGIN REP(3) { if (layer == 0) norm_mod_phase<true>(a.in[0], X, a.in[4] + layer * D, modl + 0 * D, modl + 1 * D, H, bid, G, wvs);
            else norm_mod_phase<false>(nullptr, X, a.in[4] + layer * D, modl + 0 * D, modl + 1 * D, H, bid, G, wvs); } PHASE_END(true)
        if ((layer & 1) == 0) {
            PHASE_BEGIN { pg8::Gemm g{H, (const bf16_t*)(ws + W_AIN) + (size_t)j * 2048 * 1024, M, 2048, 1024, 1024, 0, 0}; pg8::StaticOrder S; S.init(M, 2048, G, bid);
                pg8::EpiInproj E{Q, QIDX, (unsigned char*)CKV, KIDX, WIDX, a.in[7] + j * 256, a.in[8] + j * 64, a.in[9] + j * 64, (LAS float*)(lds + 8 * pg8::HTB)}; REP(5) pg8::gemm_phase(lds, g, S, E, wvs); } PHASE_END(true)
            PHASE_BEGIN {
                pg8::Gemm g{Q, (const bf16_t*)(ws + W_UK) + (size_t)j * 2048 * 256, M, 2048, 256, 1024, 1, 256}; pg8::StaticOrder S; S.init(M, 2048, G, bid);
                pg8::EpiBf16 E{QLAT, 2048, 1.4142135623730951f, 1}; pg8::gemm_phase(lds, g, S, E, wvs); } PHASE_END(true)
            PHASE_BEGIN REP(1) dsa_select_phase(lds, QIDX, KIDX, WIDX, IDX, bid, G, wvs); PHASE_END(true)
            PHASE_BEGIN REP(2) dsa_attn_phase(lds, (const unsigned char*)QLAT, (const unsigned char*)CKV, IDX, OLAT, bid, G, wvs); PHASE_END(true)
            PHASE_BEGIN { pg8::Gemm g{OLAT, (const bf16_t*)(ws + W_UV) + (size_t)j * 1024 * 512, M, 1024, 512, 2048, 0, 512}; pg8::StaticOrder S; S.init(M, 1024, G, bid);
                pg8::EpiBf16 E{O, 1024, 1.0f, 0}; pg8::gemm_phase(lds, g, S, E, wvs); } PHASE_END(true)
            PHASE_BEGIN { pg8::Gemm g{O, (const bf16_t*)(ws + W_O) + (size_t)j * 1024 * 1024, M, 1024, 1024, 1024, 0, 0}; pg8::StaticOrder S; S.init(M, 1024, G, bid);
                pg8::EpiResid E{X, modl + 2 * D}; pg8::gemm_phase(lds, g, S, E, wvs); } PHASE_END(true)
        } else {
            PHASE_BEGIN { pg8::Gemm g{H, (const bf16_t*)(ws + W_BIN) + (size_t)j * 4096 * 1024, M, 4096, 1024, 1024, 0, 0}; pg8::StaticOrder S; S.init(M, 4096, G, bid);
                pg8::EpiGelu E{U, V, STATS}; REP(7) pg8::gemm_phase(lds, g, S, E, wvs); } PHASE_END(true)
            PHASE_BEGIN smix_phase(lds, U, V, STATS, a.in[16] + (size_t)j * 8 * 128 * 128, a.in[17] + (size_t)j * 8 * 128, a.in[14] + (size_t)j * 2048, a.in[15] + (size_t)j * 2048, bid, G, wvs); PHASE_END(true)
            PHASE_BEGIN { pg8::Gemm g{U, (const bf16_t*)(ws + W_BOUT) + (size_t)j * 1024 * 2048, M, 1024, 2048, 2048, 0, 0}; pg8::StaticOrder S; S.init(M, 1024, G, bid);
                pg8::EpiResid E{X, modl + 2 * D}; pg8::gemm_phase(lds, g, S, E, wvs); } PHASE_END(true)
        }
        PHASE_BEGIN REP(3) norm_mod_phase<false>(nullptr, X, a.in[5] + layer * D, modl + 3 * D, modl + 4 * D, H, bid, G, wvs); PHASE_END(true)
        PHASE_BEGIN { pg8::Gemm g{H, (const bf16_t*)(ws + W_GU) + (size_t)layer * 5632 * 1024, M, 5632, 1024, 1024, 0, 0}; pg8::StaticOrder S; S.init(M, 5632, G, bid);
            pg8::EpiSwiglu E{(bf16_t*)ACT(S_HID, 5632)}; REP(6) pg8::gemm_phase(lds, g, S, E, wvs); } PHASE_END(true)
        PHASE_BEGIN { pg8::Gemm g{(const bf16_t*)ACT(S_HID, 5632), (const bf16_t*)(ws + W_DN) + (size_t)layer * 1024 * DFF, M, 1024, DFF, DFF, 0, 0}; pg8::StaticOrder S; S.init(M, 1024, G, bid);
            pg8::EpiResid E{X, modl + 5 * D}; pg8::gemm_phase(lds, g, S, E, wvs); } PHASE_END(true)
    };
    layer_body(0); layer_body(1); layer_body(2); layer_body(3);
    PHASE_BEGIN final_norm_phase(X, a.in[22], a.out, bid, G, wvs); PHASE_END(false)
#undef H
#undef X
#undef Q
#undef CKVR
#undef QIDX
#undef KRAW
#undef CKV
#undef KIDX
#undef WIDX
#undef IDX
#undef QLAT
#undef OLAT
#undef O
#undef U
#undef V
#undef STATS
#undef ACT
}

extern "C" void kernel_launch(void* const* d_in, const int* in_sizes, int n_in, void* d_out, int out_size, void* d_ws, size_t ws_size, hipStream_t stream) {
    static int grid_blocks = 0;
    if (grid_blocks == 0) {
        int dev = 0, cus = 0, per_cu = 0;
        if (n_in != 23 || out_size != M * D || ws_size < WS_END) { fprintf(stderr, "kernel_launch: unexpected problem (n_in %d out %d ws %zu, need ws >= %zu)\n", n_in, out_size, ws_size, (size_t)WS_END); grid_blocks = -1; return; }
        (void)hipGetDevice(&dev);
        (void)hipDeviceGetAttribute(&cus, hipDeviceAttributeMultiprocessorCount, dev);
        (void)hipFuncSetAttribute((const void*)mk_fwd, hipFuncAttributeMaxDynamicSharedMemorySize, LDS_BYTES);
        (void)hipOccupancyMaxActiveBlocksPerMultiprocessor(&per_cu, (const void*)mk_fwd, 512, LDS_BYTES);
        fprintf(stderr, "kernel_launch: cus %d per_cu %d ws %zu\n", cus, per_cu, ws_size);
        if (per_cu < 1) { fprintf(stderr, "kernel_launch: kernel does not fit a CU\n"); grid_blocks = -1; return; }
        grid_blocks = cus;
    }
    if (grid_blocks < 0) return;
    if (hipMemsetAsync((char*)d_ws + WS_BAR, 0, 16384, stream) != hipSuccess) { fprintf(stderr, "kernel_launch: memset failed\n"); return; }
    Args a{};
    for (int i = 0; i < 23; ++i) a.in[i] = (const float*)d_in[i];
    a.out = (float*)d_out; a.ws = (unsigned char*)d_ws; a.ph_lo = 0; a.ph_hi = 1000;
    void* args[] = {&a};
    hipError_t e = hipLaunchCooperativeKernel((const void*)mk_fwd, dim3(grid_blocks), dim3(512), args, LDS_BYTES, stream);
    if (e != hipSuccess) fprintf(stderr, "cooperative launch failed: %s (grid %d)\n", hipGetErrorString(e), grid_blocks);
}
```

```cpp
#include <hip/hip_runtime.h>
#include <hip/hip_cooperative_groups.h>
#include <cstdio>
#include <cstdint>
namespace cg = cooperative_groups;

#define LAS __attribute__((address_space(3)))
typedef unsigned short bf16_t;
typedef short bf16x8 __attribute__((ext_vector_type(8)));
typedef short s16x4 __attribute__((ext_vector_type(4)));
typedef float f32x4 __attribute__((ext_vector_type(4)));
typedef float f32x16 __attribute__((ext_vector_type(16)));
typedef float f32x2 __attribute__((ext_vector_type(2)));
typedef unsigned u32x4 __attribute__((ext_vector_type(4)));
typedef unsigned u32x2 __attribute__((ext_vector_type(2)));
typedef int i32x2 __attribute__((ext_vector_type(2)));
typedef _Float16 f16x8 __attribute__((ext_vector_type(8)));
typedef float f32x8 __attribute__((ext_vector_type(8)));

constexpr int D = 1024, NB = 8, T = 4096, M = NB * T, DFF = 2816, NMOD = 6 * D;
constexpr float EPS = 1e-6f;
constexpr int AIN = 1864;
constexpr size_t MiB = 1u << 20;
constexpr size_t WS_MOD = 0;
constexpr size_t WS_MODP = 1 * MiB;
constexpr size_t WS_W = 13 * MiB;
constexpr size_t W_AIN = WS_W;
constexpr size_t W_UK = W_AIN + 8 * MiB;
constexpr size_t W_UV = W_UK + 2 * MiB;
constexpr size_t W_O = W_UV + 2 * MiB;
constexpr size_t W_BIN = W_O + 4 * MiB;
constexpr size_t W_BOUT = W_BIN + 16 * MiB;
constexpr size_t W_GU = W_BOUT + 8 * MiB;
constexpr size_t W_DN = W_GU + 44 * MiB;
constexpr size_t WS_ACT = W_DN + 22 * MiB;
constexpr size_t KiB = 1024, SLAB = 47 * MiB;
constexpr size_t S_X16 = 0;
constexpr size_t S_Q = 8 * MiB;
constexpr size_t S_HID = 8 * MiB;
constexpr size_t S_U = 8 * MiB;
constexpr size_t S_V = 24 * MiB;
constexpr size_t S_STATS = 40 * MiB;
constexpr size_t S_QLAT = 16 * MiB;
constexpr size_t S_O = 16 * MiB;
constexpr size_t S_CKVR = 32 * MiB;
constexpr size_t S_CKV = 36 * MiB;
constexpr size_t S_QIDX = 38 * MiB;
constexpr size_t S_KRAW = 42 * MiB;
constexpr size_t S_KIDX = 44 * MiB;
constexpr size_t S_WIDX = 44 * MiB + 512 * KiB;
constexpr size_t S_IDX = 44 * MiB + 640 * KiB;
static_assert(S_IDX + 2 * MiB <= SLAB && S_HID + 22 * MiB <= S_CKVR && S_STATS + MiB <= SLAB, "slab map");
constexpr size_t WS_END = WS_ACT + 8 * SLAB;
constexpr int LDS_BYTES = 147456;
constexpr int LDS_MISC = LDS_BYTES - 256;
constexpr size_t WS_BAR = 1 * MiB - 16384;

__device__ __forceinline__ unsigned cvt_pk_bf16(float lo, float hi) { unsigned r; asm volatile("v_cvt_pk_bf16_f32 %0, %1, %2" : "=v"(r) : "v"(lo), "v"(hi)); return r; }
__device__ __forceinline__ float bf2f(unsigned b) { return __uint_as_float(b << 16); }
__device__ __forceinline__ float bf_round(float f) { unsigned u = __float_as_uint(f); u = (u + 0x7fffu + ((u >> 16) & 1u)) & 0xffff0000u; return __uint_as_float(u); }
__device__ __forceinline__ float wave_sum(float v) {
#pragma unroll
    for (int o = 1; o < 64; o <<= 1) v += __shfl_xor(v, o);
    return v;
}
#define LDS_WAIT() asm volatile("s_waitcnt lgkmcnt(0)" ::: "memory")
__device__ __forceinline__ unsigned bperm_u(int srclane, unsigned v) { return (unsigned)__builtin_amdgcn_ds_bpermute(srclane << 2, (int)v); }
__device__ __forceinline__ int hw_lane() { int l; asm volatile("v_mbcnt_lo_u32_b32 %0, -1, 0\n\tv_mbcnt_hi_u32_b32 %0, -1, %0" : "=v"(l)); return l; }
__device__ __forceinline__ float bperm_f(int srclane, float v) { return __int_as_float(__builtin_amdgcn_ds_bpermute(srclane << 2, __float_as_int(v))); }


#define XB_TMO      128
#define XB_XCNT(j)  (256  + 64 * (j))
#define XB_XSUB(j)  (1280 + 64 * (j))
#define XB_XGEN(j)  (2304 + 64 * (j))
#define XB_TOP      3328
#define XB_TOPGEN   3392
#define XCD_BAR_WORDS 3456
#define XB_SPIN_CAP (1u << 22)
__device__ __forceinline__ unsigned xb_ld(unsigned* p)              { return __hip_atomic_load(p, __ATOMIC_RELAXED, __HIP_MEMORY_SCOPE_AGENT); }
__device__ __forceinline__ unsigned xb_add(unsigned* p, unsigned v) { return __hip_atomic_fetch_add(p, v, __ATOMIC_RELAXED, __HIP_MEMORY_SCOPE_AGENT); }
__device__ __forceinline__ unsigned xb_xcc_id() { return (unsigned)__builtin_amdgcn_s_getreg((3 << 11) | 20) & 0xFu; }
#define XB_SPIN(cond, bar) do { unsigned _sp = 0; while (cond) { __builtin_amdgcn_s_sleep(1); \
    if ((++_sp & 255u) == 0u) { if (xb_ld(&(bar)[XB_TMO])) break; if (_sp > XB_SPIN_CAP) { atomicAdd(&(bar)[XB_TMO], 1u); break; } } } } while (0)
struct XcdBarrier { unsigned* bar; unsigned x; volatile LAS unsigned* st; int wvs; };
__device__ __forceinline__ XcdBarrier xcd_barrier_post(unsigned* bar, volatile LAS unsigned* st, int wvs) {
    XcdBarrier b; b.bar = bar; b.x = xb_xcc_id(); b.st = st; b.wvs = wvs;
    if (wvs == 0 && hw_lane() == 0) st[2] = xb_add(&bar[XB_XCNT(b.x)], 1u);
    return b;
}
__device__ __forceinline__ void xcd_barrier_complete(unsigned* bar, unsigned x, unsigned& nloc, unsigned& nx) {
    const unsigned G = gridDim.x * gridDim.y * gridDim.z;
    unsigned sum, cnt, mine, sp = 0u;
    for (;;) {
        sum = 0u; cnt = 0u; mine = 0u;
#pragma unroll
        for (unsigned j = 0; j < 16; ++j) { const unsigned c = xb_ld(&bar[XB_XCNT(j)]); sum += c; cnt += (c > 0u) ? 1u : 0u; mine = (j == x) ? c : mine; }
        if (sum == G) break;
        __builtin_amdgcn_s_sleep(1);
        if ((++sp & 255u) == 0u) { if (xb_ld(&bar[XB_TMO])) break; if (sp > XB_SPIN_CAP) { atomicAdd(&bar[XB_TMO], 1u); break; } }
    }
    nloc = mine > 0u ? mine : 1u; nx = cnt > 0u ? cnt : 1u;
}
__device__ __forceinline__ void xcd_barrier(const XcdBarrier& b) {
    asm volatile("s_waitcnt vmcnt(0)" ::: "memory");
    __syncthreads();
    if (b.wvs == 0 && hw_lane() == 0) {
        unsigned* bar = b.bar;
        __builtin_amdgcn_s_waitcnt(0);
        unsigned nloc = b.st[0], nx = b.st[1];
        if (nloc == 0u) { xcd_barrier_complete(bar, b.x, nloc, nx); b.st[0] = nloc; b.st[1] = nx; }
        const unsigned old = xb_add(&bar[XB_XSUB(b.x)], 1u);
        const unsigned gen = old / nloc;
        if (old + 1u == (gen + 1u) * nloc) {
            __builtin_amdgcn_fence(__ATOMIC_RELEASE, "agent");
            asm volatile("s_waitcnt vmcnt(0)" ::: "memory");
            const unsigned og = xb_add(&bar[XB_TOP], 1u);
            const unsigned tg = og / nx;
            if (og + 1u == (tg + 1u) * nx) xb_add(&bar[XB_TOPGEN], 1u);
            else XB_SPIN(xb_ld(&bar[XB_TOPGEN]) == tg, bar);
            __builtin_amdgcn_fence(__ATOMIC_ACQUIRE, "agent");
            xb_add(&bar[XB_XGEN(b.x)], 1u);
            asm volatile("s_waitcnt vmcnt(0)" ::: "memory");
        } else {
            XB_SPIN(xb_ld(&bar[XB_XGEN(b.x)]) == gen, bar);
            __builtin_amdgcn_fence(__ATOMIC_ACQUIRE, "agent");
            asm volatile("s_waitcnt vmcnt(0)" ::: "memory");
        }
    }
    __syncthreads();
}

__device__ __forceinline__ void xcd_barrier_local(const XcdBarrier& b) {
    asm volatile("s_waitcnt vmcnt(0)" ::: "memory");
    __syncthreads();
    if (b.wvs == 0 && hw_lane() == 0) {
        unsigned* bar = b.bar;
        __builtin_amdgcn_s_waitcnt(0);
        const unsigned nloc = b.st[0];
        asm volatile("buffer_inv sc1" ::: "memory");
        const unsigned old = xb_add(&bar[XB_XSUB(b.x)], 1u);
        const unsigned gen = old / nloc;
        if (old + 1u == (gen + 1u) * nloc) xb_add(&bar[XB_XGEN(b.x)], 1u);
        else XB_SPIN(xb_ld(&bar[XB_XGEN(b.x)]) == gen, bar);
        asm volatile("s_waitcnt vmcnt(0)" ::: "memory");
    }
    __syncthreads();
}

namespace pg8 {
constexpr int BM = 256, BK = 64, HALF = 128, HTB = HALF * BK * 2, STAGE_BYTES = 8 * HTB, NXCD = 8, WGM = 4;
__host__ __device__ __forceinline__ int lds_byte(int r, int c) { return (r >> 3) * 1024 + (r & 7) * 128 + (((c >> 3) ^ ((r >> 1) & 7)) << 4) + (c & 7) * 2; }
__host__ __device__ __forceinline__ void stage_rc(int b, int& R, int& C) { const int blk = b / 1024, sb = b % 1024; R = blk * 8 + sb / 128; C = ((((sb % 128) >> 4) ^ ((R >> 1) & 7))) * 8; }
__host__ __device__ __forceinline__ int perm32(int rho) { const int n = rho >> 4, i = rho & 15; return 8 * (i >> 2) + 4 * n + (i & 3); }

struct Unit { int pm, pn; };
struct Gemm { const bf16_t* A; const bf16_t* Bt; int M, N, K, lda, agrp_shift, agrp_stride; };

struct StaticOrder {
    int nM, nN, nwg, G, c;
    __device__ void init(int M_, int N_, int G_, int c_) { nM = M_ / BM; nN = N_ / BM; nwg = nM * nN; G = G_; c = c_; }
    __device__ bool next(int i, Unit& u) const {
        const long L = (long)i * G + c; if (L >= nwg) return false;
        int wgid = (int)L; { const int q = nwg / NXCD, r = nwg % NXCD, xcd = wgid % NXCD, off = wgid / NXCD; wgid = (xcd < r ? xcd * (q + 1) : r * (q + 1) + (xcd - r) * q) + off; }
        const int nig = WGM * nN, gid = wgid / nig, fm = gid * WGM, gsz = (nM - fm) < WGM ? (nM - fm) : WGM;
        u.pm = fm + ((wgid % nig) % gsz); u.pn = (wgid % nig) / gsz; return true;
    }
};

typedef f32x4 Acc[2][2][4][2];

__device__ __forceinline__ f32x2 gelu_pk(f32x2 v) {
    const f32x2 av = __builtin_elementwise_abs(v), d = av * 0.2316418882f + 1.0f;
    f32x2 t; t.x = __builtin_amdgcn_rcpf(d.x); t.y = __builtin_amdgcn_rcpf(d.y);
    f32x2 q = t * 0.5307027145f + (-0.7265760135f); q = q * t + 0.7107068705f; q = q * t + (-0.142248368f); q = q * t + 0.127414796f; q = q * t;
    const f32x2 s = (v * v) * (-0.72134752044f);
    f32x2 e; e.x = __builtin_amdgcn_exp2f(s.x); e.y = __builtin_amdgcn_exp2f(s.y);
    const f32x2 m = v * (q * e), r = v - m;
    f32x2 o; o.x = v.x < 0.f ? m.x : r.x; o.y = v.y < 0.f ? m.y : r.y; return o;
}
__device__ __forceinline__ f32x4 gelu4(f32x4 v) { f32x2 a = gelu_pk((f32x2){v[0], v[1]}), b = gelu_pk((f32x2){v[2], v[3]}); return (f32x4){a.x, a.y, b.x, b.y}; }
__device__ __forceinline__ u32x4 pack8(f32x4 v0, f32x4 v1) { u32x4 w; w.x = cvt_pk_bf16(v0[0], v0[1]); w.y = cvt_pk_bf16(v0[2], v0[3]); w.z = cvt_pk_bf16(v1[0], v1[1]); w.w = cvt_pk_bf16(v1[2], v1[3]); return w; }

struct EpiInproj {
    static constexpr int NS = 0, PREF = 0;
    bf16_t* Q; bf16_t* QIDX; unsigned char* CKV; bf16_t* KIDX; float* WIDX; const float* gkv; const float* gk; const float* bk; LAS float* rs;
    __device__ __forceinline__ void operator()(const Acc& acc, const Unit& u, int wr, int wc, int fr, int fq) const {
        const int row0 = u.pm * BM + wr * 64 + fr, cl = wc * 32 + 8 * fq;
        if (u.pn == 4) {
#pragma unroll
            for (int ai = 0; ai < 2; ++ai)
#pragma unroll
                for (int m = 0; m < 4; ++m) { float ss = 0.f;
#pragma unroll
                    for (int bj = 0; bj < 2; ++bj)
#pragma unroll
                        for (int n = 0; n < 2; ++n) { const f32x4 v = acc[ai][bj][m][n]; ss += (v[0] * v[0] + v[1] * v[1]) + (v[2] * v[2] + v[3] * v[3]); }
                    ss += bperm_f((16 * fq + fr) ^ 16, ss); ss += bperm_f((16 * fq + fr) ^ 32, ss);
                    if (fq == 0) rs[(ai * HALF + wr * 64 + m * 16 + fr) * 4 + wc] = ss; }
            asm volatile("s_waitcnt lgkmcnt(0)" ::: "memory"); __builtin_amdgcn_s_barrier();
            f32x4 g4[2][2];
#pragma unroll
            for (int bj = 0; bj < 2; ++bj)
#pragma unroll
                for (int n = 0; n < 2; ++n) g4[bj][n] = *(const f32x4*)(gkv + bj * HALF + cl + 4 * n);
#pragma unroll
            for (int ai = 0; ai < 2; ++ai)
#pragma unroll
                for (int m = 0; m < 4; ++m) { const f32x4 p = *(const LAS f32x4*)(rs + (ai * HALF + wr * 64 + m * 16 + fr) * 4);
                    const float rstd = rsqrtf(((p[0] + p[1]) + (p[2] + p[3])) * (1.0f / 256.0f) + EPS);
                    unsigned char* rowp = CKV + (size_t)(row0 + ai * HALF + m * 16) * 256 + cl;
#pragma unroll
                    for (int bj = 0; bj < 2; ++bj) { const f32x4 y0 = acc[ai][bj][m][0] * rstd * g4[bj][0], y1 = acc[ai][bj][m][1] * rstd * g4[bj][1]; int w0 = 0, w1 = 0;
                        w0 = __builtin_amdgcn_cvt_pk_fp8_f32(y0[0], y0[1], w0, false); w0 = __builtin_amdgcn_cvt_pk_fp8_f32(y0[2], y0[3], w0, true);
                        w1 = __builtin_amdgcn_cvt_pk_fp8_f32(y1[0], y1[1], w1, false); w1 = __builtin_amdgcn_cvt_pk_fp8_f32(y1[2], y1[3], w1, true);
                        *(u32x2*)(rowp + bj * HALF) = (u32x2){(unsigned)w0, (unsigned)w1}; } }
            return; }
        if (u.pn == 7) {
            LAS f32x2* rs2 = (LAS f32x2*)rs;
#pragma unroll
            for (int ai = 0; ai < 2; ++ai)
#pragma unroll
                for (int m = 0; m < 4; ++m) { const f32x4 v0 = acc[ai][0][m][0], v1 = acc[ai][0][m][1];
                    float sm = (v0[0] + v0[1]) + (v0[2] + v0[3]) + (v1[0] + v1[1]) + (v1[2] + v1[3]);
                    float sq = (v0[0] * v0[0] + v0[1] * v0[1]) + (v0[2] * v0[2] + v0[3] * v0[3]) + (v1[0] * v1[0] + v1[1] * v1[1]) + (v1[2] * v1[2] + v1[3] * v1[3]);
                    sm += bperm_f((16 * fq + fr) ^ 16, sm); sq += bperm_f((16 * fq + fr) ^ 16, sq); sm += bperm_f((16 * fq + fr) ^ 32, sm); sq += bperm_f((16 * fq + fr) ^ 32, sq);
                    if (fq == 0 && wc < 2) rs2[(ai * HALF + wr * 64 + m * 16 + fr) * 2 + wc] = (f32x2){sm, sq}; }
            asm volatile("s_waitcnt lgkmcnt(0)" ::: "memory"); __builtin_amdgcn_s_barrier();
            if (wc < 2) { const f32x4 ga = *(const f32x4*)(gk + cl), gb = *(const f32x4*)(gk + cl + 4), ba = *(const f32x4*)(bk + cl), bb4 = *(const f32x4*)(bk + cl + 4);
#pragma unroll
                for (int ai = 0; ai < 2; ++ai)
#pragma unroll
                    for (int m = 0; m < 4; ++m) { const f32x4 p = *(const LAS f32x4*)(rs + (ai * HALF + wr * 64 + m * 16 + fr) * 4);
                        const float mean = (p[0] + p[2]) * (1.0f / 64.0f), var = fmaxf((p[1] + p[3]) * (1.0f / 64.0f) - mean * mean, 0.f), krstd = rsqrtf(var + EPS);
                        const f32x4 y0 = (acc[ai][0][m][0] - mean) * krstd * ga + ba, y1 = (acc[ai][0][m][1] - mean) * krstd * gb + bb4;
                        const size_t r = (size_t)(row0 + ai * HALF + m * 16);
                        *(u32x4*)(KIDX + (((r >> 5) * 4 + (size_t)(cl >> 4)) * 64 + (size_t)(((cl >> 3) & 1) * 32) + (r & 31)) * 8) = pack8(y0, y1); } }
            else if (wc == 2 && fq == 0) {
#pragma unroll
                for (int ai = 0; ai < 2; ++ai)
#pragma unroll
                    for (int m = 0; m < 4; ++m) { float* p = WIDX + (size_t)(row0 + ai * HALF + m * 16) * 8; *(f32x4*)p = acc[ai][0][m][0] * 0.04419417382f; *(f32x4*)(p + 4) = acc[ai][0][m][1] * 0.04419417382f; } }
            return; }
#pragma unroll
        for (int ai = 0; ai < 2; ++ai)
#pragma unroll
            for (int m = 0; m < 4; ++m) { const size_t row = (size_t)(row0 + ai * HALF + m * 16);
#pragma unroll
                for (int bj = 0; bj < 2; ++bj) { const f32x4 v0 = acc[ai][bj][m][0], v1 = acc[ai][bj][m][1]; const int c = bj * HALF + cl;
                    if (u.pn < 4) *(u32x4*)(Q + row * 1024 + u.pn * 256 + c) = pack8(v0, v1);
                    else *(u32x4*)(QIDX + row * 512 + (u.pn - 5) * 256 + c) = pack8(v0, v1); } }
    }
};
struct EpiBf16 {
    static constexpr int NS = 16, PREF = 0;
    bf16_t* O; int ldc; float scale; int fp8;
    __device__ __forceinline__ void operator()(const Acc& acc, const Unit& u, int wr, int wc, int fr, int fq) const {
        const int row0 = u.pm * BM + wr * 64 + fr, col0 = u.pn * BM + wc * 32 + 8 * fq;
        if (fp8) {
#pragma unroll
            for (int ai = 0; ai < 2; ++ai)
#pragma unroll
                for (int m = 0; m < 4; ++m) { unsigned char* rowp = (unsigned char*)O + (size_t)(row0 + ai * HALF + m * 16) * ldc + col0;
#pragma unroll
                    for (int bj = 0; bj < 2; ++bj) { const f32x4 v0 = acc[ai][bj][m][0] * scale, v1 = acc[ai][bj][m][1] * scale; int w0 = 0, w1 = 0;
                        w0 = __builtin_amdgcn_cvt_pk_fp8_f32(v0[0], v0[1], w0, false); w0 = __builtin_amdgcn_cvt_pk_fp8_f32(v0[2], v0[3], w0, true);
                        w1 = __builtin_amdgcn_cvt_pk_fp8_f32(v1[0], v1[1], w1, false); w1 = __builtin_amdgcn_cvt_pk_fp8_f32(v1[2], v1[3], w1, true);
                        *(u32x2*)(rowp + bj * HALF) = (u32x2){(unsigned)w0, (unsigned)w1}; } }
            return; }
#pragma unroll
        for (int ai = 0; ai < 2; ++ai)
#pragma unroll
            for (int m = 0; m < 4; ++m) { bf16_t* rowp = O + (size_t)(row0 + ai * HALF + m * 16) * ldc + col0;
#pragma unroll
                for (int bj = 0; bj < 2; ++bj) *(u32x4*)(rowp + bj * HALF) = pack8(acc[ai][bj][m][0] * scale, acc[ai][bj][m][1] * scale); }
    }
};
struct EpiResid {
    static constexpr int NS = 36, PREF = 0;
    _Float16* x; const float* gate;
    __device__ __forceinline__ unsigned pref_off(const Unit& u, int wr, int wc, int lane) const { return (unsigned)((u.pm * BM + wr * 64 + lane) * D + u.pn * BM + wc * 32) * 2u; }
    __device__ __forceinline__ void operator()(const Acc& acc, const Unit& u, int wr, int wc, int fr, int fq) const {
        const int row0 = u.pm * BM + wr * 64 + fr, col0 = u.pn * BM + wc * 32 + 8 * fq;
        const float* gp = gate + (size_t)(u.pm >> 4) * NMOD + col0;
        f32x4 gv[2][2];
#pragma unroll
        for (int bj = 0; bj < 2; ++bj)
#pragma unroll
            for (int n = 0; n < 2; ++n) gv[bj][n] = *(const f32x4*)(gp + bj * HALF + 4 * n);
#pragma unroll
        for (int ai = 0; ai < 2; ++ai)
#pragma unroll
            for (int m = 0; m < 4; ++m) { _Float16* xp = x + (size_t)(row0 + ai * HALF + m * 16) * D + col0;
#pragma unroll
                for (int bj = 0; bj < 2; ++bj) { const f32x8 xo = __builtin_convertvector(*(const f16x8*)(xp + bj * HALF), f32x8);
                    const f32x4 r0 = (f32x4){xo[0], xo[1], xo[2], xo[3]} + gv[bj][0] * acc[ai][bj][m][0], r1 = (f32x4){xo[4], xo[5], xo[6], xo[7]} + gv[bj][1] * acc[ai][bj][m][1];
                    *(f16x8*)(xp + bj * HALF) = __builtin_convertvector((f32x8){r0[0], r0[1], r0[2], r0[3], r1[0], r1[1], r1[2], r1[3]}, f16x8); } }
    }
};
struct EpiGelu {
    static constexpr int NS = 16, PREF = 0;
    bf16_t* U; bf16_t* V; f32x2* STATS;
    __device__ __forceinline__ void operator()(const Acc& acc, const Unit& u, int wr, int wc, int fr, int fq) const {
        const int row0 = u.pm * BM + wr * 64 + fr, cl = wc * 32 + 8 * fq;
        const bool isv = u.pn >= 8; bf16_t* base = isv ? V + (u.pn - 8) * 256 : U + u.pn * 256;
#pragma unroll
        for (int ai = 0; ai < 2; ++ai)
#pragma unroll
            for (int m = 0; m < 4; ++m) { const size_t row = (size_t)(row0 + ai * HALF + m * 16); float s = 0.f, ss = 0.f;
#pragma unroll
                for (int bj = 0; bj < 2; ++bj) { const f32x4 v0 = gelu4(acc[ai][bj][m][0]), v1 = gelu4(acc[ai][bj][m][1]);
                    *(u32x4*)(base + row * 2048 + bj * HALF + cl) = pack8(v0, v1);
                    s += (v0[0] + v0[1]) + (v0[2] + v0[3]) + (v1[0] + v1[1]) + (v1[2] + v1[3]);
                    ss += (v0[0] * v0[0] + v0[1] * v0[1]) + (v0[2] * v0[2] + v0[3] * v0[3]) + (v1[0] * v1[0] + v1[1] * v1[1]) + (v1[2] * v1[2] + v1[3] * v1[3]); }
                if (isv) { s += __shfl_xor(s, 16); ss += __shfl_xor(ss, 16); s += __shfl_xor(s, 32); ss += __shfl_xor(ss, 32);
                    if (fq == 0) STATS[row * 32 + (u.pn - 8) * 4 + wc] = (f32x2){s, ss}; } }
    }
};
struct EpiSwiglu {
    static constexpr int NS = 8, PREF = 0;
    bf16_t* HID;
    __device__ __forceinline__ void operator()(const Acc& acc, const Unit& u, int wr, int wc, int fr, int fq) const {
        const int row0 = u.pm * BM + wr * 64 + fr, col0 = u.pn * 128 + wc * 32 + 8 * fq;
#pragma unroll
        for (int ai = 0; ai < 2; ++ai)
#pragma unroll
            for (int m = 0; m < 4; ++m) { f32x4 h[2];
#pragma unroll
                for (int n = 0; n < 2; ++n) { const f32x4 g = acc[ai][0][m][n], up = acc[ai][1][m][n];
#pragma unroll
                    for (int j = 0; j < 4; ++j) h[n][j] = g[j] * __builtin_amdgcn_rcpf(1.0f + __expf(-g[j])) * up[j]; }
                *(u32x4*)(HID + (size_t)(row0 + ai * HALF + m * 16) * DFF + col0) = pack8(h[0], h[1]); }
    }
};

template <class Epi>
__device__ __forceinline__ void gemm_phase(LAS unsigned char* lds, const Gemm g, const StaticOrder& S, const Epi& E, const int wvs) {
    int tid = wvs * 64 + hw_lane(); asm volatile("" : "+v"(tid));
    const int wid = wvs, lane = tid & 63, wr = wid >> 2, wc = wid & 3, fr = lane & 15, fq = lane >> 4;
    const int K = g.K, nt = K / BK, lda = g.lda;
    unsigned voffA[2], voffB[2];
#pragma unroll
    for (int i = 0; i < 2; ++i) { int R, C; stage_rc(tid * 16 + i * 8192, R, C); const int Rb = (R & ~31) + perm32(R & 31);
        voffA[i] = (unsigned)(R * lda + C) * 2u; voffB[i] = (unsigned)(Rb * K + C) * 2u; }
    const size_t kstep = (size_t)(BK * 2);
    const size_t hstepA = (size_t)HALF * lda * 2, hstepB = (size_t)HALF * K * 2;
    const unsigned ldsw = (unsigned)wid * 1024u; const unsigned ldsb = (unsigned)(size_t)lds + ldsw;
    const int aoff = lds_byte(wr * 64 + fr, fq * 8), boff = lds_byte(wc * 32 + fr, fq * 8);
#define PG8_SA(b, h) (((b) * 2 + (h)) * HTB)
#define PG8_SB(b, h) ((4 + (b) * 2 + (h)) * HTB)
#define PG8_STAGE(bufoff, gbase, voff) asm volatile("s_mov_b32 m0, %2\n\ts_nop 0\n\tglobal_load_lds_dwordx4 %0, %3\n\ts_mov_b32 m0, %4\n\ts_nop 0\n\tglobal_load_lds_dwordx4 %1, %3" \
        :: "v"((voff)[0]), "v"((voff)[1]), "s"(ldsb + (unsigned)(bufoff)), "s"((const char*)(gbase)), "s"(ldsb + (unsigned)(bufoff) + 8192u) : "memory", "m0")
#define PG8_LDA(dst, b, h) do { _Pragma("unroll") for (int m = 0; m < 4; ++m) _Pragma("unroll") for (int k = 0; k < 2; ++k) dst[m][k] = *(const LAS bf16x8*)(lds + PG8_SA(b, h) + (aoff ^ (k * 64)) + m * 2048); } while (0)
#define PG8_LDB(dst, b, h) do { _Pragma("unroll") for (int n = 0; n < 2; ++n) _Pragma("unroll") for (int k = 0; k < 2; ++k) dst[n][k] = *(const LAS bf16x8*)(lds + PG8_SB(b, h) + (boff ^ (k * 64)) + n * 2048); } while (0)
#define PG8_MMA(ai, bj, At, Bt) do { __builtin_amdgcn_s_setprio(1); _Pragma("unroll") for (int m = 0; m < 4; ++m) _Pragma("unroll") for (int n = 0; n < 2; ++n) _Pragma("unroll") for (int k = 0; k < 2; ++k) \
        acc[ai][bj][m][n] = __builtin_amdgcn_mfma_f32_16x16x32_bf16(Bt[n][k], At[m][k], acc[ai][bj][m][n], 0, 0, 0); __builtin_amdgcn_s_setprio(0); } while (0)
#define PG8_WAIT_V(n) asm volatile("s_waitcnt vmcnt(" #n ")" ::: "memory")
#define PG8_WAIT_V1(f) asm volatile("s_cmp_lg_u32 %0, 0\n\ts_cbranch_scc1 .Lpg8a_%=\n\ts_waitcnt vmcnt(8)\n.Lpg8a_%=:\n\ts_cmp_gt_u32 %0, 1\n\ts_cbranch_scc1 .Lpg8b_%=\n\ts_waitcnt vmcnt(%1)\n.Lpg8b_%=:\n\ts_waitcnt vmcnt(%2)" :: "s"(f), "n"(8 + Epi::PREF), "n"(8 + Epi::NS) : "memory", "scc")
#define PG8_WAIT_L(n) asm volatile("s_waitcnt lgkmcnt(" #n ")" ::: "memory")
#define PG8_BAR __builtin_amdgcn_s_barrier()
#define PG8_SCHED __builtin_amdgcn_sched_barrier(0)
#define PG8_ABASE(u) ((const char*)g.A + ((size_t)(u).pm * BM * lda + (size_t)((u).pn >> g.agrp_shift) * g.agrp_stride) * 2)
#define PG8_BBASE(u) ((const char*)g.Bt + (size_t)(u).pn * 2 * hstepB)
    Unit cur, nxt; int ui = 0;
    if (!S.next(0, cur)) return;
    Acc acc;
#pragma unroll
    for (int a = 0; a < 2; ++a)
#pragma unroll
        for (int b = 0; b < 2; ++b)
#pragma unroll
            for (int m = 0; m < 4; ++m)
#pragma unroll
                for (int n = 0; n < 2; ++n) acc[a][b][m][n] = (f32x4){0.f, 0.f, 0.f, 0.f};
    bf16x8 At[4][2], B0[2][2], B1[2][2];
    const char* cA = PG8_ABASE(cur); const char* cB = PG8_BBASE(cur);
    PG8_STAGE(PG8_SB(0, 0), cB, voffB); PG8_STAGE(PG8_SB(0, 1), cB + hstepB, voffB); PG8_STAGE(PG8_SA(0, 0), cA, voffA); PG8_STAGE(PG8_SA(0, 1), cA + hstepA, voffA);
    if (wr == 1) PG8_BAR;
    PG8_WAIT_V(2); PG8_BAR;
    PG8_STAGE(PG8_SB(1, 0), cB + kstep, voffB); PG8_STAGE(PG8_SA(1, 0), cA + kstep, voffA); PG8_STAGE(PG8_SB(1, 1), cB + hstepB + kstep, voffB);
    PG8_WAIT_V(6); PG8_BAR;
    for (;;) {
        const bool has_next = S.next(ui + 1, nxt);
        const char* nA = has_next ? PG8_ABASE(nxt) : cA; const char* nB = has_next ? PG8_BBASE(nxt) : cB;
        for (int t = 0; t < nt; t += 2) {
            const bool last = (t == nt - 2);
            const char* a1 = cA + (size_t)(t + 1) * kstep;
            const char* a2 = last ? nA : cA + (size_t)(t + 2) * kstep; const char* b2 = last ? nB : cB + (size_t)(t + 2) * kstep;
            const char* a3 = a2 + kstep; const char* b3 = b2 + kstep;
            static_assert(Epi::PREF <= Epi::NS, "wait classes must nest");
            const int lenv = (t == 0) ? (ui > 0 ? 2 : 0) : ((Epi::PREF != 0 && t == nt - 2) ? 1 : 0);
            int len; asm volatile("v_readfirstlane_b32 %0, %1" : "=s"(len) : "v"(lenv));
            if constexpr (Epi::PREF != 0) {
                unsigned ptmp; const unsigned poff = E.pref_off(cur, wr, wc, hw_lane()), pdst = (unsigned)(size_t)(lds + 8 * HTB) + (unsigned)wid * 256u;
                asm volatile("s_cmp_lg_u32 %2, 1\n\ts_cbranch_scc1 .Lpg8p_%=\n\ts_mov_b32 m0, %3\n\ts_nop 0\n\tglobal_load_lds_dword %1, %4\n\tglobal_load_lds_dword %1, %4 offset:256\n\t"
                             "v_add_u32_e32 %0, 0x40000, %1\n\tglobal_load_lds_dword %0, %4\n\tglobal_load_lds_dword %0, %4 offset:256\n.Lpg8p_%=:"
                             : "=&v"(ptmp) : "v"(poff), "s"(len), "s"(pdst), "s"(E.x) : "memory", "scc", "m0"); }
            PG8_LDB(B0, 0, 0); PG8_LDB(B1, 0, 1); PG8_SCHED; PG8_LDA(At, 0, 0); PG8_STAGE(PG8_SA(1, 1), a1 + hstepA, voffA);
            PG8_WAIT_V1(len); PG8_WAIT_L(0); PG8_BAR; PG8_MMA(0, 0, At, B0); PG8_MMA(0, 1, At, B1); PG8_BAR; PG8_SCHED;
            PG8_LDA(At, 0, 1); PG8_STAGE(PG8_SB(0, 0), b2, voffB); PG8_STAGE(PG8_SB(0, 1), b2 + hstepB, voffB); PG8_STAGE(PG8_SA(0, 0), a2, voffA);
            PG8_WAIT_V1(len); PG8_WAIT_L(0); PG8_BAR; PG8_MMA(1, 0, At, B0); PG8_MMA(1, 1, At, B1); PG8_BAR; PG8_SCHED;
            PG8_LDB(B0, 1, 0); PG8_LDB(B1, 1, 1); PG8_SCHED; PG8_LDA(At, 1, 0); PG8_STAGE(PG8_SA(0, 1), a2 + hstepA, voffA);
            PG8_WAIT_V(8); PG8_WAIT_L(0); PG8_BAR; PG8_MMA(0, 0, At, B0); PG8_MMA(0, 1, At, B1); PG8_BAR; PG8_SCHED;
            PG8_LDA(At, 1, 1); PG8_STAGE(PG8_SB(1, 0), b3, voffB); PG8_STAGE(PG8_SB(1, 1), b3 + hstepB, voffB); PG8_STAGE(PG8_SA(1, 0), a3, voffA);
            PG8_WAIT_V(8); PG8_WAIT_L(0); PG8_BAR; PG8_MMA(1, 0, At, B0); PG8_MMA(1, 1, At, B1); PG8_BAR; PG8_SCHED;
        }
        if (wr == 0) PG8_BAR;
        { const int l2 = hw_lane();
          E(acc, cur, wr, wc, l2 & 15, l2 >> 4); }
        if (!has_next) break;
#pragma unroll
        for (int a = 0; a < 2; ++a)
#pragma unroll
            for (int b = 0; b < 2; ++b)
#pragma unroll
                for (int m = 0; m < 4; ++m)
#pragma unroll
                    for (int n = 0; n < 2; ++n) acc[a][b][m][n] = (f32x4){0.f, 0.f, 0.f, 0.f};
        cur = nxt; cA = nA; cB = nB; ++ui;
        if (wr == 1) PG8_BAR;
    }
    PG8_WAIT_V(0);
    PG8_BAR;
#undef PG8_SA
#undef PG8_SB
#undef PG8_STAGE
#undef PG8_LDA
#undef PG8_LDB
#undef PG8_MMA
#undef PG8_WAIT_V
#undef PG8_WAIT_L
#undef PG8_WAIT_V1
#undef PG8_BAR
#undef PG8_SCHED
#undef PG8_ABASE
#undef PG8_BBASE
}
}

struct Args { const float* in[23]; float* out; unsigned char* ws; int ph_lo, ph_hi; };

struct CvtDesc { const float* src; bf16_t* dst; int N, ldd, mode, r0, c0, li; };
__device__ __forceinline__ void cvt_load(const CvtDesc& d, int lane, f32x4 (&t)[8]) {
    const int nblk = (d.N + 31) >> 5, k0 = 64 * (d.li / nblk), n0 = 32 * (d.li % nblk);
    const int cc = lane & 7, rr = lane >> 3; const bool ok = n0 + 4 * cc < d.N;
#pragma unroll
    for (int i = 0; i < 8; ++i) t[i] = ok ? *(const f32x4*)(d.src + (size_t)(k0 + 8 * i + rr) * d.N + n0 + 4 * cc) : (f32x4){0.f, 0.f, 0.f, 0.f};
}
__device__ __forceinline__ void cvt_store(const CvtDesc& d, LAS float* scr, int lane, const f32x4 (&t)[8]) {
    const int nblk = (d.N + 31) >> 5, k0 = 64 * (d.li / nblk), n0 = 32 * (d.li % nblk);
    { const int cc = lane & 7, rr = lane >> 3;
#pragma unroll
      for (int i = 0; i < 8; ++i) { LAS float* q = scr + (8 * i + rr) * 33 + 4 * cc; q[0] = t[i][0]; q[1] = t[i][1]; q[2] = t[i][2]; q[3] = t[i][3]; } }
    LDS_WAIT();
    const int c = lane & 7;
#pragma unroll
    for (int j = 0; j < 4; ++j) { const int nl = (lane >> 3) + 8 * j, n = n0 + nl; const LAS float* sp = scr + (8 * c) * 33 + nl;
        u32x4 o; o.x = cvt_pk_bf16(sp[0 * 33], sp[1 * 33]); o.y = cvt_pk_bf16(sp[2 * 33], sp[3 * 33]); o.z = cvt_pk_bf16(sp[4 * 33], sp[5 * 33]); o.w = cvt_pk_bf16(sp[6 * 33], sp[7 * 33]);
        if (n < d.N) { const int drow = d.mode ? ((n >> 7) * 256 + (n & 127) + d.r0) : (d.r0 + n); *(u32x4*)(d.dst + (size_t)drow * d.ldd + d.c0 + k0 + 8 * c) = o; } }
    LDS_WAIT();
}
__device__ __forceinline__ CvtDesc cvt_decode(const Args& a, unsigned char* ws, int r) {
    if (r < 1888) { const int j = r / 944; return CvtDesc{a.in[6] + (size_t)j * 1024 * AIN, (bf16_t*)(ws + W_AIN) + (size_t)j * 2048 * 1024, AIN, 1024, 0, 0, 0, r % 944}; } r -= 1888;
    if (r < 256) { const int jj = r >> 4, la = jj >> 3, h = jj & 7; return CvtDesc{a.in[10] + (size_t)(la * 8 + h) * 128 * 256, (bf16_t*)(ws + W_UK) + (size_t)la * 2048 * 256, 256, 256, 0, h * 256, (h & 1) * 128, r & 15}; } r -= 256;
    if (r < 256) { const int jj = r >> 4, la = jj >> 3, h = jj & 7; return CvtDesc{a.in[11] + (size_t)(la * 8 + h) * 256 * 128, (bf16_t*)(ws + W_UV) + (size_t)la * 1024 * 512, 128, 512, 0, (h >> 1) * 256 + (h & 1) * 128, (h & 1) * 256, r & 15}; } r -= 256;
    if (r < 1024) { const int la = r >> 9; return CvtDesc{a.in[12] + (size_t)la * 1024 * 1024, (bf16_t*)(ws + W_O) + (size_t)la * 1024 * 1024, 1024, 1024, 0, 0, 0, r & 511}; } r -= 1024;
    if (r < 4096) { const int la = r >> 11; return CvtDesc{a.in[13] + (size_t)la * 1024 * 4096, (bf16_t*)(ws + W_BIN) + (size_t)la * 4096 * 1024, 4096, 1024, 0, 0, 0, r & 2047}; } r -= 4096;
    if (r < 2048) { const int la = r >> 10; return CvtDesc{a.in[18] + (size_t)la * 2048 * 1024, (bf16_t*)(ws + W_BOUT) + (size_t)la * 1024 * 2048, 1024, 2048, 0, 0, 0, r & 1023}; } r -= 2048;
    if (r < 11264) { const int jj = r / 1408, l = jj & 3, isup = jj >> 2; return CvtDesc{a.in[isup ? 20 : 19] + (size_t)l * 1024 * DFF, (bf16_t*)(ws + W_GU) + (size_t)l * 5632 * 1024, DFF, 1024, 1, isup * 128, 0, r % 1408}; } r -= 11264;
    { const int l = r / 1408; return CvtDesc{a.in[21] + (size_t)l * DFF * 1024, (bf16_t*)(ws + W_DN) + (size_t)l * 1024 * DFF, 1024, DFF, 0, 0, 0, r % 1408}; }
}

__device__ __forceinline__ void p0_phase(const Args& a, LAS unsigned char* lds, int bid, int G, const int wvs) {
    int tid = wvs * 64 + hw_lane(); asm volatile("" : "+v"(tid));
    const int lane = tid & 63, wave = __builtin_amdgcn_readfirstlane(tid >> 6);
    unsigned char* ws = a.ws;
    LAS float* scr = (LAS float*)(lds + wave * 8704);
    const int gw = bid * 8 + wave, NGW = G * 8;
    constexpr int NITEMS = 1888 + 256 + 256 + 1024 + 4096 + 2048 + 11264 + 5632;
    {
        f32x4 tc[8], tn[8]; CvtDesc dc{}, dn{};
        if (gw < NITEMS) { dc = cvt_decode(a, ws, gw); cvt_load(dc, lane, tc); }
        for (int it = gw; it < NITEMS; it += NGW) {
            const bool hn = it + NGW < NITEMS;
            if (hn) { dn = cvt_decode(a, ws, it + NGW); cvt_load(dn, lane, tn); }
            cvt_store(dc, scr, lane, tc);
            if (hn) { dc = dn;
#pragma unroll
                for (int i = 0; i < 8; ++i) tc[i] = tn[i]; }
        }
    }
    const size_t gt = (size_t)bid * 512 + tid, NT = (size_t)G * 512;
    const u32x4 z = (u32x4){0u, 0u, 0u, 0u};
    for (size_t i = gt; i < 2 * 184 * 128; i += NT) { const int j = (int)(i / (184 * 128)), rem = (int)(i % (184 * 128)), rr = AIN + rem / 128, ch = rem % 128;
        *(u32x4*)((bf16_t*)(ws + W_AIN) + ((size_t)j * 2048 + rr) * 1024 + ch * 8) = z; }
    for (size_t i = gt; i < 2 * 2048 * 16; i += NT) { const int j = (int)(i / (2048 * 16)), rem = (int)(i % (2048 * 16)), rr = rem >> 4, ch = rem & 15, h = rr >> 8;
        *(u32x4*)((bf16_t*)(ws + W_UK) + ((size_t)j * 2048 + rr) * 256 + (1 - (h & 1)) * 128 + ch * 8) = z; }
    for (size_t i = gt; i < 2 * 1024 * 32; i += NT) { const int j = (int)(i / (1024 * 32)), rem = (int)(i % (1024 * 32)), rr = rem >> 5, ch = rem & 31, hh = (rr >> 7) & 1;
        *(u32x4*)((bf16_t*)(ws + W_UV) + ((size_t)j * 1024 + rr) * 512 + (1 - hh) * 256 + ch * 8) = z; }
    __syncthreads();
    LAS float* ca = (LAS float*)lds;
    const float* cvec = a.in[1]; const float* modw = a.in[2]; float* MODP = (float*)(ws + WS_MODP);
    for (int it = bid; it < 768; it += G) {
        const int l = it / 192, rem = it % 192, ng = rem >> 4, kc = rem & 15;
        { const int b = tid >> 6, k = tid & 63; const float cv = cvec[b * 1024 + kc * 64 + k]; ca[b * 64 + k] = cv / (1.0f + __expf(-cv)); }
        __syncthreads();
        const int n = ng * 512 + tid; float acc[8];
#pragma unroll
        for (int b = 0; b < 8; ++b) acc[b] = 0.f;
        const float* wp = modw + ((size_t)l * 1024 + kc * 64) * NMOD + n;
#pragma unroll 8
        for (int k = 0; k < 64; ++k) { const float w = wp[(size_t)k * NMOD];
#pragma unroll
            for (int b = 0; b < 8; ++b) acc[b] += ca[b * 64 + k] * w; }
#pragma unroll
        for (int b = 0; b < 8; ++b) MODP[((size_t)(kc * 4 + l) * 8 + b) * NMOD + n] = acc[b];
        __syncthreads();
    }
}
__device__ __forceinline__ void p0c_phase(const Args& a, int bid, int G, const int wvs) {
    const float* MODP = (const float*)(a.ws + WS_MODP); float* MOD = (float*)(a.ws + WS_MOD); const float* modb = a.in[3];
    int tid0 = wvs * 64 + hw_lane(); asm volatile("" : "+v"(tid0));
    for (int i = bid * 512 + tid0; i < 4 * 8 * NMOD; i += G * 512) { const int l = i / (8 * NMOD), n = i % NMOD; float s = modb[l * NMOD + n];
#pragma unroll
        for (int kc = 0; kc < 16; ++kc) s += MODP[(size_t)kc * (4 * 8 * NMOD) + i];
        MOD[i] = s; }
}

template <bool FIRST>
__device__ __forceinline__ void norm_mod_phase(const float* x32, _Float16* x16, const float* gain, const float* sh, const float* sc, bf16_t* H, int bid, int G, const int wvs) {
    int tid = wvs * 64 + hw_lane(); asm volatile("" : "+v"(tid));
    const int lane = tid & 63, wave = tid >> 6;
    for (int q = (bid >> 3) * 8 + wave; q < T / 16; q += (G >> 3) * 8) {
        const int b = bid & 7, rb = b * T + q * 16; f32x4 gs[4], sv[4];
#pragma unroll
        for (int j = 0; j < 4; ++j) { const int c = 8 * lane + 512 * (j >> 1) + 4 * (j & 1); const f32x4 g4 = *(const f32x4*)(gain + c), s4 = *(const f32x4*)(sc + (size_t)b * NMOD + c); gs[j] = g4 * (s4 + 1.0f); sv[j] = *(const f32x4*)(sh + (size_t)b * NMOD + c); }
        f32x4 nx[4]; f16x8 nh[2];
        if (FIRST) {
#pragma unroll
            for (int j = 0; j < 4; ++j) nx[j] = *(const f32x4*)(x32 + (size_t)rb * D + 8 * lane + 512 * (j >> 1) + 4 * (j & 1)); }
        else {
#pragma unroll
            for (int j = 0; j < 2; ++j) nh[j] = *(const f16x8*)(x16 + (size_t)rb * D + 8 * lane + 512 * j); }
        for (int r = rb; r < rb + 16; ++r) {
            f32x4 v[4];
            if (FIRST) {
#pragma unroll
                for (int j = 0; j < 4; ++j) v[j] = nx[j];
#pragma unroll
                for (int j = 0; j < 2; ++j) *(f16x8*)(x16 + (size_t)r * D + 8 * lane + 512 * j) = __builtin_convertvector((f32x8){v[2 * j][0], v[2 * j][1], v[2 * j][2], v[2 * j][3], v[2 * j + 1][0], v[2 * j + 1][1], v[2 * j + 1][2], v[2 * j + 1][3]}, f16x8);
            } else {
#pragma unroll
                for (int j = 0; j < 2; ++j) { const f32x8 t = __builtin_convertvector(nh[j], f32x8); v[2 * j] = (f32x4){t[0], t[1], t[2], t[3]}; v[2 * j + 1] = (f32x4){t[4], t[5], t[6], t[7]}; }
            }
            const int rn = (r + 1 < rb + 16) ? r + 1 : r;
            if (FIRST) {
#pragma unroll
                for (int j = 0; j < 4; ++j) nx[j] = *(const f32x4*)(x32 + (size_t)rn * D + 8 * lane + 512 * (j >> 1) + 4 * (j & 1)); }
            else {
#pragma unroll
                for (int j = 0; j < 2; ++j) nh[j] = *(const f16x8*)(x16 + (size_t)rn * D + 8 * lane + 512 * j); }
            float ss = 0.f;
#pragma unroll
            for (int j = 0; j < 4; ++j) ss += (v[j][0] * v[j][0] + v[j][1] * v[j][1]) + (v[j][2] * v[j][2] + v[j][3] * v[j][3]);
            const float rstd = rsqrtf(wave_sum(ss) * (1.0f / D) + EPS);
#pragma unroll
            for (int j = 0; j < 2; ++j) { const f32x4 y0 = v[2 * j] * rstd * gs[2 * j] + sv[2 * j], y1 = v[2 * j + 1] * rstd * gs[2 * j + 1] + sv[2 * j + 1];
                u32x4 w; w.x = cvt_pk_bf16(y0[0], y0[1]); w.y = cvt_pk_bf16(y0[2], y0[3]); w.z = cvt_pk_bf16(y1[0], y1[1]); w.w = cvt_pk_bf16(y1[2], y1[3]);
                *(u32x4*)(H + (size_t)r * D + 8 * lane + 512 * j) = w; }
        }
    }
}
__device__ __forceinline__ void final_norm_phase(const _Float16* x16, const float* gain, float* out, int bid, int G, const int wvs) {
    int tid = wvs * 64 + hw_lane(); asm volatile("" : "+v"(tid));
    const int lane = tid & 63, wave = tid >> 6;
    f32x4 gs[4];
#pragma unroll
    for (int j = 0; j < 4; ++j) gs[j] = *(const f32x4*)(gain + 8 * lane + 512 * (j >> 1) + 4 * (j & 1));
    f16x8 nh[2];
    { const int r0 = (bid & 7) * T + (bid >> 3) * 8 + wave;
#pragma unroll
      for (int j = 0; j < 2; ++j) nh[j] = *(const f16x8*)(x16 + (size_t)r0 * D + 8 * lane + 512 * j); }
    for (int q = (bid >> 3) * 8 + wave; q < T; q += (G >> 3) * 8) { const int r = (bid & 7) * T + q;
        f32x4 v[4]; float ss = 0.f;
#pragma unroll
        for (int j = 0; j < 2; ++j) { const f32x8 t = __builtin_convertvector(nh[j], f32x8); v[2 * j] = (f32x4){t[0], t[1], t[2], t[3]}; v[2 * j + 1] = (f32x4){t[4], t[5], t[6], t[7]}; }
        const int rn = (q + (G >> 3) * 8 < T) ? r + (G >> 3) * 8 : r;
#pragma unroll
        for (int j = 0; j < 2; ++j) nh[j] = *(const f16x8*)(x16 + (size_t)rn * D + 8 * lane + 512 * j);
#pragma unroll
        for (int j = 0; j < 4; ++j) ss += (v[j][0] * v[j][0] + v[j][1] * v[j][1]) + (v[j][2] * v[j][2] + v[j][3] * v[j][3]);
        const float rstd = rsqrtf(wave_sum(ss) * (1.0f / D) + EPS);
#pragma unroll
        for (int j = 0; j < 4; ++j) *(f32x4*)(out + (size_t)r * D + 8 * lane + 512 * (j >> 1) + 4 * (j & 1)) = v[j] * rstd * gs[j];
    }
}
__device__ __forceinline__ void dsa_rows_phase(const float* CKVR, const float* KRAW, const float* gkv, const float* gk, const float* bk, bf16_t* CKV, bf16_t* KIDX, float* WIDX, int bid, int G, const int wvs) {
    int tid = wvs * 64 + hw_lane(); asm volatile("" : "+v"(tid));
    const int lane = tid & 63, wave = tid >> 6;
    const f32x4 g4 = *(const f32x4*)(gkv + 4 * lane);
    f32x4 gk4 = (f32x4){0.f, 0.f, 0.f, 0.f}, bk4 = gk4;
    if (lane < 16) { gk4 = *(const f32x4*)(gk + 4 * lane); bk4 = *(const f32x4*)(bk + 4 * lane); }
    for (int q = (bid >> 3) * 8 + wave; q < T; q += (G >> 3) * 8) { const int r = (bid & 7) * T + q;
        const f32x4 v = *(const f32x4*)(CKVR + (size_t)r * 256 + 4 * lane);
        f32x4 kv = (f32x4){0.f, 0.f, 0.f, 0.f}; if (lane < 32) kv = *(const f32x4*)(KRAW + (size_t)r * 128 + 4 * lane);
        const float ss = wave_sum((v[0] * v[0] + v[1] * v[1]) + (v[2] * v[2] + v[3] * v[3]));
        const float rstd = rsqrtf(ss * (1.0f / 256.0f) + EPS);
        { const f32x4 y = v * rstd * g4; int w = 0; w = __builtin_amdgcn_cvt_pk_fp8_f32(y[0], y[1], w, false); w = __builtin_amdgcn_cvt_pk_fp8_f32(y[2], y[3], w, true); *(int*)((unsigned char*)CKV + (size_t)r * 256 + 4 * lane) = w; }
        const float ks = (lane < 16) ? (kv[0] + kv[1]) + (kv[2] + kv[3]) : 0.f;
        const float mean = wave_sum(ks) * (1.0f / 64.0f);
        const f32x4 dv = kv - mean;
        const float kq = (lane < 16) ? (dv[0] * dv[0] + dv[1] * dv[1]) + (dv[2] * dv[2] + dv[3] * dv[3]) : 0.f;
        const float krstd = rsqrtf(wave_sum(kq) * (1.0f / 64.0f) + EPS);
        if (lane < 16) { const f32x4 y = dv * krstd * gk4 + bk4; u32x2 w; w.x = cvt_pk_bf16(y[0], y[1]); w.y = cvt_pk_bf16(y[2], y[3]); *(u32x2*)(KIDX + ((((size_t)(r >> 5) * 4 + (lane >> 2)) * 64 + (((lane >> 1) & 1) * 32 + (r & 31))) * 8 + (lane & 1) * 4)) = w; }
        else if (lane < 18) { *(f32x4*)(WIDX + (size_t)r * 8 + 4 * (lane - 16)) = kv * 0.04419417382f; }
    }
}

__device__ __forceinline__ float relu_i(float x) { const int b = __float_as_int(x); return __int_as_float(b > 0 ? b : 0); }
__device__ __forceinline__ float relu_mul(float x, float w) { return relu_i(x) * w; }
__device__ __forceinline__ float relu_fma(float x, float w, float acc) { return __builtin_fmaf(relu_i(x), w, acc); }
__device__ __forceinline__ float fmin_raw(float a, float b) { return __builtin_amdgcn_fmed3f(a, b, -__builtin_inff()); }
__device__ __forceinline__ float fmax_raw(float a, float b) { return __builtin_amdgcn_fmed3f(a, b, __builtin_inff()); }
__device__ __forceinline__ unsigned mbcnt64(unsigned long long m) { return __builtin_amdgcn_mbcnt_hi((unsigned)(m >> 32), __builtin_amdgcn_mbcnt_lo((unsigned)m, 0u)); }

template <int SHIFT, int WIDTH>
__device__ __forceinline__ void sel_level(const unsigned (&k)[64], int N, LAS unsigned* hist, int lane, unsigned& prefix, unsigned& need) {
    LAS u32x4* hz = (LAS u32x4*)(hist + 32 * lane);
#pragma unroll
    for (int j = 0; j < 8; ++j) hz[j] = (u32x4){0u, 0u, 0u, 0u};
    LDS_WAIT();
#pragma unroll
    for (int gi = 0; gi < 8; ++gi) if (512 * gi < N) {
#pragma unroll
        for (int ii = 0; ii < 8; ++ii) { const unsigned key = k[8 * gi + ii]; const bool ok = (key >> (SHIFT + WIDTH)) == prefix;
            LAS unsigned* p = ok ? hist + ((key >> SHIFT) & ((1u << WIDTH) - 1u)) : hist + 2048 + lane;
            __hip_atomic_fetch_add(p, 1u, __ATOMIC_RELAXED, __HIP_MEMORY_SCOPE_WORKGROUP); } }
    LDS_WAIT();
    u32x4 hv[8]; unsigned ls = 0u;
#pragma unroll
    for (int j = 0; j < 8; ++j) { hv[j] = hz[j]; ls += (hv[j][0] + hv[j][1]) + (hv[j][2] + hv[j][3]); }
    unsigned incl = ls;
#pragma unroll
    for (int o = 1; o < 64; o <<= 1) { const unsigned v = bperm_u((lane + o) & 63, incl); if (lane + o < 64) incl += v; }
    const unsigned above = incl - ls;
    unsigned cnt = above, d = 0u, nn = 0u;
#pragma unroll
    for (int j = 31; j >= 0; --j) { const unsigned h = hv[j >> 2][j & 3]; const bool hit = (cnt < need) && (need <= cnt + h); d = hit ? (unsigned)(32 * lane + j) : d; nn = hit ? need - cnt : nn; cnt += h; }
    const bool found = (above < need) && (need <= above + ls);
    const unsigned long long fm = __ballot(found);
    const int src = (fm != 0ull) ? (__ffsll((long long)fm) - 1) : 0;
    d = bperm_u(src, d); need = bperm_u(src, nn);
    prefix = (prefix << WIDTH) | d;
}

__device__ __forceinline__ void dsa_select_phase(LAS unsigned char* lds, const bf16_t* QIDX, const bf16_t* KIDX, const float* WIDX, unsigned short* IDX, int bid, int G, const int wvs) {
    int tid0 = wvs * 64 + hw_lane(); asm volatile("" : "+v"(tid0));
    const int wave = __builtin_amdgcn_readfirstlane(tid0 >> 6);
    LAS float* SC = (LAS float*)lds;
    LAS unsigned short* IDXL = (LAS unsigned short*)(lds + 135168) + wave * 256;
    LAS float* MM = (LAS float*)(lds + 139264);
    bf16x8 af[2][4]; bf16x8 kb[4][4];
#define DSA_UNIT(itx, b_, t0_, mb_, ntile_, nj_) const int b_ = (itx) & 7, t0_ = ((itx) >> 3) * 8; const size_t mb_ = (size_t)b_ * T; \
    const int ntile_ = (t0_ + 8 + 31) >> 5; const int nj_ = (wave < ntile_) ? ((ntile_ - wave + 7) >> 3) : 0;
#define DSA_KLOAD(buf, j, kbase_, nj_) do { const int jc_ = ((j) < (nj_)) ? (j) : ((nj_) > 0 ? (nj_) - 1 : 0); const bf16_t* kp_ = (kbase_) + (size_t)(wave + 8 * jc_) * 2048; \
    _Pragma("unroll") for (int ks = 0; ks < 4; ++ks) kb[buf][ks] = *(const bf16x8*)(kp_ + 512 * ks); } while (0)
#define DSA_PRELOAD(t0_, mb_, nj_) do { \
    _Pragma("unroll") for (int rg = 0; rg < 2; ++rg) { const bf16_t* qp = QIDX + ((mb_) + (t0_) + 4 * rg + (col >> 3)) * 512 + (col & 7) * 64 + 8 * hf; \
        _Pragma("unroll") for (int ks = 0; ks < 4; ++ks) af[rg][ks] = *(const bf16x8*)(qp + 16 * ks); } \
    (void)(nj_); } while (0)
    { int tid = tid0; asm volatile("" : "+v"(tid)); const int lane = tid & 63, hf = lane >> 5, col = lane & 31;
      if (bid < 4096) { DSA_UNIT(bid, b, t0, mb, ntile, nj) (void)b; (void)ntile; if (t0 + 8 > 256) DSA_PRELOAD(t0, mb, nj); } }
    for (int it = bid; it < 4096; it += G) {
        int tid = tid0; asm volatile("" : "+v"(tid));
        const int lane = tid & 63, hf = lane >> 5, col = lane & 31;
        DSA_UNIT(it, b, t0, mb, ntile, nj) (void)b; (void)ntile;
        const int t = t0 + wave, N = t + 1;
        unsigned short* outp = IDX + (mb + t) * 256;
        const int itn = it + G; const bool hasn = itn < 4096;
        DSA_UNIT(hasn ? itn : it, bn, t0n, mbn, ntilen, njn) (void)bn; (void)ntilen;
        if (t0 + 8 <= 256) {
            *(u32x2*)(outp + 4 * lane) = (u32x2){(unsigned)(4 * lane) | ((unsigned)(4 * lane + 1) << 16), (unsigned)(4 * lane + 2) | ((unsigned)(4 * lane + 3) << 16)};
            if (hasn && t0n + 8 > 256) DSA_PRELOAD(t0n, mbn, njn);
            continue;
        }
        float w[2][4][4]; float mn[2][2], mx[2][2];
#pragma unroll
        for (int rg = 0; rg < 2; ++rg)
#pragma unroll
            for (int e = 0; e < 2; ++e) { mn[rg][e] = 3.0e38f; mx[rg][e] = -3.0e38f; }
        const bf16_t* kbase = KIDX + mb * 64 + (size_t)lane * 8;
        DSA_KLOAD(0, 0, kbase, nj); DSA_KLOAD(1, 1, kbase, nj); DSA_KLOAD(2, 2, kbase, nj); DSA_KLOAD(3, 3, kbase, nj);
#pragma unroll
        for (int rg = 0; rg < 2; ++rg)
#pragma unroll
            for (int qq = 0; qq < 4; ++qq) { const f32x4 wv = *(const f32x4*)(WIDX + (mb + t0 + 4 * rg + qq) * 8 + 4 * hf);
                w[rg][qq][0] = wv[0]; w[rg][qq][1] = wv[1]; w[rg][qq][2] = wv[2]; w[rg][qq][3] = wv[3]; }
#define DSA_KCOMP(buf, j) do { const int s_ = 32 * (wave + 8 * (j)) + col; f32x16 acc0, acc1; \
    _Pragma("unroll") for (int i = 0; i < 16; ++i) { acc0[i] = 0.f; acc1[i] = 0.f; } \
    _Pragma("unroll") for (int ks = 0; ks < 4; ++ks) { acc0 = __builtin_amdgcn_mfma_f32_32x32x16_bf16(af[0][ks], kb[buf][ks], acc0, 0, 0, 0); acc1 = __builtin_amdgcn_mfma_f32_32x32x16_bf16(af[1][ks], kb[buf][ks], acc1, 0, 0, 0); } \
    _Pragma("unroll") for (int rg = 0; rg < 2; ++rg) { float p[4]; \
        _Pragma("unroll") for (int qq = 0; qq < 4; ++qq) { p[qq] = relu_mul(rg ? acc1[4 * qq] : acc0[4 * qq], w[rg][qq][0]); _Pragma("unroll") for (int ii = 1; ii < 4; ++ii) p[qq] = relu_fma(rg ? acc1[4 * qq + ii] : acc0[4 * qq + ii], w[rg][qq][ii], p[qq]); } \
        _Pragma("unroll") for (int e = 0; e < 2; ++e) { const auto r = __builtin_amdgcn_permlane32_swap(__float_as_uint(p[e]), __float_as_uint(p[2 + e]), false, false); \
            const float tot = __uint_as_float(r[0]) + __uint_as_float(r[1]); SC[(4 * rg + 2 * hf + e) * 4096 + s_] = tot; mn[rg][e] = fmin_raw(mn[rg][e], tot); mx[rg][e] = fmax_raw(mx[rg][e], tot); } } } while (0)
        for (int j = 0; j < nj; j += 4) {
            DSA_KCOMP(0, j); if (j + 4 < nj) DSA_KLOAD(0, j + 4, kbase, nj);
            if (j + 1 < nj) DSA_KCOMP(1, j + 1);
            if (j + 5 < nj) DSA_KLOAD(1, j + 5, kbase, nj);
            if (j + 2 < nj) DSA_KCOMP(2, j + 2);
            if (j + 6 < nj) DSA_KLOAD(2, j + 6, kbase, nj);
            if (j + 3 < nj) DSA_KCOMP(3, j + 3);
            if (j + 7 < nj) DSA_KLOAD(3, j + 7, kbase, nj);
        }
#pragma unroll
        for (int rg = 0; rg < 2; ++rg)
#pragma unroll
            for (int e = 0; e < 2; ++e) {
#pragma unroll
                for (int o = 1; o < 32; o <<= 1) { mn[rg][e] = fminf(mn[rg][e], bperm_f(lane ^ o, mn[rg][e])); mx[rg][e] = fmaxf(mx[rg][e], bperm_f(lane ^ o, mx[rg][e])); }
                if (col == 0) { MM[(wave * 8 + 4 * rg + 2 * hf + e) * 2] = mn[rg][e]; MM[(wave * 8 + 4 * rg + 2 * hf + e) * 2 + 1] = mx[rg][e]; } }
        if (hasn && t0n + 8 > 256) DSA_PRELOAD(t0n, mbn, njn);
        __syncthreads();
        {
            const LAS float* scl = SC + wave * 4096 + lane;
            LAS unsigned* hist = (LAS unsigned*)(lds + wave * 16384);
            float lo = 3.0e38f, hi = -3.0e38f;
#pragma unroll
            for (int wv = 0; wv < 8; ++wv) { lo = fminf(lo, MM[(wv * 8 + wave) * 2]); hi = fmaxf(hi, MM[(wv * 8 + wave) * 2 + 1]); }
            const float scale = 4.0e9f / fmaxf(hi - lo, 1e-30f);
            unsigned k[64];
#pragma unroll
            for (int gi = 0; gi < 8; ++gi) { if (512 * gi < N) {
#pragma unroll
                for (int ii = 0; ii < 8; ++ii) k[8 * gi + ii] = __float_as_uint(scl[64 * (8 * gi + ii)]); } else {
#pragma unroll
                for (int ii = 0; ii < 8; ++ii) k[8 * gi + ii] = 0u; } }
            LDS_WAIT();
            { LAS u32x4* hz = (LAS u32x4*)(hist + 16 * lane);
#pragma unroll
              for (int j = 0; j < 4; ++j) hz[j] = (u32x4){0u, 0u, 0u, 0u}; }
            LDS_WAIT();
#pragma unroll
            for (int gi = 0; gi < 8; ++gi) if (512 * gi < N) {
#pragma unroll
                for (int ii = 0; ii < 8; ++ii) { const int i = 8 * gi + ii; const bool valid = lane < N - 64 * i;
                    const unsigned key = valid ? 1u + (unsigned)((__uint_as_float(k[i]) - lo) * scale) : 0u; k[i] = key;
                    LAS unsigned* p = valid ? hist + (key >> 22) : hist + 1024 + lane;
                    __hip_atomic_fetch_add(p, 1u, __ATOMIC_RELAXED, __HIP_MEMORY_SCOPE_WORKGROUP); } }
            LDS_WAIT();
            unsigned d0, need1;
            { const LAS u32x4* hz = (const LAS u32x4*)(hist + 16 * lane); u32x4 hv[4]; unsigned ls = 0u;
#pragma unroll
              for (int j = 0; j < 4; ++j) { hv[j] = hz[j]; ls += (hv[j][0] + hv[j][1]) + (hv[j][2] + hv[j][3]); }
              unsigned incl = ls;
#pragma unroll
              for (int o = 1; o < 64; o <<= 1) { const unsigned v = bperm_u((lane + o) & 63, incl); if (lane + o < 64) incl += v; }
              const unsigned above = incl - ls; unsigned cnt = above, d = 0u, nn = 0u;
#pragma unroll
              for (int j = 15; j >= 0; --j) { const unsigned h = hv[j >> 2][j & 3]; const bool hit = (cnt < 256u) && (256u <= cnt + h); d = hit ? (unsigned)(16 * lane + j) : d; nn = hit ? 256u - cnt : nn; cnt += h; }
              const bool found = (above < 256u) && (256u <= above + ls);
              const unsigned long long fm = __ballot(found);
              const int src = (fm != 0ull) ? (__ffsll((long long)fm) - 1) : 0;
              d0 = bperm_u(src, d); need1 = bperm_u(src, nn); }
            LAS unsigned* CK = hist + 1100; LAS unsigned short* CS = (LAS unsigned short*)(hist + 1170);
            unsigned base = 0u, cbase = 0u;
#pragma unroll
            for (int gi = 0; gi < 8; ++gi) if (512 * gi < N) {
#pragma unroll
                for (int ii = 0; ii < 8; ++ii) { const int i = 8 * gi + ii; const unsigned key = k[i], dg = key >> 22;
                    const bool gt = dg > d0, eq = (dg == d0) && (key != 0u);
                    const unsigned long long mgt = __ballot(gt), meq = __ballot(eq);
                    if (gt) IDXL[base + mbcnt64(mgt)] = (unsigned short)(64 * i + lane);
                    base += (unsigned)__popcll(mgt);
                    if (meq != 0ull) { const unsigned cp = cbase + mbcnt64(meq); if (eq && cp < 64u) { CK[cp] = key; CS[cp] = (unsigned short)(64 * i + lane); } cbase += (unsigned)__popcll(meq); } } }
            LDS_WAIT();
            if (cbase <= 64u) {
                const unsigned mykey = (lane < (int)cbase) ? CK[lane] : 0u; unsigned rank = 0u;
                for (unsigned j = 0; j < cbase; ++j) { const unsigned kj = CK[j]; rank += ((kj > mykey) || (kj == mykey && j < (unsigned)lane)) ? 1u : 0u; }
                const bool sel = (lane < (int)cbase) && (rank < need1);
                const unsigned long long ms = __ballot(sel);
                if (sel) IDXL[base + mbcnt64(ms)] = CS[lane];
            } else {
                unsigned prefix = d0, need = need1;
                LDS_WAIT();
                sel_level<11, 11>(k, N, hist, lane, prefix, need);
                sel_level<0, 11>(k, N, hist, lane, prefix, need);
                unsigned eb = 0u, eqb = 0u;
#pragma unroll
                for (int gi = 0; gi < 8; ++gi) if (512 * gi < N) {
#pragma unroll
                    for (int ii = 0; ii < 8; ++ii) { const int i = 8 * gi + ii; const unsigned key = k[i]; const bool gt = key > prefix, eq = key == prefix;
                        const unsigned long long meq = __ballot(eq); const bool sel = gt || (eq && (eqb + mbcnt64(meq) < need));
                        const unsigned long long msel = __ballot(sel); const unsigned pos = eb + mbcnt64(msel);
                        if (sel && pos < 256u) IDXL[pos] = (unsigned short)(64 * i + lane);
                        eb += (unsigned)__popcll(msel); eqb += (unsigned)__popcll(meq); } }
            }
            LDS_WAIT();
            *(u32x2*)(outp + 4 * lane) = *(const LAS u32x2*)(IDXL + 4 * lane);
        }
        __syncthreads();
    }
#undef DSA_UNIT
#undef DSA_KLOAD
#undef DSA_PRELOAD
#undef DSA_KCOMP
}

__device__ __forceinline__ void dsa_attn_phase(LAS unsigned char* lds, const unsigned char* QLAT8, const unsigned char* CKV8, const unsigned short* IDX, bf16_t* OLAT, int bid, int G, const int wvs) {
    int tid0 = wvs * 64 + hw_lane(); asm volatile("" : "+v"(tid0));
    const int wave = __builtin_amdgcn_readfirstlane(tid0 >> 6);
    constexpr int RS = 272, T1OFF = 16 * RS + 128, TS = 32 * RS + 128;
    LAS unsigned char* tile0 = lds + wave * (2 * TS);
    constexpr float SCL = 1.4426950408889634f / 16.0f;
    unsigned ixw[8]; u32x4 qf[4]; u32x4 ra[2][2][4];
#define ATT_Q(itx, b_, t_, m_, cnt_) const int b_ = (itx) & 7, t_ = ((itx) >> 3) * 8 + wave; const size_t m_ = (size_t)b_ * T + t_; const int cnt_ = (t_ + 1 < 256) ? t_ + 1 : 256;
#define ATT_LOAD_IX(dst, m_) do { const u32x4 xa_ = *(const u32x4*)(IDX + (m_) * 256 + 16 * c16), xb_ = *(const u32x4*)(IDX + (m_) * 256 + 16 * c16 + 8); \
    dst[0] = xa_[0]; dst[1] = xa_[1]; dst[2] = xa_[2]; dst[3] = xa_[3]; dst[4] = xb_[0]; dst[5] = xb_[1]; dst[6] = xb_[2]; dst[7] = xb_[3]; } while (0)
#define ATT_LOAD_QF(dst, m_) do { const unsigned char* qp_ = QLAT8 + (m_) * 2048 + hd * 256 + 16 * g; _Pragma("unroll") for (int kk = 0; kk < 4; ++kk) dst[kk] = *(const u32x4*)(qp_ + 64 * kk); } while (0)
#define ATT_LOAD_ROWS(buf, ix_, n0_, b_, cnt_) do { const int n1_ = (n0_) + 1; \
    const int k0_ = (16 * c16 + (n0_) < (cnt_)) ? (int)(ix_[(n0_) >> 1] & 0xffffu) : 0, k1_ = (16 * c16 + n1_ < (cnt_)) ? (int)(ix_[n1_ >> 1] >> 16) : 0; \
    const unsigned char* cb_ = CKV8 + (size_t)(b_) * T * 256 + 16 * g; \
    _Pragma("unroll") for (int kk = 0; kk < 4; ++kk) { ra[buf][0][kk] = *(const u32x4*)(cb_ + (size_t)k0_ * 256 + 64 * kk); ra[buf][1][kk] = *(const u32x4*)(cb_ + (size_t)k1_ * 256 + 64 * kk); } } while (0)
#define ATT_QK(bf, d0, d1) do { d0 = (f32x4){0.f, 0.f, 0.f, 0.f}; d1 = d0; \
    _Pragma("unroll") for (int kk = 0; kk < 4; ++kk) _Pragma("unroll") for (int hh = 0; hh < 2; ++hh) { \
        const long qv_ = (long)(((unsigned long long)qf[kk][2 * hh + 1] << 32) | qf[kk][2 * hh]); \
        const long a0_ = (long)(((unsigned long long)ra[bf][0][kk][2 * hh + 1] << 32) | ra[bf][0][kk][2 * hh]); \
        const long a1_ = (long)(((unsigned long long)ra[bf][1][kk][2 * hh + 1] << 32) | ra[bf][1][kk][2 * hh]); \
        d0 = __builtin_amdgcn_mfma_f32_16x16x32_fp8_fp8(a0_, qv_, d0, 0, 0, 0); d1 = __builtin_amdgcn_mfma_f32_16x16x32_fp8_fp8(a1_, qv_, d1, 0, 0, 0); } \
    _Pragma("unroll") for (int kk = 0; kk < 4; ++kk) { *(LAS u32x4*)(tile0 + (bf) * TS + c16 * RS + 64 * kk + 16 * g) = ra[bf][0][kk]; *(LAS u32x4*)(tile0 + (bf) * TS + T1OFF + c16 * RS + 64 * kk + 16 * g) = ra[bf][1][kk]; } } while (0)
    { int tid = tid0; asm volatile("" : "+v"(tid)); const int lane = tid & 63, g = lane >> 4, c16 = lane & 15, hd = c16 & 7;
      if (bid < 4096) { ATT_Q(bid, b, t, m, cnt) (void)t; ATT_LOAD_IX(ixw, m); ATT_LOAD_QF(qf, m); ATT_LOAD_ROWS(0, ixw, 0, b, cnt); ATT_LOAD_ROWS(1, ixw, 2, b, cnt); } }
    for (int it = bid; it < 4096; it += G) {
        int tid = tid0; asm volatile("" : "+v"(tid));
        const int lane = tid & 63, g = lane >> 4, c16 = lane & 15, hd = c16 & 7, q4 = c16 >> 2, p4 = c16 & 3;
        ATT_Q(it, b, t, m, cnt) (void)t;
        const int itn = it + G; const bool hasn = itn < 4096;
        ATT_Q(hasn ? itn : it, bn, tn, mn, cntn) (void)tn;
        f32x4 o[16];
#pragma unroll
        for (int db = 0; db < 16; ++db) o[db] = (f32x4){0.f, 0.f, 0.f, 0.f};
        const int trow = ((c16 >> 1) < 4 ? (4 * g + (c16 >> 1)) * RS : T1OFF + (4 * g + (c16 >> 1) - 4) * RS) + 8 * (c16 & 1);
        float mrun = -INFINITY, lrun = 0.f;
        f32x4 s0, s1, sn0, sn1;
        ATT_QK(0, s0, s1); ATT_LOAD_ROWS(0, ixw, 4, b, cnt);
#pragma unroll
        for (int ch = 0; ch < 8; ++ch) {
            const int bf = ch & 1, bn1 = (ch + 1) & 1;
            if (ch < 7) { ATT_QK(bn1, sn0, sn1);
                if (ch < 5) ATT_LOAD_ROWS(bn1, ixw, 2 * (ch + 3), b, cnt);
                else if (hasn) ATT_LOAD_ROWS(bn1, ixw, 2 * (ch - 5), bn, cntn); }
            if (ch == 4 && hasn) ATT_LOAD_IX(ixw, mn);
            if (ch == 6 && hasn) ATT_LOAD_QF(qf, mn);
            float cm = -INFINITY;
#pragma unroll
            for (int i = 0; i < 4; ++i) { const int jr = 16 * (4 * g + i) + 2 * ch; if (jr >= cnt) s0[i] = -INFINITY; if (jr + 1 >= cnt) s1[i] = -INFINITY; cm = fmaxf(cm, fmaxf(s0[i], s1[i])); }
            cm = fmaxf(cm, bperm_f(lane ^ 16, cm)); cm = fmaxf(cm, bperm_f(lane ^ 32, cm));
            const float mnew = fmaxf(mrun, cm), alpha = __builtin_amdgcn_exp2f((mrun - mnew) * SCL);
            float p0[4], p1[4], ps = 0.f;
#pragma unroll
            for (int i = 0; i < 4; ++i) { p0[i] = __builtin_amdgcn_exp2f((s0[i] - mnew) * SCL); p1[i] = __builtin_amdgcn_exp2f((s1[i] - mnew) * SCL); ps += p0[i] + p1[i]; }
            lrun = lrun * alpha + ps; mrun = mnew;
            asm volatile("" : "+v"(lrun));
#pragma unroll
            for (int db = 0; db < 16; ++db) o[db] = o[db] * alpha;
            int pl = 0, ph = 0;
            pl = __builtin_amdgcn_cvt_pk_fp8_f32(p0[0], p0[1], pl, false); pl = __builtin_amdgcn_cvt_pk_fp8_f32(p0[2], p0[3], pl, true);
            ph = __builtin_amdgcn_cvt_pk_fp8_f32(p1[0], p1[1], ph, false); ph = __builtin_amdgcn_cvt_pk_fp8_f32(p1[2], p1[3], ph, true);
            const long pb = (long)(((unsigned long long)(unsigned)ph << 32) | (unsigned)pl);
#pragma unroll
            for (int db = 0; db < 16; ++db) {
                const i32x2 tv = __builtin_amdgcn_ds_read_tr8_b64_v2i32((LAS i32x2*)(tile0 + bf * TS + trow + 16 * db));
                const long av = (long)(((unsigned long long)(unsigned)tv.y << 32) | (unsigned)tv.x);
                o[db] = __builtin_amdgcn_mfma_f32_16x16x32_fp8_fp8(av, pb, o[db], 0, 0, 0);
            }
            if (ch < 7) { s0 = sn0; s1 = sn1; }
        }
        float lt = lrun + bperm_f(lane ^ 16, lrun); lt += bperm_f(lane ^ 32, lt);
        const float inv = 1.0f / lt;
        if (c16 < 8) { bf16_t* op = OLAT + m * 2048 + c16 * 256 + 4 * g;
#pragma unroll
            for (int db = 0; db < 16; ++db) { const f32x4 y = o[db] * inv; *(u32x2*)(op + 16 * db) = (u32x2){cvt_pk_bf16(y[0], y[1]), cvt_pk_bf16(y[2], y[3])}; } }
    }
#undef ATT_Q
#undef ATT_LOAD_IX
#undef ATT_LOAD_QF
#undef ATT_LOAD_ROWS
#undef ATT_QK
}

__device__ __forceinline__ void smix_phase(LAS unsigned char* lds, bf16_t* UY, const bf16_t* V, const f32x2* STATS, const float* Wc, const float* bsp, const float* lng, const float* lnb, int bid, int G, const int wvs) {
    int tid0 = wvs * 64 + hw_lane(); asm volatile("" : "+v"(tid0));
    const int wave = wvs;
    LAS unsigned char* VT = lds;
    LAS unsigned char* AP = lds + 67584;
    LAS float* MU = (LAS float*)(lds + 102400); LAS float* RSTD = MU + 128; LAS float* R1 = MU + 256; LAS float* R2 = MU + 384;
    u32x4 vr[8]; f32x4 sr[4];
#define SMIX_UNIT(itx, b_, gi_, m0_) const int b_ = (itx) & 7, gi_ = ((itx) >> 3) & 7; const size_t m0_ = (size_t)b_ * T + ((itx) >> 6) * 128;
#define SMIX_PRELOAD(m0_, gi_) do { \
    _Pragma("unroll") for (int i = 0; i < 8; ++i) { const int cidx = tid + 512 * i, s_ = cidx >> 5, ch = cidx & 31; vr[i] = *(const u32x4*)(V + ((m0_) + s_) * 2048 + (gi_) * 256 + ch * 8); } \
    { const f32x4* sp = (const f32x4*)(STATS + ((m0_) + (tid >> 2)) * 32 + (tid & 3) * 8); _Pragma("unroll") for (int j = 0; j < 4; ++j) sr[j] = sp[j]; } } while (0)
    if (bid < 2048) { const int tid = tid0; SMIX_UNIT(bid, b0, gi0, m00) (void)b0; SMIX_PRELOAD(m00, gi0); }
    for (int it = bid; it < 2048; it += G) {
        int tid = tid0; asm volatile("" : "+v"(tid));
        const int lane = tid & 63, gq = lane >> 4, c16 = lane & 15, q4 = c16 >> 2, p4 = c16 & 3;
        SMIX_UNIT(it, b, gi, m0) (void)b;
        u32x4 ur[8];
#pragma unroll
        for (int i = 0; i < 8; ++i) { const int cidx = tid + 512 * i, s = cidx >> 5, ch = cidx & 31; ur[i] = *(const u32x4*)(UY + (m0 + s) * 2048 + gi * 256 + ch * 8); }
        { float s = ((sr[0][0] + sr[0][2]) + (sr[1][0] + sr[1][2])) + ((sr[2][0] + sr[2][2]) + (sr[3][0] + sr[3][2])), ss = ((sr[0][1] + sr[0][3]) + (sr[1][1] + sr[1][3])) + ((sr[2][1] + sr[2][3]) + (sr[3][1] + sr[3][3]));
          s += bperm_f(lane ^ 1, s); ss += bperm_f(lane ^ 1, ss); s += bperm_f(lane ^ 2, s); ss += bperm_f(lane ^ 2, ss);
          if ((tid & 3) == 0) { const float mu = s * (1.0f / 2048.0f), var = ss * (1.0f / 2048.0f) - mu * mu; MU[tid >> 2] = mu; RSTD[tid >> 2] = rsqrtf(fmaxf(var, 0.f) + EPS); } }
#pragma unroll
        for (int i = 0; i < 8; ++i) { const int cidx = tid + 512 * i, s = cidx >> 5, ch = cidx & 31; *(LAS u32x4*)(VT + s * 528 + ch * 16) = vr[i]; }
        f32x4 wq[8];
        { const float* wp = Wc + ((size_t)gi * 128 + (tid >> 2)) * 128 + 32 * (tid & 3);
#pragma unroll
          for (int j = 0; j < 8; ++j) wq[j] = *(const f32x4*)(wp + 4 * j); }
        __syncthreads();
        { const int t = tid >> 2, qd = tid & 3; float r1 = 0.f, r2 = 0.f;
#pragma unroll
          for (int s8 = 0; s8 < 4; ++s8) { const f32x4 wa = wq[2 * s8], wb = wq[2 * s8 + 1]; float av[8];
#pragma unroll
              for (int e = 0; e < 8; ++e) { const int s = 32 * qd + 8 * s8 + e; const float wv = (s <= t) ? (e < 4 ? wa[e] : wb[e - 4]) : 0.f; const float ab = bf_round(wv * RSTD[s]); av[e] = ab; r1 += ab * MU[s]; r2 += wv; }
              u32x4 o; o.x = cvt_pk_bf16(av[0], av[1]); o.y = cvt_pk_bf16(av[2], av[3]); o.z = cvt_pk_bf16(av[4], av[5]); o.w = cvt_pk_bf16(av[6], av[7]);
              *(LAS u32x4*)(AP + t * 272 + (32 * qd + 8 * s8) * 2) = o; }
          r1 += bperm_f(lane ^ 1, r1); r2 += bperm_f(lane ^ 1, r2); r1 += bperm_f(lane ^ 2, r1); r2 += bperm_f(lane ^ 2, r2);
          if (qd == 0) { R1[t] = r1; R2[t] = r2; } }
        __syncthreads();
        f32x4 acc[8][2];
#pragma unroll
        for (int mt = 0; mt < 8; ++mt) { acc[mt][0] = (f32x4){0.f, 0.f, 0.f, 0.f}; acc[mt][1] = acc[mt][0]; }
#pragma unroll
        for (int ks = 0; ks < 4; ++ks) {
            bf16x8 vf[2];
#pragma unroll
            for (int n2 = 0; n2 < 2; ++n2) { const int nt = 2 * wave + n2;
                const s16x4 t0v = __builtin_amdgcn_ds_read_tr16_b64_v4i16((LAS s16x4*)(VT + (32 * ks + 8 * gq + q4) * 528 + (16 * nt + 4 * p4) * 2));
                const s16x4 t1v = __builtin_amdgcn_ds_read_tr16_b64_v4i16((LAS s16x4*)(VT + (32 * ks + 8 * gq + 4 + q4) * 528 + (16 * nt + 4 * p4) * 2));
                vf[n2] = __builtin_shufflevector(t0v, t1v, 0, 1, 2, 3, 4, 5, 6, 7); }
#pragma unroll
            for (int mt = 0; mt < 8; ++mt) if (mt >= 2 * ks) {
                const bf16x8 afr = *(const LAS bf16x8*)(AP + (16 * mt + c16) * 272 + (32 * ks + 8 * gq) * 2);
                acc[mt][0] = __builtin_amdgcn_mfma_f32_16x16x32_bf16(vf[0], afr, acc[mt][0], 0, 0, 0);
                acc[mt][1] = __builtin_amdgcn_mfma_f32_16x16x32_bf16(vf[1], afr, acc[mt][1], 0, 0, 0); }
        }
        { const int itn = it + G; if (itn < 2048) { SMIX_UNIT(itn, bn, gin, m0n) (void)bn; SMIX_PRELOAD(m0n, gin); } }
        __syncthreads();
#pragma unroll
        for (int i = 0; i < 8; ++i) { const int cidx = tid + 512 * i, s = cidx >> 5, ch = cidx & 31; *(LAS u32x4*)(VT + s * 528 + ch * 16) = ur[i]; }
        __syncthreads();
#pragma unroll
        for (int n2 = 0; n2 < 2; ++n2) { const int e0 = 16 * (2 * wave + n2) + 4 * gq; const f32x4 lg4 = *(const f32x4*)(lng + gi * 256 + e0), lb4 = *(const f32x4*)(lnb + gi * 256 + e0);
#pragma unroll
            for (int mt = 0; mt < 8; ++mt) { const int t = 16 * mt + c16; const float r1 = R1[t], r2 = R2[t], bsv = bsp[gi * 128 + t];
                LAS u32x2* up = (LAS u32x2*)(VT + t * 528 + e0 * 2); const u32x2 uw = *up;
                const f32x4 mixed = lg4 * (acc[mt][n2] - r1) + lb4 * r2 + bsv;
                const float y0 = bf2f(uw.x & 0xffffu) * mixed[0], y1 = bf2f(uw.x >> 16) * mixed[1], y2 = bf2f(uw.y & 0xffffu) * mixed[2], y3 = bf2f(uw.y >> 16) * mixed[3];
                u32x2 yw; yw.x = cvt_pk_bf16(y0, y1); yw.y = cvt_pk_bf16(y2, y3); *up = yw; } }
        __syncthreads();
#pragma unroll
        for (int i = 0; i < 8; ++i) { const int cidx = tid + 512 * i, s = cidx >> 5, ch = cidx & 31;
            *(u32x4*)(UY + (m0 + s) * 2048 + gi * 256 + ch * 8) = *(const LAS u32x4*)(VT + s * 528 + ch * 16); }
        __syncthreads();
    }
#undef SMIX_UNIT
#undef SMIX_PRELOAD
}

__global__ void __launch_bounds__(512, 2) mk_fwd(Args a) {
    extern __shared__ __attribute__((aligned(16))) unsigned char lds_raw[];
    LAS unsigned char* lds = (LAS unsigned char*)lds_raw;
    cg::grid_group grid = cg::this_grid();
    int bid = blockIdx.x; const int G = gridDim.x;
    unsigned char* wsk = a.ws;
    volatile LAS unsigned* misc = (volatile LAS unsigned*)(lds + LDS_MISC);
    const int wvs = __builtin_amdgcn_readfirstlane((int)threadIdx.x >> 6);
    if (wvs == 0 && hw_lane() < 2) misc[hw_lane()] = 0u;
    __syncthreads();
    const XcdBarrier xbar = xcd_barrier_post((unsigned*)(wsk + WS_BAR), misc, wvs);
    int ph = 0;
#ifndef PROBE
#define PROBE 0
#endif
#define PHASE_BEGIN if (ph >= a.ph_lo && ph < a.ph_hi) { size_t bb = (size_t)(bid & 7); asm volatile("" : "+s"(bb)); unsigned char* const act = wsk + WS_ACT + bb * SLAB; (void)act;
#define REP(k) for (int rep_ = 0; rep_ < ((PROBE == (k)) ? 2 : 1); ++rep_)
#define PHASE_END(dosync) if ((dosync) && ph + 1 < a.ph_hi) { if (ph == 0) grid.sync(); else if (ph == 1 || !local) xcd_barrier(xbar); else xcd_barrier_local(xbar); } } ++ph;

    bool local = false;
    PHASE_BEGIN REP(4) { p0_phase(a, lds, bid, G, wvs); __syncthreads(); } PHASE_END(true)
    {   if (wvs == 0 && hw_lane() == 0) { unsigned ok = (G == 256) ? 1u : 0u;
            for (unsigned j = 0; j < 16; ++j) { const unsigned c = xb_ld(&xbar.bar[XB_XCNT(j)]); ok &= (c == (j < 8u ? 32u : 0u)) ? 1u : 0u; }
            misc[3] = ok; }
        __syncthreads();
        if (misc[3] != 0u) { local = true; bid = __builtin_amdgcn_readfirstlane((int)(misc[2] * 8u + xbar.x)); }
    }
    PHASE_BEGIN p0c_phase(a, bid, G, wvs); PHASE_END(true)

#define ACT(off, rowbytes) (act + (off) - bb * T * (size_t)(rowbytes))
#define H ((bf16_t*)((unsigned char*)a.out + bb * (16 * MiB) - bb * T * 2048))
#define X ((_Float16*)ACT(S_X16, 2048))
#define Q ((bf16_t*)ACT(S_Q, 2048))
#define CKVR ((float*)ACT(S_CKVR, 1024))
#define QIDX ((bf16_t*)ACT(S_QIDX, 1024))
#define KRAW ((float*)ACT(S_KRAW, 512))
#define CKV ((bf16_t*)ACT(S_CKV, 256))
#define KIDX ((bf16_t*)ACT(S_KIDX, 128))
#define WIDX ((float*)ACT(S_WIDX, 32))
#define IDX ((unsigned short*)ACT(S_IDX, 512))
#define QLAT ((bf16_t*)ACT(S_QLAT, 2048))
#define OLAT ((bf16_t*)a.out)
#define O ((bf16_t*)ACT(S_O, 2048))
#define U ((bf16_t*)ACT(S_U, 4096))
#define V ((bf16_t*)ACT(S_V, 4096))
#define STATS ((f32x2*)ACT(S_STATS, 256))
    auto layer_body = [&](const int layer) __attribute__((always_inline)) {
        unsigned char* ws = wsk; asm volatile("" : "+s"(ws));
        float* MOD = (float*)(ws + WS_MOD);
        const int j = layer >> 1;
        const float* modl = MOD + (size_t)layer * 8 * NMOD;
        PHASE_BEGIN REP(3) { if (layer == 0) norm_mod_phase<true>(a.in[0], X, a.in[4] + layer * D, modl + 0 * D, modl + 1 * D, H, bid, G, wvs);
            else norm_mod_phase<false>(nullptr, X, a.in[4] + layer * D, modl + 0 * D, modl + 1 * D, H, bid, G, wvs); } PHASE_END(true)
        if ((layer & 1) == 0) {
            PHASE_BEGIN { pg8::Gemm g{H, (const bf16_t*)(ws + W_AIN) + (size_t)j * 2048 * 1024, M, 2048, 1024, 1024, 0, 0}; pg8::StaticOrder S; S.init(M, 2048, G, bid);
                pg8::EpiInproj E{Q, QIDX, (unsigned char*)CKV, KIDX, WIDX, a.in[7] + j * 256, a.in[8] + j * 64, a.in[9] + j * 64, (LAS float*)(lds + 8 * pg8::HTB)}; REP(5) pg8::gemm_phase(lds, g, S, E, wvs); } PHASE_END(true)
            PHASE_BEGIN {
                pg8::Gemm g{Q, (const bf16_t*)(ws + W_UK) + (size_t)j * 2048 * 256, M, 2048, 256, 1024, 1, 256}; pg8::StaticOrder S; S.init(M, 2048, G, bid);
                pg8::EpiBf16 E{QLAT, 2048, 1.4142135623730951f, 1}; pg8::gemm_phase(lds, g, S, E, wvs); } PHASE_END(true)
            PHASE_BEGIN REP(1) dsa_select_phase(lds, QIDX, KIDX, WIDX, IDX, bid, G, wvs); PHASE_END(true)
            PHASE_BEGIN REP(2) dsa_attn_phase(lds, (const unsigned char*)QLAT, (const unsigned char*)CKV, IDX, OLAT, bid, G, wvs); PHASE_END(true)
            PHASE_BEGIN { pg8::Gemm g{OLAT, (const bf16_t*)(ws + W_UV) + (size_t)j * 1024 * 512, M, 1024, 512, 2048, 0, 512}; pg8::StaticOrder S; S.init(M, 1024, G, bid);
                pg8::EpiBf16 E{O, 1024, 1.0f, 0}; pg8::gemm_phase(lds, g, S, E, wvs); } PHASE_END(true)
            PHASE_BEGIN { pg8::Gemm g{O, (const bf16_t*)(ws + W_O) + (size_t)j * 1024 * 1024, M, 1024, 1024, 1024, 0, 0}; pg8::StaticOrder S; S.init(M, 1024, G, bid);
                pg8::EpiResid E{X, modl + 2 * D}; pg8::gemm_phase(lds, g, S, E, wvs); } PHASE_END(true)
        } else {
            PHASE_BEGIN { pg8::Gemm g{H, (const bf16_t*)(ws + W_BIN) + (size_t)j * 4096 * 1024, M, 4096, 1024, 1024, 0, 0}; pg8::StaticOrder S; S.init(M, 4096, G, bid);
                pg8::EpiGelu E{U, V, STATS}; REP(7) pg8::gemm_phase(lds, g, S, E, wvs); } PHASE_END(true)
            PHASE_BEGIN smix_phase(lds, U, V, STATS, a.in[16] + (size_t)j * 8 * 128 * 128, a.in[17] + (size_t)j * 8 * 128, a.in[14] + (size_t)j * 2048, a.in[15] + (size_t)j * 2048, bid, G, wvs); PHASE_END(true)
            PHASE_BEGIN { pg8::Gemm g{U, (const bf16_t*)(ws + W_BOUT) + (size_t)j * 1024 * 2048, M, 1024, 2048, 2048, 0, 0}; pg8::StaticOrder S; S.init(M, 1024, G, bid);
                pg8::EpiResid E{X, modl + 2 * D}; pg8::gemm_phase(lds, g, S, E, wvs); } PHASE_END(true)
        }
        PHASE_BEGIN REP(3) norm_mod_phase<false>(nullptr, X, a.in[5] + layer * D, modl + 3 * D, modl + 4 * D, H, bid, G, wvs); PHASE_END(true)
        PHASE_BEGIN { pg8::Gemm g{H, (const bf16_t*)(ws + W_GU) + (size_t)layer * 5632 * 1024, M, 5632, 1024, 1024, 0, 0}; pg8::StaticOrder S; S.init(M, 5632, G, bid);
            pg8::EpiSwiglu E{(bf16_t*)ACT(S_HID, 5632)}; REP(6) pg8::gemm_phase(lds, g, S, E, wvs); } PHASE_END(true)
        PHASE_BEGIN { pg8::Gemm g{(const bf16_t*)ACT(S_HID, 5632), (const bf16_t*)(ws + W_DN) + (size_t)layer * 1024 * DFF, M, 1024, DFF, DFF, 0, 0}; pg8::StaticOrder S; S.init(M, 1024, G, bid);
            pg8::EpiResid E{X, modl + 5 * D}; pg8::gemm_phase(lds, g, S, E, wvs); } PHASE_END(true)
    };
    layer_body(0); layer_body(1); layer_body(2); layer_body(3);
    PHASE_BEGIN final_norm_phase(X, a.in[22], a.out, bid, G, wvs); PHASE_END(false)
#undef H
#undef X
#undef Q
#undef CKVR
#undef QIDX
#undef KRAW
#undef CKV
#undef KIDX
#undef WIDX
#undef IDX
#undef QLAT
#undef OLAT
#undef O
#undef U
#undef V
#undef STATS
#undef ACT
}

extern "C" void kernel_launch(void* const* d_in, const int* in_sizes, int n_in, void* d_out, int out_size, void* d_ws, size_t ws_size, hipStream_t stream) {
    static int grid_blocks = 0;
    if (grid_blocks == 0) {
        int dev = 0, cus = 0, per_cu = 0;
        if (n_in != 23 || out_size != M * D || ws_size < WS_END) { fprintf(stderr, "kernel_launch: unexpected problem (n_in %d out %d ws %zu, need ws >= %zu)\n", n_in, out_size, ws_size, (size_t)WS_END); grid_blocks = -1; return; }
        (void)hipGetDevice(&dev);
        (void)hipDeviceGetAttribute(&cus, hipDeviceAttributeMultiprocessorCount, dev);
        (void)hipFuncSetAttribute((const void*)mk_fwd, hipFuncAttributeMaxDynamicSharedMemorySize, LDS_BYTES);
        (void)hipOccupancyMaxActiveBlocksPerMultiprocessor(&per_cu, (const void*)mk_fwd, 512, LDS_BYTES);
        fprintf(stderr, "kernel_launch: cus %d per_cu %d ws %zu\n", cus, per_cu, ws_size);
        if (per_cu < 1) { fprintf(stderr, "kernel_launch: kernel does not fit a CU\n"); grid_blocks = -1; return; }
        grid_blocks = cus;
    }
    if (grid_blocks < 0) return;
    if (hipMemsetAsync((char*)d_ws + WS_BAR, 0, 16384, stream) != hipSuccess) { fprintf(stderr, "kernel_launch: memset failed\n"); return; }
    Args a{};
    for (int i = 0; i < 23; ++i) a.in[i] = (const float*)d_in[i];
    a.out = (float*)d_out; a.ws = (unsigned char*)d_ws; a.ph_lo = 0; a.ph_hi = 1000;
    void* args[] = {&a};
    hipError_t e = hipLaunchCooperativeKernel((const void*)mk_fwd, dim3(grid_blocks), dim3(512), args, LDS_BYTES, stream);
    if (e != hipSuccess) fprintf(stderr, "cooperative launch failed: %s (grid %d)\n", hipGetErrorString(e), grid_blocks);
}
```

```cpp
#include <hip/hip_runtime.h>
#include <hip/hip_cooperative_groups.h>
#include <cstdio>
#include <cstdint>
namespace cg = cooperative_groups;

#define LAS __attribute__((address_space(3)))
typedef unsigned short bf16_t;
typedef short bf16x8 __attribute__((ext_vector_type(8)));
typedef short s16x4 __attribute__((ext_vector_type(4)));
typedef float f32x4 __attribute__((ext_vector_type(4)));
typedef float f32x16 __attribute__((ext_vector_type(16)));
typedef float f32x2 __attribute__((ext_vector_type(2)));
typedef unsigned u32x4 __attribute__((ext_vector_type(4)));
typedef unsigned u32x2 __attribute__((ext_vector_type(2)));
typedef int i32x2 __attribute__((ext_vector_type(2)));
typedef _Float16 f16x8 __attribute__((ext_vector_type(8)));
typedef float f32x8 __attribute__((ext_vector_type(8)));

constexpr int D = 1024, NB = 8, T = 4096, M = NB * T, DFF = 2816, NMOD = 6 * D;
constexpr float EPS = 1e-6f;
constexpr int AIN = 1864;
constexpr size_t MiB = 1u << 20;
constexpr size_t WS_MOD = 0;
constexpr size_t WS_MODP = 1 * MiB;
constexpr size_t WS_W = 13 * MiB;
constexpr size_t W_AIN = WS_W;
constexpr size_t W_UK = W_AIN + 8 * MiB;
constexpr size_t W_UV = W_UK + 2 * MiB;
constexpr size_t W_O = W_UV + 2 * MiB;
constexpr size_t W_BIN = W_O + 4 * MiB;
constexpr size_t W_BOUT = W_BIN + 16 * MiB;
constexpr size_t W_GU = W_BOUT + 8 * MiB;
constexpr size_t W_DN = W_GU + 44 * MiB;
constexpr size_t WS_ACT = W_DN + 22 * MiB;
constexpr size_t KiB = 1024, SLAB = 47 * MiB;
constexpr size_t S_X16 = 0;
constexpr size_t S_Q = 8 * MiB;
constexpr size_t S_HID = 8 * MiB;
constexpr int ULD = 2048 + 64;
constexpr size_t S_U = 8 * MiB;
constexpr size_t S_V = 25 * MiB;
constexpr size_t S_STATS = 42 * MiB;
constexpr size_t S_QLAT = 16 * MiB;
constexpr size_t S_O = 16 * MiB;
constexpr size_t S_CKVR = 32 * MiB;
constexpr size_t S_CKV = 36 * MiB;
constexpr size_t S_QIDX = 38 * MiB;
constexpr size_t S_KRAW = 42 * MiB;
constexpr size_t S_KIDX = 44 * MiB;
constexpr size_t S_WIDX = 44 * MiB + 512 * KiB;
constexpr size_t S_IDX = 44 * MiB + 640 * KiB;
static_assert(S_IDX + 2 * MiB <= SLAB && S_HID + 22 * MiB <= S_CKVR && S_STATS + MiB <= SLAB, "slab map");
constexpr size_t WS_END = WS_ACT + 8 * SLAB;
constexpr int LDS_BYTES = 147456;
constexpr int LDS_MISC = LDS_BYTES - 256;
constexpr size_t WS_BAR = 1 * MiB - 16384;

__device__ __forceinline__ unsigned cvt_pk_bf16(float lo, float hi) { unsigned r; asm volatile("v_cvt_pk_bf16_f32 %0, %1, %2" : "=v"(r) : "v"(lo), "v"(hi)); return r; }
__device__ __forceinline__ float bf2f(unsigned b) { return __uint_as_float(b << 16); }
__device__ __forceinline__ float bf_round(float f) { unsigned u = __float_as_uint(f); u = (u + 0x7fffu + ((u >> 16) & 1u)) & 0xffff0000u; return __uint_as_float(u); }
__device__ __forceinline__ float wave_sum(float v) {
#pragma unroll
    for (int o = 1; o < 64; o <<= 1) v += __shfl_xor(v, o);
    return v;
}
#define LDS_WAIT() asm volatile("s_waitcnt lgkmcnt(0)" ::: "memory")
__device__ __forceinline__ unsigned bperm_u(int srclane, unsigned v) { return (unsigned)__builtin_amdgcn_ds_bpermute(srclane << 2, (int)v); }
__device__ __forceinline__ int hw_lane() { int l; asm volatile("v_mbcnt_lo_u32_b32 %0, -1, 0\n\tv_mbcnt_hi_u32_b32 %0, -1, %0" : "=v"(l)); return l; }
__device__ __forceinline__ float bperm_f(int srclane, float v) { return __int_as_float(__builtin_amdgcn_ds_bpermute(srclane << 2, __float_as_int(v))); }


#define XB_TMO      128
#define XB_XCNT(j)  (256  + 64 * (j))
#define XB_XSUB(j)  (1280 + 64 * (j))
#define XB_XGEN(j)  (2304 + 64 * (j))
#define XB_TOP      3328
#define XB_TOPGEN   3392
#define XCD_BAR_WORDS 3456
#define XB_SPIN_CAP (1u << 22)
__device__ __forceinline__ unsigned xb_ld(unsigned* p)              { return __hip_atomic_load(p, __ATOMIC_RELAXED, __HIP_MEMORY_SCOPE_AGENT); }
__device__ __forceinline__ unsigned xb_add(unsigned* p, unsigned v) { return __hip_atomic_fetch_add(p, v, __ATOMIC_RELAXED, __HIP_MEMORY_SCOPE_AGENT); }
__device__ __forceinline__ unsigned xb_xcc_id() { return (unsigned)__builtin_amdgcn_s_getreg((3 << 11) | 20) & 0xFu; }
#define XB_SPIN(cond, bar) do { unsigned _sp = 0; while (cond) { __builtin_amdgcn_s_sleep(1); \
    if ((++_sp & 255u) == 0u) { if (xb_ld(&(bar)[XB_TMO])) break; if (_sp > XB_SPIN_CAP) { atomicAdd(&(bar)[XB_TMO], 1u); break; } } } } while (0)
struct XcdBarrier { unsigned* bar; unsigned x; volatile LAS unsigned* st; int wvs; };
__device__ __forceinline__ XcdBarrier xcd_barrier_post(unsigned* bar, volatile LAS unsigned* st, int wvs) {
    XcdBarrier b; b.bar = bar; b.x = xb_xcc_id(); b.st = st; b.wvs = wvs;
    if (wvs == 0 && hw_lane() == 0) st[2] = xb_add(&bar[XB_XCNT(b.x)], 1u);
    return b;
}
__device__ __forceinline__ void xcd_barrier_complete(unsigned* bar, unsigned x, unsigned& nloc, unsigned& nx) {
    const unsigned G = gridDim.x * gridDim.y * gridDim.z;
    unsigned sum, cnt, mine, sp = 0u;
    for (;;) {
        sum = 0u; cnt = 0u; mine = 0u;
#pragma unroll
        for (unsigned j = 0; j < 16; ++j) { const unsigned c = xb_ld(&bar[XB_XCNT(j)]); sum += c; cnt += (c > 0u) ? 1u : 0u; mine = (j == x) ? c : mine; }
        if (sum == G) break;
        __builtin_amdgcn_s_sleep(1);
        if ((++sp & 255u) == 0u) { if (xb_ld(&bar[XB_TMO])) break; if (sp > XB_SPIN_CAP) { atomicAdd(&bar[XB_TMO], 1u); break; } }
    }
    nloc = mine > 0u ? mine : 1u; nx = cnt > 0u ? cnt : 1u;
}
__device__ __forceinline__ void xcd_barrier(const XcdBarrier& b) {
    asm volatile("s_waitcnt vmcnt(0)" ::: "memory");
    __syncthreads();
    if (b.wvs == 0 && hw_lane() == 0) {
        unsigned* bar = b.bar;
        __builtin_amdgcn_s_waitcnt(0);
        unsigned nloc = b.st[0], nx = b.st[1];
        if (nloc == 0u) { xcd_barrier_complete(bar, b.x, nloc, nx); b.st[0] = nloc; b.st[1] = nx; }
        const unsigned old = xb_add(&bar[XB_XSUB(b.x)], 1u);
        const unsigned gen = old / nloc;
        if (old + 1u == (gen + 1u) * nloc) {
            __builtin_amdgcn_fence(__ATOMIC_RELEASE, "agent");
            asm volatile("s_waitcnt vmcnt(0)" ::: "memory");
            const unsigned og = xb_add(&bar[XB_TOP], 1u);
            const unsigned tg = og / nx;
            if (og + 1u == (tg + 1u) * nx) xb_add(&bar[XB_TOPGEN], 1u);
            else XB_SPIN(xb_ld(&bar[XB_TOPGEN]) == tg, bar);
            __builtin_amdgcn_fence(__ATOMIC_ACQUIRE, "agent");
            xb_add(&bar[XB_XGEN(b.x)], 1u);
            asm volatile("s_waitcnt vmcnt(0)" ::: "memory");
        } else {
            XB_SPIN(xb_ld(&bar[XB_XGEN(b.x)]) == gen, bar);
            __builtin_amdgcn_fence(__ATOMIC_ACQUIRE, "agent");
            asm volatile("s_waitcnt vmcnt(0)" ::: "memory");
        }
    }
    __syncthreads();
}

__device__ __forceinline__ void xcd_barrier_local(const XcdBarrier& b) {
    asm volatile("s_waitcnt vmcnt(0)" ::: "memory");
    __syncthreads();
    if (b.wvs == 0 && hw_lane() == 0) {
        unsigned* bar = b.bar;
        __builtin_amdgcn_s_waitcnt(0);
        const unsigned nloc = b.st[0];
        asm volatile("buffer_inv sc1" ::: "memory");
        const unsigned old = xb_add(&bar[XB_XSUB(b.x)], 1u);
        const unsigned gen = old / nloc;
        if (old + 1u == (gen + 1u) * nloc) xb_add(&bar[XB_XGEN(b.x)], 1u);
        else XB_SPIN(xb_ld(&bar[XB_XGEN(b.x)]) == gen, bar);
        asm volatile("s_waitcnt vmcnt(0)" ::: "memory");
    }
    __syncthreads();
}

namespace pg8 {
constexpr int BM = 256, BK = 64, HALF = 128, HTB = HALF * BK * 2, STAGE_BYTES = 8 * HTB, NXCD = 8, WGM = 8;
__host__ __device__ __forceinline__ int lds_byte(int r, int c) { return (r >> 3) * 1024 + (r & 7) * 128 + (((c >> 3) ^ ((r >> 1) & 7)) << 4) + (c & 7) * 2; }
__host__ __device__ __forceinline__ void stage_rc(int b, int& R, int& C) { const int blk = b / 1024, sb = b % 1024; R = blk * 8 + sb / 128; C = ((((sb % 128) >> 4) ^ ((R >> 1) & 7))) * 8; }
__host__ __device__ __forceinline__ int perm32(int rho) { const int n = rho >> 4, i = rho & 15; return 8 * (i >> 2) + 4 * n + (i & 3); }

struct Unit { int pm, pn; };
struct Gemm { const bf16_t* A; const bf16_t* Bt; int M, N, K, lda, agrp_shift, agrp_stride; };

struct StaticOrder {
    int nM, nN, nwg, G, c; int rev = 0;
    __device__ void init(int M_, int N_, int G_, int c_) { nM = M_ / BM; nN = N_ / BM; nwg = nM * nN; G = G_; c = c_; }
    __device__ bool next(int i, Unit& u) const {
        const long L = (long)i * G + c; if (L >= nwg) return false;
        int wgid = (int)L; { const int q = nwg / NXCD, r = nwg % NXCD, xcd = wgid % NXCD, off = wgid / NXCD; wgid = (xcd < r ? xcd * (q + 1) : r * (q + 1) + (xcd - r) * q) + off; }
        const int nig = WGM * nN, gid = (wgid / nig) ^ rev, fm = gid * WGM, gsz = (nM - fm) < WGM ? (nM - fm) : WGM;
        u.pm = fm + ((wgid % nig) % gsz); u.pn = (wgid % nig) / gsz; return true;
    }
};

typedef f32x4 Acc[2][2][4][2];

__device__ __forceinline__ float relu_i(float x) { const int b = __float_as_int(x); return __int_as_float(b > 0 ? b : 0); }
__device__ __forceinline__ f32x2 gelu_pk(f32x2 v) {
    const f32x2 av = __builtin_elementwise_abs(v), d = av * 0.2316418882f + 1.0f;
    f32x2 t; t.x = __builtin_amdgcn_rcpf(d.x); t.y = __builtin_amdgcn_rcpf(d.y);
    f32x2 q = t * 0.5307027145f + (-0.7265760135f); q = q * t + 0.7107068705f; q = q * t + (-0.142248368f); q = q * t + 0.127414796f; q = q * t;
    const f32x2 s = (v * v) * (-0.72134752044f);
    f32x2 e; e.x = __builtin_amdgcn_exp2f(s.x); e.y = __builtin_amdgcn_exp2f(s.y);
    f32x2 rl; rl.x = relu_i(v.x); rl.y = relu_i(v.y);
    return rl - av * (q * e);
}
__device__ __forceinline__ f32x4 gelu4(f32x4 v) { f32x2 a = gelu_pk((f32x2){v[0], v[1]}), b = gelu_pk((f32x2){v[2], v[3]}); return (f32x4){a.x, a.y, b.x, b.y}; }
__device__ __forceinline__ u32x4 pack8(f32x4 v0, f32x4 v1) { u32x4 w; w.x = cvt_pk_bf16(v0[0], v0[1]); w.y = cvt_pk_bf16(v0[2], v0[3]); w.z = cvt_pk_bf16(v1[0], v1[1]); w.w = cvt_pk_bf16(v1[2], v1[3]); return w; }

struct EpiInproj {
    static constexpr int NS = 0, PREF = 0;
    bf16_t* Q; bf16_t* QIDX; unsigned char* CKV; bf16_t* KIDX; float* WIDX; const float* gkv; const float* gk; const float* bk; LAS float* rs;
    __device__ __forceinline__ void operator()(const Acc& acc, const Unit& u, int wr, int wc, int fr, int fq) const {
        const int row0 = u.pm * BM + wr * 64 + fr, cl = wc * 32 + 8 * fq;
        if (u.pn == 4) {
#pragma unroll
            for (int ai = 0; ai < 2; ++ai)
#pragma unroll
                for (int m = 0; m < 4; ++m) { float ss = 0.f;
#pragma unroll
                    for (int bj = 0; bj < 2; ++bj)
#pragma unroll
                        for (int n = 0; n < 2; ++n) { const f32x4 v = acc[ai][bj][m][n]; ss += (v[0] * v[0] + v[1] * v[1]) + (v[2] * v[2] + v[3] * v[3]); }
                    ss += bperm_f((16 * fq + fr) ^ 16, ss); ss += bperm_f((16 * fq + fr) ^ 32, ss);
                    if (fq == 0) rs[(ai * HALF + wr * 64 + m * 16 + fr) * 4 + wc] = ss; }
            asm volatile("s_waitcnt lgkmcnt(0)" ::: "memory"); __builtin_amdgcn_s_barrier();
            f32x4 g4[2][2];
#pragma unroll
            for (int bj = 0; bj < 2; ++bj)
#pragma unroll
                for (int n = 0; n < 2; ++n) g4[bj][n] = *(const f32x4*)(gkv + bj * HALF + cl + 4 * n);
#pragma unroll
            for (int ai = 0; ai < 2; ++ai)
#pragma unroll
                for (int m = 0; m < 4; ++m) { const f32x4 p = *(const LAS f32x4*)(rs + (ai * HALF + wr * 64 + m * 16 + fr) * 4);
                    const float rstd = rsqrtf(((p[0] + p[1]) + (p[2] + p[3])) * (1.0f / 256.0f) + EPS);
                    unsigned char* rowp = CKV + (size_t)(row0 + ai * HALF + m * 16) * 256 + cl;
#pragma unroll
                    for (int bj = 0; bj < 2; ++bj) { const f32x4 y0 = acc[ai][bj][m][0] * rstd * g4[bj][0], y1 = acc[ai][bj][m][1] * rstd * g4[bj][1]; int w0 = 0, w1 = 0;
                        w0 = __builtin_amdgcn_cvt_pk_fp8_f32(y0[0], y0[1], w0, false); w0 = __builtin_amdgcn_cvt_pk_fp8_f32(y0[2], y0[3], w0, true);
                        w1 = __builtin_amdgcn_cvt_pk_fp8_f32(y1[0], y1[1], w1, false); w1 = __builtin_amdgcn_cvt_pk_fp8_f32(y1[2], y1[3], w1, true);
                        *(u32x2*)(rowp + bj * HALF) = (u32x2){(unsigned)w0, (unsigned)w1}; } }
            return; }
        if (u.pn == 7) {
            LAS f32x2* rs2 = (LAS f32x2*)rs;
#pragma unroll
            for (int ai = 0; ai < 2; ++ai)
#pragma unroll
                for (int m = 0; m < 4; ++m) { const f32x4 v0 = acc[ai][0][m][0], v1 = acc[ai][0][m][1];
                    float sm = (v0[0] + v0[1]) + (v0[2] + v0[3]) + (v1[0] + v1[1]) + (v1[2] + v1[3]);
                    float sq = (v0[0] * v0[0] + v0[1] * v0[1]) + (v0[2] * v0[2] + v0[3] * v0[3]) + (v1[0] * v1[0] + v1[1] * v1[1]) + (v1[2] * v1[2] + v1[3] * v1[3]);
                    sm += bperm_f((16 * fq + fr) ^ 16, sm); sq += bperm_f((16 * fq + fr) ^ 16, sq); sm += bperm_f((16 * fq + fr) ^ 32, sm); sq += bperm_f((16 * fq + fr) ^ 32, sq);
                    if (fq == 0 && wc < 2) rs2[(ai * HALF + wr * 64 + m * 16 + fr) * 2 + wc] = (f32x2){sm, sq}; }
            asm volatile("s_waitcnt lgkmcnt(0)" ::: "memory"); __builtin_amdgcn_s_barrier();
            if (wc < 2) { const f32x4 ga = *(const f32x4*)(gk + cl), gb = *(const f32x4*)(gk + cl + 4), ba = *(const f32x4*)(bk + cl), bb4 = *(const f32x4*)(bk + cl + 4);
#pragma unroll
                for (int ai = 0; ai < 2; ++ai)
#pragma unroll
                    for (int m = 0; m < 4; ++m) { const f32x4 p = *(const LAS f32x4*)(rs + (ai * HALF + wr * 64 + m * 16 + fr) * 4);
                        const float mean = (p[0] + p[2]) * (1.0f / 64.0f), var = fmaxf((p[1] + p[3]) * (1.0f / 64.0f) - mean * mean, 0.f), krstd = rsqrtf(var + EPS);
                        const f32x4 y0 = (acc[ai][0][m][0] - mean) * krstd * ga + ba, y1 = (acc[ai][0][m][1] - mean) * krstd * gb + bb4;
                        const size_t r = (size_t)(row0 + ai * HALF + m * 16);
                        *(u32x4*)(KIDX + (((r >> 5) * 4 + (size_t)(cl >> 4)) * 64 + (size_t)(((cl >> 3) & 1) * 32) + (r & 31)) * 8) = pack8(y0, y1); } }
            else if (wc == 2 && fq == 0) {
#pragma unroll
                for (int ai = 0; ai < 2; ++ai)
#pragma unroll
                    for (int m = 0; m < 4; ++m) { float* p = WIDX + (size_t)(row0 + ai * HALF + m * 16) * 8; *(f32x4*)p = acc[ai][0][m][0] * 0.04419417382f; *(f32x4*)(p + 4) = acc[ai][0][m][1] * 0.04419417382f; } }
            return; }
#pragma unroll
        for (int ai = 0; ai < 2; ++ai)
#pragma unroll
            for (int m = 0; m < 4; ++m) { const size_t row = (size_t)(row0 + ai * HALF + m * 16);
#pragma unroll
                for (int bj = 0; bj < 2; ++bj) { const f32x4 v0 = acc[ai][bj][m][0], v1 = acc[ai][bj][m][1]; const int c = bj * HALF + cl;
                    if (u.pn < 4) *(u32x4*)(Q + row * 1024 + u.pn * 256 + c) = pack8(v0, v1);
                    else *(u32x4*)(QIDX + row * 512 + (u.pn - 5) * 256 + c) = pack8(v0, v1); } }
    }
};
struct EpiBf16 {
    static constexpr int NS = 16, PREF = 0;
    bf16_t* O; int ldc; float scale; int fp8;
    __device__ __forceinline__ void operator()(const Acc& acc, const Unit& u, int wr, int wc, int fr, int fq) const {
        const int row0 = u.pm * BM + wr * 64 + fr, col0 = u.pn * BM + wc * 32 + 8 * fq;
        if (fp8) {
#pragma unroll
            for (int ai = 0; ai < 2; ++ai)
#pragma unroll
                for (int m = 0; m < 4; ++m) { unsigned char* rowp = (unsigned char*)O + (size_t)(row0 + ai * HALF + m * 16) * ldc + col0;
#pragma unroll
                    for (int bj = 0; bj < 2; ++bj) { const f32x4 v0 = acc[ai][bj][m][0] * scale, v1 = acc[ai][bj][m][1] * scale; int w0 = 0, w1 = 0;
                        w0 = __builtin_amdgcn_cvt_pk_fp8_f32(v0[0], v0[1], w0, false); w0 = __builtin_amdgcn_cvt_pk_fp8_f32(v0[2], v0[3], w0, true);
                        w1 = __builtin_amdgcn_cvt_pk_fp8_f32(v1[0], v1[1], w1, false); w1 = __builtin_amdgcn_cvt_pk_fp8_f32(v1[2], v1[3], w1, true);
                        *(u32x2*)(rowp + bj * HALF) = (u32x2){(unsigned)w0, (unsigned)w1}; } }
            return; }
#pragma unroll
        for (int ai = 0; ai < 2; ++ai)
#pragma unroll
            for (int m = 0; m < 4; ++m) { bf16_t* rowp = O + (size_t)(row0 + ai * HALF + m * 16) * ldc + col0;
#pragma unroll
                for (int bj = 0; bj < 2; ++bj) *(u32x4*)(rowp + bj * HALF) = pack8(acc[ai][bj][m][0] * scale, acc[ai][bj][m][1] * scale); }
    }
};
struct EpiResid {
    static constexpr int NS = 36, PREF = 0;
    _Float16* x; const float* gate;
    __device__ __forceinline__ unsigned pref_off(const Unit& u, int wr, int wc, int lane) const { return (unsigned)((u.pm * BM + wr * 64 + lane) * D + u.pn * BM + wc * 32) * 2u; }
    __device__ __forceinline__ void operator()(const Acc& acc, const Unit& u, int wr, int wc, int fr, int fq) const {
        const int row0 = u.pm * BM + wr * 64 + fr, col0 = u.pn * BM + wc * 32 + 8 * fq;
        const float* gp = gate + (size_t)(u.pm >> 4) * NMOD + col0;
        f32x4 gv[2][2];
#pragma unroll
        for (int bj = 0; bj < 2; ++bj)
#pragma unroll
            for (int n = 0; n < 2; ++n) gv[bj][n] = *(const f32x4*)(gp + bj * HALF + 4 * n);
#pragma unroll
        for (int ai = 0; ai < 2; ++ai)
#pragma unroll
            for (int m = 0; m < 4; ++m) { _Float16* xp = x + (size_t)(row0 + ai * HALF + m * 16) * D + col0;
#pragma unroll
                for (int bj = 0; bj < 2; ++bj) { const f32x8 xo = __builtin_convertvector(*(const f16x8*)(xp + bj * HALF), f32x8);
                    const f32x4 r0 = (f32x4){xo[0], xo[1], xo[2], xo[3]} + gv[bj][0] * acc[ai][bj][m][0], r1 = (f32x4){xo[4], xo[5], xo[6], xo[7]} + gv[bj][1] * acc[ai][bj][m][1];
                    *(f16x8*)(xp + bj * HALF) = __builtin_convertvector((f32x8){r0[0], r0[1], r0[2], r0[3], r1[0], r1[1], r1[2], r1[3]}, f16x8); } }
    }
};
struct EpiGelu {
    static constexpr int NS = 16, PREF = 0;
    bf16_t* U; bf16_t* V; f32x2* STATS;
    __device__ __forceinline__ void operator()(const Acc& acc, const Unit& u, int wr, int wc, int fr, int fq) const {
        const int row0 = u.pm * BM + wr * 64 + fr, cl = wc * 32 + 8 * fq;
        const bool isv = u.pn >= 8; bf16_t* base = isv ? V + (u.pn - 8) * 256 : U + u.pn * 256;
#pragma unroll
        for (int ai = 0; ai < 2; ++ai)
#pragma unroll
            for (int m = 0; m < 4; ++m) { const size_t row = (size_t)(row0 + ai * HALF + m * 16); float s = 0.f, ss = 0.f;
#pragma unroll
                for (int bj = 0; bj < 2; ++bj) { const f32x4 v0 = gelu4(acc[ai][bj][m][0]), v1 = gelu4(acc[ai][bj][m][1]);
                    *(u32x4*)(base + row * ULD + bj * HALF + cl) = pack8(v0, v1);
                    s += (v0[0] + v0[1]) + (v0[2] + v0[3]) + (v1[0] + v1[1]) + (v1[2] + v1[3]);
                    ss += (v0[0] * v0[0] + v0[1] * v0[1]) + (v0[2] * v0[2] + v0[3] * v0[3]) + (v1[0] * v1[0] + v1[1] * v1[1]) + (v1[2] * v1[2] + v1[3] * v1[3]); }
                if (isv) { s += __shfl_xor(s, 16); ss += __shfl_xor(ss, 16); s += __shfl_xor(s, 32); ss += __shfl_xor(ss, 32);
                    if (fq == 0) STATS[row * 32 + (u.pn - 8) * 4 + wc] = (f32x2){s, ss}; } }
    }
};
struct EpiSwiglu {
    static constexpr int NS = 8, PREF = 0;
    bf16_t* HID;
    __device__ __forceinline__ void operator()(const Acc& acc, const Unit& u, int wr, int wc, int fr, int fq) const {
        const int row0 = u.pm * BM + wr * 64 + fr, col0 = u.pn * 128 + wc * 32 + 8 * fq;
#pragma unroll
        for (int ai = 0; ai < 2; ++ai)
#pragma unroll
            for (int m = 0; m < 4; ++m) { f32x4 h[2];
#pragma unroll
                for (int n = 0; n < 2; ++n) { const f32x4 g = acc[ai][0][m][n], up = acc[ai][1][m][n];
#pragma unroll
                    for (int j = 0; j < 4; j += 2) {
                        const f32x2 g2 = (f32x2){g[j], g[j + 1]}, u2 = (f32x2){up[j], up[j + 1]}, t2 = g2 * (-1.4426950408889634f);
                        f32x2 d2; d2.x = __builtin_amdgcn_exp2f(t2.x); d2.y = __builtin_amdgcn_exp2f(t2.y); d2 = d2 + 1.0f;
                        f32x2 r2; r2.x = __builtin_amdgcn_rcpf(d2.x); r2.y = __builtin_amdgcn_rcpf(d2.y);
                        const f32x2 h2 = (g2 * u2) * r2; h[n][j] = h2.x; h[n][j + 1] = h2.y; } }
                *(u32x4*)(HID + (size_t)(row0 + ai * HALF + m * 16) * DFF + col0) = pack8(h[0], h[1]); }
    }
};

template <class Epi>
__device__ __forceinline__ void gemm_phase(LAS unsigned char* lds, const Gemm g, const StaticOrder& S, const Epi& E, const int wvs) {
    int tid = wvs * 64 + hw_lane(); asm volatile("" : "+v"(tid));
    const int wid = wvs, lane = tid & 63, wr = wid >> 2, wc = wid & 3, fr = lane & 15, fq = lane >> 4;
    const int K = g.K, nt = K / BK, lda = g.lda;
    unsigned voffA[2], voffB[2];
#pragma unroll
    for (int i = 0; i < 2; ++i) { int R, C; stage_rc(tid * 16 + i * 8192, R, C); const int Rb = (R & ~31) + perm32(R & 31);
        voffA[i] = (unsigned)(R * lda + C) * 2u; voffB[i] = (unsigned)(Rb * K + C) * 2u; }
    const size_t kstep = (size_t)(BK * 2);
    const size_t hstepA = (size_t)HALF * lda * 2, hstepB = (size_t)HALF * K * 2;
    const unsigned ldsw = (unsigned)wid * 1024u; const unsigned ldsb = (unsigned)(size_t)lds + ldsw;
    const int aoff = lds_byte(wr * 64 + fr, fq * 8), boff = lds_byte(wc * 32 + fr, fq * 8);
#define PG8_SA(b, h) (((b) * 2 + (h)) * HTB)
#define PG8_SB(b, h) ((4 + (b) * 2 + (h)) * HTB)
#define PG8_STAGE(bufoff, gbase, voff) asm volatile("s_mov_b32 m0, %2\n\ts_nop 0\n\tglobal_load_lds_dwordx4 %0, %3\n\ts_mov_b32 m0, %4\n\ts_nop 0\n\tglobal_load_lds_dwordx4 %1, %3" \
        :: "v"((voff)[0]), "v"((voff)[1]), "s"(ldsb + (unsigned)(bufoff)), "s"((const char*)(gbase)), "s"(ldsb + (unsigned)(bufoff) + 8192u) : "memory", "m0")
#define PG8_LDA(dst, b, h) do { _Pragma("unroll") for (int m = 0; m < 4; ++m) _Pragma("unroll") for (int k = 0; k < 2; ++k) dst[m][k] = *(const LAS bf16x8*)(lds + PG8_SA(b, h) + (aoff ^ (k * 64)) + m * 2048); } while (0)
#define PG8_LDB(dst, b, h) do { _Pragma("unroll") for (int n = 0; n < 2; ++n) _Pragma("unroll") for (int k = 0; k < 2; ++k) dst[n][k] = *(const LAS bf16x8*)(lds + PG8_SB(b, h) + (boff ^ (k * 64)) + n * 2048); } while (0)
#define PG8_MMA(ai, bj, At, Bt) do { __builtin_amdgcn_s_setprio(1); _Pragma("unroll") for (int m = 0; m < 4; ++m) _Pragma("unroll") for (int n = 0; n < 2; ++n) _Pragma("unroll") for (int k = 0; k < 2; ++k) \
        acc[ai][bj][m][n] = __builtin_amdgcn_mfma_f32_16x16x32_bf16(Bt[n][k], At[m][k], acc[ai][bj][m][n], 0, 0, 0); __builtin_amdgcn_s_setprio(0); } while (0)
#define PG8_WAIT_V(n) asm volatile("s_waitcnt vmcnt(" #n ")" ::: "memory")
#define PG8_WAIT_V1(f) asm volatile("s_cmp_lg_u32 %0, 0\n\ts_cbranch_scc1 .Lpg8a_%=\n\ts_waitcnt vmcnt(8)\n.Lpg8a_%=:\n\ts_cmp_gt_u32 %0, 1\n\ts_cbranch_scc1 .Lpg8b_%=\n\ts_waitcnt vmcnt(%1)\n.Lpg8b_%=:\n\ts_waitcnt vmcnt(%2)" :: "s"(f), "n"(8 + Epi::PREF), "n"(8 + Epi::NS) : "memory", "scc")
#define PG8_WAIT_L(n) asm volatile("s_waitcnt lgkmcnt(" #n ")" ::: "memory")
#define PG8_BAR __builtin_amdgcn_s_barrier()
#define PG8_SCHED __builtin_amdgcn_sched_barrier(0)
#define PG8_ABASE(u) ((const char*)g.A + ((size_t)(u).pm * BM * lda + (size_t)((u).pn >> g.agrp_shift) * g.agrp_stride) * 2)
#define PG8_BBASE(u) ((const char*)g.Bt + (size_t)(u).pn * 2 * hstepB)
    Unit cur, nxt; int ui = 0;
    if (!S.next(0, cur)) return;
    Acc acc;
#pragma unroll
    for (int a = 0; a < 2; ++a)
#pragma unroll
        for (int b = 0; b < 2; ++b)
#pragma unroll
            for (int m = 0; m < 4; ++m)
#pragma unroll
                for (int n = 0; n < 2; ++n) acc[a][b][m][n] = (f32x4){0.f, 0.f, 0.f, 0.f};
    bf16x8 At[4][2], B0[2][2], B1[2][2];
    const char* cA = PG8_ABASE(cur); const char* cB = PG8_BBASE(cur);
    PG8_STAGE(PG8_SB(0, 0), cB, voffB); PG8_STAGE(PG8_SB(0, 1), cB + hstepB, voffB); PG8_STAGE(PG8_SA(0, 0), cA, voffA); PG8_STAGE(PG8_SA(0, 1), cA + hstepA, voffA);
    if (wr == 1) PG8_BAR;
    PG8_WAIT_V(2); PG8_BAR;
    PG8_STAGE(PG8_SB(1, 0), cB + kstep, voffB); PG8_STAGE(PG8_SA(1, 0), cA + kstep, voffA); PG8_STAGE(PG8_SB(1, 1), cB + hstepB + kstep, voffB);
    PG8_WAIT_V(6); PG8_BAR;
    for (;;) {
        const bool has_next = S.next(ui + 1, nxt);
        const char* nA = has_next ? PG8_ABASE(nxt) : cA; const char* nB = has_next ? PG8_BBASE(nxt) : cB;
        for (int t = 0; t < nt; t += 2) {
            const bool last = (t == nt - 2);
            const char* a1 = cA + (size_t)(t + 1) * kstep;
            const char* a2 = last ? nA : cA + (size_t)(t + 2) * kstep; const char* b2 = last ? nB : cB + (size_t)(t + 2) * kstep;
            const char* a3 = a2 + kstep; const char* b3 = b2 + kstep;
            static_assert(Epi::PREF <= Epi::NS, "wait classes must nest");
            const int lenv = (t == 0) ? (ui > 0 ? 2 : 0) : ((Epi::PREF != 0 && t == nt - 2) ? 1 : 0);
            int len; asm volatile("v_readfirstlane_b32 %0, %1" : "=s"(len) : "v"(lenv));
            if constexpr (Epi::PREF != 0) {
                unsigned ptmp; const unsigned poff = E.pref_off(cur, wr, wc, hw_lane()), pdst = (unsigned)(size_t)(lds + 8 * HTB) + (unsigned)wid * 256u;
                asm volatile("s_cmp_lg_u32 %2, 1\n\ts_cbranch_scc1 .Lpg8p_%=\n\ts_mov_b32 m0, %3\n\ts_nop 0\n\tglobal_load_lds_dword %1, %4\n\tglobal_load_lds_dword %1, %4 offset:256\n\t"
                             "v_add_u32_e32 %0, 0x40000, %1\n\tglobal_load_lds_dword %0, %4\n\tglobal_load_lds_dword %0, %4 offset:256\n.Lpg8p_%=:"
                             : "=&v"(ptmp) : "v"(poff), "s"(len), "s"(pdst), "s"(E.x) : "memory", "scc", "m0"); }
            PG8_LDB(B0, 0, 0); PG8_LDB(B1, 0, 1); PG8_SCHED; PG8_LDA(At, 0, 0); PG8_STAGE(PG8_SA(1, 1), a1 + hstepA, voffA);
            PG8_WAIT_V1(len); PG8_WAIT_L(0); PG8_BAR; PG8_MMA(0, 0, At, B0); PG8_MMA(0, 1, At, B1); PG8_BAR; PG8_SCHED;
            PG8_LDA(At, 0, 1); PG8_STAGE(PG8_SB(0, 0), b2, voffB); PG8_STAGE(PG8_SB(0, 1), b2 + hstepB, voffB); PG8_STAGE(PG8_SA(0, 0), a2, voffA);
            PG8_WAIT_V1(len); PG8_WAIT_L(0); PG8_BAR; PG8_MMA(1, 0, At, B0); PG8_MMA(1, 1, At, B1); PG8_BAR; PG8_SCHED;
            PG8_LDB(B0, 1, 0); PG8_LDB(B1, 1, 1); PG8_SCHED; PG8_LDA(At, 1, 0); PG8_STAGE(PG8_SA(0, 1), a2 + hstepA, voffA);
            PG8_WAIT_V(8); PG8_WAIT_L(0); PG8_BAR; PG8_MMA(0, 0, At, B0); PG8_MMA(0, 1, At, B1); PG8_BAR; PG8_SCHED;
            PG8_LDA(At, 1, 1); PG8_STAGE(PG8_SB(1, 0), b3, voffB); PG8_STAGE(PG8_SB(1, 1), b3 + hstepB, voffB); PG8_STAGE(PG8_SA(1, 0), a3, voffA);
            PG8_WAIT_V(8); PG8_WAIT_L(0); PG8_BAR; PG8_MMA(1, 0, At, B0); PG8_MMA(1, 1, At, B1); PG8_BAR; PG8_SCHED;
        }
        if (wr == 0) PG8_BAR;
        { const int l2 = hw_lane();
          E(acc, cur, wr, wc, l2 & 15, l2 >> 4); }
        if (!has_next) break;
#pragma unroll
        for (int a = 0; a < 2; ++a)
#pragma unroll
            for (int b = 0; b < 2; ++b)
#pragma unroll
                for (int m = 0; m < 4; ++m)
#pragma unroll
                    for (int n = 0; n < 2; ++n) acc[a][b][m][n] = (f32x4){0.f, 0.f, 0.f, 0.f};
        cur = nxt; cA = nA; cB = nB; ++ui;
        if (wr == 1) PG8_BAR;
    }
    PG8_WAIT_V(0);
    PG8_BAR;
#undef PG8_SA
#undef PG8_SB
#undef PG8_STAGE
#undef PG8_LDA
#undef PG8_LDB
#undef PG8_MMA
#undef PG8_WAIT_V
#undef PG8_WAIT_L
#undef PG8_WAIT_V1
#undef PG8_BAR
#undef PG8_SCHED
#undef PG8_ABASE
#undef PG8_BBASE
}
}
using pg8::relu_i;

struct Args { const float* in[23]; float* out; unsigned char* ws; int ph_lo, ph_hi; };

struct CvtDesc { const float* src; bf16_t* dst; int N, ldd, mode, r0, c0, li; };
__device__ __forceinline__ void cvt_load(const CvtDesc& d, int lane, f32x4 (&t)[8]) {
    const int nblk = (d.N + 31) >> 5, k0 = 64 * (d.li / nblk), n0 = 32 * (d.li % nblk);
    const int cc = lane & 7, rr = lane >> 3; const bool ok = n0 + 4 * cc < d.N;
#pragma unroll
    for (int i = 0; i < 8; ++i) t[i] = ok ? *(const f32x4*)(d.src + (size_t)(k0 + 8 * i + rr) * d.N + n0 + 4 * cc) : (f32x4){0.f, 0.f, 0.f, 0.f};
}
__device__ __forceinline__ void cvt_store(const CvtDesc& d, LAS float* scr, int lane, const f32x4 (&t)[8]) {
    const int nblk = (d.N + 31) >> 5, k0 = 64 * (d.li / nblk), n0 = 32 * (d.li % nblk);
    { const int cc = lane & 7, rr = lane >> 3;
#pragma unroll
      for (int i = 0; i < 8; ++i) { LAS float* q = scr + (8 * i + rr) * 33 + 4 * cc; q[0] = t[i][0]; q[1] = t[i][1]; q[2] = t[i][2]; q[3] = t[i][3]; } }
    LDS_WAIT();
    const int c = lane & 7;
#pragma unroll
    for (int j = 0; j < 4; ++j) { const int nl = (lane >> 3) + 8 * j, n = n0 + nl; const LAS float* sp = scr + (8 * c) * 33 + nl;
        u32x4 o; o.x = cvt_pk_bf16(sp[0 * 33], sp[1 * 33]); o.y = cvt_pk_bf16(sp[2 * 33], sp[3 * 33]); o.z = cvt_pk_bf16(sp[4 * 33], sp[5 * 33]); o.w = cvt_pk_bf16(sp[6 * 33], sp[7 * 33]);
        if (n < d.N) { const int drow = d.mode ? ((n >> 7) * 256 + (n & 127) + d.r0) : (d.r0 + n); *(u32x4*)(d.dst + (size_t)drow * d.ldd + d.c0 + k0 + 8 * c) = o; } }
    LDS_WAIT();
}
__device__ __forceinline__ CvtDesc cvt_decode(const Args& a, unsigned char* ws, int r) {
    if (r < 1888) { const int j = r / 944; return CvtDesc{a.in[6] + (size_t)j * 1024 * AIN, (bf16_t*)(ws + W_AIN) + (size_t)j * 2048 * 1024, AIN, 1024, 0, 0, 0, r % 944}; } r -= 1888;
    if (r < 256) { const int jj = r >> 4, la = jj >> 3, h = jj & 7; return CvtDesc{a.in[10] + (size_t)(la * 8 + h) * 128 * 256, (bf16_t*)(ws + W_UK) + (size_t)la * 2048 * 256, 256, 256, 0, h * 256, (h & 1) * 128, r & 15}; } r -= 256;
    if (r < 256) { const int jj = r >> 4, la = jj >> 3, h = jj & 7; return CvtDesc{a.in[11] + (size_t)(la * 8 + h) * 256 * 128, (bf16_t*)(ws + W_UV) + (size_t)la * 1024 * 512, 128, 512, 0, (h >> 1) * 256 + (h & 1) * 128, (h & 1) * 256, r & 15}; } r -= 256;
    if (r < 1024) { const int la = r >> 9; return CvtDesc{a.in[12] + (size_t)la * 1024 * 1024, (bf16_t*)(ws + W_O) + (size_t)la * 1024 * 1024, 1024, 1024, 0, 0, 0, r & 511}; } r -= 1024;
    if (r < 4096) { const int la = r >> 11; return CvtDesc{a.in[13] + (size_t)la * 1024 * 4096, (bf16_t*)(ws + W_BIN) + (size_t)la * 4096 * 1024, 4096, 1024, 0, 0, 0, r & 2047}; } r -= 4096;
    if (r < 2048) { const int la = r >> 10; return CvtDesc{a.in[18] + (size_t)la * 2048 * 1024, (bf16_t*)(ws + W_BOUT) + (size_t)la * 1024 * 2048, 1024, 2048, 0, 0, 0, r & 1023}; } r -= 2048;
    if (r < 11264) { const int jj = r / 1408, l = jj & 3, isup = jj >> 2; return CvtDesc{a.in[isup ? 20 : 19] + (size_t)l * 1024 * DFF, (bf16_t*)(ws + W_GU) + (size_t)l * 5632 * 1024, DFF, 1024, 1, isup * 128, 0, r % 1408}; } r -= 11264;
    { const int l = r / 1408; return CvtDesc{a.in[21] + (size_t)l * DFF * 1024, (bf16_t*)(ws + W_DN) + (size_t)l * 1024 * DFF, 1024, DFF, 0, 0, 0, r % 1408}; }
}

__device__ __forceinline__ void p0_phase(const Args& a, LAS unsigned char* lds, int bid, int G, const int wvs) {
    int tid = wvs * 64 + hw_lane(); asm volatile("" : "+v"(tid));
    const int lane = tid & 63, wave = __builtin_amdgcn_readfirstlane(tid >> 6);
    unsigned char* ws = a.ws;
    LAS float* scr = (LAS float*)(lds + wave * 8704);
    const int gw = bid * 8 + wave, NGW = G * 8;
    constexpr int NITEMS = 1888 + 256 + 256 + 1024 + 4096 + 2048 + 11264 + 5632;
    {
        f32x4 tc[8], tn[8]; CvtDesc dc{}, dn{};
        if (gw < NITEMS) { dc = cvt_decode(a, ws, gw); cvt_load(dc, lane, tc); }
        for (int it = gw; it < NITEMS; it += NGW) {
            const bool hn = it + NGW < NITEMS;
            if (hn) { dn = cvt_decode(a, ws, it + NGW); cvt_load(dn, lane, tn); }
            cvt_store(dc, scr, lane, tc);
            if (hn) { dc = dn;
#pragma unroll
                for (int i = 0; i < 8; ++i) tc[i] = tn[i]; }
        }
    }
    const size_t gt = (size_t)bid * 512 + tid, NT = (size_t)G * 512;
    const u32x4 z = (u32x4){0u, 0u, 0u, 0u};
    for (size_t i = gt; i < 2 * 184 * 128; i += NT) { const int j = (int)(i / (184 * 128)), rem = (int)(i % (184 * 128)), rr = AIN + rem / 128, ch = rem % 128;
        *(u32x4*)((bf16_t*)(ws + W_AIN) + ((size_t)j * 2048 + rr) * 1024 + ch * 8) = z; }
    for (size_t i = gt; i < 2 * 2048 * 16; i += NT) { const int j = (int)(i / (2048 * 16)), rem = (int)(i % (2048 * 16)), rr = rem >> 4, ch = rem & 15, h = rr >> 8;
        *(u32x4*)((bf16_t*)(ws + W_UK) + ((size_t)j * 2048 + rr) * 256 + (1 - (h & 1)) * 128 + ch * 8) = z; }
    for (size_t i = gt; i < 2 * 1024 * 32; i += NT) { const int j = (int)(i / (1024 * 32)), rem = (int)(i % (1024 * 32)), rr = rem >> 5, ch = rem & 31, hh = (rr >> 7) & 1;
        *(u32x4*)((bf16_t*)(ws + W_UV) + ((size_t)j * 1024 + rr) * 512 + (1 - hh) * 256 + ch * 8) = z; }
    __syncthreads();
    LAS float* ca = (LAS float*)lds;
    const float* cvec = a.in[1]; const float* modw = a.in[2]; float* MODP = (float*)(ws + WS_MODP);
    for (int it = bid; it < 768; it += G) {
        const int l = it / 192, rem = it % 192, ng = rem >> 4, kc = rem & 15;
        const int n = ng * 512 + tid; float acc[8];
        const float* wp = modw + ((size_t)l * 1024 + kc * 64) * NMOD + n;
        float wv[64];
#pragma unroll
        for (int k = 0; k < 64; ++k) wv[k] = wp[(size_t)k * NMOD];
        { const int b = tid >> 6, k = tid & 63; const float cv = cvec[b * 1024 + kc * 64 + k]; ca[b * 64 + k] = cv / (1.0f + __expf(-cv)); }
        __syncthreads();
#pragma unroll
        for (int b = 0; b < 8; ++b) acc[b] = 0.f;
#pragma unroll
        for (int k = 0; k < 64; ++k) {
#pragma unroll
            for (int b = 0; b < 8; ++b) acc[b] += ca[b * 64 + k] * wv[k]; }
#pragma unroll
        for (int b = 0; b < 8; ++b) MODP[((size_t)(kc * 4 + l) * 8 + b) * NMOD + n] = acc[b];
        __syncthreads();
    }
}
__device__ __forceinline__ void p0c_phase(const Args& a, int bid, int G, const int wvs) {
    const float* MODP = (const float*)(a.ws + WS_MODP); float* MOD = (float*)(a.ws + WS_MOD); const float* modb = a.in[3];
    int tid0 = wvs * 64 + hw_lane(); asm volatile("" : "+v"(tid0));
    for (int i = bid * 512 + tid0; i < 4 * 8 * NMOD; i += G * 512) { const int l = i / (8 * NMOD), n = i % NMOD; float s = modb[l * NMOD + n];
#pragma unroll
        for (int kc = 0; kc < 16; ++kc) s += MODP[(size_t)kc * (4 * 8 * NMOD) + i];
        MOD[i] = s; }
}

template <bool FIRST>
__device__ __forceinline__ void norm_mod_phase(const float* x32, _Float16* x16, const float* gain, const float* sh, const float* sc, bf16_t* H, int bid, int G, const int wvs) {
    int tid = wvs * 64 + hw_lane(); asm volatile("" : "+v"(tid));
    const int lane = tid & 63, wave = tid >> 6;
    for (int q = (bid >> 3) * 8 + wave; q < T / 16; q += (G >> 3) * 8) {
        const int b = bid & 7, rb = b * T + q * 16; f32x4 gs[4], sv[4];
#pragma unroll
        for (int j = 0; j < 4; ++j) { const int c = 8 * lane + 512 * (j >> 1) + 4 * (j & 1); const f32x4 g4 = *(const f32x4*)(gain + c), s4 = *(const f32x4*)(sc + (size_t)b * NMOD + c); gs[j] = g4 * (s4 + 1.0f); sv[j] = *(const f32x4*)(sh + (size_t)b * NMOD + c); }
        f32x4 nx[4]; f16x8 nh[2];
        if (FIRST) {
#pragma unroll
            for (int j = 0; j < 4; ++j) nx[j] = *(const f32x4*)(x32 + (size_t)rb * D + 8 * lane + 512 * (j >> 1) + 4 * (j & 1)); }
        else {
#pragma unroll
            for (int j = 0; j < 2; ++j) nh[j] = *(const f16x8*)(x16 + (size_t)rb * D + 8 * lane + 512 * j); }
        for (int r = rb; r < rb + 16; ++r) {
            f32x4 v[4];
            if (FIRST) {
#pragma unroll
                for (int j = 0; j < 4; ++j) v[j] = nx[j];
#pragma unroll
                for (int j = 0; j < 2; ++j) *(f16x8*)(x16 + (size_t)r * D + 8 * lane + 512 * j) = __builtin_convertvector((f32x8){v[2 * j][0], v[2 * j][1], v[2 * j][2], v[2 * j][3], v[2 * j + 1][0], v[2 * j + 1][1], v[2 * j + 1][2], v[2 * j + 1][3]}, f16x8);
            } else {
#pragma unroll
                for (int j = 0; j < 2; ++j) { const f32x8 t = __builtin_convertvector(nh[j], f32x8); v[2 * j] = (f32x4){t[0], t[1], t[2], t[3]}; v[2 * j + 1] = (f32x4){t[4], t[5], t[6], t[7]}; }
            }
            const int rn = (r + 1 < rb + 16) ? r + 1 : r;
            if (FIRST) {
#pragma unroll
                for (int j = 0; j < 4; ++j) nx[j] = *(const f32x4*)(x32 + (size_t)rn * D + 8 * lane + 512 * (j >> 1) + 4 * (j & 1)); }
            else {
#pragma unroll
                for (int j = 0; j < 2; ++j) nh[j] = *(const f16x8*)(x16 + (size_t)rn * D + 8 * lane + 512 * j); }
            float ss = 0.f;
#pragma unroll
            for (int j = 0; j < 4; ++j) ss += (v[j][0] * v[j][0] + v[j][1] * v[j][1]) + (v[j][2] * v[j][2] + v[j][3] * v[j][3]);
            const float rstd = rsqrtf(wave_sum(ss) * (1.0f / D) + EPS);
#pragma unroll
            for (int j = 0; j < 2; ++j) { const f32x4 y0 = v[2 * j] * rstd * gs[2 * j] + sv[2 * j], y1 = v[2 * j + 1] * rstd * gs[2 * j + 1] + sv[2 * j + 1];
                u32x4 w; w.x = cvt_pk_bf16(y0[0], y0[1]); w.y = cvt_pk_bf16(y0[2], y0[3]); w.z = cvt_pk_bf16(y1[0], y1[1]); w.w = cvt_pk_bf16(y1[2], y1[3]);
                *(u32x4*)(H + (size_t)r * D + 8 * lane + 512 * j) = w; }
        }
    }
}
__device__ __forceinline__ void final_norm_phase(const _Float16* x16, const float* gain, float* out, int bid, int G, const int wvs) {
    int tid = wvs * 64 + hw_lane(); asm volatile("" : "+v"(tid));
    const int lane = tid & 63, wave = tid >> 6;
    f32x4 gs[4];
#pragma unroll
    for (int j = 0; j < 4; ++j) gs[j] = *(const f32x4*)(gain + 8 * lane + 512 * (j >> 1) + 4 * (j & 1));
    f16x8 nh[2];
    { const int r0 = (bid & 7) * T + (bid >> 3) * 8 + wave;
#pragma unroll
      for (int j = 0; j < 2; ++j) nh[j] = *(const f16x8*)(x16 + (size_t)r0 * D + 8 * lane + 512 * j); }
    for (int q = (bid >> 3) * 8 + wave; q < T; q += (G >> 3) * 8) { const int r = (bid & 7) * T + q;
        f32x4 v[4]; float ss = 0.f;
#pragma unroll
        for (int j = 0; j < 2; ++j) { const f32x8 t = __builtin_convertvector(nh[j], f32x8); v[2 * j] = (f32x4){t[0], t[1], t[2], t[3]}; v[2 * j + 1] = (f32x4){t[4], t[5], t[6], t[7]}; }
        const int rn = (q + (G >> 3) * 8 < T) ? r + (G >> 3) * 8 : r;
#pragma unroll
        for (int j = 0; j < 2; ++j) nh[j] = *(const f16x8*)(x16 + (size_t)rn * D + 8 * lane + 512 * j);
#pragma unroll
        for (int j = 0; j < 4; ++j) ss += (v[j][0] * v[j][0] + v[j][1] * v[j][1]) + (v[j][2] * v[j][2] + v[j][3] * v[j][3]);
        const float rstd = rsqrtf(wave_sum(ss) * (1.0f / D) + EPS);
#pragma unroll
        for (int j = 0; j < 4; ++j) *(f32x4*)(out + (size_t)r * D + 8 * lane + 512 * (j >> 1) + 4 * (j & 1)) = v[j] * rstd * gs[j];
    }
}
__device__ __forceinline__ void dsa_rows_phase(const float* CKVR, const float* KRAW, const float* gkv, const float* gk, const float* bk, bf16_t* CKV, bf16_t* KIDX, float* WIDX, int bid, int G, const int wvs) {
    int tid = wvs * 64 + hw_lane(); asm volatile("" : "+v"(tid));
    const int lane = tid & 63, wave = tid >> 6;
    const f32x4 g4 = *(const f32x4*)(gkv + 4 * lane);
    f32x4 gk4 = (f32x4){0.f, 0.f, 0.f, 0.f}, bk4 = gk4;
    if (lane < 16) { gk4 = *(const f32x4*)(gk + 4 * lane); bk4 = *(const f32x4*)(bk + 4 * lane); }
    for (int q = (bid >> 3) * 8 + wave; q < T; q += (G >> 3) * 8) { const int r = (bid & 7) * T + q;
        const f32x4 v = *(const f32x4*)(CKVR + (size_t)r * 256 + 4 * lane);
        f32x4 kv = (f32x4){0.f, 0.f, 0.f, 0.f}; if (lane < 32) kv = *(const f32x4*)(KRAW + (size_t)r * 128 + 4 * lane);
        const float ss = wave_sum((v[0] * v[0] + v[1] * v[1]) + (v[2] * v[2] + v[3] * v[3]));
        const float rstd = rsqrtf(ss * (1.0f / 256.0f) + EPS);
        { const f32x4 y = v * rstd * g4; int w = 0; w = __builtin_amdgcn_cvt_pk_fp8_f32(y[0], y[1], w, false); w = __builtin_amdgcn_cvt_pk_fp8_f32(y[2], y[3], w, true); *(int*)((unsigned char*)CKV + (size_t)r * 256 + 4 * lane) = w; }
        const float ks = (lane < 16) ? (kv[0] + kv[1]) + (kv[2] + kv[3]) : 0.f;
        const float mean = wave_sum(ks) * (1.0f / 64.0f);
        const f32x4 dv = kv - mean;
        const float kq = (lane < 16) ? (dv[0] * dv[0] + dv[1] * dv[1]) + (dv[2] * dv[2] + dv[3] * dv[3]) : 0.f;
        const float krstd = rsqrtf(wave_sum(kq) * (1.0f / 64.0f) + EPS);
        if (lane < 16) { const f32x4 y = dv * krstd * gk4 + bk4; u32x2 w; w.x = cvt_pk_bf16(y[0], y[1]); w.y = cvt_pk_bf16(y[2], y[3]); *(u32x2*)(KIDX + ((((size_t)(r >> 5) * 4 + (lane >> 2)) * 64 + (((lane >> 1) & 1) * 32 + (r & 31))) * 8 + (lane & 1) * 4)) = w; }
        else if (lane < 18) { *(f32x4*)(WIDX + (size_t)r * 8 + 4 * (lane - 16)) = kv * 0.04419417382f; }
    }
}

__device__ __forceinline__ float relu_mul(float x, float w) { return relu_i(x) * w; }
__device__ __forceinline__ float relu_fma(float x, float w, float acc) { return __builtin_fmaf(relu_i(x), w, acc); }
__device__ __forceinline__ float fmin_raw(float a, float b) { float r; asm("v_min_f32_e32 %0, %1, %2" : "=v"(r) : "v"(a), "v"(b)); return r; }
__device__ __forceinline__ float fmax_raw(float a, float b) { float r; asm("v_max_f32_e32 %0, %1, %2" : "=v"(r) : "v"(a), "v"(b)); return r; }
__device__ __forceinline__ unsigned mbcnt64(unsigned long long m) { return __builtin_amdgcn_mbcnt_hi((unsigned)(m >> 32), __builtin_amdgcn_mbcnt_lo((unsigned)m, 0u)); }

template <int SHIFT, int WIDTH>
__device__ __forceinline__ void sel_level(const unsigned (&k)[64], int N, LAS unsigned* hist, int lane, unsigned& prefix, unsigned& need) {
    LAS u32x4* hz = (LAS u32x4*)(hist + 32 * lane);
#pragma unroll
    for (int j = 0; j < 8; ++j) hz[j] = (u32x4){0u, 0u, 0u, 0u};
    LDS_WAIT();
#pragma unroll
    for (int gi = 0; gi < 8; ++gi) if (512 * gi < N) {
#pragma unroll
        for (int ii = 0; ii < 8; ++ii) { const unsigned key = k[8 * gi + ii]; const bool ok = (key >> (SHIFT + WIDTH)) == prefix;
            LAS unsigned* p = ok ? hist + ((key >> SHIFT) & ((1u << WIDTH) - 1u)) : hist + 2048 + lane;
            __hip_atomic_fetch_add(p, 1u, __ATOMIC_RELAXED, __HIP_MEMORY_SCOPE_WORKGROUP); } }
    LDS_WAIT();
    u32x4 hv[8]; unsigned ls = 0u;
#pragma unroll
    for (int j = 0; j < 8; ++j) { hv[j] = hz[j]; ls += (hv[j][0] + hv[j][1]) + (hv[j][2] + hv[j][3]); }
    unsigned incl = ls;
#pragma unroll
    for (int o = 1; o < 64; o <<= 1) { const unsigned v = bperm_u((lane + o) & 63, incl); if (lane + o < 64) incl += v; }
    const unsigned above = incl - ls;
    unsigned cnt = above, d = 0u, nn = 0u;
#pragma unroll
    for (int j = 31; j >= 0; --j) { const unsigned h = hv[j >> 2][j & 3]; const bool hit = (cnt < need) && (need <= cnt + h); d = hit ? (unsigned)(32 * lane + j) : d; nn = hit ? need - cnt : nn; cnt += h; }
    const bool found = (above < need) && (need <= above + ls);
    const unsigned long long fm = __ballot(found);
    const int src = (fm != 0ull) ? (__ffsll((long long)fm) - 1) : 0;
    d = bperm_u(src, d); need = bperm_u(src, nn);
    prefix = (prefix << WIDTH) | d;
}

__device__ __forceinline__ void dsa_select_phase(LAS unsigned char* lds, const bf16_t* QIDX, const bf16_t* KIDX, const float* WIDX, unsigned short* IDX, int bid, int G, const int wvs) {
    int tid0 = wvs * 64 + hw_lane(); asm volatile("" : "+v"(tid0));
    const int wave = __builtin_amdgcn_readfirstlane(tid0 >> 6);
    LAS float* SC = (LAS float*)lds;
    LAS unsigned short* IDXL = (LAS unsigned short*)(lds + 135168) + wave * 256;
    LAS float* MM = (LAS float*)(lds + 139264);
#define DUMW ((LAS unsigned short*)(lds + 139776 + wave * 256 + lane * 4))
    bf16x8 af[2][4]; bf16x8 kb[4][4];
#define DSA_UNIT(itx, b_, t0_, mb_, ntile_, nj_) const int b_ = (itx) & 7, t0_ = ((itx) >> 3) * 8; const size_t mb_ = (size_t)b_ * T; \
    const int ntile_ = (t0_ + 8 + 31) >> 5; const int nj_ = (wave < ntile_) ? ((ntile_ - wave + 7) >> 3) : 0;
#define DSA_KLOAD(buf, j, kbase_, nj_) do { const int jc_ = ((j) < (nj_)) ? (j) : ((nj_) > 0 ? (nj_) - 1 : 0); const bf16_t* kp_ = (kbase_) + (size_t)(wave + 8 * jc_) * 2048; \
    _Pragma("unroll") for (int ks = 0; ks < 4; ++ks) kb[buf][ks] = *(const bf16x8*)(kp_ + 512 * ks); } while (0)
#define DSA_PRELOAD(t0_, mb_, nj_) do { \
    _Pragma("unroll") for (int rg = 0; rg < 2; ++rg) { const bf16_t* qp = QIDX + ((mb_) + (t0_) + 4 * rg + (col >> 3)) * 512 + (col & 7) * 64 + 8 * hf; \
        _Pragma("unroll") for (int ks = 0; ks < 4; ++ks) af[rg][ks] = *(const bf16x8*)(qp + 16 * ks); } \
    (void)(nj_); } while (0)
    { int tid = tid0; asm volatile("" : "+v"(tid)); const int lane = tid & 63, hf = lane >> 5, col = lane & 31;
      if (bid < 4096) { DSA_UNIT(bid, b, t0, mb, ntile, nj) (void)b; (void)ntile; if (t0 + 8 > 256) DSA_PRELOAD(t0, mb, nj); } }
    for (int it = bid; it < 4096; it += G) {
        int tid = tid0; asm volatile("" : "+v"(tid));
        const int lane = tid & 63, hf = lane >> 5, col = lane & 31;
        DSA_UNIT(it, b, t0, mb, ntile, nj) (void)b; (void)ntile;
        const int t = t0 + wave, N = t + 1;
        unsigned short* outp = IDX + (mb + t) * 256;
        const int itn = it + G; const bool hasn = itn < 4096;
        DSA_UNIT(hasn ? itn : it, bn, t0n, mbn, ntilen, njn) (void)bn; (void)ntilen;
        if (t0 + 8 <= 256) {
            *(u32x2*)(outp + 4 * lane) = (u32x2){(unsigned)(4 * lane) | ((unsigned)(4 * lane + 1) << 16), (unsigned)(4 * lane + 2) | ((unsigned)(4 * lane + 3) << 16)};
            if (hasn && t0n + 8 > 256) DSA_PRELOAD(t0n, mbn, njn);
            continue;
        }
        float w[2][4][4]; float mn[2][2], mx[2][2];
#pragma unroll
        for (int rg = 0; rg < 2; ++rg)
#pragma unroll
            for (int e = 0; e < 2; ++e) { mn[rg][e] = 3.0e38f; mx[rg][e] = -3.0e38f; }
        const bf16_t* kbase = KIDX + mb * 64 + (size_t)lane * 8;
        DSA_KLOAD(0, 0, kbase, nj); DSA_KLOAD(1, 1, kbase, nj); DSA_KLOAD(2, 2, kbase, nj); DSA_KLOAD(3, 3, kbase, nj);
#pragma unroll
        for (int rg = 0; rg < 2; ++rg)
#pragma unroll
            for (int qq = 0; qq < 4; ++qq) { const f32x4 wv = *(const f32x4*)(WIDX + (mb + t0 + 4 * rg + qq) * 8 + 4 * hf);
                w[rg][qq][0] = wv[0]; w[rg][qq][1] = wv[1]; w[rg][qq][2] = wv[2]; w[rg][qq][3] = wv[3]; }
#define DSA_KCOMP(buf, j) do { const int s_ = 32 * (wave + 8 * (j)) + col; f32x16 acc0, acc1; \
    _Pragma("unroll") for (int i = 0; i < 16; ++i) { acc0[i] = 0.f; acc1[i] = 0.f; } \
    _Pragma("unroll") for (int ks = 0; ks < 4; ++ks) { acc0 = __builtin_amdgcn_mfma_f32_32x32x16_bf16(af[0][ks], kb[buf][ks], acc0, 0, 0, 0); acc1 = __builtin_amdgcn_mfma_f32_32x32x16_bf16(af[1][ks], kb[buf][ks], acc1, 0, 0, 0); } \
    _Pragma("unroll") for (int rg = 0; rg < 2; ++rg) { float p[4]; \
        _Pragma("unroll") for (int qq = 0; qq < 4; ++qq) { p[qq] = relu_mul(rg ? acc1[4 * qq] : acc0[4 * qq], w[rg][qq][0]); _Pragma("unroll") for (int ii = 1; ii < 4; ++ii) p[qq] = relu_fma(rg ? acc1[4 * qq + ii] : acc0[4 * qq + ii], w[rg][qq][ii], p[qq]); } \
        _Pragma("unroll") for (int e = 0; e < 2; ++e) { const auto r = __builtin_amdgcn_permlane32_swap(__float_as_uint(p[e]), __float_as_uint(p[2 + e]), false, false); \
            const float tot = __uint_as_float(r[0]) + __uint_as_float(r[1]); SC[(4 * rg + 2 * hf + e) * 4096 + s_] = tot; mn[rg][e] = fmin_raw(mn[rg][e], tot); mx[rg][e] = fmax_raw(mx[rg][e], tot); } } } while (0)
        for (int j = 0; j < nj; j += 4) {
            DSA_KCOMP(0, j); if (j + 4 < nj) DSA_KLOAD(0, j + 4, kbase, nj);
            if (j + 1 < nj) DSA_KCOMP(1, j + 1);
            if (j + 5 < nj) DSA_KLOAD(1, j + 5, kbase, nj);
            if (j + 2 < nj) DSA_KCOMP(2, j + 2);
            if (j + 6 < nj) DSA_KLOAD(2, j + 6, kbase, nj);
            if (j + 3 < nj) DSA_KCOMP(3, j + 3);
            if (j + 7 < nj) DSA_KLOAD(3, j + 7, kbase, nj);
        }
#pragma unroll
        for (int rg = 0; rg < 2; ++rg)
#pragma unroll
            for (int e = 0; e < 2; ++e) {
#pragma unroll
                for (int o = 1; o < 32; o <<= 1) { mn[rg][e] = fminf(mn[rg][e], bperm_f(lane ^ o, mn[rg][e])); mx[rg][e] = fmaxf(mx[rg][e], bperm_f(lane ^ o, mx[rg][e])); }
                if (col == 0) { MM[(wave * 8 + 4 * rg + 2 * hf + e) * 2] = mn[rg][e]; MM[(wave * 8 + 4 * rg + 2 * hf + e) * 2 + 1] = mx[rg][e]; } }
        if (hasn && t0n + 8 > 256) DSA_PRELOAD(t0n, mbn, njn);
        __syncthreads();
        {
            const LAS float* scl = SC + wave * 4096 + lane;
            LAS unsigned* hist = (LAS unsigned*)(lds + wave * 16384);
            float lo = 3.0e38f, hi = -3.0e38f;
#pragma unroll
            for (int wv = 0; wv < 8; ++wv) { lo = fminf(lo, MM[(wv * 8 + wave) * 2]); hi = fmaxf(hi, MM[(wv * 8 + wave) * 2 + 1]); }
            const float scale = 4.0e9f / fmaxf(hi - lo, 1e-30f);
            unsigned k[64];
#pragma unroll
            for (int gi = 0; gi < 8; ++gi) { if (512 * gi < N) {
#pragma unroll
                for (int ii = 0; ii < 8; ++ii) k[8 * gi + ii] = __float_as_uint(scl[64 * (8 * gi + ii)]); } else {
#pragma unroll
                for (int ii = 0; ii < 8; ++ii) k[8 * gi + ii] = 0u; } }
            LDS_WAIT();
            { LAS u32x4* hz = (LAS u32x4*)(hist + 16 * lane);
#pragma unroll
              for (int j = 0; j < 4; ++j) hz[j] = (u32x4){0u, 0u, 0u, 0u}; }
            LDS_WAIT();
#pragma unroll
            for (int gi = 0; gi < 8; ++gi) if (512 * gi < N) {
                if (512 * (gi + 1) <= N) {
#pragma unroll
                    for (int ii = 0; ii < 8; ++ii) { const int i = 8 * gi + ii;
                        const unsigned key = 1u + (unsigned)((__uint_as_float(k[i]) - lo) * scale); k[i] = key;
                        __hip_atomic_fetch_add(hist + (key >> 22), 1u, __ATOMIC_RELAXED, __HIP_MEMORY_SCOPE_WORKGROUP); }
                } else {
#pragma unroll
                    for (int ii = 0; ii < 8; ++ii) { const int i = 8 * gi + ii; const bool valid = lane < N - 64 * i;
                        const unsigned key = valid ? 1u + (unsigned)((__uint_as_float(k[i]) - lo) * scale) : 0u; k[i] = key;
                        LAS unsigned* p = valid ? hist + (key >> 22) : hist + 1024 + lane;
                        __hip_atomic_fetch_add(p, 1u, __ATOMIC_RELAXED, __HIP_MEMORY_SCOPE_WORKGROUP); } } }
            LDS_WAIT();
            unsigned d0, need1;
            { const LAS u32x4* hz = (const LAS u32x4*)(hist + 16 * lane); u32x4 hv[4]; unsigned ls = 0u;
#pragma unroll
              for (int j = 0; j < 4; ++j) { hv[j] = hz[j]; ls += (hv[j][0] + hv[j][1]) + (hv[j][2] + hv[j][3]); }
              unsigned incl = ls;
#pragma unroll
              for (int o = 1; o < 64; o <<= 1) { const unsigned v = bperm_u((lane + o) & 63, incl); if (lane + o < 64) incl += v; }
              const unsigned above = incl - ls; unsigned cnt = above, d = 0u, nn = 0u;
#pragma unroll
              for (int j = 15; j >= 0; --j) { const unsigned h = hv[j >> 2][j & 3]; const bool hit = (cnt < 256u) && (256u <= cnt + h); d = hit ? (unsigned)(16 * lane + j) : d; nn = hit ? 256u - cnt : nn; cnt += h; }
              const bool found = (above < 256u) && (256u <= above + ls);
              const unsigned long long fm = __ballot(found);
              const int src = (fm != 0ull) ? (__ffsll((long long)fm) - 1) : 0;
              d0 = bperm_u(src, d); need1 = bperm_u(src, nn); }
            LAS unsigned* CK = hist + 1100; LAS unsigned short* CS = (LAS unsigned short*)(hist + 1170);
            unsigned base = 0u, cbase = 0u;
            const unsigned tmax = (d0 << 22) | 0x3fffffu, tlo = (d0 != 0u) ? (d0 << 22) : 1u, twid = (d0 != 0u) ? 0x400000u : 0x3fffffu;
#pragma unroll
            for (int gi = 0; gi < 8; ++gi) if (512 * gi < N) {
#pragma unroll
                for (int ii = 0; ii < 8; ++ii) { const int i = 8 * gi + ii; const unsigned key = k[i];
                    const bool gt = key > tmax, eq = (key - tlo) < twid;
                    const unsigned long long mgt = __ballot(gt), meq = __ballot(eq);
                    { LAS unsigned short* wp_ = gt ? IDXL + base + mbcnt64(mgt) : DUMW; *wp_ = (unsigned short)(64 * i + lane); }
                    base += (unsigned)__popcll(mgt);
                    if (meq != 0ull) { const unsigned cp = cbase + mbcnt64(meq); if (eq && cp < 64u) { CK[cp] = key; CS[cp] = (unsigned short)(64 * i + lane); } cbase += (unsigned)__popcll(meq); } } }
            LDS_WAIT();
            if (cbase <= 64u) {
                const unsigned mykey = (lane < (int)cbase) ? CK[lane] : 0u; unsigned rank = 0u;
                for (unsigned j = 0; j < cbase; ++j) { const unsigned kj = CK[j]; rank += ((kj > mykey) || (kj == mykey && j < (unsigned)lane)) ? 1u : 0u; }
                const bool sel = (lane < (int)cbase) && (rank < need1);
                const unsigned long long ms = __ballot(sel);
                if (sel) IDXL[base + mbcnt64(ms)] = CS[lane];
            } else {
                unsigned prefix = d0, need = need1;
                LDS_WAIT();
                sel_level<11, 11>(k, N, hist, lane, prefix, need);
                sel_level<0, 11>(k, N, hist, lane, prefix, need);
                unsigned eb = 0u, eqb = 0u;
#pragma unroll
                for (int gi = 0; gi < 8; ++gi) if (512 * gi < N) {
#pragma unroll
                    for (int ii = 0; ii < 8; ++ii) { const int i = 8 * gi + ii; const unsigned key = k[i]; const bool gt = key > prefix, eq = key == prefix;
                        const unsigned long long meq = __ballot(eq); const bool sel = gt || (eq && (eqb + mbcnt64(meq) < need));
                        const unsigned long long msel = __ballot(sel); const unsigned pos = eb + mbcnt64(msel);
                        if (sel && pos < 256u) IDXL[pos] = (unsigned short)(64 * i + lane);
                        eb += (unsigned)__popcll(msel); eqb += (unsigned)__popcll(meq); } }
            }
            LDS_WAIT();
            *(u32x2*)(outp + 4 * lane) = *(const LAS u32x2*)(IDXL + 4 * lane);
        }
        __syncthreads();
    }
#undef DSA_UNIT
#undef DUMW
#undef DSA_KLOAD
#undef DSA_PRELOAD
#undef DSA_KCOMP
}

__device__ __forceinline__ void dsa_attn_phase(LAS unsigned char* lds, const unsigned char* QLAT8, const unsigned char* CKV8, const unsigned short* IDX, bf16_t* OLAT, int bid, int G, const int wvs) {
    int tid0 = wvs * 64 + hw_lane(); asm volatile("" : "+v"(tid0));
    const int wave = __builtin_amdgcn_readfirstlane(tid0 >> 6);
    constexpr int RS = 272, T1OFF = 16 * RS + 128, TS = 32 * RS + 128;
    LAS unsigned char* tile0 = lds + wave * (2 * TS);
    constexpr float SCL = 1.4426950408889634f / 16.0f;
    unsigned ixw[8]; u32x4 qf[4]; u32x4 ra[2][2][4];
#define ATT_Q(itx, b_, t_, m_, cnt_) const int b_ = (itx) & 7, t_ = ((itx) >> 3) * 8 + wave; const size_t m_ = (size_t)b_ * T + t_; const int cnt_ = (t_ + 1 < 256) ? t_ + 1 : 256;
#define ATT_LOAD_IX(dst, m_) do { const u32x4 xa_ = *(const u32x4*)(IDX + (m_) * 256 + 16 * c16), xb_ = *(const u32x4*)(IDX + (m_) * 256 + 16 * c16 + 8); \
    dst[0] = xa_[0]; dst[1] = xa_[1]; dst[2] = xa_[2]; dst[3] = xa_[3]; dst[4] = xb_[0]; dst[5] = xb_[1]; dst[6] = xb_[2]; dst[7] = xb_[3]; } while (0)
#define ATT_LOAD_QF(dst, m_) do { const unsigned char* qp_ = QLAT8 + (m_) * 2048 + hd * 256 + 16 * g; _Pragma("unroll") for (int kk = 0; kk < 4; ++kk) dst[kk] = *(const u32x4*)(qp_ + 64 * kk); } while (0)
#define ATT_LOAD_ROWS(buf, ix_, n0_, b_, cnt_) do { const int n1_ = (n0_) + 1; \
    const int k0_ = (16 * c16 + (n0_) < (cnt_)) ? (int)(ix_[(n0_) >> 1] & 0xffffu) : 0, k1_ = (16 * c16 + n1_ < (cnt_)) ? (int)(ix_[n1_ >> 1] >> 16) : 0; \
    const unsigned char* cb_ = CKV8 + (size_t)(b_) * T * 256 + 16 * g; \
    _Pragma("unroll") for (int kk = 0; kk < 4; ++kk) { ra[buf][0][kk] = *(const u32x4*)(cb_ + (size_t)k0_ * 256 + 64 * kk); ra[buf][1][kk] = *(const u32x4*)(cb_ + (size_t)k1_ * 256 + 64 * kk); } } while (0)
#define ATT_QK(bf, d0, d1) do { d0 = (f32x4){0.f, 0.f, 0.f, 0.f}; d1 = d0; \
    _Pragma("unroll") for (int kk = 0; kk < 4; ++kk) _Pragma("unroll") for (int hh = 0; hh < 2; ++hh) { \
        const long qv_ = (long)(((unsigned long long)qf[kk][2 * hh + 1] << 32) | qf[kk][2 * hh]); \
        const long a0_ = (long)(((unsigned long long)ra[bf][0][kk][2 * hh + 1] << 32) | ra[bf][0][kk][2 * hh]); \
        const long a1_ = (long)(((unsigned long long)ra[bf][1][kk][2 * hh + 1] << 32) | ra[bf][1][kk][2 * hh]); \
        d0 = __builtin_amdgcn_mfma_f32_16x16x32_fp8_fp8(a0_, qv_, d0, 0, 0, 0); d1 = __builtin_amdgcn_mfma_f32_16x16x32_fp8_fp8(a1_, qv_, d1, 0, 0, 0); } \
    _Pragma("unroll") for (int kk = 0; kk < 4; ++kk) { *(LAS u32x4*)(tile0 + (bf) * TS + c16 * RS + 64 * kk + 16 * g) = ra[bf][0][kk]; *(LAS u32x4*)(tile0 + (bf) * TS + T1OFF + c16 * RS + 64 * kk + 16 * g) = ra[bf][1][kk]; } } while (0)
    { int tid = tid0; asm volatile("" : "+v"(tid)); const int lane = tid & 63, g = lane >> 4, c16 = lane & 15, hd = c16 & 7;
      if (bid < 4096) { ATT_Q(bid, b, t, m, cnt) (void)t; ATT_LOAD_IX(ixw, m); ATT_LOAD_QF(qf, m); ATT_LOAD_ROWS(0, ixw, 0, b, cnt); ATT_LOAD_ROWS(1, ixw, 2, b, cnt); } }
    for (int it = bid; it < 4096; it += G) {
        int tid = tid0; asm volatile("" : "+v"(tid));
        const int lane = tid & 63, g = lane >> 4, c16 = lane & 15, hd = c16 & 7, q4 = c16 >> 2, p4 = c16 & 3;
        ATT_Q(it, b, t, m, cnt) (void)t;
        const int itn = it + G; const bool hasn = itn < 4096;
        ATT_Q(hasn ? itn : it, bn, tn, mn, cntn) (void)tn;
        f32x4 o[16];
#pragma unroll
        for (int db = 0; db < 16; ++db) o[db] = (f32x4){0.f, 0.f, 0.f, 0.f};
        const int trow = ((c16 >> 1) < 4 ? (4 * g + (c16 >> 1)) * RS : T1OFF + (4 * g + (c16 >> 1) - 4) * RS) + 8 * (c16 & 1);
        float mrun = -INFINITY, lrun = 0.f;
        f32x4 s0, s1, sn0, sn1;
        ATT_QK(0, s0, s1); ATT_LOAD_ROWS(0, ixw, 4, b, cnt);
#pragma unroll
        for (int ch = 0; ch < 8; ++ch) {
            const int bf = ch & 1, bn1 = (ch + 1) & 1;
            if (ch < 7) { ATT_QK(bn1, sn0, sn1);
                if (ch < 5) ATT_LOAD_ROWS(bn1, ixw, 2 * (ch + 3), b, cnt);
                else if (hasn) ATT_LOAD_ROWS(bn1, ixw, 2 * (ch - 5), bn, cntn); }
            if (ch == 4 && hasn) ATT_LOAD_IX(ixw, mn);
            if (ch == 6 && hasn) ATT_LOAD_QF(qf, mn);
            float t0[4], t1[4];
#pragma unroll
            for (int i = 0; i < 4; ++i) { t0[i] = s0[i] * SCL; t1[i] = s1[i] * SCL; }
            if (cnt < 256) {
#pragma unroll
                for (int i = 0; i < 4; ++i) { const int jr = 16 * (4 * g + i) + 2 * ch; if (jr >= cnt) t0[i] = -INFINITY; if (jr + 1 >= cnt) t1[i] = -INFINITY; } }
            float cm = fmaxf(fmaxf(t0[0], t1[0]), fmaxf(t0[1], t1[1]));
            cm = fmaxf(cm, fmaxf(fmaxf(t0[2], t1[2]), fmaxf(t0[3], t1[3])));
            cm = fmaxf(cm, bperm_f(lane ^ 16, cm)); cm = fmaxf(cm, bperm_f(lane ^ 32, cm));
            const float mtrue = fmaxf(mrun, cm);
            const bool upd = __builtin_amdgcn_ballot_w64((mtrue - mrun) > 4.0f) != 0ull;
            const float mnew = upd ? mtrue : mrun, alpha = upd ? __builtin_amdgcn_exp2f(mrun - mnew) : 1.0f;
            float p0[4], p1[4], ps = 0.f;
#pragma unroll
            for (int i = 0; i < 4; ++i) { p0[i] = __builtin_amdgcn_exp2f(t0[i] - mnew); p1[i] = __builtin_amdgcn_exp2f(t1[i] - mnew); ps += p0[i] + p1[i]; }
            lrun = lrun * alpha + ps; mrun = mnew;
            asm volatile("" : "+v"(lrun));
            if (upd) {
#pragma unroll
                for (int db = 0; db < 16; ++db) o[db] = o[db] * alpha; }
            int pl = 0, ph = 0;
            pl = __builtin_amdgcn_cvt_pk_fp8_f32(p0[0], p0[1], pl, false); pl = __builtin_amdgcn_cvt_pk_fp8_f32(p0[2], p0[3], pl, true);
            ph = __builtin_amdgcn_cvt_pk_fp8_f32(p1[0], p1[1], ph, false); ph = __builtin_amdgcn_cvt_pk_fp8_f32(p1[2], p1[3], ph, true);
            const long pb = (long)(((unsigned long long)(unsigned)ph << 32) | (unsigned)pl);
#pragma unroll
            for (int db = 0; db < 16; ++db) {
                const i32x2 tv = __builtin_amdgcn_ds_read_tr8_b64_v2i32((LAS i32x2*)(tile0 + bf * TS + trow + 16 * db));
                const long av = (long)(((unsigned long long)(unsigned)tv.y << 32) | (unsigned)tv.x);
                o[db] = __builtin_amdgcn_mfma_f32_16x16x32_fp8_fp8(av, pb, o[db], 0, 0, 0);
            }
            if (ch < 7) { s0 = sn0; s1 = sn1; }
        }
        float lt = lrun + bperm_f(lane ^ 16, lrun); lt += bperm_f(lane ^ 32, lt);
        const float inv = 1.0f / lt;
        if (c16 < 8) { bf16_t* op = OLAT + m * 2048 + c16 * 256 + 4 * g;
#pragma unroll
            for (int db = 0; db < 16; ++db) { const f32x4 y = o[db] * inv; *(u32x2*)(op + 16 * db) = (u32x2){cvt_pk_bf16(y[0], y[1]), cvt_pk_bf16(y[2], y[3])}; } }
    }
#undef ATT_Q
#undef ATT_LOAD_IX
#undef ATT_LOAD_QF
#undef ATT_LOAD_ROWS
#undef ATT_QK
}

__device__ __forceinline__ void smix_phase(LAS unsigned char* lds, bf16_t* UY, const bf16_t* V, const f32x2* STATS, const float* Wc, const float* bsp, const float* lng, const float* lnb, int bid, int G, const int wvs) {
    int tid0 = wvs * 64 + hw_lane(); asm volatile("" : "+v"(tid0));
    const int wave = wvs;
    LAS unsigned char* VT = lds;
    LAS unsigned char* AP = lds + 67584;
    LAS float* MU = (LAS float*)(lds + 102400); LAS float* RSTD = MU + 128; LAS float* R1 = MU + 256; LAS float* R2 = MU + 384;
    u32x4 vr[8]; f32x4 sr[4];
#define SMIX_UNIT(itx, b_, gi_, m0_) const int b_ = (itx) & 7, gi_ = ((itx) >> 3) & 7; const size_t m0_ = (size_t)b_ * T + ((itx) >> 6) * 128;
#define SMIX_PRELOAD(m0_, gi_) do { \
    _Pragma("unroll") for (int i = 0; i < 8; ++i) { const int cidx = tid + 512 * i, s_ = cidx >> 5, ch = cidx & 31; vr[i] = *(const u32x4*)(V + ((m0_) + s_) * ULD + (gi_) * 256 + ch * 8); } \
    { const f32x4* sp = (const f32x4*)(STATS + ((m0_) + (tid >> 2)) * 32 + (tid & 3) * 8); _Pragma("unroll") for (int j = 0; j < 4; ++j) sr[j] = sp[j]; } } while (0)
    if (bid < 2048) { const int tid = tid0; SMIX_UNIT(bid, b0, gi0, m00) (void)b0; SMIX_PRELOAD(m00, gi0); }
    for (int it = bid; it < 2048; it += G) {
        int tid = tid0; asm volatile("" : "+v"(tid));
        const int lane = tid & 63, gq = lane >> 4, c16 = lane & 15, q4 = c16 >> 2, p4 = c16 & 3;
        SMIX_UNIT(it, b, gi, m0) (void)b;
        u32x4 ur[8];
#pragma unroll
        for (int i = 0; i < 8; ++i) { const int cidx = tid + 512 * i, s = cidx >> 5, ch = cidx & 31; ur[i] = *(const u32x4*)(UY + (m0 + s) * ULD + gi * 256 + ch * 8); }
        { float s = ((sr[0][0] + sr[0][2]) + (sr[1][0] + sr[1][2])) + ((sr[2][0] + sr[2][2]) + (sr[3][0] + sr[3][2])), ss = ((sr[0][1] + sr[0][3]) + (sr[1][1] + sr[1][3])) + ((sr[2][1] + sr[2][3]) + (sr[3][1] + sr[3][3]));
          s += bperm_f(lane ^ 1, s); ss += bperm_f(lane ^ 1, ss); s += bperm_f(lane ^ 2, s); ss += bperm_f(lane ^ 2, ss);
          if ((tid & 3) == 0) { const float mu = s * (1.0f / 2048.0f), var = ss * (1.0f / 2048.0f) - mu * mu; MU[tid >> 2] = mu; RSTD[tid >> 2] = rsqrtf(fmaxf(var, 0.f) + EPS); } }
#pragma unroll
        for (int i = 0; i < 8; ++i) { const int cidx = tid + 512 * i, s = cidx >> 5, ch = cidx & 31; *(LAS u32x4*)(VT + s * 528 + ch * 16) = vr[i]; }
        f32x4 wq[8];
        { const float* wp = Wc + ((size_t)gi * 128 + (tid >> 2)) * 128 + 32 * (tid & 3);
#pragma unroll
          for (int j = 0; j < 8; ++j) wq[j] = *(const f32x4*)(wp + 4 * j); }
        __syncthreads();
        { const int t = tid >> 2, qd = tid & 3; float r1 = 0.f, r2 = 0.f;
#pragma unroll
          for (int s8 = 0; s8 < 4; ++s8) { const f32x4 wa = wq[2 * s8], wb = wq[2 * s8 + 1]; float av[8];
#pragma unroll
              for (int e = 0; e < 8; ++e) { const int s = 32 * qd + 8 * s8 + e; const float wv = (s <= t) ? (e < 4 ? wa[e] : wb[e - 4]) : 0.f; const float ab = bf_round(wv * RSTD[s]); av[e] = ab; r1 += ab * MU[s]; r2 += wv; }
              u32x4 o; o.x = cvt_pk_bf16(av[0], av[1]); o.y = cvt_pk_bf16(av[2], av[3]); o.z = cvt_pk_bf16(av[4], av[5]); o.w = cvt_pk_bf16(av[6], av[7]);
              *(LAS u32x4*)(AP + t * 272 + (32 * qd + 8 * s8) * 2) = o; }
          r1 += bperm_f(lane ^ 1, r1); r2 += bperm_f(lane ^ 1, r2); r1 += bperm_f(lane ^ 2, r1); r2 += bperm_f(lane ^ 2, r2);
          if (qd == 0) { R1[t] = r1; R2[t] = r2; } }
        __syncthreads();
        f32x4 acc[8][2];
#pragma unroll
        for (int mt = 0; mt < 8; ++mt) { acc[mt][0] = (f32x4){0.f, 0.f, 0.f, 0.f}; acc[mt][1] = acc[mt][0]; }
#pragma unroll
        for (int ks = 0; ks < 4; ++ks) {
            bf16x8 vf[2];
#pragma unroll
            for (int n2 = 0; n2 < 2; ++n2) { const int nt = 2 * wave + n2;
                const s16x4 t0v = __builtin_amdgcn_ds_read_tr16_b64_v4i16((LAS s16x4*)(VT + (32 * ks + 8 * gq + q4) * 528 + (16 * nt + 4 * p4) * 2));
                const s16x4 t1v = __builtin_amdgcn_ds_read_tr16_b64_v4i16((LAS s16x4*)(VT + (32 * ks + 8 * gq + 4 + q4) * 528 + (16 * nt + 4 * p4) * 2));
                vf[n2] = __builtin_shufflevector(t0v, t1v, 0, 1, 2, 3, 4, 5, 6, 7); }
#pragma unroll
            for (int mt = 0; mt < 8; ++mt) if (mt >= 2 * ks) {
                const bf16x8 afr = *(const LAS bf16x8*)(AP + (16 * mt + c16) * 272 + (32 * ks + 8 * gq) * 2);
                acc[mt][0] = __builtin_amdgcn_mfma_f32_16x16x32_bf16(vf[0], afr, acc[mt][0], 0, 0, 0);
                acc[mt][1] = __builtin_amdgcn_mfma_f32_16x16x32_bf16(vf[1], afr, acc[mt][1], 0, 0, 0); }
        }
        { const int itn = it + G; if (itn < 2048) { SMIX_UNIT(itn, bn, gin, m0n) (void)bn; SMIX_PRELOAD(m0n, gin); } }
        __syncthreads();
#pragma unroll
        for (int i = 0; i < 8; ++i) { const int cidx = tid + 512 * i, s = cidx >> 5, ch = cidx & 31; *(LAS u32x4*)(VT + s * 528 + ch * 16) = ur[i]; }
        __syncthreads();
#pragma unroll
        for (int n2 = 0; n2 < 2; ++n2) { const int e0 = 16 * (2 * wave + n2) + 4 * gq; const f32x4 lg4 = *(const f32x4*)(lng + gi * 256 + e0), lb4 = *(const f32x4*)(lnb + gi * 256 + e0);
#pragma unroll
            for (int mt = 0; mt < 8; ++mt) { const int t = 16 * mt + c16; const float r1 = R1[t], r2 = R2[t], bsv = bsp[gi * 128 + t];
                LAS u32x2* up = (LAS u32x2*)(VT + t * 528 + e0 * 2); const u32x2 uw = *up;
                const f32x4 mixed = lg4 * (acc[mt][n2] - r1) + lb4 * r2 + bsv;
                const float y0 = bf2f(uw.x & 0xffffu) * mixed[0], y1 = bf2f(uw.x >> 16) * mixed[1], y2 = bf2f(uw.y & 0xffffu) * mixed[2], y3 = bf2f(uw.y >> 16) * mixed[3];
                u32x2 yw; yw.x = cvt_pk_bf16(y0, y1); yw.y = cvt_pk_bf16(y2, y3); *up = yw; } }
        __syncthreads();
#pragma unroll
        for (int i = 0; i < 8; ++i) { const int cidx = tid + 512 * i, s = cidx >> 5, ch = cidx & 31;
            *(u32x4*)(UY + (m0 + s) * ULD + gi * 256 + ch * 8) = *(const LAS u32x4*)(VT + s * 528 + ch * 16); }
        __syncthreads();
    }
#undef SMIX_UNIT
#undef SMIX_PRELOAD
}

__global__ void __launch_bounds__(512, 2) mk_fwd(Args a) {
    extern __shared__ __attribute__((aligned(16))) unsigned char lds_raw[];
    LAS unsigned char* lds = (LAS unsigned char*)lds_raw;
    cg::grid_group grid = cg::this_grid();
    int bid = blockIdx.x; const int G = gridDim.x;
    unsigned char* wsk = a.ws;
    volatile LAS unsigned* misc = (volatile LAS unsigned*)(lds + LDS_MISC);
    const int wvs = __builtin_amdgcn_readfirstlane((int)threadIdx.x >> 6);
    if (wvs == 0 && hw_lane() < 2) misc[hw_lane()] = 0u;
    __syncthreads();
    const XcdBarrier xbar = xcd_barrier_post((unsigned*)(wsk + WS_BAR), misc, wvs);
    int ph = 0;
#ifndef PROBE
#define PROBE 0
#endif
#define PHASE_BEGIN if (ph >= a.ph_lo && ph < a.ph_hi) { size_t bb = (size_t)(bid & 7); asm volatile("" : "+s"(bb)); unsigned char* const act = wsk + WS_ACT + bb * SLAB; (void)act;
#define REP(k) for (int rep_ = 0; rep_ < ((PROBE == (k)) ? 2 : 1); ++rep_)
#define PHASE_END(dosync) if ((dosync) && ph + 1 < a.ph_hi) { if (ph == 0) grid.sync(); else if (ph == 1 || !local) xcd_barrier(xbar); else xcd_barrier_local(xbar); } } ++ph;

    bool local = false;
    PHASE_BEGIN REP(4) { p0_phase(a, lds, bid, G, wvs); __syncthreads(); } PHASE_END(true)
    {   if (wvs == 0 && hw_lane() == 0) { unsigned ok = (G == 256) ? 1u : 0u;
            for (unsigned j = 0; j < 16; ++j) { const unsigned c = xb_ld(&xbar.bar[XB_XCNT(j)]); ok &= (c == (j < 8u ? 32u : 0u)) ? 1u : 0u; }
            misc[3] = ok; }
        __syncthreads();
        if (misc[3] != 0u) { local = true; bid = __builtin_amdgcn_readfirstlane((int)(misc[2] * 8u + xbar.x)); }
    }
    PHASE_BEGIN p0c_phase(a, bid, G, wvs); PHASE_END(true)

#define ACT(off, rowbytes) (act + (off) - bb * T * (size_t)(rowbytes))
#define H ((bf16_t*)((unsigned char*)a.out + bb * (16 * MiB) - bb * T * 2048))
#define X ((_Float16*)ACT(S_X16, 2048))
#define Q ((bf16_t*)ACT(S_Q, 2048))
#define CKVR ((float*)ACT(S_CKVR, 1024))
#define QIDX ((bf16_t*)ACT(S_QIDX, 1024))
#define KRAW ((float*)ACT(S_KRAW, 512))
#define CKV ((bf16_t*)ACT(S_CKV, 256))
#define KIDX ((bf16_t*)ACT(S_KIDX, 128))
#define WIDX ((float*)ACT(S_WIDX, 32))
#define IDX ((unsigned short*)ACT(S_IDX, 512))
#define QLAT ((bf16_t*)ACT(S_QLAT, 2048))
#define OLAT ((bf16_t*)a.out)
#define O ((bf16_t*)ACT(S_O, 2048))
#define U ((bf16_t*)ACT(S_U, 2 * ULD))
#define V ((bf16_t*)ACT(S_V, 2 * ULD))
#define STATS ((f32x2*)ACT(S_STATS, 256))
    auto layer_body = [&](const int layer) __attribute__((always_inline)) {
        unsigned char* ws = wsk; asm volatile("" : "+s"(ws));
        float* MOD = (float*)(ws + WS_MOD);
        const int j = layer >> 1;
        const float* modl = MOD + (size_t)layer * 8 * NMOD;
        PHASE_BEGIN REP(3) { if (layer == 0) norm_mod_phase<true>(a.in[0], X, a.in[4] + layer * D, modl + 0 * D, modl + 1 * D, H, bid, G, wvs);
            else norm_mod_phase<false>(nullptr, X, a.in[4] + layer * D, modl + 0 * D, modl + 1 * D, H, bid, G, wvs); } PHASE_END(true)
        if ((layer & 1) == 0) {
            PHASE_BEGIN { pg8::Gemm g{H, (const bf16_t*)(ws + W_AIN) + (size_t)j * 2048 * 1024, M, 2048, 1024, 1024, 0, 0}; pg8::StaticOrder S; S.init(M, 2048, G, bid);
                pg8::EpiInproj E{Q, QIDX, (unsigned char*)CKV, KIDX, WIDX, a.in[7] + j * 256, a.in[8] + j * 64, a.in[9] + j * 64, (LAS float*)(lds + 8 * pg8::HTB)}; REP(5) pg8::gemm_phase(lds, g, S, E, wvs); } PHASE_END(true)
            PHASE_BEGIN {
                pg8::Gemm g{Q, (const bf16_t*)(ws + W_UK) + (size_t)j * 2048 * 256, M, 2048, 256, 1024, 1, 256}; pg8::StaticOrder S; S.init(M, 2048, G, bid);
                pg8::EpiBf16 E{QLAT, 2048, 1.4142135623730951f, 1}; pg8::gemm_phase(lds, g, S, E, wvs); } PHASE_END(true)
            PHASE_BEGIN REP(1) dsa_select_phase(lds, QIDX, KIDX, WIDX, IDX, bid, G, wvs); PHASE_END(true)
            PHASE_BEGIN REP(2) dsa_attn_phase(lds, (const unsigned char*)QLAT, (const unsigned char*)CKV, IDX, OLAT, bid, G, wvs); PHASE_END(true)
            PHASE_BEGIN { pg8::Gemm g{OLAT, (const bf16_t*)(ws + W_UV) + (size_t)j * 1024 * 512, M, 1024, 512, 2048, 0, 512}; pg8::StaticOrder S; S.init(M, 1024, G, bid);
                pg8::EpiBf16 E{O, 1024, 1.0f, 0}; pg8::gemm_phase(lds, g, S, E, wvs); } PHASE_END(true)
            PHASE_BEGIN { pg8::Gemm g{O, (const bf16_t*)(ws + W_O) + (size_t)j * 1024 * 1024, M, 1024, 1024, 1024, 0, 0}; pg8::StaticOrder S; S.init(M, 1024, G, bid);
                pg8::EpiResid E{X, modl + 2 * D}; pg8::gemm_phase(lds, g, S, E, wvs); } PHASE_END(true)
        } else {
            PHASE_BEGIN { pg8::Gemm g{H, (const bf16_t*)(ws + W_BIN) + (size_t)j * 4096 * 1024, M, 4096, 1024, 1024, 0, 0}; pg8::StaticOrder S; S.init(M, 4096, G, bid);
                pg8::EpiGelu E{U, V, STATS}; REP(7) pg8::gemm_phase(lds, g, S, E, wvs); } PHASE_END(true)
            PHASE_BEGIN smix_phase(lds, U, V, STATS, a.in[16] + (size_t)j * 8 * 128 * 128, a.in[17] + (size_t)j * 8 * 128, a.in[14] + (size_t)j * 2048, a.in[15] + (size_t)j * 2048, bid, G, wvs); PHASE_END(true)
            PHASE_BEGIN { pg8::Gemm g{U, (const bf16_t*)(ws + W_BOUT) + (size_t)j * 1024 * 2048, M, 1024, 2048, ULD, 0, 0}; pg8::StaticOrder S; S.init(M, 1024, G, bid);
                pg8::EpiResid E{X, modl + 2 * D}; pg8::gemm_phase(lds, g, S, E, wvs); } PHASE_END(true)
        }
        PHASE_BEGIN REP(3) norm_mod_phase<false>(nullptr, X, a.in[5] + layer * D, modl + 3 * D, modl + 4 * D, H, bid, G, wvs); PHASE_END(true)
        PHASE_BEGIN { pg8::Gemm g{H, (const bf16_t*)(ws + W_GU) + (size_t)layer * 5632 * 1024, M, 5632, 1024, 1024, 0, 0}; pg8::StaticOrder S; S.init(M, 5632, G, bid);
            pg8::EpiSwiglu E{(bf16_t*)ACT(S_HID, 5632)}; REP(6) pg8::gemm_phase(lds, g, S, E, wvs); } PHASE_END(true)
        PHASE_BEGIN { pg8::Gemm g{(const bf16_t*)ACT(S_HID, 5632), (const bf16_t*)(ws + W_DN) + (size_t)layer * 1024 * DFF, M, 1024, DFF, DFF, 0, 0}; pg8::StaticOrder S; S.init(M, 1024, G, bid); S.rev = 1;
            pg8::EpiResid E{X, modl + 5 * D}; pg8::gemm_phase(lds, g, S, E, wvs); } PHASE_END(true)
    };
    layer_body(0); layer_body(1); layer_body(2); layer_body(3);
    PHASE_BEGIN final_norm_phase(X, a.in[22], a.out, bid, G, wvs); PHASE_END(false)
#undef H
#undef X
#undef Q
#undef CKVR
#undef QIDX
#undef KRAW
#undef CKV
#undef KIDX
#undef WIDX
#undef IDX
#undef QLAT
#undef OLAT
#undef O
#undef U
#undef V
#undef STATS
#undef ACT
}

extern "C" void kernel_launch(void* const* d_in, const int* in_sizes, int n_in, void* d_out, int out_size, void* d_ws, size_t ws_size, hipStream_t stream) {
    static int grid_blocks = 0;
    if (grid_blocks == 0) {
        int dev = 0, cus = 0, per_cu = 0;
        if (n_in != 23 || out_size != M * D || ws_size < WS_END) { fprintf(stderr, "kernel_launch: unexpected problem (n_in %d out %d ws %zu, need ws >= %zu)\n", n_in, out_size, ws_size, (size_t)WS_END); grid_blocks = -1; return; }
        (void)hipGetDevice(&dev);
        (void)hipDeviceGetAttribute(&cus, hipDeviceAttributeMultiprocessorCount, dev);
        (void)hipFuncSetAttribute((const void*)mk_fwd, hipFuncAttributeMaxDynamicSharedMemorySize, LDS_BYTES);
        (void)hipOccupancyMaxActiveBlocksPerMultiprocessor(&per_cu, (const void*)mk_fwd, 512, LDS_BYTES);
        fprintf(stderr, "kernel_launch: cus %d per_cu %d ws %zu\n", cus, per_cu, ws_size);
        if (per_cu < 1) { fprintf(stderr, "kernel_launch: kernel does not fit a CU\n"); grid_blocks = -1; return; }
        grid_blocks = cus;
    }
    if (grid_blocks < 0) return;
    if (hipMemsetAsync((char*)d_ws + WS_BAR, 0, 16384, stream) != hipSuccess) { fprintf(stderr, "kernel_launch: memset failed\n"); return; }
    Args a{};
    for (int i = 0; i < 23; ++i) a.in[i] = (const float*)d_in[i];
    a.out = (float*)d_out; a.ws = (unsigned char*)d_ws; a.ph_lo = 0; a.ph_hi = 1000;
    void* args[] = {&a};
    hipError_t e = hipLaunchCooperativeKernel((const void*)mk_fwd, dim3(grid_blocks), dim3(512), args, LDS_BYTES, stream);
    if (e != hipSuccess) fprintf(stderr, "cooperative launch failed: %s (grid %d)\n", hipGetErrorString(e), grid_blocks);
}
```
